# Optimizing an MI355X kernel written in HIP

```python
import math
import jax
import jax.numpy as jnp
from jax import lax
import numpy as np

D_MODEL = 1024
BATCH = 2
SEQ = 8192
DEPTH = 2

GRID_W = 64
CTX_LEN = 256
EPS = 1e-6
M_HEADS = 4
M_DH = D_MODEL // M_HEADS
M_WIDTH = M_HEADS * M_DH
M_CHUNK = 128
A_HEADS = 8
A_DH = D_MODEL // (2 * A_HEADS)
A_WIDTH = A_HEADS * 2 * A_DH
Q_BLOCK = 128
ROPE_BASE = 10000.0
H_WIDTH = D_MODEL
H_EMB = 33
H_FFN = 64
H_DECAY_MIN_PCT = 0.3
H_DECAY_MAX_PCT = 1.5
SHORT_CONV = 3
N_EXPERTS = 32
N_GROUPS = 4
TOPK_GROUPS = 1
TOP_K = 2
D_EXPERT = 512
MOE_BLOCK = 128
IN_SPLITS = (M_WIDTH, M_WIDTH, M_WIDTH, M_WIDTH, 4 * M_HEADS,
             A_WIDTH, A_WIDTH, A_WIDTH,
             H_WIDTH, H_WIDTH, H_WIDTH,
             3 * D_MODEL)
D_IN = sum(IN_SPLITS)

kernel_name = 'hybrid_mlstm_diffattn_hyena_moe_dit'


def _rmsnorm(x, g):
    xf = x.astype(jnp.float32)
    y = xf * lax.rsqrt(jnp.mean(xf * xf, axis=-1, keepdims=True) + EPS)
    return (y * g.astype(jnp.float32)).astype(x.dtype)


def _modulate(xn, shift, scale):
    return xn * (1 + scale) + shift


def _short_conv(u, w, b):
    L = u.shape[1]
    pad = SHORT_CONV // 2
    up = jnp.pad(u, ((0, 0), (pad, pad), (0, 0)))
    y = b
    for j in range(SHORT_CONV):
        y = y + up[:, j:j + L] * w[j]
    return y


def _heads(a, n_heads):
    B, L, W = a.shape
    return a.reshape(B, L, n_heads, W // n_heads).transpose(0, 2, 1, 3)


def _flip(a):
    return jnp.flip(a, axis=2)


def _axial_rope(L, dh):
    rows = L // GRID_W
    row = jnp.broadcast_to(jnp.arange(rows)[:, None], (rows, GRID_W)).reshape(-1).astype(jnp.float32)
    col = jnp.broadcast_to(jnp.arange(GRID_W)[None, :], (rows, GRID_W)).reshape(-1).astype(jnp.float32)
    nf = dh // 4
    inv = ROPE_BASE ** (-jnp.arange(nf, dtype=jnp.float32) / nf)
    ang_r = row[:, None] * inv
    ang_c = col[:, None] * inv
    ang = jnp.concatenate([ang_r, ang_r, ang_c, ang_c], axis=-1)
    return jnp.cos(ang), jnp.sin(ang)


def _rot_half(h):
    h1, h2 = jnp.split(h, 2, axis=-1)
    return jnp.concatenate([-h2, h1], axis=-1)


def _apply_rope(x, cos, sin):
    xr, xc = jnp.split(x, 2, axis=-1)
    rot = jnp.concatenate([_rot_half(xr), _rot_half(xc)], axis=-1)
    return (x.astype(jnp.float32) * cos + rot.astype(jnp.float32) * sin).astype(x.dtype)


def _mlstm_scan(q, k, v, li, lf, state):
    B, H, L, dk = q.shape
    dv = v.shape[-1]
    nc = L // M_CHUNK

    def chunks(a):
        return jnp.moveaxis(a.reshape((B, H, nc, M_CHUNK) + a.shape[3:]), 2, 0)

    mask = jnp.tril(jnp.ones((M_CHUNK, M_CHUNK), dtype=bool))

    def step(carry, inp):
        C, n, m = carry
        qc, kc, vc, lic, lfc = inp
        b = jnp.cumsum(lfc, axis=-1)
        Dm = jnp.where(mask, b[..., :, None] - b[..., None, :] + lic[..., None, :], -jnp.inf)
        inter = b + m[..., None]
        mt = jnp.maximum(inter, jnp.max(Dm, axis=-1))
        S = jnp.einsum('bhtd,bhsd->bhts', qc, kc) * jnp.exp(Dm - mt[..., None])
        wi = jnp.exp(inter - mt)
        num = jnp.einsum('bhts,bhsv->bhtv', S, vc) + wi[..., None] * jnp.einsum('bhtk,bhkv->bhtv', qc, C)
        den = jnp.sum(S, axis=-1) + wi * jnp.einsum('bhtk,bhk->bht', qc, n)
        h = num / jnp.maximum(jnp.abs(den), jnp.exp(-mt))[..., None]
        bQ = b[..., -1]
        ws = bQ[..., None] - b + lic
        m_new = jnp.maximum(bQ + m, jnp.max(ws, axis=-1))
        decay = jnp.exp(bQ + m - m_new)
        kw = kc * jnp.exp(ws - m_new[..., None])[..., None]
        C_new = decay[..., None, None] * C + jnp.einsum('bhsk,bhsv->bhkv', kw, vc)
        n_new = decay[..., None] * n + jnp.sum(kw, axis=2)
        return (C_new, n_new, m_new), h

    state, hs = lax.scan(step, state, (chunks(q), chunks(k), chunks(v), chunks(li), chunks(lf)))
    h = jnp.moveaxis(hs, 0, 2).reshape(B, H, L, dv)
    return h, state


def _mlstm_inputs(mq, mk, mv, mg, conv_w, conv_b, gate_b):
    qk = jax.nn.silu(_short_conv(jnp.concatenate([mq, mk], axis=-1), conv_w, conv_b))
    q, k = jnp.split(qk, 2, axis=-1)
    q = _heads(q, M_HEADS).astype(jnp.float32)
    k = _heads(k, M_HEADS).astype(jnp.float32) * (M_DH ** -0.5)
    v = _heads(mv, M_HEADS).astype(jnp.float32)
    B, L, _ = mg.shape
    g = (mg.astype(jnp.float32) + gate_b.astype(jnp.float32)).reshape(B, L, 4, M_HEADS).transpose(2, 0, 3, 1)
    return q, k, v, g[0], jax.nn.log_sigmoid(g[1]), g[2], jax.nn.log_sigmoid(g[3])


def _mlstm_out(h, o, g):
    B, H, L, dv = h.shape
    y = _rmsnorm(h.transpose(0, 2, 1, 3), g).reshape(B, L, H * dv)
    return (y * jax.nn.sigmoid(o.astype(jnp.float32))).astype(o.dtype)


def _mlstm_branch(parts_l, parts_c, conv_w, conv_b, gate_b, norm_g, need_ctx):
    mq_l, mk_l, mv_l, mo_l, mg_l = parts_l
    mq_c, mk_c, mv_c, mo_c, mg_c = parts_c
    ql, kl, vl, ilf, flf, ilb, flb = _mlstm_inputs(mq_l, mk_l, mv_l, mg_l, conv_w, conv_b, gate_b)
    qc, kc, vc, icf, fcf, icb, fcb = _mlstm_inputs(mq_c, mk_c, mv_c, mg_c, conv_w, conv_b, gate_b)
    B = ql.shape[0]
    zero = (jnp.zeros((B, M_HEADS, M_DH, M_DH), jnp.float32),
            jnp.zeros((B, M_HEADS, M_DH), jnp.float32),
            jnp.zeros((B, M_HEADS), jnp.float32))
    hcf, s_f = _mlstm_scan(qc, kc, vc, icf, fcf, zero)
    hcb, s_b = _mlstm_scan(_flip(qc), _flip(kc), _flip(vc), _flip(icb), _flip(fcb), zero)
    hlf, _ = _mlstm_scan(ql, kl, vl, ilf, flf, s_f)
    hlb, _ = _mlstm_scan(_flip(ql), _flip(kl), _flip(vl), _flip(ilb), _flip(flb), s_b)
    yl = _mlstm_out(hlf + _flip(hlb), mo_l, norm_g)
    yc = _mlstm_out(hcf + _flip(hcb), mo_c, norm_g) if need_ctx else None
    return yl, yc


def _diff_inputs(aq, ak, av, qg, kg):
    B, L, _ = aq.shape
    q = _rmsnorm(aq.reshape(B, L, A_HEADS, 2, A_DH), qg).transpose(0, 2, 3, 1, 4)
    k = _rmsnorm(ak.reshape(B, L, A_HEADS, 2, A_DH), kg).transpose(0, 2, 3, 1, 4)
    v = _heads(av, A_HEADS)
    return q, k, v


def _diff_attend(q, k, v, lam):
    s = jnp.einsum('bhcqd,bhckd->bhcqk', q, k).astype(jnp.float32) * (A_DH ** -0.5)
    p = jax.nn.softmax(s, axis=-1)
    w = p[:, :, 0] - lam * p[:, :, 1]
    return jnp.einsum('bhqk,bhkd->bhqd', w.astype(v.dtype), v)


def _diff_out(o, g, lam_init):
    B, H, L, dv = o.shape
    return (_rmsnorm(o.transpose(0, 2, 1, 3), g) * (1.0 - lam_init)).reshape(B, L, H * dv)


def _diff_branch(parts_l, parts_c, qg, kg, lam_p, sub_g, lam_init, cos, sin, need_ctx):
    ql, kl, vl = _diff_inputs(parts_l[0], parts_l[1], parts_l[2], qg, kg)
    qc, kc, vc = _diff_inputs(parts_c[0], parts_c[1], parts_c[2], qg, kg)
    ql = _apply_rope(ql, cos, sin)
    kl = _apply_rope(kl, cos, sin)
    lp = lam_p.astype(jnp.float32)
    lam = jnp.exp(jnp.sum(lp[0] * lp[1])) - jnp.exp(jnp.sum(lp[2] * lp[3])) + lam_init
    k_all = jnp.concatenate([kc, kl], axis=3)
    v_all = jnp.concatenate([vc, vl], axis=2)
    B, H, _, L, dh = ql.shape
    nb = L // Q_BLOCK
    qb = jnp.moveaxis(ql.reshape(B, H, 2, nb, Q_BLOCK, dh), 3, 0)
    ob = lax.map(lambda qq: _diff_attend(qq, k_all, v_all, lam), qb)
    ol = jnp.moveaxis(ob, 0, 2).reshape(B, H, L, 2 * dh)
    yl = _diff_out(ol, sub_g, lam_init)
    yc = _diff_out(_diff_attend(qc, kc, vc, lam), sub_g, lam_init) if need_ctx else None
    return yl, yc


def _hyena_filters(L, w1, b1, w2, b2, w3, freq, delta):
    t = jnp.linspace(0.0, 1.0, L, dtype=jnp.float32)[:, None]
    bands = (H_EMB - 1) // 2
    w = 2.0 * math.pi * jnp.arange(L, dtype=jnp.float32)[:, None] / L
    f = jnp.linspace(1e-4, bands - 1, bands, dtype=jnp.float32)[None, :]
    z = jnp.concatenate([t, jnp.cos(f * w), -jnp.sin(f * w)], axis=-1)
    hdn = jnp.sin(freq * (z @ w1 + b1))
    hdn = jnp.sin(freq * (hdn @ w2 + b2))
    h = ((hdn @ w3) * jnp.exp(-t * jnp.abs(delta))).astype(jnp.float32)
    h = h.reshape(L, 2, H_WIDTH)
    h = h * lax.rsqrt(jnp.sum(h * h, axis=(0, 1), keepdims=True) + EPS)
    return h[:, 0], h[:, 1]


def _bidir_longconv(u, hf, hb):
    L = u.shape[1]
    n = 2 * L
    taps = jnp.concatenate([hf, jnp.zeros_like(hf[:1]), jnp.flip(hb[1:], axis=0)], axis=0)
    U = jnp.fft.rfft(u.astype(jnp.float32), n=n, axis=1)
    Hf = jnp.fft.rfft(taps, n=n, axis=0)
    return jnp.fft.irfft(U * Hf[None], n=n, axis=1)[:, :L]


def _hyena_seq(hx0, hx1, hv, conv_w, conv_b, filt, bias):
    u = _short_conv(jnp.concatenate([hx0, hx1, hv], axis=-1), conv_w, conv_b)
    x0, x1, v = jnp.split(u.astype(jnp.float32), 3, axis=-1)
    hf, hb = _hyena_filters(u.shape[1], *filt)
    z = v * x1
    z = _bidir_longconv(z, hf, hb) + bias.astype(jnp.float32) * z
    return (x0 * z).astype(hx0.dtype)


def _merge(ym, ya, yh, gpre, mb, wm, wa, wh, wo):
    g = jax.nn.sigmoid((gpre + mb).astype(jnp.float32)).astype(ym.dtype)
    g_m, g_a, g_h = jnp.split(g, 3, axis=-1)
    y = g_m * (ym @ wm) + g_a * (ya @ wa) + g_h * (yh @ wh)
    return y @ wo


def _moe(h, router_w, router_b, w1, w3, w2):
    N, D = h.shape
    E, G, K = N_EXPERTS, N_GROUPS, TOP_K
    s = jax.nn.sigmoid((h @ router_w).astype(jnp.float32))
    sb = s + router_b.astype(jnp.float32)
    gscore = jnp.sum(lax.top_k(sb.reshape(N, G, E // G), 2)[0], axis=-1)
    _, gidx = lax.top_k(gscore, TOPK_GROUPS)
    gmask = jnp.any(gidx[:, :, None] == jnp.arange(G)[None, None, :], axis=1)
    emask = jnp.repeat(gmask, E // G, axis=1)
    _, eidx = lax.top_k(jnp.where(emask, sb, -jnp.inf), K)
    wsel = jnp.take_along_axis(s, eidx, axis=1)
    wsel = wsel / jnp.sum(wsel, axis=-1, keepdims=True)
    A = N * K
    flat_e = eidx.reshape(A)
    flat_t = jnp.repeat(jnp.arange(N, dtype=jnp.int32), K)
    flat_w = wsel.reshape(A)
    order = jnp.argsort(flat_e)
    se = flat_e[order]
    counts = jnp.bincount(flat_e, length=E)
    start = jnp.cumsum(counts) - counts
    padded = (counts + MOE_BLOCK - 1) // MOE_BLOCK * MOE_BLOCK
    pend = jnp.cumsum(padded)
    pstart = pend - padded
    dest = pstart[se] + jnp.arange(A) - start[se]
    P = -(-(A + E * (MOE_BLOCK - 1)) // MOE_BLOCK) * MOE_BLOCK
    tok_buf = jnp.zeros((P,), jnp.int32).at[dest].set(flat_t[order])
    w_buf = jnp.zeros((P,), jnp.float32).at[dest].set(flat_w[order])
    nblk = P // MOE_BLOCK
    blk_e = jnp.minimum(jnp.sum(pend[None, :] <= (jnp.arange(nblk) * MOE_BLOCK)[:, None], axis=1), E - 1)
    xb = h[tok_buf].reshape(nblk, MOE_BLOCK, D)

    def expert_block(args):
        xe, e = args
        return (jax.nn.silu(xe @ w1[e]) * (xe @ w3[e])) @ w2[e]

    yb = lax.map(expert_block, (xb, blk_e)).reshape(P, D)
    return jax.ops.segment_sum(yb * w_buf[:, None].astype(yb.dtype), tok_buf, num_segments=N)


def setup_inputs(seed: int = 0) -> dict:
    key = jax.random.key(seed)
    ks = iter(jax.random.split(key, 48))

    def nrm(shape, scale):
        return jax.random.normal(next(ks), shape, jnp.float32) * scale

    D = D_MODEL
    fb = jnp.linspace(3.0, 6.0, M_HEADS, dtype=jnp.float32)
    m_gate_b = jnp.concatenate([nrm((DEPTH, M_HEADS), 0.1), fb + nrm((DEPTH, M_HEADS), 0.1),
                                nrm((DEPTH, M_HEADS), 0.1), fb + nrm((DEPTH, M_HEADS), 0.1)], axis=-1)
    decay0 = jnp.linspace(math.log(1e-2) / H_DECAY_MIN_PCT, math.log(1e-2) / H_DECAY_MAX_PCT,
                          2 * H_WIDTH, dtype=jnp.float32)
    return {
        'x': nrm((BATCH, SEQ, D), 1.0),
        'c': nrm((BATCH, D), 1.0),
        'ctx': nrm((BATCH, CTX_LEN, D), 1.0),
        'c_ctx': nrm((D,), 1.0),
        'mod_w': nrm((DEPTH, D, 6 * D), 0.5 * D ** -0.5),
        'mod_b': nrm((DEPTH, 6 * D), 0.02),
        'norm1_g': 1.0 + nrm((DEPTH, D), 0.02),
        'norm2_g': 1.0 + nrm((DEPTH, D), 0.02),
        'w_in': nrm((DEPTH, D, D_IN), D ** -0.5),
        'merge_b': nrm((DEPTH, 3 * D), 0.02),
        'm_conv_w': nrm((DEPTH, SHORT_CONV, 2 * M_WIDTH), 0.5),
        'm_conv_b': nrm((DEPTH, 2 * M_WIDTH), 0.02),
        'm_gate_b': m_gate_b,
        'm_norm_g': 1.0 + nrm((DEPTH, M_DH), 0.02),
        'a_qnorm_g': 1.0 + nrm((DEPTH, A_DH), 0.02),
        'a_knorm_g': 1.0 + nrm((DEPTH, A_DH), 0.02),
        'a_lambda': nrm((DEPTH, 4, A_DH), 0.1),
        'a_subln_g': 1.0 + nrm((DEPTH, 2 * A_DH), 0.02),
        'h_conv_w': nrm((DEPTH, SHORT_CONV, 3 * H_WIDTH), 0.5),
        'h_conv_b': nrm((DEPTH, 3 * H_WIDTH), 0.02),
        'h_ffn_w1': nrm((DEPTH, H_EMB, H_FFN), H_EMB ** -0.5),
        'h_ffn_b1': nrm((DEPTH, H_FFN), 0.1),
        'h_ffn_w2': nrm((DEPTH, H_FFN, H_FFN), H_FFN ** -0.5),
        'h_ffn_b2': nrm((DEPTH, H_FFN), 0.1),
        'h_ffn_w3': nrm((DEPTH, H_FFN, 2 * H_WIDTH), H_FFN ** -0.5),
        'h_freq': 1.0 + nrm((DEPTH, H_FFN), 0.02),
        'h_decay': decay0 + nrm((DEPTH, 2 * H_WIDTH), 0.05),
        'h_bias': nrm((DEPTH, H_WIDTH), 1.0),
        'w_br_m': nrm((DEPTH, M_WIDTH, D), M_WIDTH ** -0.5),
        'w_br_a': nrm((DEPTH, A_WIDTH, D), A_WIDTH ** -0.5),
        'w_br_h': nrm((DEPTH, H_WIDTH, D), H_WIDTH ** -0.5),
        'w_out': nrm((DEPTH, D, D), D ** -0.5),
        'router_w': nrm((D, N_EXPERTS), D ** -0.5),
        'router_b': nrm((N_EXPERTS,), 0.01),
        'e_w1': nrm((DEPTH, N_EXPERTS, D, D_EXPERT), D ** -0.5),
        'e_w3': nrm((DEPTH, N_EXPERTS, D, D_EXPERT), D ** -0.5),
        'e_w2': nrm((DEPTH, N_EXPERTS, D_EXPERT, D), D_EXPERT ** -0.5),
    }


def reference(x, c, ctx, c_ctx, mod_w, mod_b, norm1_g, norm2_g, w_in, merge_b,
              m_conv_w, m_conv_b, m_gate_b, m_norm_g,
              a_qnorm_g, a_knorm_g, a_lambda, a_subln_g,
              h_conv_w, h_conv_b, h_ffn_w1, h_ffn_b1, h_ffn_w2, h_ffn_b2, h_ffn_w3,
              h_freq, h_decay, h_bias,
              w_br_m, w_br_a, w_br_h, w_out,
              router_w, router_b, e_w1, e_w3, e_w2):
    B, L, D = x.shape
    Lc = ctx.shape[1]
    rope_cos, rope_sin = _axial_rope(L, A_DH)
    offs = [int(o) for o in np.cumsum(IN_SPLITS)[:-1]]
    xl, xc = x, ctx
    for l in range(DEPTH):
        need_ctx = l < DEPTH - 1
        lam_init = 0.8 - 0.6 * math.exp(-0.3 * l)
        mod_l = jax.nn.silu(c) @ mod_w[l] + mod_b[l]
        mod_c = jax.nn.silu(c_ctx) @ mod_w[l] + mod_b[l]
        sh1, sc1, g1, sh2, sc2, g2 = jnp.split(mod_l[:, None, :], 6, axis=-1)
        sh1c, sc1c, g1c, sh2c, sc2c, g2c = jnp.split(mod_c, 6, axis=-1)
        hl = _modulate(_rmsnorm(xl, norm1_g[l]), sh1, sc1)
        hc = _modulate(_rmsnorm(xc, norm1_g[l]), sh1c, sc1c)
        pl = jnp.split(hl @ w_in[l], offs, axis=-1)
        pc = jnp.split(hc @ w_in[l], offs, axis=-1)
        ym_l, ym_c = _mlstm_branch(pl[0:5], pc[0:5], m_conv_w[l], m_conv_b[l], m_gate_b[l],
                                   m_norm_g[l], need_ctx)
        ya_l, ya_c = _diff_branch(pl[5:8], pc[5:8], a_qnorm_g[l], a_knorm_g[l], a_lambda[l],
                                  a_subln_g[l], lam_init, rope_cos, rope_sin, need_ctx)
        filt = (h_ffn_w1[l], h_ffn_b1[l], h_ffn_w2[l], h_ffn_b2[l], h_ffn_w3[l], h_freq[l], h_decay[l])
        yh_l = _hyena_seq(pl[8], pl[9], pl[10], h_conv_w[l], h_conv_b[l], filt, h_bias[l])
        mix_l = _merge(ym_l, ya_l, yh_l, pl[11], merge_b[l], w_br_m[l], w_br_a[l], w_br_h[l], w_out[l])
        if need_ctx:
            yh_c = _hyena_seq(pc[8], pc[9], pc[10], h_conv_w[l], h_conv_b[l], filt, h_bias[l])
            mix_c = _merge(ym_c, ya_c, yh_c, pc[11], merge_b[l], w_br_m[l], w_br_a[l], w_br_h[l], w_out[l])
            xc = xc + g1c * mix_c
        xl = xl + g1 * mix_l
        tok = _modulate(_rmsnorm(xl, norm2_g[l]), sh2, sc2).reshape(B * L, D)
        if need_ctx:
            tok_c = _modulate(_rmsnorm(xc, norm2_g[l]), sh2c, sc2c).reshape(B * Lc, D)
            tok = jnp.concatenate([tok, tok_c], axis=0)
        f = _moe(tok, router_w, router_b, e_w1[l], e_w3[l], e_w2[l])
        xl = xl + g2 * f[:B * L].reshape(B, L, D)
        if need_ctx:
            xc = xc + g2c * f[B * L:].reshape(B, Lc, D)
    return xl
```

```cpp
#include <hip/hip_runtime.h>
#include <cstdio>
#include <cstdint>
#include <cstring>
#define XB_TMO      128
#define XB_XCNT(j)  (256  + 64 * (j))
#define XB_XSUB(j)  (1280 + 64 * (j))
#define XB_XGEN(j)  (2304 + 64 * (j))
#define XB_TOP      3328
#define XB_TOPGEN   3392
#define XCD_BAR_WORDS 3456
#define XB_SPIN_CAP (1u << 24)
#define LAS __attribute__((address_space(3)))

__device__ __forceinline__ unsigned xb_ld(unsigned* p)              { return __hip_atomic_load(p, __ATOMIC_RELAXED, __HIP_MEMORY_SCOPE_AGENT); }
__device__ __forceinline__ unsigned xb_add(unsigned* p, unsigned v) { return __hip_atomic_fetch_add(p, v, __ATOMIC_RELAXED, __HIP_MEMORY_SCOPE_AGENT); }
__device__ __forceinline__ unsigned xb_xcc_id() { return (unsigned)__builtin_amdgcn_s_getreg((3 << 11) | 20) & 0xFu; }
#define XB_SPIN(cond, bar) do { unsigned _sp = 0; while (cond) { __builtin_amdgcn_s_sleep(1); \
    if ((++_sp & 255u) == 0u) { if (xb_ld(&(bar)[XB_TMO])) break; if (_sp > XB_SPIN_CAP) { atomicAdd(&(bar)[XB_TMO], 1u); break; } } } } while (0)

struct XcdBarrier {
    unsigned* bar; unsigned x;
    volatile LAS unsigned* st;
};

__device__ __forceinline__ XcdBarrier xcd_barrier_post(unsigned* bar, volatile LAS unsigned* st) {
    XcdBarrier b; b.bar = bar; b.x = xb_xcc_id(); b.st = st;
    if (threadIdx.x == 0) (void)xb_add(&bar[XB_XCNT(b.x)], 1u);
    return b;
}
__device__ __forceinline__ void xcd_barrier_complete(unsigned* bar, unsigned x, unsigned& nloc, unsigned& nx) {
    const unsigned G = gridDim.x * gridDim.y * gridDim.z;
    unsigned sum, cnt, mine, sp = 0u;
    for (;;) {
        sum = 0u; cnt = 0u; mine = 0u;
#pragma unroll
        for (unsigned j = 0; j < 16; ++j) { const unsigned c = xb_ld(&bar[XB_XCNT(j)]); sum += c; cnt += (c > 0u) ? 1u : 0u; mine = (j == x) ? c : mine; }
        if (sum == G) break;
        __builtin_amdgcn_s_sleep(1);
        if ((++sp & 255u) == 0u) { if (xb_ld(&bar[XB_TMO])) break; if (sp > XB_SPIN_CAP) { atomicAdd(&bar[XB_TMO], 1u); break; } }
    }
    nloc = mine > 0u ? mine : 1u; nx = cnt > 0u ? cnt : 1u;
}

__device__ __forceinline__ void xcd_barrier(const XcdBarrier& b) {
    asm volatile("s_waitcnt vmcnt(0)" ::: "memory");
    __syncthreads();
    if (threadIdx.x == 0) {
        unsigned* bar = b.bar;
        __builtin_amdgcn_s_waitcnt(0);
        unsigned nloc = b.st[0], nx = b.st[1];
        if (nloc == 0u) { xcd_barrier_complete(bar, b.x, nloc, nx); b.st[0] = nloc; b.st[1] = nx; }
        const unsigned old = xb_add(&bar[XB_XSUB(b.x)], 1u);
        const unsigned gen = old / nloc;
        if (old + 1u == (gen + 1u) * nloc) {
            __builtin_amdgcn_fence(__ATOMIC_RELEASE, "agent");
            asm volatile("s_waitcnt vmcnt(0)" ::: "memory");
            const unsigned og = xb_add(&bar[XB_TOP], 1u);
            const unsigned tg = og / nx;
            if (og + 1u == (tg + 1u) * nx) xb_add(&bar[XB_TOPGEN], 1u);
            else XB_SPIN(xb_ld(&bar[XB_TOPGEN]) == tg, bar);
            __builtin_amdgcn_fence(__ATOMIC_ACQUIRE, "agent");
            xb_add(&bar[XB_XGEN(b.x)], 1u);
            asm volatile("s_waitcnt vmcnt(0)" ::: "memory");
        } else {
            XB_SPIN(xb_ld(&bar[XB_XGEN(b.x)]) == gen, bar);
            __builtin_amdgcn_fence(__ATOMIC_ACQUIRE, "agent");
            asm volatile("s_waitcnt vmcnt(0)" ::: "memory");
        }
    }
    __syncthreads();
}
namespace pg8 {
#define PG8_LAS __attribute__((address_space(3)))
typedef unsigned short bf16_t;
typedef short bf16x8 __attribute__((ext_vector_type(8)));
typedef float f32x4 __attribute__((ext_vector_type(4)));
typedef unsigned u32x4 __attribute__((ext_vector_type(4)));
constexpr int BM = 256, BK = 64, HALF = 128, HTB = HALF * BK * 2  , STAGE_BYTES = 8 * HTB, NXCD = 8, WGM = 8;

__host__ __device__ __forceinline__ int lds_byte(int r, int c) { const int st = (r >> 4) * 2 + (c >> 5), rr = r & 15, cc = c & 31, ob = rr * 64 + cc * 2; return st * 1024 + (ob ^ (((ob >> 9) & 1) << 5)); }
__host__ __device__ __forceinline__ void stage_rc(int b, int& R, int& C) { const int st = b / 1024, sb = b % 1024, swz = sb ^ (((sb >> 9) & 1) << 5); R = (st >> 1) * 16 + swz / 64; C = (st & 1) * 32 + (swz % 64) / 2; }
__host__ __device__ __forceinline__ int perm32(int rho) { const int n = rho >> 4, i = rho & 15; return 8 * (i >> 2) + 4 * n + (i & 3); }

struct Unit { int pm, pn; };
struct Gemm { const bf16_t* A; const bf16_t* Bt; int M, N, K; };

struct StaticOrder {
    int nM, nN, nwg, G, c;
    __host__ __device__ void init(int M, int N, int G_, int c_) { nM = M / BM; nN = N / BM; nwg = nM * nN; G = G_; c = c_; }
    __host__ __device__ bool next(int i, Unit& u) const {
        const long L = (long)i * G + c; if (L >= nwg) return false;
        int wgid = (int)L; { const int q = nwg / NXCD, r = nwg % NXCD, xcd = wgid % NXCD, off = wgid / NXCD; wgid = (xcd < r ? xcd * (q + 1) : r * (q + 1) + (xcd - r) * q) + off; }
        const int nig = WGM * nN, gid = wgid / nig, fm = gid * WGM, gsz = (nM - fm) < WGM ? (nM - fm) : WGM;
        u.pm = fm + ((wgid % nig) % gsz); u.pn = (wgid % nig) / gsz; return true;
    }
    __device__ __forceinline__ void a_ready(const Unit&) const {}
    __device__ __forceinline__ void done(const Unit&) const {}
};
struct CountedOrder : StaticOrder {
    const unsigned* ready; unsigned need; unsigned* tmo;
    __device__ __forceinline__ void a_ready(const Unit& u) const {
        if (threadIdx.x < 64) {
            const unsigned long long t0 = __builtin_amdgcn_s_memrealtime(); unsigned polls = 0;
            while ((unsigned)__builtin_amdgcn_readfirstlane(__hip_atomic_load(ready + 64 * u.pm, __ATOMIC_RELAXED, __HIP_MEMORY_SCOPE_AGENT)) < need) {
                if ((++polls & 255u) == 0u && __builtin_amdgcn_readfirstlane(__hip_atomic_load(tmo, __ATOMIC_RELAXED, __HIP_MEMORY_SCOPE_AGENT)) != 0u) break;
                if (__builtin_amdgcn_s_memrealtime() - t0 > 2000000ull) {
                    if (threadIdx.x == 0) { unsigned expect = 0u; __hip_atomic_compare_exchange_strong(tmo + 1, &expect, 0x600u | (unsigned)(u.pm & 0xff), __ATOMIC_RELAXED, __ATOMIC_RELAXED, __HIP_MEMORY_SCOPE_AGENT); __hip_atomic_store(tmo, 1u, __ATOMIC_RELAXED, __HIP_MEMORY_SCOPE_AGENT); }
                    break; }
                __builtin_amdgcn_s_sleep(2); }
            __builtin_amdgcn_fence(__ATOMIC_ACQUIRE, "agent");
            asm volatile("s_waitcnt vmcnt(0)" ::: "memory");
        }
#if !defined(BROKEN_HOOK_NO_BARRIER)
        asm volatile("" ::: "memory"); __builtin_amdgcn_s_barrier(); asm volatile("" ::: "memory");
#endif
    }
};

__device__ __forceinline__ unsigned cvt_pk_bf16(float lo, float hi) { unsigned r; asm volatile("v_cvt_pk_bf16_f32 %0, %1, %2" : "=v"(r) : "v"(lo), "v"(hi)); return r; }
typedef float f32x2 __attribute__((ext_vector_type(2)));
__device__ __forceinline__ f32x2 gelu_pk(f32x2 v) {
    const f32x2 av = __builtin_elementwise_abs(v), d = av * 0.2316418882f + 1.0f;
    f32x2 t; t.x = __builtin_amdgcn_rcpf(d.x); t.y = __builtin_amdgcn_rcpf(d.y);
    f32x2 q = t * 0.5307027145f + (-0.7265760135f); q = q * t + 0.7107068705f; q = q * t + (-0.142248368f); q = q * t + 0.127414796f; q = q * t;
    const f32x2 s = (v * v) * (-0.72134752044f);
    f32x2 e; e.x = __builtin_amdgcn_exp2f(s.x); e.y = __builtin_amdgcn_exp2f(s.y);
    const f32x2 m = v * (q * e), r = v - m;
    f32x2 o; o.x = v.x < 0.f ? m.x : r.x; o.y = v.y < 0.f ? m.y : r.y; return o;
}

struct EpiF32 {
    static constexpr bool PERM = false, AFTER_DRAIN = false;
    float* C; int ldc; const float* bias;
    __device__ __forceinline__ void operator()(const f32x4 (&acc)[2][2][4][2], const Unit& u, int wr, int wc, int fr, int fq) const {
        const int row0 = u.pm * BM + wr * 64 + fr, col0 = u.pn * BM + wc * 32 + 4 * fq;
        f32x4 bv[2][2];
#pragma unroll
        for (int bj = 0; bj < 2; ++bj)
#pragma unroll
            for (int n = 0; n < 2; ++n) bv[bj][n] = bias ? *(const f32x4*)(bias + col0 + bj * HALF + n * 16) : (f32x4){0.f, 0.f, 0.f, 0.f};
#pragma unroll
        for (int ai = 0; ai < 2; ++ai)
#pragma unroll
            for (int m = 0; m < 4; ++m) { float* rowp = C + (size_t)(row0 + ai * HALF + m * 16) * ldc + col0;
#pragma unroll
                for (int bj = 0; bj < 2; ++bj)
#pragma unroll
                    for (int n = 0; n < 2; ++n) *(f32x4*)(rowp + bj * HALF + n * 16) = acc[ai][bj][m][n] + bv[bj][n]; }
    }
};
template <int ACT  > struct EpiBf16 {
    static constexpr bool PERM = true, AFTER_DRAIN = false;
    bf16_t* O; int ldc; const float* bias; int split_cols; size_t split_stride;
    __device__ __forceinline__ void operator()(const f32x4 (&acc)[2][2][4][2], const Unit& u, int wr, int wc, int fr, int fq) const {
        const int row0 = u.pm * BM + wr * 64 + fr; int colt = u.pn * BM; bf16_t* base = O;
        if (split_cols) { const int t = colt / split_cols; base += (size_t)t * split_stride; colt -= t * split_cols; }
        const int col0 = colt + wc * 32 + 8 * fq, bcol0 = u.pn * BM + wc * 32 + 8 * fq;
        f32x4 bv[2][2];
#pragma unroll
        for (int bj = 0; bj < 2; ++bj)
#pragma unroll
            for (int n = 0; n < 2; ++n) bv[bj][n] = bias ? *(const f32x4*)(bias + bcol0 + bj * HALF + 4 * n) : (f32x4){0.f, 0.f, 0.f, 0.f};
#pragma unroll
        for (int ai = 0; ai < 2; ++ai)
#pragma unroll
            for (int m = 0; m < 4; ++m) { bf16_t* rowp = base + (size_t)(row0 + ai * HALF + m * 16) * ldc + col0;
#pragma unroll
                for (int bj = 0; bj < 2; ++bj) { f32x4 v0 = acc[ai][bj][m][0] + bv[bj][0], v1 = acc[ai][bj][m][1] + bv[bj][1];
                    if (ACT == 1) { f32x2 a = gelu_pk((f32x2){v0[0], v0[1]}), b = gelu_pk((f32x2){v0[2], v0[3]}), c = gelu_pk((f32x2){v1[0], v1[1]}), d = gelu_pk((f32x2){v1[2], v1[3]});
                        v0 = (f32x4){a.x, a.y, b.x, b.y}; v1 = (f32x4){c.x, c.y, d.x, d.y}; }
                    if (ACT == 2) {
#pragma unroll
                        for (int j = 0; j < 4; ++j) { v0[j] = 0.5f * v0[j] * (1.0f + erff(v0[j] * 0.70710678f)); v1[j] = 0.5f * v1[j] * (1.0f + erff(v1[j] * 0.70710678f)); } }
                    u32x4 w; w.x = cvt_pk_bf16(v0[0], v0[1]); w.y = cvt_pk_bf16(v0[2], v0[3]); w.z = cvt_pk_bf16(v1[0], v1[1]); w.w = cvt_pk_bf16(v1[2], v1[3]);
                    *(u32x4*)(rowp + bj * HALF) = w; } }
    }
};

struct PanelStats {
    unsigned* xbuf;
    unsigned* cnt;
    unsigned* tmo;
    int ntn; float eps;
    unsigned code;
    __device__ __forceinline__ bool run(const f32x4 (&v)[2][2][4][2], const Unit& u, int wr, int wc, int fr, int fq, PG8_LAS unsigned char* lds, int wid, int lane) const {
        typedef float f32x2v __attribute__((ext_vector_type(2)));
        PG8_LAS f32x2v* P = (PG8_LAS f32x2v*)lds;
        PG8_LAS f32x2v* S = (PG8_LAS f32x2v*)(lds + 8192);
        PG8_LAS unsigned* flag = (PG8_LAS unsigned*)(lds + 8192 + 2048);
#pragma unroll
        for (int ai = 0; ai < 2; ++ai)
#pragma unroll
            for (int m = 0; m < 4; ++m) {
                float s = 0.f;
#pragma unroll
                for (int bj = 0; bj < 2; ++bj)
#pragma unroll
                    for (int n = 0; n < 2; ++n) { const f32x4 x = v[ai][bj][m][n]; s += (x[0] + x[1]) + (x[2] + x[3]); }
                s += __shfl_xor(s, 16); s += __shfl_xor(s, 32);
                const float mw = s * (1.0f / 64.0f); float q = 0.f;
#pragma unroll
                for (int bj = 0; bj < 2; ++bj)
#pragma unroll
                    for (int n = 0; n < 2; ++n) { const f32x4 d = v[ai][bj][m][n] - mw; q += (d[0] * d[0] + d[1] * d[1]) + (d[2] * d[2] + d[3] * d[3]); }
                q += __shfl_xor(q, 16); q += __shfl_xor(q, 32);
                if (fq == 0) P[(ai * HALF + wr * 64 + m * 16 + fr) * 4 + wc] = (f32x2v){mw, q};
            }
        asm volatile("s_waitcnt lgkmcnt(0)" ::: "memory"); __builtin_amdgcn_s_barrier(); asm volatile("" ::: "memory");
#if defined(BROKEN_NO_WAIT)
        if (blockIdx.x >= 64) { const long long t0 = clock64(); while (clock64() - t0 < 60000) __builtin_amdgcn_s_sleep(8); }
#endif
        const int row = wid * 32 + (lane & 31);
        if (lane < 32) {
            const f32x2v a = P[row * 4 + 0], b = P[row * 4 + 1], c = P[row * 4 + 2], d = P[row * 4 + 3];
            const float mt = (a.x + b.x + c.x + d.x) * 0.25f;
            const float da = a.x - mt, db = b.x - mt, dc = c.x - mt, dd = d.x - mt;
            const float m2 = (a.y + b.y) + (c.y + d.y) + 64.0f * ((da * da + db * db) + (dc * dc + dd * dd));
            unsigned long long* slot = (unsigned long long*)xbuf + ((size_t)(u.pm * BM + row) * 4 + u.pn);
            __hip_atomic_store(slot, ((unsigned long long)__float_as_uint(m2) << 32) | __float_as_uint(mt), __ATOMIC_RELAXED, __HIP_MEMORY_SCOPE_AGENT);
        }
        asm volatile("s_waitcnt vmcnt(0)" ::: "memory");
        if (lane == 0) __hip_atomic_fetch_add(cnt + 64 * u.pm, 1u, __ATOMIC_RELAXED, __HIP_MEMORY_SCOPE_AGENT);
        if (wid == 0) {
            bool dead = false; const unsigned long long t0 = __builtin_amdgcn_s_memrealtime(); const unsigned want = 8u * (unsigned)ntn;
            for (;;) {
#if defined(BROKEN_NO_WAIT)
                break;
#endif
                if ((unsigned)__builtin_amdgcn_readfirstlane(__hip_atomic_load(cnt + 64 * u.pm, __ATOMIC_RELAXED, __HIP_MEMORY_SCOPE_AGENT)) >= want) break;
                if (__builtin_amdgcn_s_memrealtime() - t0 > 2000000ull) {
                    if (lane == 0) { unsigned expect = 0u; __hip_atomic_compare_exchange_strong(tmo + 1, &expect, code | (unsigned)(u.pm & 0xff), __ATOMIC_RELAXED, __ATOMIC_RELAXED, __HIP_MEMORY_SCOPE_AGENT);
                                     __hip_atomic_store(tmo, 1u, __ATOMIC_RELAXED, __HIP_MEMORY_SCOPE_AGENT); }
                    dead = true; break; }
                __builtin_amdgcn_s_sleep(2);
            }
            __builtin_amdgcn_fence(__ATOMIC_ACQUIRE, "agent");
            if (lane == 0) flag[0] = dead ? 1u : 0u;
        }
        asm volatile("s_waitcnt vmcnt(0) lgkmcnt(0)" ::: "memory"); __builtin_amdgcn_s_barrier(); asm volatile("" ::: "memory");
        const bool bad = flag[0] != 0u;
        if (lane < 32) {
            const unsigned long long* slot = (const unsigned long long*)xbuf + (size_t)(u.pm * BM + row) * 4; float mt[4], m2[4]; float ms = 0.f;
#pragma unroll
            for (int t = 0; t < 4; ++t) { if (t < ntn) { const unsigned long long w = __hip_atomic_load(slot + t, __ATOMIC_RELAXED, __HIP_MEMORY_SCOPE_AGENT); mt[t] = __uint_as_float((unsigned)w); m2[t] = __uint_as_float((unsigned)(w >> 32)); } else { mt[t] = 0.f; m2[t] = 0.f; } ms += mt[t]; }
            const float mean = ms / (float)ntn; float q = 0.f;
#pragma unroll
            for (int t = 0; t < 4; ++t) if (t < ntn) { const float dm = mt[t] - mean; q += m2[t] + 256.0f * dm * dm; }
            S[row] = (f32x2v){mean, 1.0f / sqrtf(q / (256.0f * (float)ntn) + eps)};
        }
        asm volatile("s_waitcnt lgkmcnt(0)" ::: "memory"); __builtin_amdgcn_s_barrier(); asm volatile("" ::: "memory");
        return bad;
    }
};
struct EpiLnRes {
    static constexpr bool PERM = false, AFTER_DRAIN = true;
    const float* base; float* out; int ldc; const float* bias; PanelStats st; unsigned poison;
    __device__ __forceinline__ void refuse(size_t i0, size_t stride, int M, int N) const { const float q = __builtin_nanf(""); for (size_t i = i0; i < (size_t)M * N; i += stride) out[(i / N) * ldc + i % N] = q;
        if (i0 == 0) { unsigned expect = 0u; __hip_atomic_compare_exchange_strong(st.tmo + 1, &expect, 0x7f0u, __ATOMIC_RELAXED, __ATOMIC_RELAXED, __HIP_MEMORY_SCOPE_AGENT); __hip_atomic_store(st.tmo, 1u, __ATOMIC_RELAXED, __HIP_MEMORY_SCOPE_AGENT); } }
    __device__ __forceinline__ void fused(f32x4 (&acc)[2][2][4][2], const Unit& u, int wr, int wc, int fr, int fq, PG8_LAS unsigned char* lds, int wid, int lane) const {
        typedef float f32x2v __attribute__((ext_vector_type(2)));
        const PG8_LAS f32x2v* S = (const PG8_LAS f32x2v*)(lds + 8192);
        const int col0 = u.pn * BM + wc * 32 + 4 * fq;
#pragma unroll
        for (int bj = 0; bj < 2; ++bj)
#pragma unroll
            for (int n = 0; n < 2; ++n) { const f32x4 bv = bias ? *(const f32x4*)(bias + col0 + bj * HALF + n * 16) : (f32x4){0.f, 0.f, 0.f, 0.f};
#pragma unroll
                for (int ai = 0; ai < 2; ++ai)
#pragma unroll
                    for (int m = 0; m < 4; ++m) acc[ai][bj][m][n] += bv; }
        const bool bad = st.run(acc, u, wr, wc, fr, fq, lds, wid, lane) || poison != 0u;
        const float qnan = __builtin_nanf("");
#pragma unroll
        for (int ai = 0; ai < 2; ++ai)
#pragma unroll
            for (int m = 0; m < 4; ++m) { const int r = ai * HALF + wr * 64 + m * 16 + fr; const f32x2v sr = S[r]; const size_t off = (size_t)(u.pm * BM + r) * ldc + col0;
#pragma unroll
                for (int bj = 0; bj < 2; ++bj)
#pragma unroll
                    for (int n = 0; n < 2; ++n) { const f32x4 bs = *(const f32x4*)(base + off + bj * HALF + n * 16); f32x4 o = bs + (acc[ai][bj][m][n] - sr.x) * sr.y;
                        if (bad) o = (f32x4){qnan, qnan, qnan, qnan}; *(f32x4*)(out + off + bj * HALF + n * 16) = o; }
                asm volatile("" ::: "memory"); }
    }
};
struct EpiLnResLn {
    static constexpr bool PERM = false, AFTER_DRAIN = true;
    const float* base; float* out; bf16_t* xn; int ldc; const float* bias; PanelStats st1, st2; unsigned poison;
    __device__ __forceinline__ void refuse(size_t i0, size_t stride, int M, int N) const { const float q = __builtin_nanf(""); for (size_t i = i0; i < (size_t)M * N; i += stride) { const size_t o = (i / N) * ldc + i % N; out[o] = q; xn[o] = (bf16_t)0x7fc0u; }
        if (i0 == 0) { unsigned expect = 0u; __hip_atomic_compare_exchange_strong(st1.tmo + 1, &expect, 0x7f0u, __ATOMIC_RELAXED, __ATOMIC_RELAXED, __HIP_MEMORY_SCOPE_AGENT); __hip_atomic_store(st1.tmo, 1u, __ATOMIC_RELAXED, __HIP_MEMORY_SCOPE_AGENT); } }
    __device__ __forceinline__ void fused(f32x4 (&acc)[2][2][4][2], const Unit& u, int wr, int wc, int fr, int fq, PG8_LAS unsigned char* lds, int wid, int lane) const {
        typedef float f32x2v __attribute__((ext_vector_type(2))); typedef unsigned u32x2v __attribute__((ext_vector_type(2)));
        const PG8_LAS f32x2v* S = (const PG8_LAS f32x2v*)(lds + 8192);
        const int col0 = u.pn * BM + wc * 32 + 4 * fq;
#pragma unroll
        for (int bj = 0; bj < 2; ++bj)
#pragma unroll
            for (int n = 0; n < 2; ++n) { const f32x4 bv = bias ? *(const f32x4*)(bias + col0 + bj * HALF + n * 16) : (f32x4){0.f, 0.f, 0.f, 0.f};
#pragma unroll
                for (int ai = 0; ai < 2; ++ai)
#pragma unroll
                    for (int m = 0; m < 4; ++m) acc[ai][bj][m][n] += bv; }
        bool bad = st1.run(acc, u, wr, wc, fr, fq, lds, wid, lane) || poison != 0u;
        const float qnan = __builtin_nanf("");
#pragma unroll
        for (int ai = 0; ai < 2; ++ai)
#pragma unroll
            for (int m = 0; m < 4; ++m) { const int r = ai * HALF + wr * 64 + m * 16 + fr; const f32x2v sr = S[r]; const size_t off = (size_t)(u.pm * BM + r) * ldc + col0;
#pragma unroll
                for (int bj = 0; bj < 2; ++bj)
#pragma unroll
                    for (int n = 0; n < 2; ++n) { const f32x4 bs = *(const f32x4*)(base + off + bj * HALF + n * 16); acc[ai][bj][m][n] = bs + (acc[ai][bj][m][n] - sr.x) * sr.y; }
                asm volatile("" : "+v"(acc[ai][0][m][0]), "+v"(acc[ai][0][m][1]), "+v"(acc[ai][1][m][0]), "+v"(acc[ai][1][m][1]));
                if (m & 1) asm volatile("" ::: "memory"); }
        const bool bad1 = bad;
        bad = st2.run(acc, u, wr, wc, fr, fq, lds, wid, lane) || bad;
#pragma unroll
        for (int ai = 0; ai < 2; ++ai)
#pragma unroll
            for (int m = 0; m < 4; ++m) { const int r = ai * HALF + wr * 64 + m * 16 + fr; const f32x2v sr = S[r]; const size_t off = (size_t)(u.pm * BM + r) * ldc + col0;
#pragma unroll
                for (int bj = 0; bj < 2; ++bj)
#pragma unroll
                    for (int n = 0; n < 2; ++n) { const f32x4 x1 = acc[ai][bj][m][n]; *(f32x4*)(out + off + bj * HALF + n * 16) = bad1 ? (f32x4){qnan, qnan, qnan, qnan} : x1;
                        const f32x4 o = (x1 - sr.x) * sr.y; u32x2v w; w.x = cvt_pk_bf16(o[0], o[1]); w.y = cvt_pk_bf16(o[2], o[3]);
                        if (bad) { w.x = 0x7fc07fc0u; w.y = 0x7fc07fc0u; } *(u32x2v*)(xn + off + bj * HALF + n * 16) = w; }
                asm volatile("" ::: "memory"); }
    }
};

template <class Epi, class Sched, bool STAMP = false>
__device__ __forceinline__ void gemm_phase(PG8_LAS unsigned char* lds, const Gemm g, const Sched& S, const Epi& E, unsigned long long* stamps) {
    int tid_l_ = (int)threadIdx.x; asm volatile("" : "+v"(tid_l_)); const int tid = tid_l_, wid = __builtin_amdgcn_readfirstlane(tid >> 6), lane = tid & 63, wr = wid >> 2, wc = wid & 3, fr = lane & 15, fq = lane >> 4;
    const int K = g.K, nt = K / BK;
    int ts_lo = 0, ts_hi = 0, nts = 0; const unsigned long long rt_entry = STAMP ? (unsigned long long)wall_clock64() : 0ull;
#define PG8_STAMP() do { if (STAMP && wid == 0 && nts < 64) { const unsigned long long _c = (unsigned long long)clock64(); \
        ts_lo = (lane == nts) ? (int)(unsigned)_c : ts_lo; ts_hi = (lane == nts) ? (int)(unsigned)(_c >> 32) : ts_hi; ++nts; } } while (0)
    PG8_STAMP();
    unsigned voffA[2], voffB[2];
#pragma unroll
    for (int i = 0; i < 2; ++i) { int R, C; stage_rc(tid * 16 + i * 8192, R, C); const int Rb = Epi::PERM ? ((R & ~31) + perm32(R & 31)) : R;
        voffA[i] = (unsigned)(R * K + C) * 2u; voffB[i] = (unsigned)(Rb * K + C) * 2u; }
    const size_t kstep = (size_t)(BK * 2);
    const size_t hstep = (size_t)HALF * K * 2;
    const size_t tstep = 2 * hstep;
    const unsigned ldsw = (unsigned)wid * 1024u;
    const int aoff = lds_byte(wr * 64 + fr, fq * 8), boff = lds_byte(wc * 32 + fr, fq * 8);
#define PG8_SA(b, h) (((b) * 2 + (h)) * HTB)
#define PG8_SB(b, h) ((4 + (b) * 2 + (h)) * HTB)
#define PG8_STAGE(bufoff, gbase, voff) do { _Pragma("unroll") for (int _i = 0; _i < 2; ++_i) \
        __builtin_amdgcn_global_load_lds((const unsigned*)((const char*)(gbase) + (voff)[_i]), (PG8_LAS unsigned*)(lds + (bufoff) + ldsw + _i * 8192), 16, 0, 0); } while (0)
#define PG8_LDA(dst, b, h) do { _Pragma("unroll") for (int m = 0; m < 4; ++m) _Pragma("unroll") for (int k = 0; k < 2; ++k) dst[m][k] = *(const PG8_LAS bf16x8*)(lds + PG8_SA(b, h) + aoff + m * 2048 + k * 1024); } while (0)
#define PG8_LDB(dst, b, h) do { _Pragma("unroll") for (int n = 0; n < 2; ++n) _Pragma("unroll") for (int k = 0; k < 2; ++k) dst[n][k] = *(const PG8_LAS bf16x8*)(lds + PG8_SB(b, h) + boff + n * 2048 + k * 1024); } while (0)
#define PG8_MMA(ai, bj, At, Bt) do { __builtin_amdgcn_s_setprio(1); _Pragma("unroll") for (int m = 0; m < 4; ++m) _Pragma("unroll") for (int n = 0; n < 2; ++n) _Pragma("unroll") for (int k = 0; k < 2; ++k) \
        acc[ai][bj][m][n] = __builtin_amdgcn_mfma_f32_16x16x32_bf16(Bt[n][k], At[m][k], acc[ai][bj][m][n], 0, 0, 0); __builtin_amdgcn_s_setprio(0); } while (0)
#define PG8_WAIT_V(n) asm volatile("s_waitcnt vmcnt(" #n ")" ::: "memory")
#define PG8_WAIT_L(n) asm volatile("s_waitcnt lgkmcnt(" #n ")" ::: "memory")
#define PG8_BAR __builtin_amdgcn_s_barrier()
#define PG8_SCHED __builtin_amdgcn_sched_barrier(0)
    Unit cur, nxt; int ui = 0;
    if (!S.next(0, cur)) return;
    f32x4 acc[2][2][4][2];
#pragma unroll
    for (int a = 0; a < 2; ++a)
#pragma unroll
        for (int b = 0; b < 2; ++b)
#pragma unroll
            for (int m = 0; m < 4; ++m)
#pragma unroll
                for (int n = 0; n < 2; ++n) acc[a][b][m][n] = (f32x4){0.f, 0.f, 0.f, 0.f};
    bf16x8 At[4][2], B0[2][2], B1[2][2];
    const char* cA = (const char*)g.A + (size_t)cur.pm * tstep; const char* cB = (const char*)g.Bt + (size_t)cur.pn * tstep;
    S.a_ready(cur);
    PG8_STAGE(PG8_SB(0, 0), cB, voffB); PG8_STAGE(PG8_SA(0, 0), cA, voffA); PG8_STAGE(PG8_SB(0, 1), cB + hstep, voffB); PG8_STAGE(PG8_SA(0, 1), cA + hstep, voffA);
    if (wr == 1) PG8_BAR;
    PG8_WAIT_V(4); PG8_BAR;
    PG8_STAGE(PG8_SB(1, 0), cB + kstep, voffB); PG8_STAGE(PG8_SA(1, 0), cA + kstep, voffA); PG8_STAGE(PG8_SB(1, 1), cB + hstep + kstep, voffB);
    PG8_WAIT_V(6); PG8_BAR;
    PG8_STAMP();
    for (;;) {
        const bool has_next = S.next(ui + 1, nxt);
        const char* nA = has_next ? (const char*)g.A + (size_t)nxt.pm * tstep : cA; const char* nB = has_next ? (const char*)g.Bt + (size_t)nxt.pn * tstep : cB;
        for (int t = 0; t < nt; t += 2) {
            const bool last = (t == nt - 2);
            const char* a1 = cA + (size_t)(t + 1) * kstep;
            const char* a2 = last ? nA : cA + (size_t)(t + 2) * kstep; const char* b2 = last ? nB : cB + (size_t)(t + 2) * kstep;
            const char* a3 = a2 + kstep; const char* b3 = b2 + kstep;
            if (last && has_next) S.a_ready(nxt);
            PG8_LDB(B0, 0, 0); PG8_SCHED; PG8_LDA(At, 0, 0); PG8_STAGE(PG8_SA(1, 1), a1 + hstep, voffA);
            PG8_WAIT_L(8); PG8_BAR; PG8_WAIT_L(0); PG8_MMA(0, 0, At, B0); PG8_BAR; PG8_SCHED;
            PG8_LDB(B1, 0, 1); PG8_STAGE(PG8_SB(0, 0), b2, voffB);
            PG8_BAR; PG8_WAIT_L(0); PG8_MMA(0, 1, At, B1); PG8_BAR;
            PG8_LDA(At, 0, 1); PG8_STAGE(PG8_SA(0, 0), a2, voffA);
            PG8_BAR; PG8_WAIT_L(0); PG8_MMA(1, 0, At, B0); PG8_BAR; PG8_SCHED;
            PG8_STAGE(PG8_SB(0, 1), b2 + hstep, voffB);
            PG8_WAIT_V(6); PG8_BAR; PG8_MMA(1, 1, At, B1); PG8_BAR;
            PG8_LDB(B0, 1, 0); PG8_SCHED; PG8_LDA(At, 1, 0); PG8_STAGE(PG8_SA(0, 1), a2 + hstep, voffA);
            PG8_WAIT_L(8); PG8_BAR; PG8_WAIT_L(0); PG8_MMA(0, 0, At, B0); PG8_BAR; PG8_SCHED;
            PG8_LDB(B1, 1, 1); PG8_STAGE(PG8_SB(1, 0), b3, voffB);
            PG8_BAR; PG8_WAIT_L(0); PG8_MMA(0, 1, At, B1); PG8_BAR;
            PG8_LDA(At, 1, 1); PG8_STAGE(PG8_SA(1, 0), a3, voffA);
            PG8_BAR; PG8_WAIT_L(0); PG8_MMA(1, 0, At, B0); PG8_BAR; PG8_SCHED;
            PG8_STAGE(PG8_SB(1, 1), b3 + hstep, voffB);
            PG8_WAIT_V(6); PG8_BAR; PG8_MMA(1, 1, At, B1); PG8_BAR;
        }
        PG8_STAMP();
        if constexpr (!Epi::AFTER_DRAIN) { E(acc, cur, wr, wc, fr, fq); S.done(cur); }
        PG8_STAMP();
        if (!has_next) break;
#pragma unroll
        for (int a = 0; a < 2; ++a)
#pragma unroll
            for (int b = 0; b < 2; ++b)
#pragma unroll
                for (int m = 0; m < 4; ++m)
#pragma unroll
                    for (int n = 0; n < 2; ++n) acc[a][b][m][n] = (f32x4){0.f, 0.f, 0.f, 0.f};
        cur = nxt; cA = nA; cB = nB; ++ui;
    }
    PG8_WAIT_V(0);
    if (wr == 0) PG8_BAR;
    PG8_BAR;
    if constexpr (Epi::AFTER_DRAIN) { E.fused(acc, cur, wr, wc, fr, fq, lds, wid, lane); S.done(cur); }
    PG8_STAMP();
    if (STAMP && wid == 0) { stamps[lane] = lane < nts ? (((unsigned long long)(unsigned)ts_hi << 32) | (unsigned)ts_lo) : 0ull;
        if (lane == 62) stamps[62] = rt_entry; if (lane == 63) stamps[63] = (unsigned long long)wall_clock64(); }
#undef PG8_STAMP
#undef PG8_SA
#undef PG8_SB
#undef PG8_STAGE
#undef PG8_LDA
#undef PG8_LDB
#undef PG8_MMA
#undef PG8_WAIT_V
#undef PG8_WAIT_L
#undef PG8_BAR
#undef PG8_SCHED
}
}

using pg8::bf16_t; using pg8::bf16x8; using pg8::f32x4;
typedef float f32x16 __attribute__((ext_vector_type(16)));
typedef float f32x2v __attribute__((ext_vector_type(2)));
typedef __bf16 bf16x2v __attribute__((ext_vector_type(2)));
typedef short s16x4 __attribute__((ext_vector_type(4)));
typedef unsigned u32x4 __attribute__((ext_vector_type(4)));
typedef unsigned u32x2 __attribute__((ext_vector_type(2)));
typedef PG8_LAS unsigned char* LDSP;
typedef PG8_LAS float* LASF;

constexpr int NTH = 512;
constexpr int LDS_BYTES = 156 * 1024;
constexpr int DM = 1024, LL = 8192, LC = 256, SEQB = 8448, TT = 16896, NPAN = 66, TPAD = 41984;
constexpr size_t UU = (size_t)TT * 1024 * 2;
constexpr float EPS_ = 1e-6f;
constexpr float INV2PI = 0.15915494309189535f;

__device__ __forceinline__ int ltid() { int t = (int)threadIdx.x; asm volatile("" : "+v"(t)); return t; }
__device__ __forceinline__ f32x2v mk2_(float x, float y) { f32x2v r; r.x = x; r.y = y; return r; }
__device__ __forceinline__ float bf2f(bf16_t v) { return __uint_as_float(((unsigned)v) << 16); }
__device__ __forceinline__ unsigned pk2(float lo, float hi) { f32x2v v = {lo, hi}; bf16x2v b = __builtin_convertvector(v, bf16x2v); return __builtin_bit_cast(unsigned, b); }
__device__ __forceinline__ bf16_t f2bf(float f) { return (bf16_t)(pk2(f, 0.f) & 0xffffu); }
__device__ __forceinline__ float lo16(unsigned w) { return __uint_as_float(w << 16); }
__device__ __forceinline__ float hi16(unsigned w) { return __uint_as_float(w & 0xffff0000u); }
__device__ __forceinline__ float sigmoidf_(float x) { return 1.0f / (1.0f + __expf(-x)); }
__device__ __forceinline__ float siluf_(float x) { return x / (1.0f + __expf(-x)); }
__device__ __forceinline__ float logsigf_(float x) { return fminf(x, 0.f) - log1pf(__expf(-fabsf(x))); }
__device__ __forceinline__ float sin2pi(float rev) { return __builtin_amdgcn_sinf(rev); }
__device__ __forceinline__ float cos2pi(float rev) { return __builtin_amdgcn_cosf(rev); }
__device__ __forceinline__ int crow(int r, int hi) { return (r & 3) + 8 * (r >> 2) + 4 * hi; }
__device__ __forceinline__ float wave_sum(float v) {
#pragma unroll
    for (int o = 32; o >= 1; o >>= 1) v += __shfl_xor(v, o);
    return v; }
__device__ __forceinline__ float wave_max(float v) {
#pragma unroll
    for (int o = 32; o >= 1; o >>= 1) v = fmaxf(v, __shfl_xor(v, o));
    return v; }
__device__ __forceinline__ void unpack8(const u32x4 w, float (&f)[8]) {
    f[0] = lo16(w.x); f[1] = hi16(w.x); f[2] = lo16(w.y); f[3] = hi16(w.y); f[4] = lo16(w.z); f[5] = hi16(w.z); f[6] = lo16(w.w); f[7] = hi16(w.w); }
__device__ __forceinline__ u32x4 pack8(const float (&f)[8]) { u32x4 w; w.x = pk2(f[0], f[1]); w.y = pk2(f[2], f[3]); w.z = pk2(f[4], f[5]); w.w = pk2(f[6], f[7]); return w; }

template <class T> struct GP { __attribute__((address_space(1))) T* p;
    __host__ __device__ __forceinline__ GP& operator=(T* q) { p = (__attribute__((address_space(1))) T*)q; return *this; }
    __device__ __forceinline__ operator T*() const { return (T*)p; } };
struct Params {
    GP<const float> x, c, ctx, c_ctx, mod_w, mod_b, norm1_g, norm2_g, w_in, merge_b, m_conv_w, m_conv_b, m_gate_b, m_norm_g;
    GP<const float> a_qnorm_g, a_knorm_g, a_lambda, a_subln_g, h_conv_w, h_conv_b, h_ffn_w1, h_ffn_b1, h_ffn_w2, h_ffn_b2, h_ffn_w3;
    GP<const float> h_freq, h_decay, h_bias, w_br_m, w_br_a, w_br_h, w_out, router_w, router_b, e_w1, e_w3, e_w2;
    GP<float> out;
    GP<unsigned> bar; GP<int> cnt; GP<int> cur; GP<float> sumsq; GP<float> sumsqC;
    GP<float> modv; GP<float> hdn2; GP<float> G; GP<float> xc; GP<int> sel_e; GP<float> sel_w; GP<int> posbuf;
    GP<float> scal; GP<float> ms; GP<float> dn; GP<float> nst; GP<float> hfC; GP<float> hbC;
    GP<bf16_t> Wt_in, Wt_br, Wt_out, hn, Y3;
    GP<unsigned char> R;
};

__device__ __forceinline__ const float* resid_row_in(const Params& p, int layer, int s) {
    const int b = s / SEQB, pos = s - b * SEQB;
    if (pos < LC) return (layer == 0 ? p.ctx : p.xc) + (size_t)(b * LC + pos) * DM;
    return (layer == 0 ? p.x : p.out) + (size_t)(b * LL + pos - LC) * DM; }
__device__ __forceinline__ float* resid_row(const Params& p, int s) {
    const int b = s / SEQB, pos = s - b * SEQB;
    if (pos < LC) return p.xc + (size_t)(b * LC + pos) * DM;
    return p.out + (size_t)(b * LL + pos - LC) * DM; }
__device__ __forceinline__ const float* modvec(const Params& p, int layer, int s) { const int b = s / SEQB, pos = s - b * SEQB; return p.modv + (size_t)(layer * 3 + (pos < LC ? 2 : b)) * 6144; }

struct MapWin { const float* w;
    __device__ __forceinline__ const float* operator()(int n0, int cb, int k) const { const int d = n0 >> 10; const int off = d < 6 ? 4112 + 1024 * d : (d < 10 ? 1024 * (d - 6) : 10256 + 1024 * (d - 10));
        return w + (size_t)k * 13328 + off + (n0 & 1023) + cb * 4; } };
struct MapPlain { const float* w; int ld;
    __device__ __forceinline__ const float* operator()(int n0, int cb, int k) const { return w + (size_t)k * ld + n0 + cb * 4; } };
struct MapE13 { const float* w1; long d31;
    __device__ __forceinline__ const float* operator()(int n0, int cb, int k) const { return w1 + ((cb & 1) ? d31 : 0l) + (size_t)k * 512 + (n0 >> 1) + 4 * (cb >> 1); } };
template <class MAP> __device__ __forceinline__ void xpose_tile(const MAP& map, int n0, int k0, bf16_t* dst, int K, LDSP lds) {
    LASF tl = (LASF)lds; const int tid = ltid();
#pragma unroll
    for (int pass = 0; pass < 2; ++pass) { const int k = pass * 32 + (tid >> 4), cb = tid & 15; const float4 v = *(const float4*)map(n0, cb, k0 + k);
        tl[k * 65 + cb * 4 + 0] = v.x; tl[k * 65 + cb * 4 + 1] = v.y; tl[k * 65 + cb * 4 + 2] = v.z; tl[k * 65 + cb * 4 + 3] = v.w; }
    __syncthreads();
    { const int n = tid >> 3, kq = (tid & 7) * 8; float f[8];
#pragma unroll
      for (int i = 0; i < 8; ++i) f[i] = tl[(kq + i) * 65 + n];
      *(u32x4*)(dst + (size_t)(n0 + n) * K + k0 + kq) = pack8(f); }
    __syncthreads();
}
template <class MAP> __device__ __forceinline__ void xpose_mat(const MAP& map, int N, int K, bf16_t* dst, LDSP lds, int bid, int nb) {
    const int ntn = N / 64, ntk = K / 64;
    for (int ti = bid; ti < ntn * ntk; ti += nb) { const int nt = ti / ntk, kt = ti - nt * ntk; xpose_tile(map, nt * 64, kt * 64, dst, K, lds); }
}
__device__ __forceinline__ void phase_conv_small(const Params& p, int layer, LDSP lds, int bid, int nb) {
    { MapWin m{p.w_in + (size_t)layer * 1024 * 13328}; xpose_mat(m, 13312, 1024, p.Wt_in, lds, bid, nb); }
    { MapPlain m{p.w_br_m + (size_t)layer * 1048576, 1024}; xpose_mat(m, 1024, 1024, p.Wt_br, lds, bid, nb); }
    { MapPlain m{p.w_br_a + (size_t)layer * 1048576, 1024}; xpose_mat(m, 1024, 1024, p.Wt_br + 1048576, lds, bid, nb); }
    { MapPlain m{p.w_br_h + (size_t)layer * 1048576, 1024}; xpose_mat(m, 1024, 1024, p.Wt_br + 2 * 1048576, lds, bid, nb); }
    { MapPlain m{p.w_out + (size_t)layer * 1048576, 1024}; xpose_mat(m, 1024, 1024, p.Wt_out, lds, bid, nb); }
}
__device__ __forceinline__ void phase_conv_experts(const Params& p, int layer, bf16_t* Wt13, bf16_t* Wt2, LDSP lds, int bid, int nb) {
    for (int ti = bid; ti < 32 * 256; ti += nb) { const int e = ti >> 8, r = ti & 255, nt = r >> 4, kt = r & 15;
        MapE13 m{p.e_w1 + ((size_t)layer * 32 + e) * 524288, (long)(p.e_w3 - p.e_w1)};
        xpose_tile(m, nt * 64, kt * 64, Wt13 + (size_t)e * 1048576, 1024, lds); }
    for (int ti = bid; ti < 32 * 128; ti += nb) { const int e = ti >> 7, r = ti & 127, nt = r >> 3, kt = r & 7;
        MapPlain m{p.e_w2 + ((size_t)layer * 32 + e) * 524288, 1024};
        xpose_tile(m, nt * 64, kt * 64, Wt2 + (size_t)e * 524288, 512, lds); }
}

__device__ __forceinline__ void phase_modvec(const Params& p, LDSP lds, int bid, int nb) {
    LASF red = (LASF)lds; const int tid = ltid();
    for (int u = bid; u < 192; u += nb) {
        const int l = u / 96, cg = u - l * 96, col = tid & 63, ks = tid >> 6;
        const float* W = p.mod_w + (size_t)l * 1024 * 6144 + cg * 64 + col;
        float a0 = 0.f, a1 = 0.f, a2 = 0.f;
        for (int k = ks * 128; k < ks * 128 + 128; ++k) { const float w = W[(size_t)k * 6144]; a0 += siluf_(p.c[k]) * w; a1 += siluf_(p.c[1024 + k]) * w; a2 += siluf_(p.c_ctx[k]) * w; }
        red[(ks * 3 + 0) * 64 + col] = a0; red[(ks * 3 + 1) * 64 + col] = a1; red[(ks * 3 + 2) * 64 + col] = a2;
        __syncthreads();
        if (tid < 192) { const int v = tid >> 6, cc = tid & 63; float s = p.mod_b[l * 6144 + cg * 64 + cc];
#pragma unroll
            for (int q = 0; q < 8; ++q) s += red[(q * 3 + v) * 64 + cc];
            p.modv[(size_t)(l * 3 + v) * 6144 + cg * 64 + cc] = s; }
        __syncthreads();
    }
}

__device__ __forceinline__ void phase_hdn(const Params& p, LDSP lds, int bid, int nb) {
    LASF w1s = (LASF)lds, b1s = w1s + 33 * 64, w2s = b1s + 64, b2s = w2s + 64 * 64, frs = b2s + 64, hbuf = frs + 64;
    const int tid = ltid();
    for (int u = bid; u < 132; u += nb) {
        const int l = u / 66, pu = u - l * 66;
        for (int i = tid; i < 33 * 64; i += NTH) w1s[i] = p.h_ffn_w1[l * 33 * 64 + i];
        for (int i = tid; i < 64 * 64; i += NTH) w2s[i] = p.h_ffn_w2[l * 4096 + i];
        if (tid < 64) { b1s[tid] = p.h_ffn_b1[l * 64 + tid]; b2s[tid] = p.h_ffn_b2[l * 64 + tid]; frs[tid] = p.h_freq[l * 64 + tid]; }
        __syncthreads();
        const int pos = tid >> 2, qd = tid & 3, q = pu * 128 + pos;
        const int Lf = q < 8192 ? 8192 : 256, t = q < 8192 ? q : q - 8192;
        float z[33];
        z[0] = (float)t / (float)(Lf - 1);
        const float wrev = (float)t / (float)Lf;
#pragma unroll
        for (int j = 0; j < 16; ++j) { const float f = 1e-4f + (float)j * ((15.0f - 1e-4f) / 15.0f); float ph = f * wrev; ph -= floorf(ph); z[1 + j] = cos2pi(ph); z[17 + j] = -sin2pi(ph); }
#pragma unroll
        for (int jj = 0; jj < 16; ++jj) { const int j = qd * 16 + jj; float a = b1s[j];
#pragma unroll
            for (int i = 0; i < 33; ++i) a += z[i] * w1s[i * 64 + j];
            hbuf[pos * 65 + j] = sinf(frs[j] * a); }
        __syncthreads();
        float acc[16];
#pragma unroll
        for (int jj = 0; jj < 16; ++jj) acc[jj] = b2s[qd * 16 + jj];
        for (int i = 0; i < 64; ++i) { const float hv = hbuf[pos * 65 + i];
#pragma unroll
            for (int jj = 0; jj < 16; ++jj) acc[jj] += hv * w2s[i * 64 + qd * 16 + jj]; }
#pragma unroll
        for (int jj = 0; jj < 16; ++jj) p.hdn2[((size_t)l * 8448 + q) * 64 + qd * 16 + jj] = sinf(frs[qd * 16 + jj] * acc[jj]);
        __syncthreads();
    }
}
__device__ __forceinline__ void phase_taps(const Params& p, int layer, float* tapsT, LDSP lds, int bid, int nb) {
    LASF w3s = (LASF)lds, dec = w3s + 32 * 64, wsum = dec + 64; const int tid = ltid(), lane = tid & 63;
    const int nunits = 512 + (layer == 0 ? 64 : 0);
    for (int u = bid; u < nunits; u += nb) {
        const bool isc = u >= 512; const int cg = isc ? u - 512 : (u >> 3), tch = isc ? 0 : (u & 7);
        for (int i = tid; i < 64 * 32; i += NTH) { const int k = i >> 5, jj = i & 31; w3s[jj * 64 + k] = p.h_ffn_w3[(size_t)layer * 64 * 2048 + k * 2048 + (jj < 16 ? 16 * cg + jj : 1024 + 16 * cg + jj - 16)]; }
        if (tid < 32) dec[tid] = fabsf(p.h_decay[layer * 2048 + (tid < 16 ? 16 * cg + tid : 1024 + 16 * cg + tid - 16)]);
        if (tid < 256) wsum[tid] = 0.f;
        __syncthreads();
        const int Lf = isc ? 256 : 8192;
#pragma unroll 1
        for (int ps = 0; ps < (isc ? 1 : 2); ++ps) {
            const int t = isc ? tid : tch * 1024 + ps * 512 + tid; const bool val = t < Lf;
            const float* hr = p.hdn2 + ((size_t)layer * 8448 + (val ? (isc ? 8192 + t : t) : 0)) * 64;
            f32x4 h[16];
#pragma unroll
            for (int i = 0; i < 16; ++i) h[i] = *(const f32x4*)(hr + 4 * i);
            const float tl = (float)t / (float)(Lf - 1);
#pragma unroll 1
            for (int jp = 0; jp < 16; ++jp) {
                const int c = 16 * cg + jp; float af = 0.f, ab = 0.f;
#pragma unroll
                for (int i = 0; i < 16; ++i) { const f32x4 w = *(const PG8_LAS f32x4*)(w3s + jp * 64 + 4 * i); af += h[i].x * w.x + h[i].y * w.y + h[i].z * w.z + h[i].w * w.w; }
                __builtin_amdgcn_sched_barrier(0);
#pragma unroll
                for (int i = 0; i < 16; ++i) { const f32x4 w = *(const PG8_LAS f32x4*)(w3s + (16 + jp) * 64 + 4 * i); ab += h[i].x * w.x + h[i].y * w.y + h[i].z * w.z + h[i].w * w.w; }
                af *= __expf(-tl * dec[jp]); ab *= __expf(-tl * dec[16 + jp]);
                float ssum = 0.f;
                if (val) { ssum = af * af + ab * ab;
                    if (isc) { p.hfC[c * 256 + t] = af; p.hbC[c * 256 + t] = ab; }
                    else { tapsT[(size_t)c * 16384 + t] = af; if (t > 0) tapsT[(size_t)c * 16384 + 16384 - t] = ab; else tapsT[(size_t)c * 16384 + 8192] = 0.f; } }
                ssum = wave_sum(ssum);
                if (lane == 0) wsum[(ps * 16 + jp) * 8 + (tid >> 6)] = ssum;
            }
        }
        __syncthreads();
        if (tid < 16) { float tot = 0.f;
#pragma unroll
            for (int q = 0; q < 16; ++q) tot += wsum[((q >> 3) * 16 + tid) * 8 + (q & 7)];
            if (isc) p.sumsqC[16 * cg + tid] = tot; else p.sumsq[((size_t)(layer * 64 + cg) * 8 + tch) * 16 + tid] = tot; }
        __syncthreads();
    }
}

__device__ __forceinline__ void phase_norm1(const Params& p, int layer, LDSP lds, int bid, int nb) {
    LASF wg = (LASF)lds;
    const int tid = ltid(), lane = tid & 63, wid = tid >> 6;
    for (int i = tid; i < 1024 * 4; i += NTH) { const int n = i >> 2, j4 = (i & 3) * 4; const float4 v = *(const float4*)(p.w_in + (size_t)layer * 1024 * 13328 + (size_t)n * 13328 + 4096 + j4);
        wg[n * 20 + j4] = v.x; wg[n * 20 + j4 + 1] = v.y; wg[n * 20 + j4 + 2] = v.z; wg[n * 20 + j4 + 3] = v.w; }
    __syncthreads();
    const float* gn = p.norm1_g + layer * 1024;
    for (int s = bid * 8 + wid; s < TT; s += nb * 8) {
        const float* xr = resid_row_in(p, layer, s); const float* mv = modvec(p, layer, s);
        float ssq = 0.f;
#pragma unroll
        for (int i = 0; i < 16; ++i) { const float xv = xr[lane + 64 * i]; ssq += xv * xv; }
        ssq = wave_sum(ssq); const float rstd = rsqrtf(ssq * (1.0f / 1024.0f) + EPS_);
        float acc[16];
#pragma unroll
        for (int j = 0; j < 16; ++j) acc[j] = 0.f;
#pragma unroll 2
        for (int i = 0; i < 16; ++i) { const int n = lane + 64 * i; const float hv = xr[n] * rstd * gn[n] * (1.0f + mv[1024 + n]) + mv[n];
            p.hn[(size_t)s * 1024 + n] = f2bf(hv);
#pragma unroll
            for (int j4 = 0; j4 < 4; ++j4) { const f32x4 w = *(const PG8_LAS f32x4*)(wg + n * 20 + 4 * j4); acc[4 * j4] += hv * w.x; acc[4 * j4 + 1] += hv * w.y; acc[4 * j4 + 2] += hv * w.z; acc[4 * j4 + 3] += hv * w.w; } }
        float mine = 0.f;
#pragma unroll
        for (int j = 0; j < 16; ++j) { const float sj = wave_sum(acc[j]); if (lane == j) mine = sj; }
        if (lane < 16) p.G[(size_t)s * 16 + lane] = mine;
    }
    __syncthreads();
}

__device__ __forceinline__ void phase_attn_prep(const Params& p, int layer, bf16_t* aq, bf16_t* ak, int bid, int nb) {
    const int tid = ltid(), lane = tid & 63, wid = tid >> 6;
    const int grp = lane >> 2, i4 = lane & 3;
    const float* qg = p.a_qnorm_g + layer * 64; const float* kg = p.a_knorm_g + layer * 64;
    float gq[16], gk[16];
#pragma unroll
    for (int c = 0; c < 4; ++c)
#pragma unroll
        for (int e = 0; e < 4; ++e) { gq[c * 4 + e] = qg[16 * c + 4 * i4 + e]; gk[c * 4 + e] = kg[16 * c + 4 * i4 + e]; }
    float inv[4];
#pragma unroll
    for (int e = 0; e < 4; ++e) inv[e] = exp2f(-(float)(4 * i4 + e) * (13.287712379549449f / 16.0f));
    const float qscale = 0.125f * 1.4426950408889634f;
    for (int s = bid * 8 + wid; s < TT; s += nb * 8) {
        const int b = s / SEQB, pos = s - b * SEQB; const bool lat = pos >= LC; const int t = pos - LC;
        float cs[8], sn[8];
        if (lat) { const float rowf = (float)(t >> 6), colf = (float)(t & 63);
#pragma unroll
            for (int e = 0; e < 4; ++e) { float ar = rowf * inv[e] * INV2PI, ac = colf * inv[e] * INV2PI; ar -= floorf(ar); ac -= floorf(ac);
                cs[e] = cos2pi(ar); sn[e] = sin2pi(ar); cs[4 + e] = cos2pi(ac); sn[4 + e] = sin2pi(ac); } }
#pragma unroll
        for (int which = 0; which < 2; ++which) {
            bf16_t* base = (which ? ak : aq) + (size_t)s * 1024 + grp * 64 + 4 * i4;
            float v[16]; float ssq = 0.f;
#pragma unroll
            for (int c = 0; c < 4; ++c) { const u32x2 w = *(const u32x2*)(base + 16 * c); v[4 * c] = lo16(w.x); v[4 * c + 1] = hi16(w.x); v[4 * c + 2] = lo16(w.y); v[4 * c + 3] = hi16(w.y); }
#pragma unroll
            for (int i = 0; i < 16; ++i) ssq += v[i] * v[i];
            ssq += __shfl_xor(ssq, 1); ssq += __shfl_xor(ssq, 2);
            const float rstd = rsqrtf(ssq * (1.0f / 64.0f) + EPS_) * (which ? 1.0f : qscale);
#pragma unroll
            for (int i = 0; i < 16; ++i) v[i] = v[i] * rstd * (which ? gk[i] : gq[i]);
            if (lat) {
#pragma unroll
                for (int hf = 0; hf < 2; ++hf)
#pragma unroll
                    for (int e = 0; e < 4; ++e) { const float x1 = v[8 * hf + e], x2 = v[8 * hf + 4 + e], cc = cs[4 * hf + e], sv = sn[4 * hf + e];
                        v[8 * hf + e] = x1 * cc - x2 * sv; v[8 * hf + 4 + e] = x2 * cc + x1 * sv; }
            }
#pragma unroll
            for (int c = 0; c < 4; ++c) { u32x2 w; w.x = pk2(v[4 * c], v[4 * c + 1]); w.y = pk2(v[4 * c + 2], v[4 * c + 3]); *(u32x2*)(base + 16 * c) = w; }
        }
    }
}

__device__ __forceinline__ s16x4 vtr16(const PG8_LAS unsigned char* ptr) {
    typedef short v4i16_t __attribute__((ext_vector_type(4)));
    return __builtin_bit_cast(s16x4, __builtin_amdgcn_ds_read_tr16_b64_v4i16((PG8_LAS v4i16_t*)ptr)); }

__device__ __forceinline__ void attn_unit(const Params& p, int layer, const bf16_t* Q, const bf16_t* K, const bf16_t* V, bf16_t* O, int b, int h, int q0pos, int nkeys, float lam, float lam_init, LDSP lds) {
    const int tid = ltid(), lane = tid & 63, r32 = lane & 31, hi = lane >> 5; const int wid = __builtin_amdgcn_readfirstlane(tid >> 6), comp = wid >> 2, qblk = wid & 3;
    const size_t rowb = (size_t)b * SEQB;
    const bf16_t* qrow = Q + (rowb + q0pos + 32 * qblk + r32) * 1024 + h * 128 + comp * 64 + hi * 8;
    bf16x8 qf[4];
#pragma unroll
    for (int d0 = 0; d0 < 4; ++d0) qf[d0] = *(const bf16x8*)(qrow + d0 * 16);
    f32x16 o[4];
#pragma unroll
    for (int d0 = 0; d0 < 4; ++d0)
#pragma unroll
        for (int r = 0; r < 16; ++r) o[d0][r] = 0.f;
    float m = -1e30f, l = 0.f;
    const int ntiles = nkeys >> 6;
    const bf16_t* ksrc = K + (rowb + lane) * 1024 + h * 128 + (2 * wid) * 8;
    const bf16_t* vsrc = V + (rowb + (lane >> 2)) * 1024 + h * 128 + (lane & 3) * 8;
#define ATT_DMA(t, slot) do { _Pragma("unroll") for (int i_ = 0; i_ < 2; ++i_) { \
        __builtin_amdgcn_global_load_lds((const unsigned*)(ksrc + (size_t)(t) * 64 * 1024 + i_ * 8), (PG8_LAS unsigned*)(lds + (slot) * 16384 + (2 * wid + i_) * 1024), 16, 0, 0); \
        const int pc_ = 2 * wid + i_, d0_ = pc_ >> 2, ks_ = pc_ & 3; \
        __builtin_amdgcn_global_load_lds((const unsigned*)(vsrc + ((size_t)(t) * 64 + 16 * ks_) * 1024 + d0_ * 32), (PG8_LAS unsigned*)(lds + 32768 + (slot) * 16384 + pc_ * 1024), 16, 0, 0); } } while (0)
    ATT_DMA(0, 0);
    __syncthreads();
    for (int t = 0; t < ntiles; ++t) {
        const int slot = t & 1;
        if (t + 1 < ntiles) ATT_DMA(t + 1, slot ^ 1);
        const PG8_LAS unsigned char* Ks = lds + slot * 16384 + comp * 8192 + hi * 1024 + r32 * 16;
        const PG8_LAS unsigned char* Vs = lds + 32768 + slot * 16384 + ((lane >> 4) & 1) * 32 + (lane & 3) * 8 + (4 * hi + ((lane & 15) >> 2)) * 64;
        f32x16 s0, s1;
#pragma unroll
        for (int r = 0; r < 16; ++r) { s0[r] = 0.f; s1[r] = 0.f; }
#pragma unroll
        for (int d0 = 0; d0 < 4; ++d0) { const bf16x8 k0 = *(const PG8_LAS bf16x8*)(Ks + d0 * 2048), k1 = *(const PG8_LAS bf16x8*)(Ks + d0 * 2048 + 512);
            s0 = __builtin_amdgcn_mfma_f32_32x32x16_bf16(k0, qf[d0], s0, 0, 0, 0); s1 = __builtin_amdgcn_mfma_f32_32x32x16_bf16(k1, qf[d0], s1, 0, 0, 0); }
        float rm = fmaxf(s0[0], s1[0]);
#pragma unroll
        for (int r = 1; r < 16; ++r) rm = fmaxf(rm, fmaxf(s0[r], s1[r]));
        rm = fmaxf(rm, __shfl_xor(rm, 32));
        const float mn = fmaxf(m, rm), alpha = exp2f(m - mn);
        float ps = 0.f;
#pragma unroll
        for (int r = 0; r < 16; ++r) { s0[r] = exp2f(s0[r] - mn); s1[r] = exp2f(s1[r] - mn); ps += s0[r] + s1[r]; }
        l = l * alpha + ps; m = mn;
#pragma unroll
        for (int d0 = 0; d0 < 4; ++d0)
#pragma unroll
            for (int r = 0; r < 16; ++r) o[d0][r] *= alpha;
        bf16x8 pf[4];
#pragma unroll
        for (int ks = 0; ks < 4; ++ks) { u32x4 w;
            if (ks < 2) { w.x = pk2(s0[8 * ks], s0[8 * ks + 1]); w.y = pk2(s0[8 * ks + 2], s0[8 * ks + 3]); w.z = pk2(s0[8 * ks + 4], s0[8 * ks + 5]); w.w = pk2(s0[8 * ks + 6], s0[8 * ks + 7]); }
            else { const int k2 = ks - 2; w.x = pk2(s1[8 * k2], s1[8 * k2 + 1]); w.y = pk2(s1[8 * k2 + 2], s1[8 * k2 + 3]); w.z = pk2(s1[8 * k2 + 4], s1[8 * k2 + 5]); w.w = pk2(s1[8 * k2 + 6], s1[8 * k2 + 7]); }
            pf[ks] = __builtin_bit_cast(bf16x8, w); }
#pragma unroll
        for (int d0 = 0; d0 < 4; ++d0) {
#pragma unroll
            for (int ks = 0; ks < 4; ++ks) { const s16x4 lo = vtr16(Vs + d0 * 4096 + ks * 1024), hh = vtr16(Vs + d0 * 4096 + ks * 1024 + 512);
                const bf16x8 vf = (bf16x8){lo[0], lo[1], lo[2], lo[3], hh[0], hh[1], hh[2], hh[3]};
                o[d0] = __builtin_amdgcn_mfma_f32_32x32x16_bf16(vf, pf[ks], o[d0], 0, 0, 0); }
            __builtin_amdgcn_sched_barrier(0); }
        __syncthreads();
    }
#undef ATT_DMA
    l += __shfl_xor(l, 32);
    const float rl = 1.0f / l;
    LASF xch = (LASF)(lds + 65536) + qblk * 4096;
    if (comp == 1) {
#pragma unroll
        for (int d0 = 0; d0 < 4; ++d0)
#pragma unroll
            for (int r = 0; r < 16; ++r) xch[(32 * d0 + crow(r, hi)) * 32 + r32] = o[d0][r] * rl;
    }
    __syncthreads();
    if (comp == 0) {
        float ssq = 0.f;
#pragma unroll
        for (int d0 = 0; d0 < 4; ++d0)
#pragma unroll
            for (int r = 0; r < 16; ++r) { const float y = o[d0][r] * rl - lam * xch[(32 * d0 + crow(r, hi)) * 32 + r32]; o[d0][r] = y; ssq += y * y; }
        ssq += __shfl_xor(ssq, 32);
        const float sc = rsqrtf(ssq * (1.0f / 128.0f) + EPS_) * (1.0f - lam_init);
        const float* sg = p.a_subln_g + layer * 128;
        bf16_t* orow = O + (rowb + q0pos + 32 * qblk + r32) * 1024 + h * 128;
#pragma unroll
        for (int d0 = 0; d0 < 4; ++d0)
#pragma unroll
            for (int r4 = 0; r4 < 4; ++r4) { const int d = 32 * d0 + 8 * r4 + 4 * hi; u32x2 w;
                w.x = pk2(o[d0][4 * r4] * sc * sg[d], o[d0][4 * r4 + 1] * sc * sg[d + 1]); w.y = pk2(o[d0][4 * r4 + 2] * sc * sg[d + 2], o[d0][4 * r4 + 3] * sc * sg[d + 3]);
                *(u32x2*)(orow + d) = w; }
    }
    __syncthreads();
}
__device__ __forceinline__ void phase_attn(const Params& p, int layer, const bf16_t* Q, const bf16_t* K, const bf16_t* V, bf16_t* O, LDSP lds, int bid, int nb) {
    const float lam_init = 0.8f - 0.6f * expf(-0.3f * (float)layer);
    const float* lp = p.a_lambda + layer * 256; float d1 = 0.f, d2 = 0.f;
    for (int i = 0; i < 64; ++i) { d1 += lp[i] * lp[64 + i]; d2 += lp[128 + i] * lp[192 + i]; }
    const float lam = expf(d1) - expf(d2) + lam_init;
    const int nunits = 1024 + (layer == 0 ? 32 : 0);
    for (int u = bid; u < nunits; u += nb) {
        if (u < 1024) { const int bh = u >> 6, qb = u & 63; attn_unit(p, layer, Q, K, V, O, bh >> 3, bh & 7, LC + qb * 128, SEQB, lam, lam_init, lds); }
        else { const int v = u - 1024, bh = v >> 1, qb = v & 1; attn_unit(p, layer, Q, K, V, O, bh >> 3, bh & 7, qb * 128, LC, lam, lam_init, lds); }
    }
}

__device__ __forceinline__ int scan_idx(int dir, int c) { return dir == 0 ? c : (c < 2 ? 1 - c : 67 - c); }

__device__ __forceinline__ void phase_mprep(const Params& p, int layer, const bf16_t* mq, const bf16_t* mk, const bf16_t* mv, bf16_t* qc, bf16_t* kc, bf16_t* kT, bf16_t* vT, LDSP lds, int bid, int nb) {
    const int tid = ltid();
    PG8_LAS bf16_t* kt = (PG8_LAS bf16_t*)lds; PG8_LAS bf16_t* vt = kt + 64 * 264;
    const float* cw = p.m_conv_w + (size_t)layer * 3 * 2048; const float* cb = p.m_conv_b + layer * 2048;
    for (int u = bid; u < 2 * 132 * 4; u += nb) {
        const int h = u & 3, tb = (u >> 2) % 132, b = (u >> 2) / 132;
        const int t = tid >> 3, pos = tb * 64 + t; const size_t row = (size_t)b * SEQB + pos;
        const bool hasp = (pos != 0) && (pos != LC), hasn = (pos != LC - 1) && (pos != SEQB - 1);
#pragma unroll
        for (int v8 = 0; v8 < 4; ++v8) {
            const int d = (tid & 7) * 32 + v8 * 8, ch = h * 256 + d;
#pragma unroll
            for (int which = 0; which < 2; ++which) {
                const bf16_t* src = (which ? mk : mq) + row * 1024 + ch; const int cc = which * 1024 + ch;
                float up[8], uc[8], un[8], o[8];
                unpack8(*(const u32x4*)src, uc);
                if (hasp) unpack8(*(const u32x4*)(src - 1024), up); else {
#pragma unroll
                    for (int i = 0; i < 8; ++i) up[i] = 0.f; }
                if (hasn) unpack8(*(const u32x4*)(src + 1024), un); else {
#pragma unroll
                    for (int i = 0; i < 8; ++i) un[i] = 0.f; }
#pragma unroll
                for (int i = 0; i < 8; ++i) { const float y = cb[cc + i] + up[i] * cw[cc + i] + uc[i] * cw[2048 + cc + i] + un[i] * cw[4096 + cc + i]; o[i] = siluf_(y) * (which ? 0.0625f : 1.0f); }
                const u32x4 w = pack8(o);
                *(u32x4*)((which ? kc : qc) + row * 1024 + ch) = w;
                if (which) *(PG8_LAS u32x4*)(kt + t * 264 + d) = w;
            }
            *(PG8_LAS u32x4*)(vt + t * 264 + d) = *(const u32x4*)(mv + row * 1024 + ch);
        }
        __syncthreads();
        { const int d = tid >> 1, th = tid & 1;
#pragma unroll
          for (int which = 0; which < 2; ++which) { const PG8_LAS bf16_t* srcl = (which ? vt : kt) + (32 * th) * 264 + d;
              bf16_t* dst = (which ? vT : kT) + ((size_t)((b * 4 + h) * 256 + d)) * SEQB + tb * 64 + 32 * th;
#pragma unroll
              for (int q = 0; q < 4; ++q) { u32x4 w;
                  w.x = (unsigned)srcl[(8 * q + 0) * 264] | ((unsigned)srcl[(8 * q + 1) * 264] << 16); w.y = (unsigned)srcl[(8 * q + 2) * 264] | ((unsigned)srcl[(8 * q + 3) * 264] << 16);
                  w.z = (unsigned)srcl[(8 * q + 4) * 264] | ((unsigned)srcl[(8 * q + 5) * 264] << 16); w.w = (unsigned)srcl[(8 * q + 6) * 264] | ((unsigned)srcl[(8 * q + 7) * 264] << 16);
                  *(u32x4*)(dst + 8 * q) = w; } } }
        __syncthreads();
    }
}

__device__ __forceinline__ void load_gates(const Params& p, int layer, size_t row0, int h, LASF tb) {
    const int tid = ltid();
    if (tid < 128) { const float* g = p.G + (row0 + tid) * 16; const float* gb = p.m_gate_b + layer * 16;
        tb[tid] = g[h] + gb[h]; tb[128 + tid] = logsigf_(g[4 + h] + gb[4 + h]); tb[256 + tid] = g[8 + h] + gb[8 + h]; tb[384 + tid] = logsigf_(g[12 + h] + gb[12 + h]); }
}

__device__ __forceinline__ void phase_mA(const Params& p, int layer, const bf16_t* kT, const bf16_t* vT, bf16_t* ST, LDSP lds, int bid, int nb) {
    const int tid = ltid(), lane = tid & 63, r32 = lane & 31, hi = lane >> 5; const int wid = __builtin_amdgcn_readfirstlane(tid >> 6);
    LDSP kw = lds;
    LASF tb = (LASF)(lds + 256 * 272);
    for (int u = bid; u < 8 * 66; u += nb) {
        const int c = u % 66, bh = u / 66, b = bh >> 2, h = bh & 3;
        const size_t row0 = (size_t)b * SEQB + 128 * c;
        load_gates(p, layer, row0, h, tb);
        __syncthreads();
        if (tid < 128) { float sf = 0.f; for (int r = tid + 1; r < 128; ++r) sf += tb[128 + r]; tb[512 + tid] = sf + tb[tid];
                         float sb = 0.f; for (int r = 0; r < tid; ++r) sb += tb[384 + r]; tb[640 + tid] = sb + tb[256 + tid]; }
        __syncthreads();
        if (tid < 64) { const float bqf = wave_sum(tb[128 + tid] + tb[192 + tid]), bqb = wave_sum(tb[384 + tid] + tb[448 + tid]);
            const float mf = wave_max(fmaxf(tb[512 + tid], tb[576 + tid])), mb = wave_max(fmaxf(tb[640 + tid], tb[704 + tid]));
            if (tid == 0) { tb[768] = bqf; tb[769] = mf; tb[770] = bqb; tb[771] = mb;
                float* s0 = p.scal + ((size_t)(bh * 2 + 0) * 66 + scan_idx(0, c)) * 2; s0[0] = bqf; s0[1] = mf;
                float* s1 = p.scal + ((size_t)(bh * 2 + 1) * 66 + scan_idx(1, c)) * 2; s1[0] = bqb; s1[1] = mb; } }
        __syncthreads();
        for (int dir = 0; dir < 2; ++dir) {
            const float mloc = tb[769 + 2 * dir]; const LASF ws = tb + 512 + 128 * dir;
            const int idx = scan_idx(dir, c), bhd = bh * 2 + dir;
            for (int i = tid; i < 256 * 16; i += NTH) { const int kd = i >> 4, s8 = (i & 15) * 8; float f[8];
                unpack8(*(const u32x4*)(kT + ((size_t)(bh * 256 + kd)) * SEQB + 128 * c + s8), f);
#pragma unroll
                for (int e = 0; e < 8; ++e) f[e] *= __expf(ws[s8 + e] - mloc);
                *(PG8_LAS u32x4*)(kw + kd * 272 + s8 * 2) = pack8(f); }
            __syncthreads();
            if (tid < 256) { float s = 0.f;
#pragma unroll
                for (int q = 0; q < 16; ++q) { float f[8]; unpack8(*(const PG8_LAS u32x4*)(kw + tid * 272 + q * 16), f);
#pragma unroll
                    for (int e = 0; e < 8; ++e) s += f[e]; }
                p.dn[((size_t)bhd * 66 + idx) * 256 + tid] = s; }
            const bf16_t* vrow = vT + ((size_t)(bh * 256 + 32 * wid + r32)) * SEQB + 128 * c + 8 * hi;
            bf16_t* st = ST + ((size_t)bhd * 66 + idx) * 65536;
#pragma unroll 1
            for (int kh = 0; kh < 2; ++kh) {
                f32x16 acc[4];
#pragma unroll
                for (int kb = 0; kb < 4; ++kb)
#pragma unroll
                    for (int r = 0; r < 16; ++r) acc[kb][r] = 0.f;
#pragma unroll 2
                for (int ks = 0; ks < 8; ++ks) { const bf16x8 a = *(const bf16x8*)(vrow + 16 * ks);
#pragma unroll
                    for (int kb = 0; kb < 4; ++kb) { const bf16x8 bb = *(const PG8_LAS bf16x8*)(kw + (32 * (4 * kh + kb) + r32) * 272 + (16 * ks + 8 * hi) * 2);
                        acc[kb] = __builtin_amdgcn_mfma_f32_32x32x16_bf16(a, bb, acc[kb], 0, 0, 0); } }
#pragma unroll
                for (int r4 = 0; r4 < 4; ++r4) { bf16_t* sp = st + (32 * wid + 8 * r4 + 4 * hi) * 256 + 128 * kh + r32;
#pragma unroll
                    for (int i = 0; i < 4; ++i)
#pragma unroll
                        for (int kb = 0; kb < 4; ++kb) sp[i * 256 + 32 * kb] = f2bf(acc[kb][4 * r4 + i]); }
            }
            __syncthreads();
        }
    }
}

__device__ __forceinline__ void phase_mB(const Params& p, bf16_t* ST, int bid, int nb) {
    const int tid = ltid();
    for (int it = bid * NTH + tid; it < 16 * 8192; it += nb * NTH) {
        const int bhd = it >> 13; bf16_t* st = ST + (size_t)bhd * 66 * 65536 + (size_t)(it & 8191) * 8; const float* sc = p.scal + (size_t)bhd * 132;
        float C[8];
#pragma unroll
        for (int e = 0; e < 8; ++e) C[e] = 0.f;
        float m = 0.f;
        for (int i0 = 0; i0 < 66; i0 += 6) {
            u32x4 v[6];
#pragma unroll
            for (int j = 0; j < 6; ++j) v[j] = *(const u32x4*)(st + (size_t)(i0 + j) * 65536);
#pragma unroll
            for (int j = 0; j < 6; ++j) { const float bq = sc[2 * (i0 + j)], ml = sc[2 * (i0 + j) + 1]; const float mn = fmaxf(bq + m, ml), a = __expf(bq + m - mn), bb = __expf(ml - mn);
                float f[8]; unpack8(v[j], f);
#pragma unroll
                for (int e = 0; e < 8; ++e) C[e] = a * C[e] + bb * f[e];
                *(u32x4*)(st + (size_t)(i0 + j) * 65536) = pack8(C); m = mn; }
        }
    }
    for (int it = bid * NTH + tid; it < 16 * 256; it += nb * NTH) {
        const int bhd = it >> 8, kd = it & 255; const float* sc = p.scal + (size_t)bhd * 132; float n = 0.f, m = 0.f;
        if (kd == 0) p.ms[bhd * 67] = 0.f;
        for (int i = 0; i < 66; ++i) { const float bq = sc[2 * i], ml = sc[2 * i + 1]; const float mn = fmaxf(bq + m, ml), a = __expf(bq + m - mn), bb = __expf(ml - mn);
            n = a * n + bb * p.dn[((size_t)bhd * 66 + i) * 256 + kd]; p.nst[((size_t)bhd * 66 + i) * 256 + kd] = n; m = mn; if (kd == 0) p.ms[bhd * 67 + i + 1] = mn; }
    }
}

__device__ __forceinline__ void phase_mC(const Params& p, int layer, const bf16_t* qc, const bf16_t* kc, const bf16_t* vT, const bf16_t* mo, const bf16_t* ST, bf16_t* ym, LDSP lds, int bid, int nb) {
    const int tid = ltid(), lane = tid & 63, r32 = lane & 31, hi = lane >> 5; const int wid = __builtin_amdgcn_readfirstlane(tid >> 6);
    LDSP qs = lds; LDSP ksm = lds + 67584; LDSP Wf = ksm; LDSP Wb = ksm + 34816;
    LASF T = (LASF)(lds + 67584 + 69632);
    LASF red = T + 2048; LASF den2 = red + 1024; LASF qn2 = den2 + 512;
    const int skip = layer == 0 ? 0 : 2;
    const int nun = 8 * (66 - skip);
    for (int u = bid; u < nun; u += nb) {
        const int c = skip + u % (66 - skip), bh = u / (66 - skip), b = bh >> 2, h = bh & 3;
        const size_t row0 = (size_t)b * SEQB + 128 * c;
        const int idxf = scan_idx(0, c), idxb = scan_idx(1, c);
        load_gates(p, layer, row0, h, T);
        for (int i = tid; i < 128 * 32; i += NTH) { const int t = i >> 5, ch = (i & 31) * 8;
            *(PG8_LAS u32x4*)(qs + t * 528 + ch * 2) = *(const u32x4*)(qc + (row0 + t) * 1024 + h * 256 + ch);
            *(PG8_LAS u32x4*)(ksm + t * 528 + ch * 2) = *(const u32x4*)(kc + (row0 + t) * 1024 + h * 256 + ch); }
        __syncthreads();
        const float mpf = p.ms[(bh * 2 + 0) * 67 + idxf], mpb = p.ms[(bh * 2 + 1) * 67 + idxb];
        if (tid < 128) {
            float bsum = 0.f, pm = -1e30f, a_me = 0.f; for (int r = 0; r <= tid; ++r) { bsum += T[128 + r]; const float a = T[r] - bsum; pm = fmaxf(pm, a); a_me = a; }
            const float g = fmaxf(mpf, pm); T[512 + tid] = a_me; T[768 + tid] = g; T[1024 + tid] = __expf(mpf - g); T[1280 + tid] = __expf(-(bsum + g));
        } else if (tid < 256) { const int t = tid - 128;
            float csum = 0.f, pm = -1e30f, a_me = 0.f; for (int r = 127; r >= t; --r) { csum += T[384 + r]; const float a = T[256 + r] - csum; pm = fmaxf(pm, a); a_me = a; }
            const float g = fmaxf(mpb, pm); T[640 + t] = a_me; T[896 + t] = g; T[1152 + t] = __expf(mpb - g); T[1408 + t] = __expf(-(csum + g));
        }
        { const int t = tid & 127, part = tid >> 7; float sf = 0.f, sb = 0.f;
          if (idxf > 0 || idxb > 0) {
              const float* nf = p.nst + ((size_t)(bh * 2 + 0) * 66 + (idxf > 0 ? idxf - 1 : 0)) * 256 + part * 64; const float* nbk = p.nst + ((size_t)(bh * 2 + 1) * 66 + (idxb > 0 ? idxb - 1 : 0)) * 256 + part * 64;
              for (int d8 = 0; d8 < 8; ++d8) { float f[8]; unpack8(*(const PG8_LAS u32x4*)(qs + t * 528 + (part * 64 + d8 * 8) * 2), f);
#pragma unroll
                  for (int e = 0; e < 8; ++e) { sf += f[e] * nf[d8 * 8 + e]; sb += f[e] * nbk[d8 * 8 + e]; } } }
          qn2[(part * 2 + 0) * 128 + t] = idxf > 0 ? sf : 0.f; qn2[(part * 2 + 1) * 128 + t] = idxb > 0 ? sb : 0.f; }
        const int tj = wid & 3, sg = wid >> 2;
        f32x16 sacc[2];
#pragma unroll
        for (int e = 0; e < 2; ++e)
#pragma unroll
            for (int r = 0; r < 16; ++r) sacc[e][r] = 0.f;
#pragma unroll 4
        for (int kk = 0; kk < 16; ++kk) { const bf16x8 bq = *(const PG8_LAS bf16x8*)(qs + (32 * tj + r32) * 528 + (16 * kk + 8 * hi) * 2);
#pragma unroll
            for (int e = 0; e < 2; ++e) { const bf16x8 ak = *(const PG8_LAS bf16x8*)(ksm + (32 * (2 * sg + e) + r32) * 528 + (16 * kk + 8 * hi) * 2);
                sacc[e] = __builtin_amdgcn_mfma_f32_32x32x16_bf16(ak, bq, sacc[e], 0, 0, 0); } }
        __syncthreads();
        { const int t = 32 * tj + r32; const float gf = T[768 + t], gb = T[896 + t]; float denf = 0.f, denb = 0.f;
#pragma unroll
          for (int e = 0; e < 2; ++e)
#pragma unroll
              for (int r4 = 0; r4 < 4; ++r4) { const int s0 = 32 * (2 * sg + e) + 8 * r4 + 4 * hi; float wf[4], wb[4];
#pragma unroll
                  for (int i = 0; i < 4; ++i) { const int s = s0 + i; const float sv = sacc[e][4 * r4 + i];
                      wf[i] = (s <= t) ? sv * __expf(T[512 + s] - gf) : 0.f; wb[i] = (s >= t) ? sv * __expf(T[640 + s] - gb) : 0.f; denf += wf[i]; denb += wb[i]; }
                  u32x2 w; w.x = pk2(wf[0], wf[1]); w.y = pk2(wf[2], wf[3]); *(PG8_LAS u32x2*)(Wf + t * 272 + s0 * 2) = w;
                  w.x = pk2(wb[0], wb[1]); w.y = pk2(wb[2], wb[3]); *(PG8_LAS u32x2*)(Wb + t * 272 + s0 * 2) = w; }
          denf += __shfl_xor(denf, 32); denb += __shfl_xor(denb, 32);
          if (hi == 0) { den2[(sg * 2 + 0) * 128 + t] = denf; den2[(sg * 2 + 1) * 128 + t] = denb; } }
        __syncthreads();
        const float* mng = p.m_norm_g + layer * 256;
#pragma unroll 1
        for (int jh = 0; jh < 2; ++jh) {
            f32x16 hs[2];
#pragma unroll
            for (int dir = 0; dir < 2; ++dir) {
                const int idx = dir ? idxb : idxf, bhd = bh * 2 + dir;
                f32x16 acc[2];
#pragma unroll
                for (int j = 0; j < 2; ++j)
#pragma unroll
                    for (int r = 0; r < 16; ++r) acc[j][r] = 0.f;
                if (idx > 0) {
                    const bf16_t* Cp = ST + ((size_t)bhd * 66 + idx - 1) * 65536 + (32 * wid + r32) * 256 + 8 * hi;
#pragma unroll 4
                    for (int kk = 0; kk < 16; ++kk) { const bf16x8 a = *(const bf16x8*)(Cp + 16 * kk);
#pragma unroll
                        for (int j = 0; j < 2; ++j) { const bf16x8 bq = *(const PG8_LAS bf16x8*)(qs + (32 * (2 * jh + j) + r32) * 528 + (16 * kk + 8 * hi) * 2);
                            acc[j] = __builtin_amdgcn_mfma_f32_32x32x16_bf16(a, bq, acc[j], 0, 0, 0); } }
#pragma unroll
                    for (int j = 0; j < 2; ++j) { const float wi = T[1024 + 128 * dir + 32 * (2 * jh + j) + r32];
#pragma unroll
                        for (int r = 0; r < 16; ++r) acc[j][r] *= wi; }
                }
                const bf16_t* vp = vT + ((size_t)(bh * 256 + 32 * wid + r32)) * SEQB + 128 * c + 8 * hi;
                const LDSP W = dir ? Wb : Wf;
#pragma unroll 4
                for (int ks = 0; ks < 8; ++ks) { const bf16x8 a = *(const bf16x8*)(vp + 16 * ks);
#pragma unroll
                    for (int j = 0; j < 2; ++j) { const bf16x8 bw = *(const PG8_LAS bf16x8*)(W + (32 * (2 * jh + j) + r32) * 272 + (16 * ks + 8 * hi) * 2);
                        acc[j] = __builtin_amdgcn_mfma_f32_32x32x16_bf16(a, bw, acc[j], 0, 0, 0); } }
#pragma unroll
                for (int j = 0; j < 2; ++j) { const int t = 32 * (2 * jh + j) + r32;
                    const float qn = qn2[(0 * 2 + dir) * 128 + t] + qn2[(1 * 2 + dir) * 128 + t] + qn2[(2 * 2 + dir) * 128 + t] + qn2[(3 * 2 + dir) * 128 + t];
                    const float den = den2[(0 * 2 + dir) * 128 + t] + den2[(1 * 2 + dir) * 128 + t] + T[1024 + 128 * dir + t] * qn;
                    const float inv = 1.0f / fmaxf(fabsf(den), T[1280 + 128 * dir + t]);
#pragma unroll
                    for (int r = 0; r < 16; ++r) hs[j][r] = dir ? hs[j][r] + acc[j][r] * inv : acc[j][r] * inv; }
            }
#pragma unroll
            for (int j = 0; j < 2; ++j) { float ssq = 0.f;
#pragma unroll
                for (int r = 0; r < 16; ++r) ssq += hs[j][r] * hs[j][r];
                ssq += __shfl_xor(ssq, 32); if (hi == 0) red[wid * 128 + 32 * (2 * jh + j) + r32] = ssq; }
            __syncthreads();
#pragma unroll
            for (int j = 0; j < 2; ++j) { const int t = 32 * (2 * jh + j) + r32; float tot = 0.f;
#pragma unroll
                for (int w = 0; w < 8; ++w) tot += red[w * 128 + t];
                const float rstd = rsqrtf(tot * (1.0f / 256.0f) + EPS_);
#pragma unroll
                for (int r4 = 0; r4 < 4; ++r4) { const int v0 = 32 * wid + 8 * r4 + 4 * hi; const size_t off = (row0 + t) * 1024 + h * 256 + v0;
                    const u32x2 g = *(const u32x2*)(mo + off); u32x2 w;
                    w.x = pk2(hs[j][4 * r4] * rstd * mng[v0] * sigmoidf_(lo16(g.x)), hs[j][4 * r4 + 1] * rstd * mng[v0 + 1] * sigmoidf_(hi16(g.x)));
                    w.y = pk2(hs[j][4 * r4 + 2] * rstd * mng[v0 + 2] * sigmoidf_(lo16(g.y)), hs[j][4 * r4 + 3] * rstd * mng[v0 + 3] * sigmoidf_(hi16(g.y)));
                    *(u32x2*)(ym + off) = w; } }
        }
        __syncthreads();
    }
}

__device__ __forceinline__ void hconv8(const bf16_t* src, bool hasp, bool hasn, const float* cw, const float* cb, int cch, float (&o)[8]) {
    float up[8], uc[8], un[8];
    unpack8(*(const u32x4*)src, uc);
    if (hasp) unpack8(*(const u32x4*)(src - 1024), up); else {
#pragma unroll
        for (int i = 0; i < 8; ++i) up[i] = 0.f; }
    if (hasn) unpack8(*(const u32x4*)(src + 1024), un); else {
#pragma unroll
        for (int i = 0; i < 8; ++i) un[i] = 0.f; }
#pragma unroll
    for (int i = 0; i < 8; ++i) o[i] = cb[cch + i] + up[i] * cw[cch + i] + uc[i] * cw[3072 + cch + i] + un[i] * cw[6144 + cch + i];
}
__device__ __forceinline__ void phase_hprep(const Params& p, int layer, const bf16_t* hx1, const bf16_t* hv, float* zT, LDSP lds, int bid, int nb) {
    const int tid = ltid(); LASF zt = (LASF)lds;
    const float* cw = p.h_conv_w + (size_t)layer * 3 * 3072; const float* cb = p.h_conv_b + layer * 3072;
    for (int u = bid; u < 2 * 128 * 4; u += nb) {
        const int cg = u & 3, tb = (u >> 2) & 127, b = u >> 9;
        const int t = tid >> 3, tl = tb * 64 + t; const size_t row = (size_t)b * SEQB + LC + tl; const bool hasp = tl != 0, hasn = tl != LL - 1;
#pragma unroll
        for (int v8 = 0; v8 < 4; ++v8) { const int cl = (tid & 7) * 32 + v8 * 8, c = cg * 256 + cl; float x1[8], vv[8];
            hconv8(hx1 + row * 1024 + c, hasp, hasn, cw, cb, 1024 + c, x1); hconv8(hv + row * 1024 + c, hasp, hasn, cw, cb, 2048 + c, vv);
#pragma unroll
            for (int i = 0; i < 8; ++i) zt[t * 257 + cl + i] = vv[i] * x1[i]; }
        __syncthreads();
        { const int cl = tid >> 1, th = tid & 1; float* dst = zT + ((size_t)(b * 1024 + cg * 256 + cl)) * LL + tb * 64 + 32 * th;
#pragma unroll
          for (int q = 0; q < 8; ++q) { float4 v; v.x = zt[(32 * th + 4 * q) * 257 + cl]; v.y = zt[(32 * th + 4 * q + 1) * 257 + cl]; v.z = zt[(32 * th + 4 * q + 2) * 257 + cl]; v.w = zt[(32 * th + 4 * q + 3) * 257 + cl];
              *(float4*)(dst + 4 * q) = v; } }
        __syncthreads();
    }
}

__device__ __forceinline__ f32x2v cmul_(f32x2v a, f32x2v b) { return mk2_(a.x * b.x - a.y * b.y, a.x * b.y + a.y * b.x); }
__device__ __forceinline__ f32x2v cmulc_(f32x2v a, f32x2v b) { return mk2_(a.x * b.x + a.y * b.y, a.y * b.x - a.x * b.y); }
__device__ __forceinline__ f32x2v cadd_(f32x2v a, f32x2v b) { return mk2_(a.x + b.x, a.y + b.y); }
__device__ __forceinline__ f32x2v csub_(f32x2v a, f32x2v b) { return mk2_(a.x - b.x, a.y - b.y); }
__device__ __forceinline__ int fphys(int i) { return i + (i >> 5); }
template <bool INV> __device__ __forceinline__ void bfly16(f32x2v (&v)[16], const f32x2v w1) {
    const f32x2v w2 = cmul_(w1, w1), w4 = cmul_(w2, w2), w8 = cmul_(w4, w4);
    const float C1 = 0.92387953251128674f, S1 = 0.38268343236508977f, R2 = 0.70710678118654752f;
    const f32x2v c16[8] = {mk2_(1.f, 0.f), mk2_(C1, -S1), mk2_(R2, -R2), mk2_(S1, -C1), mk2_(0.f, -1.f), mk2_(-S1, -C1), mk2_(-R2, -R2), mk2_(-C1, -S1)};
    if (!INV) {
#pragma unroll
        for (int m = 0; m < 8; ++m) { const f32x2v W = cmul_(w1, c16[m]); const f32x2v a = v[m], b = v[m + 8]; v[m] = cadd_(a, b); v[m + 8] = cmul_(csub_(a, b), W); }
#pragma unroll
        for (int g = 0; g < 16; g += 8)
#pragma unroll
            for (int m = 0; m < 4; ++m) { const f32x2v W = cmul_(w2, c16[2 * m]); const f32x2v a = v[g + m], b = v[g + m + 4]; v[g + m] = cadd_(a, b); v[g + m + 4] = cmul_(csub_(a, b), W); }
#pragma unroll
        for (int g = 0; g < 16; g += 4)
#pragma unroll
            for (int m = 0; m < 2; ++m) { const f32x2v W = cmul_(w4, c16[4 * m]); const f32x2v a = v[g + m], b = v[g + m + 2]; v[g + m] = cadd_(a, b); v[g + m + 2] = cmul_(csub_(a, b), W); }
#pragma unroll
        for (int g = 0; g < 16; g += 2) { const f32x2v a = v[g], b = v[g + 1]; v[g] = cadd_(a, b); v[g + 1] = cmul_(csub_(a, b), w8); }
    } else {
#pragma unroll
        for (int g = 0; g < 16; g += 2) { const f32x2v a = v[g], b = cmulc_(v[g + 1], w8); v[g] = cadd_(a, b); v[g + 1] = csub_(a, b); }
#pragma unroll
        for (int g = 0; g < 16; g += 4)
#pragma unroll
            for (int m = 0; m < 2; ++m) { const f32x2v W = cmul_(w4, c16[4 * m]); const f32x2v a = v[g + m], b = cmulc_(v[g + m + 2], W); v[g + m] = cadd_(a, b); v[g + m + 2] = csub_(a, b); }
#pragma unroll
        for (int g = 0; g < 16; g += 8)
#pragma unroll
            for (int m = 0; m < 4; ++m) { const f32x2v W = cmul_(w2, c16[2 * m]); const f32x2v a = v[g + m], b = cmulc_(v[g + m + 4], W); v[g + m] = cadd_(a, b); v[g + m + 4] = csub_(a, b); }
#pragma unroll
        for (int m = 0; m < 8; ++m) { const f32x2v W = cmul_(w1, c16[m]); const f32x2v a = v[m], b = cmulc_(v[m + 8], W); v[m] = cadd_(a, b); v[m + 8] = csub_(a, b); }
    }
}
template <bool INV, int S> __device__ __forceinline__ void fft_pass16(PG8_LAS f32x2v* cb) {
    constexpr int STR = S / 16;
    int tz = ltid();
#pragma unroll 1
    for (int k = 0; k < 2; ++k) { const int q = tz + NTH * k; const int j = q & (STR - 1), base = (q / STR) * S + j;
        f32x2v v[16];
#pragma unroll
        for (int m = 0; m < 16; ++m) v[m] = cb[fphys(base + STR * m)];
        const float rev = (float)j * (1.0f / (float)S); const f32x2v w1 = mk2_(cos2pi(rev), -sin2pi(rev));
        bfly16<INV>(v, w1);
#pragma unroll
        for (int m = 0; m < 16; ++m) cb[fphys(base + STR * m)] = v[m]; }
    __syncthreads();
}
__device__ __forceinline__ void r4_dif(f32x2v (&a)[4]) {
    const f32x2v b0 = cadd_(a[0], a[2]), b2 = csub_(a[0], a[2]), b1 = cadd_(a[1], a[3]); const f32x2v d = csub_(a[1], a[3]); const f32x2v b3 = mk2_(d.y, -d.x);
    a[0] = cadd_(b0, b1); a[1] = csub_(b0, b1); a[2] = cadd_(b2, b3); a[3] = csub_(b2, b3); }
__device__ __forceinline__ void r4_dit(f32x2v (&c)[4]) {
    const f32x2v b0 = cadd_(c[0], c[1]), b1 = csub_(c[0], c[1]), b2 = cadd_(c[2], c[3]), b3 = csub_(c[2], c[3]); const f32x2v ib3 = mk2_(-b3.y, b3.x);
    c[0] = cadd_(b0, b2); c[2] = csub_(b0, b2); c[1] = cadd_(b1, ib3); c[3] = csub_(b1, ib3); }

__device__ __forceinline__ void phase_fft(const Params& p, int layer, const float* tapsT, float* zT, float* Hscr, LDSP lds, int bid, int nb) {
    PG8_LAS f32x2v* cb = (PG8_LAS f32x2v*)lds; const int tid = ltid();
    for (int c = bid; c < 1024; c += nb) {
        for (int i = tid; i < 16384; i += NTH) cb[fphys(i)] = mk2_(tapsT[(size_t)c * 16384 + i], 0.f);
        __syncthreads();
        fft_pass16<false, 16384>(cb); fft_pass16<false, 1024>(cb); fft_pass16<false, 64>(cb);
        float ssq_c = 0.f;
#pragma unroll
        for (int q = 0; q < 8; ++q) ssq_c += p.sumsq[((size_t)(layer * 64 + (c >> 4)) * 8 + q) * 16 + (c & 15)];
        const float scale = rsqrtf(ssq_c + EPS_) * (1.0f / 16384.0f);
        f32x2v* Hs = (f32x2v*)(Hscr + (size_t)bid * 32768);
        int tz = ltid();
#pragma unroll 1
        for (int k = 0; k < 8; ++k) { const int q = tz + NTH * k; f32x2v a[4];
#pragma unroll
            for (int m = 0; m < 4; ++m) a[m] = cb[fphys(4 * q + m)];
            r4_dif(a);
#pragma unroll
            for (int m = 0; m < 4; ++m) Hs[4 * q + m] = mk2_(a[m].x * scale, a[m].y * scale); }
        __syncthreads();
        const float* z0 = zT + (size_t)c * LL; const float* z1 = zT + (size_t)(1024 + c) * LL;
        for (int i = tid; i < 8192; i += NTH) { cb[fphys(i)] = mk2_(z0[i], z1[i]); cb[fphys(8192 + i)] = mk2_(0.f, 0.f); }
        __syncthreads();
        fft_pass16<false, 16384>(cb); fft_pass16<false, 1024>(cb); fft_pass16<false, 64>(cb);
        asm volatile("" : "+v"(tz));
#pragma unroll 1
        for (int k = 0; k < 8; ++k) { const int q = tz + NTH * k; f32x2v a[4];
#pragma unroll
            for (int m = 0; m < 4; ++m) a[m] = cb[fphys(4 * q + m)];
            r4_dif(a);
#pragma unroll
            for (int m = 0; m < 4; ++m) a[m] = cmul_(a[m], Hs[4 * q + m]);
            r4_dit(a);
#pragma unroll
            for (int m = 0; m < 4; ++m) cb[fphys(4 * q + m)] = a[m]; }
        __syncthreads();
        fft_pass16<true, 64>(cb); fft_pass16<true, 1024>(cb); fft_pass16<true, 16384>(cb);
        float* y0 = zT + (size_t)c * LL; float* y1 = zT + (size_t)(1024 + c) * LL;
        for (int i = tid; i < 8192; i += NTH) { const f32x2v v = cb[fphys(i)]; y0[i] = v.x; y1[i] = v.y; }
        __syncthreads();
    }
}
__device__ __forceinline__ void phase_hfin(const Params& p, int layer, const bf16_t* hx0, const bf16_t* hx1, const bf16_t* hv, const float* yT, bf16_t* yh, LDSP lds, int bid, int nb) {
    const int tid = ltid(); LASF yt = (LASF)lds;
    const float* cw = p.h_conv_w + (size_t)layer * 3 * 3072; const float* cb = p.h_conv_b + layer * 3072; const float* hb = p.h_bias + layer * 1024;
    for (int u = bid; u < 2 * 128 * 4; u += nb) {
        const int cg = u & 3, tb = (u >> 2) & 127, b = u >> 9;
        { const int cl = tid >> 1, th = tid & 1; const float* src = yT + ((size_t)(b * 1024 + cg * 256 + cl)) * LL + tb * 64 + 32 * th;
#pragma unroll
          for (int q = 0; q < 8; ++q) { const float4 v = *(const float4*)(src + 4 * q); yt[cl * 65 + 32 * th + 4 * q] = v.x; yt[cl * 65 + 32 * th + 4 * q + 1] = v.y; yt[cl * 65 + 32 * th + 4 * q + 2] = v.z; yt[cl * 65 + 32 * th + 4 * q + 3] = v.w; } }
        __syncthreads();
        const int t = tid >> 3, tl = tb * 64 + t; const size_t row = (size_t)b * SEQB + LC + tl; const bool hasp = tl != 0, hasn = tl != LL - 1;
#pragma unroll
        for (int v8 = 0; v8 < 4; ++v8) { const int cl = (tid & 7) * 32 + v8 * 8, c = cg * 256 + cl; float x0[8], x1[8], vv[8], o[8];
            hconv8(hx0 + row * 1024 + c, hasp, hasn, cw, cb, c, x0); hconv8(hx1 + row * 1024 + c, hasp, hasn, cw, cb, 1024 + c, x1); hconv8(hv + row * 1024 + c, hasp, hasn, cw, cb, 2048 + c, vv);
#pragma unroll
            for (int i = 0; i < 8; ++i) o[i] = x0[i] * (yt[(cl + i) * 65 + t] + hb[c + i] * vv[i] * x1[i]);
            *(u32x4*)(yh + row * 1024 + c) = pack8(o); }
        __syncthreads();
    }
}
__device__ __forceinline__ void phase_hctx(const Params& p, int layer, const bf16_t* hx0, const bf16_t* hx1, const bf16_t* hv, bf16_t* yh, LDSP lds, int bid, int nb) {
    const int tid = ltid(); LASF zc = (LASF)lds, x0c = zc + 8192, hf = x0c + 8192, hbk = hf + 8192;
    const float* cw = p.h_conv_w + (size_t)layer * 3 * 3072; const float* cb = p.h_conv_b + layer * 3072; const float* hbias = p.h_bias + layer * 1024;
    for (int u = bid; u < 64; u += nb) {
        const int b = u >> 5, c0 = (u & 31) * 32;
        { const int t = tid >> 1, half = tid & 1; const size_t row = (size_t)b * SEQB + t; const bool hasp = t != 0, hasn = t != LC - 1;
#pragma unroll
          for (int v8 = 0; v8 < 2; ++v8) { const int cl = half * 16 + v8 * 8, c = c0 + cl; float x0[8], x1[8], vv[8];
              hconv8(hx0 + row * 1024 + c, hasp, hasn, cw, cb, c, x0); hconv8(hx1 + row * 1024 + c, hasp, hasn, cw, cb, 1024 + c, x1); hconv8(hv + row * 1024 + c, hasp, hasn, cw, cb, 2048 + c, vv);
#pragma unroll
              for (int i = 0; i < 8; ++i) { zc[t * 32 + cl + i] = vv[i] * x1[i]; x0c[t * 32 + cl + i] = x0[i]; } } }
        for (int i = tid; i < 256 * 32; i += NTH) { const int j = i & 255, cl = i >> 8; const float rs = rsqrtf(p.sumsqC[c0 + cl] + EPS_);
            hf[j * 32 + cl] = p.hfC[(size_t)(c0 + cl) * 256 + j] * rs; hbk[j * 32 + cl] = p.hbC[(size_t)(c0 + cl) * 256 + j] * rs; }
        __syncthreads();
        { const int cl = tid & 31, tg = tid >> 5;
#pragma unroll 1
          for (int ti = 0; ti < 16; ++ti) { const int t = tg + 16 * ti; float y = 0.f;
#pragma unroll 4
              for (int j = 0; j <= t; ++j) y += hf[j * 32 + cl] * zc[(t - j) * 32 + cl];
#pragma unroll 4
              for (int j = 1; j <= 255 - t; ++j) y += hbk[j * 32 + cl] * zc[(t + j) * 32 + cl];
              const float o = x0c[t * 32 + cl] * (y + hbias[c0 + cl] * zc[t * 32 + cl]);
              yh[((size_t)b * SEQB + t) * 1024 + c0 + cl] = f2bf(o); } }
        __syncthreads();
    }
}

struct MergeOrder { int ntile, G, c, lat_only;
    __device__ __forceinline__ bool next(int i, pg8::Unit& u) const { const int tile = (i / 3) * G + c, j = i - (i / 3) * 3; if (tile >= ntile) return false;
        int pi = tile >> 2; const int n = tile & 3; if (lat_only) pi = (pi >> 5) * 33 + 1 + (pi & 31);
        u.pm = j * NPAN + pi; u.pn = j * 4 + n; return true; }
    __device__ __forceinline__ void a_ready(const pg8::Unit&) const {}
    __device__ __forceinline__ void done(const pg8::Unit&) const {} };
struct MergeEpi { static constexpr bool PERM = true, AFTER_DRAIN = false;
    const bf16_t* gates; const float* mb; bf16_t* ysum;
    __device__ __forceinline__ void operator()(const f32x4 (&acc)[2][2][4][2], const pg8::Unit& u, int wr, int wc, int fr, int fq) const {
        const int j = u.pn >> 2, pi = u.pm - j * NPAN, nt = u.pn & 3;
        const int row0 = pi * 256 + wr * 64 + fr, col0 = nt * 256 + wc * 32 + 8 * fq;
#pragma unroll
        for (int bj = 0; bj < 2; ++bj) { const int col = col0 + bj * 128; float mbv[8];
#pragma unroll
            for (int i = 0; i < 8; ++i) mbv[i] = mb[j * 1024 + col + i];
#pragma unroll
            for (int ai = 0; ai < 2; ++ai)
#pragma unroll
                for (int m = 0; m < 4; ++m) { const size_t off = (size_t)(row0 + ai * 128 + m * 16) * 1024 + col;
                    float g[8], o[8]; unpack8(*(const u32x4*)(gates + (size_t)j * TT * 1024 + off), g);
#pragma unroll
                    for (int i = 0; i < 8; ++i) o[i] = sigmoidf_(g[i] + mbv[i]) * acc[ai][bj][m][i >> 2][i & 3];
                    if (j > 0) { float old[8]; unpack8(*(const u32x4*)(ysum + off), old);
#pragma unroll
                        for (int i = 0; i < 8; ++i) o[i] += old[i]; }
                    *(u32x4*)(ysum + off) = pack8(o); } }
    } };
struct OutOrder { int ntile, G, c, lat_only;
    __device__ __forceinline__ bool next(int i, pg8::Unit& u) const { const int tile = i * G + c; if (tile >= ntile) return false;
        int pi = tile >> 2; if (lat_only) pi = (pi >> 5) * 33 + 1 + (pi & 31); u.pm = pi; u.pn = tile & 3; return true; }
    __device__ __forceinline__ void a_ready(const pg8::Unit&) const {}
    __device__ __forceinline__ void done(const pg8::Unit&) const {} };
struct OutEpi { static constexpr bool PERM = false, AFTER_DRAIN = false;
    const Params* p; int layer;
    __device__ __forceinline__ void operator()(const f32x4 (&acc)[2][2][4][2], const pg8::Unit& u, int wr, int wc, int fr, int fq) const {
        const int row0 = u.pm * 256 + wr * 64 + fr, col0 = u.pn * 256 + wc * 32 + 4 * fq;
        const float* g1 = modvec(*p, layer, u.pm * 256) + 2048;
#pragma unroll
        for (int ai = 0; ai < 2; ++ai)
#pragma unroll
            for (int m = 0; m < 4; ++m) { const int s = row0 + ai * 128 + m * 16; const float* rin = resid_row_in(*p, layer, s); float* ro = resid_row(*p, s);
#pragma unroll
                for (int bj = 0; bj < 2; ++bj)
#pragma unroll
                    for (int n = 0; n < 2; ++n) { const int col = col0 + bj * 128 + n * 16; const f32x4 x = *(const f32x4*)(rin + col), g = *(const f32x4*)(g1 + col);
                        *(f32x4*)(ro + col) = x + g * acc[ai][bj][m][n]; } }
    } };
struct MoeOrder { const PG8_LAS int* te; int ntl, G, c;
    __device__ __forceinline__ bool next(int i, pg8::Unit& u) const { const int L = i * G + c; if (L >= ntl * 4) return false; const int tile = L >> 2; u.pm = tile; u.pn = te[tile] * 4 + (L & 3); return true; }
    __device__ __forceinline__ void a_ready(const pg8::Unit&) const {}
    __device__ __forceinline__ void done(const pg8::Unit&) const {} };
struct E1Epi { static constexpr bool PERM = true, AFTER_DRAIN = false;
    bf16_t* H;
    __device__ __forceinline__ void operator()(const f32x4 (&acc)[2][2][4][2], const pg8::Unit& u, int wr, int wc, int fr, int fq) const {
        const int row0 = u.pm * 256 + wr * 64 + fr, hid0 = ((u.pn & 3) * 256 + wc * 32 + 8 * fq) >> 1;
#pragma unroll
        for (int ai = 0; ai < 2; ++ai)
#pragma unroll
            for (int m = 0; m < 4; ++m)
#pragma unroll
                for (int bj = 0; bj < 2; ++bj) { const f32x4 a = acc[ai][bj][m][0], b = acc[ai][bj][m][1]; u32x2 w;
                    w.x = pk2(siluf_(a[0]) * b[0], siluf_(a[1]) * b[1]); w.y = pk2(siluf_(a[2]) * b[2], siluf_(a[3]) * b[3]);
                    *(u32x2*)(H + (size_t)(row0 + ai * 128 + m * 16) * 512 + hid0 + bj * 64) = w; }
    } };

__device__ __forceinline__ void phase_norm2_router(const Params& p, int layer, LDSP lds, int bid, int nb) {
    LASF rw = (LASF)lds;
    const int tid = ltid(), lane = tid & 63, wid = tid >> 6;
    for (int i = tid; i < 1024 * 8; i += NTH) { const int n = i >> 3, e4 = (i & 7) * 4; const float4 v = *(const float4*)(p.router_w + n * 32 + e4);
        rw[n * 36 + e4] = v.x; rw[n * 36 + e4 + 1] = v.y; rw[n * 36 + e4 + 2] = v.z; rw[n * 36 + e4 + 3] = v.w; }
    __syncthreads();
    const float* gn = p.norm2_g + layer * 1024;
    for (int s = bid * 8 + wid; s < TT; s += nb * 8) {
        const int pos = s % SEQB; if (layer == 1 && pos < LC) continue;
        const float* xr = resid_row(p, s); const float* mv = modvec(p, layer, s);
        float ssq = 0.f;
#pragma unroll
        for (int i = 0; i < 16; ++i) { const float xv = xr[lane + 64 * i]; ssq += xv * xv; }
        ssq = wave_sum(ssq); const float rstd = rsqrtf(ssq * (1.0f / 1024.0f) + EPS_);
        float acc[32];
#pragma unroll
        for (int e = 0; e < 32; ++e) acc[e] = 0.f;
#pragma unroll 2
        for (int i = 0; i < 16; ++i) { const int n = lane + 64 * i; const float hv = xr[n] * rstd * gn[n] * (1.0f + mv[4096 + n]) + mv[3072 + n];
            p.hn[(size_t)s * 1024 + n] = f2bf(hv);
#pragma unroll
            for (int e4 = 0; e4 < 8; ++e4) { const f32x4 w = *(const PG8_LAS f32x4*)(rw + n * 36 + 4 * e4); acc[4 * e4] += hv * w.x; acc[4 * e4 + 1] += hv * w.y; acc[4 * e4 + 2] += hv * w.z; acc[4 * e4 + 3] += hv * w.w; } }
        float sv[32], sb[32];
#pragma unroll
        for (int e = 0; e < 32; ++e) { const float lg = wave_sum(acc[e]); sv[e] = sigmoidf_(lg); sb[e] = sv[e] + p.router_b[e]; }
        float best = -1e30f, bs1 = 0.f, bs2 = 0.f; int be1 = 0, be2 = 1;
#pragma unroll
        for (int g = 0; g < 4; ++g) { float v1 = -1e30f, v2 = -1e30f, s1 = 0.f, s2 = 0.f; int i1 = 0, i2 = 0;
#pragma unroll
            for (int q = 0; q < 8; ++q) { const int e = g * 8 + q; const float v = sb[e];
                if (v > v1) { v2 = v1; i2 = i1; s2 = s1; v1 = v; i1 = e; s1 = sv[e]; } else if (v > v2) { v2 = v; i2 = e; s2 = sv[e]; } }
            const float gsc = v1 + v2; if (gsc > best) { best = gsc; be1 = i1; be2 = i2; bs1 = s1; bs2 = s2; } }
        if (lane == 0) { const float inv = 1.0f / (bs1 + bs2); p.sel_e[s * 2] = be1; p.sel_e[s * 2 + 1] = be2; p.sel_w[s * 2] = bs1 * inv; p.sel_w[s * 2 + 1] = bs2 * inv;
            atomicAdd(p.cnt + layer * 32 + be1, 1); atomicAdd(p.cnt + layer * 32 + be2, 1); }
    }
    __syncthreads();
}
__device__ __forceinline__ int moe_plan(const Params& p, int layer, PG8_LAS int* pstart, PG8_LAS int* te) {
    if (ltid() == 0) { int tl = 0; for (int e = 0; e < 32; ++e) { const int cn = p.cnt[layer * 32 + e]; pstart[e] = tl * 256; const int nt = (cn + 255) >> 8; for (int q = 0; q < nt; ++q) te[tl + q] = e; tl += nt; } pstart[32] = tl; }
    __syncthreads();
    return pstart[32];
}
__device__ __forceinline__ void phase_moe_gather(const Params& p, int layer, bf16_t* Xg, LDSP lds, int bid, int nb) {
    PG8_LAS int* pstart = (PG8_LAS int*)lds; PG8_LAS int* te = pstart + 64;
    moe_plan(p, layer, pstart, te);
    const int tid = ltid(), lane = tid & 63, wid = tid >> 6;
    for (int s = bid * 8 + wid; s < TT; s += nb * 8) {
        const int pos = s % SEQB; if (layer == 1 && pos < LC) continue;
        const int e0 = p.sel_e[s * 2], e1 = p.sel_e[s * 2 + 1]; int p0 = 0, p1 = 0;
        if (lane == 0) { p0 = pstart[e0] + atomicAdd(p.cur + layer * 32 + e0, 1); p1 = pstart[e1] + atomicAdd(p.cur + layer * 32 + e1, 1); p.posbuf[s * 2] = p0; p.posbuf[s * 2 + 1] = p1; }
        p0 = __shfl(p0, 0); p1 = __shfl(p1, 0);
        const u32x4* src = (const u32x4*)(p.hn + (size_t)s * 1024);
        const u32x4 a = src[lane], b2 = src[64 + lane];
        u32x4* d0 = (u32x4*)(Xg + (size_t)p0 * 1024); u32x4* d1 = (u32x4*)(Xg + (size_t)p1 * 1024);
        d0[lane] = a; d0[64 + lane] = b2; d1[lane] = a; d1[64 + lane] = b2;
    }
    __syncthreads();
}
__device__ __forceinline__ void phase_moe_combine(const Params& p, int layer, const bf16_t* Yb, int bid, int nb) {
    const int tid = ltid(), lane = tid & 63, wid = tid >> 6;
    for (int s = bid * 8 + wid; s < TT; s += nb * 8) {
        const int pos = s % SEQB; if (layer == 1 && pos < LC) continue;
        const int p0 = p.posbuf[s * 2], p1 = p.posbuf[s * 2 + 1]; const float w0 = p.sel_w[s * 2], w1 = p.sel_w[s * 2 + 1];
        float* xr = resid_row(p, s); const float* g2 = modvec(p, layer, s) + 5120;
#pragma unroll
        for (int i = 0; i < 4; ++i) { const int col = 4 * lane + 256 * i; const u32x2 a = *(const u32x2*)(Yb + (size_t)p0 * 1024 + col), b = *(const u32x2*)(Yb + (size_t)p1 * 1024 + col);
            f32x4 x = *(const f32x4*)(xr + col); const f32x4 g = *(const f32x4*)(g2 + col);
            x[0] += g[0] * (w0 * lo16(a.x) + w1 * lo16(b.x)); x[1] += g[1] * (w0 * hi16(a.x) + w1 * hi16(b.x)); x[2] += g[2] * (w0 * lo16(a.y) + w1 * lo16(b.y)); x[3] += g[3] * (w0 * hi16(a.y) + w1 * hi16(b.y));
            *(f32x4*)(xr + col) = x; }
    }
}

constexpr size_t R_BYTES = 12 * UU;
constexpr size_t OFF_WT13 = 0, OFF_WT2 = OFF_WT13 + (size_t)32 * 1024 * 1024 * 2, OFF_XG = OFF_WT2 + (size_t)32 * 1024 * 512 * 2, OFF_H = OFF_XG + (size_t)TPAD * 1024 * 2, OFF_YB = OFF_H + (size_t)TPAD * 512 * 2;
static_assert(OFF_YB + (size_t)TPAD * 1024 * 2 <= R_BYTES, "MoE buffers must fit the big region");

#define GRID_BAR() do { xcd_barrier(bar); asm volatile("" : "+s"(bid), "+s"(nb)); } while (0)

constexpr int PW = (int)(sizeof(Params) / 8);
static_assert(sizeof(Params) % 8 == 0 && sizeof(Params) <= 1024, "Params is a block of 8-byte words");
struct ParamsRaw { unsigned long long w[PW]; };
template <int layer> __device__ __forceinline__ void layer_body(const Params& p, const XcdBarrier& bar, LDSP lds, int& bid, int& nb);
__global__ void __launch_bounds__(512, 2) fwd_kernel(ParamsRaw raw, unsigned long long* gp, unsigned* barw) {
    extern __shared__ __attribute__((aligned(16))) unsigned char shm[];
    LDSP lds = (LDSP)shm;
    int bid = blockIdx.x, nb = gridDim.x; const int tid = threadIdx.x;
    unsigned long long* mygp = gp + (size_t)bid * 128;
    if (tid == 0) {
#pragma unroll
        for (int k = 0; k < PW; ++k) mygp[k] = raw.w[k];
        *(PG8_LAS u32x4*)(lds + LDS_BYTES - 16) = (u32x4){0u, 0u, 0u, 0u};
        asm volatile("s_waitcnt vmcnt(0)" ::: "memory"); }
    __syncthreads();
    const Params& p = *(const Params*)mygp;
    XcdBarrier bar = xcd_barrier_post(barw, (volatile LAS unsigned*)(lds + LDS_BYTES - 16));

#define RB ((unsigned char*)p.R)
#define aq ((bf16_t*)(RB))
#define ak ((bf16_t*)(RB + UU))
#define av ((bf16_t*)(RB + 2 * UU))
#define hx0 ((bf16_t*)(RB + 3 * UU))
#define hx1 ((bf16_t*)(RB + 4 * UU))
#define hv ((bf16_t*)(RB + 5 * UU))
#define zT ((float*)(RB + 6 * UU))
#define tapsT ((float*)(RB + 8 * UU))
#define ST ((bf16_t*)(RB))
#define mq ((bf16_t*)(RB + UU))
#define mk ((bf16_t*)(RB + 2 * UU))
#define mv ((bf16_t*)(RB + 3 * UU))
#define mo ((bf16_t*)(RB + 4 * UU))
#define gates ((bf16_t*)(RB + 5 * UU))
#define qc ((bf16_t*)(RB + 8 * UU))
#define kc ((bf16_t*)(RB + 9 * UU))
#define kT ((bf16_t*)(RB + 10 * UU))
#define vT ((bf16_t*)(RB + 11 * UU))
#define Wt13 ((bf16_t*)(RB + OFF_WT13))
#define Wt2 ((bf16_t*)(RB + OFF_WT2))
#define Xg ((bf16_t*)(RB + OFF_XG))
#define Hb ((bf16_t*)(RB + OFF_H))
#define Yb ((bf16_t*)(RB + OFF_YB))
#define ym ((bf16_t*)p.Y3)
#define ya ((bf16_t*)p.Y3 + (size_t)TT * 1024)
#define yh ((bf16_t*)p.Y3 + (size_t)2 * TT * 1024)

    phase_conv_small(p, 0, lds, bid, nb);
    phase_modvec(p, lds, bid, nb);
    phase_hdn(p, lds, bid, nb);
    GRID_BAR();
    layer_body<0>(p, bar, lds, bid, nb);
#if defined(PROBE_LEVEL) && (PROBE_LEVEL == 1 || PROBE_LEVEL == 2)
    return;
#endif
    layer_body<1>(p, bar, lds, bid, nb);
    if (bid == 0 && tid == 0 && xb_ld(&barw[XB_TMO]) != 0u) p.out[0] = __builtin_nanf("");
}
template <int layer> __device__ __forceinline__ void layer_body(const Params& p, const XcdBarrier& bar, LDSP lds, int& bid, int& nb) {
        phase_norm1(p, layer, lds, bid, nb);
        phase_taps(p, layer, tapsT, lds, bid, nb);
        GRID_BAR();
        { pg8::Gemm g{p.hn, p.Wt_in, TT, 6144, 1024}; pg8::StaticOrder S; S.init(TT, 6144, nb, bid);
          pg8::EpiBf16<0> E{aq, 1024, nullptr, 1024, (size_t)TT * 1024};
          pg8::gemm_phase<pg8::EpiBf16<0>, pg8::StaticOrder, false>(lds, g, S, E, nullptr); }
        GRID_BAR();
        phase_attn_prep(p, layer, aq, ak, bid, nb);
        phase_hprep(p, layer, hx1, hv, zT, lds, bid, nb);
        if (layer == 0) phase_hctx(p, layer, hx0, hx1, hv, yh, lds, bid, nb);
        GRID_BAR();
        phase_fft(p, layer, tapsT, zT, (float*)(RB + 10 * UU), lds, bid, nb);
        phase_attn(p, layer, aq, ak, av, ya, lds, bid, nb);
        GRID_BAR();
        phase_hfin(p, layer, hx0, hx1, hv, zT, yh, lds, bid, nb);
        GRID_BAR();
        { pg8::Gemm g{p.hn, p.Wt_in + (size_t)6144 * 1024, TT, 7168, 1024}; pg8::StaticOrder S; S.init(TT, 7168, nb, bid);
          pg8::EpiBf16<0> E{mq, 1024, nullptr, 1024, (size_t)TT * 1024};
          pg8::gemm_phase<pg8::EpiBf16<0>, pg8::StaticOrder, false>(lds, g, S, E, nullptr); }
        GRID_BAR();
        phase_mprep(p, layer, mq, mk, mv, qc, kc, kT, vT, lds, bid, nb);
        GRID_BAR();
        phase_mA(p, layer, kT, vT, ST, lds, bid, nb);
        GRID_BAR();
        phase_mB(p, ST, bid, nb);
        GRID_BAR();
        phase_mC(p, layer, qc, kc, vT, mo, ST, ym, lds, bid, nb);
        GRID_BAR();
        { pg8::Gemm g{p.Y3, p.Wt_br, 3 * TT, 3072, 1024}; MergeOrder S{layer == 0 ? 264 : 256, nb, bid, layer == 0 ? 0 : 1};
          MergeEpi E{gates, p.merge_b + layer * 3072, p.hn};
          pg8::gemm_phase<MergeEpi, MergeOrder, false>(lds, g, S, E, nullptr); }
        GRID_BAR();
        { pg8::Gemm g{p.hn, p.Wt_out, TT, 1024, 1024}; OutOrder S{layer == 0 ? 264 : 256, nb, bid, layer == 0 ? 0 : 1};
          OutEpi E{&p, layer};
          pg8::gemm_phase<OutEpi, OutOrder, false>(lds, g, S, E, nullptr); }
        __syncthreads();
#if defined(PROBE_LEVEL) && PROBE_LEVEL == 1
        if (layer == 0) return;
#endif
#if defined(PROBE_LEVEL) && PROBE_LEVEL == 3
        if (layer == 1) return;
#endif
        phase_conv_experts(p, layer, Wt13, Wt2, lds, bid, nb);
        GRID_BAR();
        phase_norm2_router(p, layer, lds, bid, nb);
        GRID_BAR();
        phase_moe_gather(p, layer, Xg, lds, bid, nb);
        GRID_BAR();
        { PG8_LAS int* pstart = (PG8_LAS int*)(lds + 132 * 1024); PG8_LAS int* te = pstart + 64;
          const int ntl = moe_plan(p, layer, pstart, te);
          { pg8::Gemm g{Xg, Wt13, TPAD, 32 * 1024, 1024}; MoeOrder S{te, ntl, nb, bid}; E1Epi E{Hb};
            pg8::gemm_phase<E1Epi, MoeOrder, false>(lds, g, S, E, nullptr); }
          GRID_BAR();
          { pg8::Gemm g{Hb, Wt2, TPAD, 32 * 1024, 512}; MoeOrder S{te, ntl, nb, bid}; pg8::EpiBf16<0> E{Yb, 1024, nullptr, 1024, (size_t)0};
            pg8::gemm_phase<pg8::EpiBf16<0>, MoeOrder, false>(lds, g, S, E, nullptr); }
          GRID_BAR(); }
        phase_moe_combine(p, layer, Yb, bid, nb);
        if (layer == 0) phase_conv_small(p, 1, lds, bid, nb);
        GRID_BAR();
}

extern "C" void kernel_launch(void* const* d_in, const int* in_sizes, int n_in, void* d_out, int out_size, void* d_ws, size_t ws_size, hipStream_t stream) {
    (void)in_sizes; (void)n_in; (void)out_size;
    Params p; memset(&p, 0, sizeof(p));
    const float* const* in = (const float* const*)d_in;
    p.x = in[0]; p.c = in[1]; p.ctx = in[2]; p.c_ctx = in[3]; p.mod_w = in[4]; p.mod_b = in[5]; p.norm1_g = in[6]; p.norm2_g = in[7]; p.w_in = in[8]; p.merge_b = in[9];
    p.m_conv_w = in[10]; p.m_conv_b = in[11]; p.m_gate_b = in[12]; p.m_norm_g = in[13]; p.a_qnorm_g = in[14]; p.a_knorm_g = in[15]; p.a_lambda = in[16]; p.a_subln_g = in[17];
    p.h_conv_w = in[18]; p.h_conv_b = in[19]; p.h_ffn_w1 = in[20]; p.h_ffn_b1 = in[21]; p.h_ffn_w2 = in[22]; p.h_ffn_b2 = in[23]; p.h_ffn_w3 = in[24]; p.h_freq = in[25]; p.h_decay = in[26]; p.h_bias = in[27];
    p.w_br_m = in[28]; p.w_br_a = in[29]; p.w_br_h = in[30]; p.w_out = in[31]; p.router_w = in[32]; p.router_b = in[33]; p.e_w1 = in[34]; p.e_w3 = in[35]; p.e_w2 = in[36];
    p.out = (float*)d_out;
    unsigned char* w = (unsigned char*)d_ws; size_t off = 0;
    auto take = [&](size_t bytes) { unsigned char* r = w + off; off += (bytes + 255) & ~(size_t)255; return r; };
    constexpr size_t ZERO_BYTES = 32768;
    unsigned char* z = take(ZERO_BYTES);
    p.bar = (unsigned*)z; p.cnt = (int*)(z + 16384); p.cur = (int*)(z + 16384 + 256); p.sumsq = (float*)take((size_t)2 * 64 * 8 * 16 * 4); p.sumsqC = (float*)take((size_t)1024 * 4);
    p.modv = (float*)take((size_t)6 * 6144 * 4); p.hdn2 = (float*)take((size_t)2 * 8448 * 64 * 4); p.G = (float*)take((size_t)TT * 16 * 4); p.xc = (float*)take((size_t)512 * 1024 * 4);
    p.sel_e = (int*)take((size_t)TT * 2 * 4); p.sel_w = (float*)take((size_t)TT * 2 * 4); p.posbuf = (int*)take((size_t)TT * 2 * 4);
    p.scal = (float*)take((size_t)16 * 66 * 2 * 4); p.ms = (float*)take((size_t)16 * 67 * 4); p.dn = (float*)take((size_t)16 * 66 * 256 * 4); p.nst = (float*)take((size_t)16 * 66 * 256 * 4);
    p.hfC = (float*)take((size_t)1024 * 256 * 4); p.hbC = (float*)take((size_t)1024 * 256 * 4);
    p.Wt_in = (bf16_t*)take((size_t)13312 * 1024 * 2); p.Wt_br = (bf16_t*)take((size_t)3072 * 1024 * 2); p.Wt_out = (bf16_t*)take((size_t)1024 * 1024 * 2);
    unsigned long long* gpbuf = (unsigned long long*)take((size_t)1024 * 1024);
    p.hn = (bf16_t*)take(UU); p.Y3 = (bf16_t*)take(3 * UU); p.R = take(R_BYTES);
    if (off > ws_size) { fprintf(stderr, "kernel_launch: workspace too small: need %zu, have %zu\n", off, ws_size); return; }
    static int grid = 0;
    if (!grid) {
        int dev = 0, cus = 0; (void)hipGetDevice(&dev); (void)hipDeviceGetAttribute(&cus, hipDeviceAttributeMultiprocessorCount, dev);
        if (hipFuncSetAttribute((const void*)fwd_kernel, hipFuncAttributeMaxDynamicSharedMemorySize, LDS_BYTES) != hipSuccess) { fprintf(stderr, "kernel_launch: hipFuncSetAttribute failed\n"); return; }
        int per_cu = 0; (void)hipOccupancyMaxActiveBlocksPerMultiprocessor(&per_cu, (const void*)fwd_kernel, NTH, LDS_BYTES);
        if (per_cu < 1) fprintf(stderr, "kernel_launch: occupancy query reports %d blocks per CU\n", per_cu);
        grid = cus > 0 ? (cus > 1024 ? 1024 : cus) : 256;
    }
    (void)hipMemsetAsync(z, 0, ZERO_BYTES, stream);
    ParamsRaw raw; memcpy(&raw, &p, sizeof(raw));
    hipLaunchKernelGGL(fwd_kernel, dim3(grid), dim3(NTH), LDS_BYTES, stream, raw, gpbuf, (unsigned*)z);
}
```

```cpp
#include <hip/hip_runtime.h>
#include <cstdio>
#include <cstdint>
#include <cstring>
#define REPEAT_MASK 0
#define XB_TMO      128
#define XB_XCNT(j)  (256  + 64 * (j))
#define XB_XSUB(j)  (1280 + 64 * (j))
#define XB_XGEN(j)  (2304 + 64 * (j))
#define XB_TOP      3328
#define XB_TOPGEN   3392
#define XCD_BAR_WORDS 3456
#define XB_SPIN_CAP (1u << 24)
#define LAS __attribute__((address_space(3)))

__device__ __forceinline__ unsigned xb_ld(unsigned* p)              { return __hip_atomic_load(p, __ATOMIC_RELAXED, __HIP_MEMORY_SCOPE_AGENT); }
__device__ __forceinline__ unsigned xb_add(unsigned* p, unsigned v) { return __hip_atomic_fetch_add(p, v, __ATOMIC_RELAXED, __HIP_MEMORY_SCOPE_AGENT); }
__device__ __forceinline__ unsigned xb_xcc_id() { return (unsigned)__builtin_amdgcn_s_getreg((3 << 11) | 20) & 0xFu; }
#define XB_SPIN(cond, bar) do { unsigned _sp = 0; while (cond) { __builtin_amdgcn_s_sleep(1); \
    if ((++_sp & 255u) == 0u) { if (xb_ld(&(bar)[XB_TMO])) break; if (_sp > XB_SPIN_CAP) { atomicAdd(&(bar)[XB_TMO], 1u); break; } } } } while (0)

struct XcdBarrier {
    unsigned* bar; unsigned x;
    volatile LAS unsigned* st;
};

__device__ __forceinline__ XcdBarrier xcd_barrier_post(unsigned* bar, volatile LAS unsigned* st) {
    XcdBarrier b; b.bar = bar; b.x = xb_xcc_id(); b.st = st;
    if (threadIdx.x == 0) (void)xb_add(&bar[XB_XCNT(b.x)], 1u);
    return b;
}
__device__ __forceinline__ void xcd_barrier_complete(unsigned* bar, unsigned x, unsigned& nloc, unsigned& nx) {
    const unsigned G = gridDim.x * gridDim.y * gridDim.z;
    unsigned sum, cnt, mine, sp = 0u;
    for (;;) {
        sum = 0u; cnt = 0u; mine = 0u;
#pragma unroll
        for (unsigned j = 0; j < 16; ++j) { const unsigned c = xb_ld(&bar[XB_XCNT(j)]); sum += c; cnt += (c > 0u) ? 1u : 0u; mine = (j == x) ? c : mine; }
        if (sum == G) break;
        __builtin_amdgcn_s_sleep(1);
        if ((++sp & 255u) == 0u) { if (xb_ld(&bar[XB_TMO])) break; if (sp > XB_SPIN_CAP) { atomicAdd(&bar[XB_TMO], 1u); break; } }
    }
    nloc = mine > 0u ? mine : 1u; nx = cnt > 0u ? cnt : 1u;
}

__device__ __forceinline__ void xcd_barrier(const XcdBarrier& b) {
    asm volatile("s_waitcnt vmcnt(0)" ::: "memory");
    __syncthreads();
    if (threadIdx.x == 0) {
        unsigned* bar = b.bar;
        __builtin_amdgcn_s_waitcnt(0);
        unsigned nloc = b.st[0], nx = b.st[1];
        if (nloc == 0u) { xcd_barrier_complete(bar, b.x, nloc, nx); b.st[0] = nloc; b.st[1] = nx; }
        const unsigned old = xb_add(&bar[XB_XSUB(b.x)], 1u);
        const unsigned gen = old / nloc;
        if (old + 1u == (gen + 1u) * nloc) {
            __builtin_amdgcn_fence(__ATOMIC_RELEASE, "agent");
            asm volatile("s_waitcnt vmcnt(0)" ::: "memory");
            const unsigned og = xb_add(&bar[XB_TOP], 1u);
            const unsigned tg = og / nx;
            if (og + 1u == (tg + 1u) * nx) xb_add(&bar[XB_TOPGEN], 1u);
            else XB_SPIN(xb_ld(&bar[XB_TOPGEN]) == tg, bar);
            __builtin_amdgcn_fence(__ATOMIC_ACQUIRE, "agent");
            xb_add(&bar[XB_XGEN(b.x)], 1u);
            asm volatile("s_waitcnt vmcnt(0)" ::: "memory");
        } else {
            XB_SPIN(xb_ld(&bar[XB_XGEN(b.x)]) == gen, bar);
            __builtin_amdgcn_fence(__ATOMIC_ACQUIRE, "agent");
            asm volatile("s_waitcnt vmcnt(0)" ::: "memory");
        }
    }
    __syncthreads();
}
namespace pg8 {
#define PG8_LAS __attribute__((address_space(3)))
typedef unsigned short bf16_t;
typedef short bf16x8 __attribute__((ext_vector_type(8)));
typedef float f32x4 __attribute__((ext_vector_type(4)));
typedef unsigned u32x4 __attribute__((ext_vector_type(4)));
constexpr int BM = 256, BK = 64, HALF = 128, HTB = HALF * BK * 2  , STAGE_BYTES = 8 * HTB, NXCD = 8, WGM = 8;

__host__ __device__ __forceinline__ int lds_byte(int r, int c) { const int st = (r >> 4) * 2 + (c >> 5), rr = r & 15, cc = c & 31, ob = rr * 64 + cc * 2; return st * 1024 + (ob ^ (((ob >> 9) & 1) << 5)); }
__host__ __device__ __forceinline__ void stage_rc(int b, int& R, int& C) { const int st = b / 1024, sb = b % 1024, swz = sb ^ (((sb >> 9) & 1) << 5); R = (st >> 1) * 16 + swz / 64; C = (st & 1) * 32 + (swz % 64) / 2; }
__host__ __device__ __forceinline__ int perm32(int rho) { const int n = rho >> 4, i = rho & 15; return 8 * (i >> 2) + 4 * n + (i & 3); }

struct Unit { int pm, pn; };
struct Gemm { const bf16_t* A; const bf16_t* Bt; int M, N, K; };

struct StaticOrder {
    int nM, nN, nwg, G, c;
    __host__ __device__ void init(int M, int N, int G_, int c_) { nM = M / BM; nN = N / BM; nwg = nM * nN; G = G_; c = c_; }
    __host__ __device__ bool next(int i, Unit& u) const {
        const long L = (long)i * G + c; if (L >= nwg) return false;
        int wgid = (int)L; { const int q = nwg / NXCD, r = nwg % NXCD, xcd = wgid % NXCD, off = wgid / NXCD; wgid = (xcd < r ? xcd * (q + 1) : r * (q + 1) + (xcd - r) * q) + off; }
        const int nig = WGM * nN, gid = wgid / nig, fm = gid * WGM, gsz = (nM - fm) < WGM ? (nM - fm) : WGM;
        u.pm = fm + ((wgid % nig) % gsz); u.pn = (wgid % nig) / gsz; return true;
    }
    __device__ __forceinline__ void a_ready(const Unit&) const {}
    __device__ __forceinline__ void done(const Unit&) const {}
};
struct CountedOrder : StaticOrder {
    const unsigned* ready; unsigned need; unsigned* tmo;
    __device__ __forceinline__ void a_ready(const Unit& u) const {
        if (threadIdx.x < 64) {
            const unsigned long long t0 = __builtin_amdgcn_s_memrealtime(); unsigned polls = 0;
            while ((unsigned)__builtin_amdgcn_readfirstlane(__hip_atomic_load(ready + 64 * u.pm, __ATOMIC_RELAXED, __HIP_MEMORY_SCOPE_AGENT)) < need) {
                if ((++polls & 255u) == 0u && __builtin_amdgcn_readfirstlane(__hip_atomic_load(tmo, __ATOMIC_RELAXED, __HIP_MEMORY_SCOPE_AGENT)) != 0u) break;
                if (__builtin_amdgcn_s_memrealtime() - t0 > 2000000ull) {
                    if (threadIdx.x == 0) { unsigned expect = 0u; __hip_atomic_compare_exchange_strong(tmo + 1, &expect, 0x600u | (unsigned)(u.pm & 0xff), __ATOMIC_RELAXED, __ATOMIC_RELAXED, __HIP_MEMORY_SCOPE_AGENT); __hip_atomic_store(tmo, 1u, __ATOMIC_RELAXED, __HIP_MEMORY_SCOPE_AGENT); }
                    break; }
                __builtin_amdgcn_s_sleep(2); }
            __builtin_amdgcn_fence(__ATOMIC_ACQUIRE, "agent");
            asm volatile("s_waitcnt vmcnt(0)" ::: "memory");
        }
#if !defined(BROKEN_HOOK_NO_BARRIER)
        asm volatile("" ::: "memory"); __builtin_amdgcn_s_barrier(); asm volatile("" ::: "memory");
#endif
    }
};

__device__ __forceinline__ unsigned cvt_pk_bf16(float lo, float hi) { unsigned r; asm volatile("v_cvt_pk_bf16_f32 %0, %1, %2" : "=v"(r) : "v"(lo), "v"(hi)); return r; }
typedef float f32x2 __attribute__((ext_vector_type(2)));
__device__ __forceinline__ f32x2 gelu_pk(f32x2 v) {
    const f32x2 av = __builtin_elementwise_abs(v), d = av * 0.2316418882f + 1.0f;
    f32x2 t; t.x = __builtin_amdgcn_rcpf(d.x); t.y = __builtin_amdgcn_rcpf(d.y);
    f32x2 q = t * 0.5307027145f + (-0.7265760135f); q = q * t + 0.7107068705f; q = q * t + (-0.142248368f); q = q * t + 0.127414796f; q = q * t;
    const f32x2 s = (v * v) * (-0.72134752044f);
    f32x2 e; e.x = __builtin_amdgcn_exp2f(s.x); e.y = __builtin_amdgcn_exp2f(s.y);
    const f32x2 m = v * (q * e), r = v - m;
    f32x2 o; o.x = v.x < 0.f ? m.x : r.x; o.y = v.y < 0.f ? m.y : r.y; return o;
}

struct EpiF32 {
    static constexpr bool PERM = false, AFTER_DRAIN = false;
    float* C; int ldc; const float* bias;
    __device__ __forceinline__ void operator()(const f32x4 (&acc)[2][2][4][2], const Unit& u, int wr, int wc, int fr, int fq) const {
        const int row0 = u.pm * BM + wr * 64 + fr, col0 = u.pn * BM + wc * 32 + 4 * fq;
        f32x4 bv[2][2];
#pragma unroll
        for (int bj = 0; bj < 2; ++bj)
#pragma unroll
            for (int n = 0; n < 2; ++n) bv[bj][n] = bias ? *(const f32x4*)(bias + col0 + bj * HALF + n * 16) : (f32x4){0.f, 0.f, 0.f, 0.f};
#pragma unroll
        for (int ai = 0; ai < 2; ++ai)
#pragma unroll
            for (int m = 0; m < 4; ++m) { float* rowp = C + (size_t)(row0 + ai * HALF + m * 16) * ldc + col0;
#pragma unroll
                for (int bj = 0; bj < 2; ++bj)
#pragma unroll
                    for (int n = 0; n < 2; ++n) *(f32x4*)(rowp + bj * HALF + n * 16) = acc[ai][bj][m][n] + bv[bj][n]; }
    }
};
template <int ACT  > struct EpiBf16 {
    static constexpr bool PERM = true, AFTER_DRAIN = false;
    bf16_t* O; int ldc; const float* bias; int split_cols; size_t split_stride;
    __device__ __forceinline__ void operator()(const f32x4 (&acc)[2][2][4][2], const Unit& u, int wr, int wc, int fr, int fq) const {
        const int row0 = u.pm * BM + wr * 64 + fr; int colt = u.pn * BM; bf16_t* base = O;
        if (split_cols) { const int t = colt / split_cols; base += (size_t)t * split_stride; colt -= t * split_cols; }
        const int col0 = colt + wc * 32 + 8 * fq, bcol0 = u.pn * BM + wc * 32 + 8 * fq;
        f32x4 bv[2][2];
#pragma unroll
        for (int bj = 0; bj < 2; ++bj)
#pragma unroll
            for (int n = 0; n < 2; ++n) bv[bj][n] = bias ? *(const f32x4*)(bias + bcol0 + bj * HALF + 4 * n) : (f32x4){0.f, 0.f, 0.f, 0.f};
#pragma unroll
        for (int ai = 0; ai < 2; ++ai)
#pragma unroll
            for (int m = 0; m < 4; ++m) { bf16_t* rowp = base + (size_t)(row0 + ai * HALF + m * 16) * ldc + col0;
#pragma unroll
                for (int bj = 0; bj < 2; ++bj) { f32x4 v0 = acc[ai][bj][m][0] + bv[bj][0], v1 = acc[ai][bj][m][1] + bv[bj][1];
                    if (ACT == 1) { f32x2 a = gelu_pk((f32x2){v0[0], v0[1]}), b = gelu_pk((f32x2){v0[2], v0[3]}), c = gelu_pk((f32x2){v1[0], v1[1]}), d = gelu_pk((f32x2){v1[2], v1[3]});
                        v0 = (f32x4){a.x, a.y, b.x, b.y}; v1 = (f32x4){c.x, c.y, d.x, d.y}; }
                    if (ACT == 2) {
#pragma unroll
                        for (int j = 0; j < 4; ++j) { v0[j] = 0.5f * v0[j] * (1.0f + erff(v0[j] * 0.70710678f)); v1[j] = 0.5f * v1[j] * (1.0f + erff(v1[j] * 0.70710678f)); } }
                    u32x4 w; w.x = cvt_pk_bf16(v0[0], v0[1]); w.y = cvt_pk_bf16(v0[2], v0[3]); w.z = cvt_pk_bf16(v1[0], v1[1]); w.w = cvt_pk_bf16(v1[2], v1[3]);
                    *(u32x4*)(rowp + bj * HALF) = w; } }
    }
};

struct PanelStats {
    unsigned* xbuf;
    unsigned* cnt;
    unsigned* tmo;
    int ntn; float eps;
    unsigned code;
    __device__ __forceinline__ bool run(const f32x4 (&v)[2][2][4][2], const Unit& u, int wr, int wc, int fr, int fq, PG8_LAS unsigned char* lds, int wid, int lane) const {
        typedef float f32x2v __attribute__((ext_vector_type(2)));
        PG8_LAS f32x2v* P = (PG8_LAS f32x2v*)lds;
        PG8_LAS f32x2v* S = (PG8_LAS f32x2v*)(lds + 8192);
        PG8_LAS unsigned* flag = (PG8_LAS unsigned*)(lds + 8192 + 2048);
#pragma unroll
        for (int ai = 0; ai < 2; ++ai)
#pragma unroll
            for (int m = 0; m < 4; ++m) {
                float s = 0.f;
#pragma unroll
                for (int bj = 0; bj < 2; ++bj)
#pragma unroll
                    for (int n = 0; n < 2; ++n) { const f32x4 x = v[ai][bj][m][n]; s += (x[0] + x[1]) + (x[2] + x[3]); }
                s += __shfl_xor(s, 16); s += __shfl_xor(s, 32);
                const float mw = s * (1.0f / 64.0f); float q = 0.f;
#pragma unroll
                for (int bj = 0; bj < 2; ++bj)
#pragma unroll
                    for (int n = 0; n < 2; ++n) { const f32x4 d = v[ai][bj][m][n] - mw; q += (d[0] * d[0] + d[1] * d[1]) + (d[2] * d[2] + d[3] * d[3]); }
                q += __shfl_xor(q, 16); q += __shfl_xor(q, 32);
                if (fq == 0) P[(ai * HALF + wr * 64 + m * 16 + fr) * 4 + wc] = (f32x2v){mw, q};
            }
        asm volatile("s_waitcnt lgkmcnt(0)" ::: "memory"); __builtin_amdgcn_s_barrier(); asm volatile("" ::: "memory");
#if defined(BROKEN_NO_WAIT)
        if (blockIdx.x >= 64) { const long long t0 = clock64(); while (clock64() - t0 < 60000) __builtin_amdgcn_s_sleep(8); }
#endif
        const int row = wid * 32 + (lane & 31);
        if (lane < 32) {
            const f32x2v a = P[row * 4 + 0], b = P[row * 4 + 1], c = P[row * 4 + 2], d = P[row * 4 + 3];
            const float mt = (a.x + b.x + c.x + d.x) * 0.25f;
            const float da = a.x - mt, db = b.x - mt, dc = c.x - mt, dd = d.x - mt;
            const float m2 = (a.y + b.y) + (c.y + d.y) + 64.0f * ((da * da + db * db) + (dc * dc + dd * dd));
            unsigned long long* slot = (unsigned long long*)xbuf + ((size_t)(u.pm * BM + row) * 4 + u.pn);
            __hip_atomic_store(slot, ((unsigned long long)__float_as_uint(m2) << 32) | __float_as_uint(mt), __ATOMIC_RELAXED, __HIP_MEMORY_SCOPE_AGENT);
        }
        asm volatile("s_waitcnt vmcnt(0)" ::: "memory");
        if (lane == 0) __hip_atomic_fetch_add(cnt + 64 * u.pm, 1u, __ATOMIC_RELAXED, __HIP_MEMORY_SCOPE_AGENT);
        if (wid == 0) {
            bool dead = false; const unsigned long long t0 = __builtin_amdgcn_s_memrealtime(); const unsigned want = 8u * (unsigned)ntn;
            for (;;) {
#if defined(BROKEN_NO_WAIT)
                break;
#endif
                if ((unsigned)__builtin_amdgcn_readfirstlane(__hip_atomic_load(cnt + 64 * u.pm, __ATOMIC_RELAXED, __HIP_MEMORY_SCOPE_AGENT)) >= want) break;
                if (__builtin_amdgcn_s_memrealtime() - t0 > 2000000ull) {
                    if (lane == 0) { unsigned expect = 0u; __hip_atomic_compare_exchange_strong(tmo + 1, &expect, code | (unsigned)(u.pm & 0xff), __ATOMIC_RELAXED, __ATOMIC_RELAXED, __HIP_MEMORY_SCOPE_AGENT);
                                     __hip_atomic_store(tmo, 1u, __ATOMIC_RELAXED, __HIP_MEMORY_SCOPE_AGENT); }
                    dead = true; break; }
                __builtin_amdgcn_s_sleep(2);
            }
            __builtin_amdgcn_fence(__ATOMIC_ACQUIRE, "agent");
            if (lane == 0) flag[0] = dead ? 1u : 0u;
        }
        asm volatile("s_waitcnt vmcnt(0) lgkmcnt(0)" ::: "memory"); __builtin_amdgcn_s_barrier(); asm volatile("" ::: "memory");
        const bool bad = flag[0] != 0u;
        if (lane < 32) {
            const unsigned long long* slot = (const unsigned long long*)xbuf + (size_t)(u.pm * BM + row) * 4; float mt[4], m2[4]; float ms = 0.f;
#pragma unroll
            for (int t = 0; t < 4; ++t) { if (t < ntn) { const unsigned long long w = __hip_atomic_load(slot + t, __ATOMIC_RELAXED, __HIP_MEMORY_SCOPE_AGENT); mt[t] = __uint_as_float((unsigned)w); m2[t] = __uint_as_float((unsigned)(w >> 32)); } else { mt[t] = 0.f; m2[t] = 0.f; } ms += mt[t]; }
            const float mean = ms / (float)ntn; float q = 0.f;
#pragma unroll
            for (int t = 0; t < 4; ++t) if (t < ntn) { const float dm = mt[t] - mean; q += m2[t] + 256.0f * dm * dm; }
            S[row] = (f32x2v){mean, 1.0f / sqrtf(q / (256.0f * (float)ntn) + eps)};
        }
        asm volatile("s_waitcnt lgkmcnt(0)" ::: "memory"); __builtin_amdgcn_s_barrier(); asm volatile("" ::: "memory");
        return bad;
    }
};
struct EpiLnRes {
    static constexpr bool PERM = false, AFTER_DRAIN = true;
    const float* base; float* out; int ldc; const float* bias; PanelStats st; unsigned poison;
    __device__ __forceinline__ void refuse(size_t i0, size_t stride, int M, int N) const { const float q = __builtin_nanf(""); for (size_t i = i0; i < (size_t)M * N; i += stride) out[(i / N) * ldc + i % N] = q;
        if (i0 == 0) { unsigned expect = 0u; __hip_atomic_compare_exchange_strong(st.tmo + 1, &expect, 0x7f0u, __ATOMIC_RELAXED, __ATOMIC_RELAXED, __HIP_MEMORY_SCOPE_AGENT); __hip_atomic_store(st.tmo, 1u, __ATOMIC_RELAXED, __HIP_MEMORY_SCOPE_AGENT); } }
    __device__ __forceinline__ void fused(f32x4 (&acc)[2][2][4][2], const Unit& u, int wr, int wc, int fr, int fq, PG8_LAS unsigned char* lds, int wid, int lane) const {
        typedef float f32x2v __attribute__((ext_vector_type(2)));
        const PG8_LAS f32x2v* S = (const PG8_LAS f32x2v*)(lds + 8192);
        const int col0 = u.pn * BM + wc * 32 + 4 * fq;
#pragma unroll
        for (int bj = 0; bj < 2; ++bj)
#pragma unroll
            for (int n = 0; n < 2; ++n) { const f32x4 bv = bias ? *(const f32x4*)(bias + col0 + bj * HALF + n * 16) : (f32x4){0.f, 0.f, 0.f, 0.f};
#pragma unroll
                for (int ai = 0; ai < 2; ++ai)
#pragma unroll
                    for (int m = 0; m < 4; ++m) acc[ai][bj][m][n] += bv; }
        const bool bad = st.run(acc, u, wr, wc, fr, fq, lds, wid, lane) || poison != 0u;
        const float qnan = __builtin_nanf("");
#pragma unroll
        for (int ai = 0; ai < 2; ++ai)
#pragma unroll
            for (int m = 0; m < 4; ++m) { const int r = ai * HALF + wr * 64 + m * 16 + fr; const f32x2v sr = S[r]; const size_t off = (size_t)(u.pm * BM + r) * ldc + col0;
#pragma unroll
                for (int bj = 0; bj < 2; ++bj)
#pragma unroll
                    for (int n = 0; n < 2; ++n) { const f32x4 bs = *(const f32x4*)(base + off + bj * HALF + n * 16); f32x4 o = bs + (acc[ai][bj][m][n] - sr.x) * sr.y;
                        if (bad) o = (f32x4){qnan, qnan, qnan, qnan}; *(f32x4*)(out + off + bj * HALF + n * 16) = o; }
                asm volatile("" ::: "memory"); }
    }
};
struct EpiLnResLn {
    static constexpr bool PERM = false, AFTER_DRAIN = true;
    const float* base; float* out; bf16_t* xn; int ldc; const float* bias; PanelStats st1, st2; unsigned poison;
    __device__ __forceinline__ void refuse(size_t i0, size_t stride, int M, int N) const { const float q = __builtin_nanf(""); for (size_t i = i0; i < (size_t)M * N; i += stride) { const size_t o = (i / N) * ldc + i % N; out[o] = q; xn[o] = (bf16_t)0x7fc0u; }
        if (i0 == 0) { unsigned expect = 0u; __hip_atomic_compare_exchange_strong(st1.tmo + 1, &expect, 0x7f0u, __ATOMIC_RELAXED, __ATOMIC_RELAXED, __HIP_MEMORY_SCOPE_AGENT); __hip_atomic_store(st1.tmo, 1u, __ATOMIC_RELAXED, __HIP_MEMORY_SCOPE_AGENT); } }
    __device__ __forceinline__ void fused(f32x4 (&acc)[2][2][4][2], const Unit& u, int wr, int wc, int fr, int fq, PG8_LAS unsigned char* lds, int wid, int lane) const {
        typedef float f32x2v __attribute__((ext_vector_type(2))); typedef unsigned u32x2v __attribute__((ext_vector_type(2)));
        const PG8_LAS f32x2v* S = (const PG8_LAS f32x2v*)(lds + 8192);
        const int col0 = u.pn * BM + wc * 32 + 4 * fq;
#pragma unroll
        for (int bj = 0; bj < 2; ++bj)
#pragma unroll
            for (int n = 0; n < 2; ++n) { const f32x4 bv = bias ? *(const f32x4*)(bias + col0 + bj * HALF + n * 16) : (f32x4){0.f, 0.f, 0.f, 0.f};
#pragma unroll
                for (int ai = 0; ai < 2; ++ai)
#pragma unroll
                    for (int m = 0; m < 4; ++m) acc[ai][bj][m][n] += bv; }
        bool bad = st1.run(acc, u, wr, wc, fr, fq, lds, wid, lane) || poison != 0u;
        const float qnan = __builtin_nanf("");
#pragma unroll
        for (int ai = 0; ai < 2; ++ai)
#pragma unroll
            for (int m = 0; m < 4; ++m) { const int r = ai * HALF + wr * 64 + m * 16 + fr; const f32x2v sr = S[r]; const size_t off = (size_t)(u.pm * BM + r) * ldc + col0;
#pragma unroll
                for (int bj = 0; bj < 2; ++bj)
#pragma unroll
                    for (int n = 0; n < 2; ++n) { const f32x4 bs = *(const f32x4*)(base + off + bj * HALF + n * 16); acc[ai][bj][m][n] = bs + (acc[ai][bj][m][n] - sr.x) * sr.y; }
                asm volatile("" : "+v"(acc[ai][0][m][0]), "+v"(acc[ai][0][m][1]), "+v"(acc[ai][1][m][0]), "+v"(acc[ai][1][m][1]));
                if (m & 1) asm volatile("" ::: "memory"); }
        const bool bad1 = bad;
        bad = st2.run(acc, u, wr, wc, fr, fq, lds, wid, lane) || bad;
#pragma unroll
        for (int ai = 0; ai < 2; ++ai)
#pragma unroll
            for (int m = 0; m < 4; ++m) { const int r = ai * HALF + wr * 64 + m * 16 + fr; const f32x2v sr = S[r]; const size_t off = (size_t)(u.pm * BM + r) * ldc + col0;
#pragma unroll
                for (int bj = 0; bj < 2; ++bj)
#pragma unroll
                    for (int n = 0; n < 2; ++n) { const f32x4 x1 = acc[ai][bj][m][n]; *(f32x4*)(out + off + bj * HALF + n * 16) = bad1 ? (f32x4){qnan, qnan, qnan, qnan} : x1;
                        const f32x4 o = (x1 - sr.x) * sr.y; u32x2v w; w.x = cvt_pk_bf16(o[0], o[1]); w.y = cvt_pk_bf16(o[2], o[3]);
                        if (bad) { w.x = 0x7fc07fc0u; w.y = 0x7fc07fc0u; } *(u32x2v*)(xn + off + bj * HALF + n * 16) = w; }
                asm volatile("" ::: "memory"); }
    }
};

template <class Epi, class Sched, bool STAMP = false>
__device__ __forceinline__ void gemm_phase(PG8_LAS unsigned char* lds, const Gemm g, const Sched& S, const Epi& E, unsigned long long* stamps) {
    int tid_l_ = (int)threadIdx.x; asm volatile("" : "+v"(tid_l_)); const int tid = tid_l_, wid = __builtin_amdgcn_readfirstlane(tid >> 6), lane = tid & 63, wr = wid >> 2, wc = wid & 3, fr = lane & 15, fq = lane >> 4;
    const int K = g.K, nt = K / BK;
    int ts_lo = 0, ts_hi = 0, nts = 0; const unsigned long long rt_entry = STAMP ? (unsigned long long)wall_clock64() : 0ull;
#define PG8_STAMP() do { if (STAMP && wid == 0 && nts < 64) { const unsigned long long _c = (unsigned long long)clock64(); \
        ts_lo = (lane == nts) ? (int)(unsigned)_c : ts_lo; ts_hi = (lane == nts) ? (int)(unsigned)(_c >> 32) : ts_hi; ++nts; } } while (0)
    PG8_STAMP();
    unsigned voffA[2], voffB[2];
#pragma unroll
    for (int i = 0; i < 2; ++i) { int R, C; stage_rc(tid * 16 + i * 8192, R, C); const int Rb = Epi::PERM ? ((R & ~31) + perm32(R & 31)) : R;
        voffA[i] = (unsigned)(R * K + C) * 2u; voffB[i] = (unsigned)(Rb * K + C) * 2u; }
    const size_t kstep = (size_t)(BK * 2);
    const size_t hstep = (size_t)HALF * K * 2;
    const size_t tstep = 2 * hstep;
    const unsigned ldsw = (unsigned)wid * 1024u;
    const int aoff = lds_byte(wr * 64 + fr, fq * 8), boff = lds_byte(wc * 32 + fr, fq * 8);
#define PG8_SA(b, h) (((b) * 2 + (h)) * HTB)
#define PG8_SB(b, h) ((4 + (b) * 2 + (h)) * HTB)
#define PG8_STAGE(bufoff, gbase, voff) do { _Pragma("unroll") for (int _i = 0; _i < 2; ++_i) \
        __builtin_amdgcn_global_load_lds((const unsigned*)((const char*)(gbase) + (voff)[_i]), (PG8_LAS unsigned*)(lds + (bufoff) + ldsw + _i * 8192), 16, 0, 0); } while (0)
#define PG8_LDA(dst, b, h) do { _Pragma("unroll") for (int m = 0; m < 4; ++m) _Pragma("unroll") for (int k = 0; k < 2; ++k) dst[m][k] = *(const PG8_LAS bf16x8*)(lds + PG8_SA(b, h) + aoff + m * 2048 + k * 1024); } while (0)
#define PG8_LDB(dst, b, h) do { _Pragma("unroll") for (int n = 0; n < 2; ++n) _Pragma("unroll") for (int k = 0; k < 2; ++k) dst[n][k] = *(const PG8_LAS bf16x8*)(lds + PG8_SB(b, h) + boff + n * 2048 + k * 1024); } while (0)
#define PG8_MMA(ai, bj, At, Bt) do { __builtin_amdgcn_s_setprio(1); _Pragma("unroll") for (int m = 0; m < 4; ++m) _Pragma("unroll") for (int n = 0; n < 2; ++n) _Pragma("unroll") for (int k = 0; k < 2; ++k) \
        acc[ai][bj][m][n] = __builtin_amdgcn_mfma_f32_16x16x32_bf16(Bt[n][k], At[m][k], acc[ai][bj][m][n], 0, 0, 0); __builtin_amdgcn_s_setprio(0); } while (0)
#define PG8_WAIT_V(n) asm volatile("s_waitcnt vmcnt(" #n ")" ::: "memory")
#define PG8_WAIT_L(n) asm volatile("s_waitcnt lgkmcnt(" #n ")" ::: "memory")
#define PG8_BAR __builtin_amdgcn_s_barrier()
#define PG8_SCHED __builtin_amdgcn_sched_barrier(0)
    Unit cur, nxt; int ui = 0;
    if (!S.next(0, cur)) return;
    f32x4 acc[2][2][4][2];
#pragma unroll
    for (int a = 0; a < 2; ++a)
#pragma unroll
        for (int b = 0; b < 2; ++b)
#pragma unroll
            for (int m = 0; m < 4; ++m)
#pragma unroll
                for (int n = 0; n < 2; ++n) acc[a][b][m][n] = (f32x4){0.f, 0.f, 0.f, 0.f};
    bf16x8 At[4][2], B0[2][2], B1[2][2];
    const char* cA = (const char*)g.A + (size_t)cur.pm * tstep; const char* cB = (const char*)g.Bt + (size_t)cur.pn * tstep;
    S.a_ready(cur);
    PG8_STAGE(PG8_SB(0, 0), cB, voffB); PG8_STAGE(PG8_SA(0, 0), cA, voffA); PG8_STAGE(PG8_SB(0, 1), cB + hstep, voffB); PG8_STAGE(PG8_SA(0, 1), cA + hstep, voffA);
    if (wr == 1) PG8_BAR;
    PG8_WAIT_V(4); PG8_BAR;
    PG8_STAGE(PG8_SB(1, 0), cB + kstep, voffB); PG8_STAGE(PG8_SA(1, 0), cA + kstep, voffA); PG8_STAGE(PG8_SB(1, 1), cB + hstep + kstep, voffB);
    PG8_WAIT_V(6); PG8_BAR;
    PG8_STAMP();
    for (;;) {
        const bool has_next = S.next(ui + 1, nxt);
        const char* nA = has_next ? (const char*)g.A + (size_t)nxt.pm * tstep : cA; const char* nB = has_next ? (const char*)g.Bt + (size_t)nxt.pn * tstep : cB;
        for (int t = 0; t < nt; t += 2) {
            const bool last = (t == nt - 2);
            const char* a1 = cA + (size_t)(t + 1) * kstep;
            const char* a2 = last ? nA : cA + (size_t)(t + 2) * kstep; const char* b2 = last ? nB : cB + (size_t)(t + 2) * kstep;
            const char* a3 = a2 + kstep; const char* b3 = b2 + kstep;
            if (last && has_next) S.a_ready(nxt);
            PG8_LDB(B0, 0, 0); PG8_SCHED; PG8_LDA(At, 0, 0); PG8_STAGE(PG8_SA(1, 1), a1 + hstep, voffA);
            PG8_WAIT_L(8); PG8_BAR; PG8_WAIT_L(0); PG8_MMA(0, 0, At, B0); PG8_BAR; PG8_SCHED;
            PG8_LDB(B1, 0, 1); PG8_STAGE(PG8_SB(0, 0), b2, voffB);
            PG8_BAR; PG8_WAIT_L(0); PG8_MMA(0, 1, At, B1); PG8_BAR;
            PG8_LDA(At, 0, 1); PG8_STAGE(PG8_SA(0, 0), a2, voffA);
            PG8_BAR; PG8_WAIT_L(0); PG8_MMA(1, 0, At, B0); PG8_BAR; PG8_SCHED;
            PG8_STAGE(PG8_SB(0, 1), b2 + hstep, voffB);
            PG8_WAIT_V(6); PG8_BAR; PG8_MMA(1, 1, At, B1); PG8_BAR;
            PG8_LDB(B0, 1, 0); PG8_SCHED; PG8_LDA(At, 1, 0); PG8_STAGE(PG8_SA(0, 1), a2 + hstep, voffA);
            PG8_WAIT_L(8); PG8_BAR; PG8_WAIT_L(0); PG8_MMA(0, 0, At, B0); PG8_BAR; PG8_SCHED;
            PG8_LDB(B1, 1, 1); PG8_STAGE(PG8_SB(1, 0), b3, voffB);
            PG8_BAR; PG8_WAIT_L(0); PG8_MMA(0, 1, At, B1); PG8_BAR;
            PG8_LDA(At, 1, 1); PG8_STAGE(PG8_SA(1, 0), a3, voffA);
            PG8_BAR; PG8_WAIT_L(0); PG8_MMA(1, 0, At, B0); PG8_BAR; PG8_SCHED;
            PG8_STAGE(PG8_SB(1, 1), b3 + hstep, voffB);
            PG8_WAIT_V(6); PG8_BAR; PG8_MMA(1, 1, At, B1); PG8_BAR;
        }
        PG8_STAMP();
        if constexpr (!Epi::AFTER_DRAIN) { E(acc, cur, wr, wc, fr, fq); S.done(cur); }
        PG8_STAMP();
        if (!has_next) break;
#pragma unroll
        for (int a = 0; a < 2; ++a)
#pragma unroll
            for (int b = 0; b < 2; ++b)
#pragma unroll
                for (int m = 0; m < 4; ++m)
#pragma unroll
                    for (int n = 0; n < 2; ++n) acc[a][b][m][n] = (f32x4){0.f, 0.f, 0.f, 0.f};
        cur = nxt; cA = nA; cB = nB; ++ui;
    }
    PG8_WAIT_V(0);
    if (wr == 0) PG8_BAR;
    PG8_BAR;
    if constexpr (Epi::AFTER_DRAIN) { E.fused(acc, cur, wr, wc, fr, fq, lds, wid, lane); S.done(cur); }
    PG8_STAMP();
    if (STAMP && wid == 0) { stamps[lane] = lane < nts ? (((unsigned long long)(unsigned)ts_hi << 32) | (unsigned)ts_lo) : 0ull;
        if (lane == 62) stamps[62] = rt_entry; if (lane == 63) stamps[63] = (unsigned long long)wall_clock64(); }
#undef PG8_STAMP
#undef PG8_SA
#undef PG8_SB
#undef PG8_STAGE
#undef PG8_LDA
#undef PG8_LDB
#undef PG8_MMA
#undef PG8_WAIT_V
#undef PG8_WAIT_L
#undef PG8_BAR
#undef PG8_SCHED
}
template <class Epi, class Sched, bool STAMP = false>
__device__ __forceinline__ void gemm_phase_g(PG8_LAS unsigned char* lds, const Gemm g, const Sched& S, const Epi& E, const PG8_LAS int* ridx) {
    unsigned long long* stamps = nullptr;
    int tid_l_ = (int)threadIdx.x; asm volatile("" : "+v"(tid_l_)); const int tid = tid_l_, wid = __builtin_amdgcn_readfirstlane(tid >> 6), lane = tid & 63, wr = wid >> 2, wc = wid & 3, fr = lane & 15, fq = lane >> 4;
    const int K = g.K, nt = K / BK;
    int ts_lo = 0, ts_hi = 0, nts = 0; const unsigned long long rt_entry = STAMP ? (unsigned long long)wall_clock64() : 0ull;
#define PG8_STAMP() do { if (STAMP && wid == 0 && nts < 64) { const unsigned long long _c = (unsigned long long)clock64(); \
        ts_lo = (lane == nts) ? (int)(unsigned)_c : ts_lo; ts_hi = (lane == nts) ? (int)(unsigned)(_c >> 32) : ts_hi; ++nts; } } while (0)
    PG8_STAMP();
    unsigned voffB[2]; int rA[2]; unsigned cA2[2];
#pragma unroll
    for (int i = 0; i < 2; ++i) { int R, C; stage_rc(tid * 16 + i * 8192, R, C); const int Rb = Epi::PERM ? ((R & ~31) + perm32(R & 31)) : R;
        rA[i] = R; cA2[i] = (unsigned)C * 2u; voffB[i] = (unsigned)(Rb * K + C) * 2u; }
    unsigned vc[2][2], vn[2][2];
#define PG8_GIDX(dst, ui_) do { _Pragma("unroll") for (int h_ = 0; h_ < 2; ++h_) _Pragma("unroll") for (int i_ = 0; i_ < 2; ++i_) dst[h_][i_] = (unsigned)ridx[(ui_) * 256 + h_ * 128 + rA[i_]] * (unsigned)(K * 2) + cA2[i_]; \
        asm volatile("s_waitcnt lgkmcnt(0)" ::: "memory"); } while (0)
    const size_t kstep = (size_t)(BK * 2);
    const size_t hstep = (size_t)HALF * K * 2;
    const size_t tstep = 2 * hstep;
    const unsigned ldsw = (unsigned)wid * 1024u;
    const int aoff = lds_byte(wr * 64 + fr, fq * 8), boff = lds_byte(wc * 32 + fr, fq * 8);
#define PG8_SA(b, h) (((b) * 2 + (h)) * HTB)
#define PG8_SB(b, h) ((4 + (b) * 2 + (h)) * HTB)
#define PG8_STAGE(bufoff, gbase, voff) do { _Pragma("unroll") for (int _i = 0; _i < 2; ++_i) \
        __builtin_amdgcn_global_load_lds((const unsigned*)((const char*)(gbase) + (voff)[_i]), (PG8_LAS unsigned*)(lds + (bufoff) + ldsw + _i * 8192), 16, 0, 0); } while (0)
#define PG8_LDA(dst, b, h) do { _Pragma("unroll") for (int m = 0; m < 4; ++m) _Pragma("unroll") for (int k = 0; k < 2; ++k) dst[m][k] = *(const PG8_LAS bf16x8*)(lds + PG8_SA(b, h) + aoff + m * 2048 + k * 1024); } while (0)
#define PG8_LDB(dst, b, h) do { _Pragma("unroll") for (int n = 0; n < 2; ++n) _Pragma("unroll") for (int k = 0; k < 2; ++k) dst[n][k] = *(const PG8_LAS bf16x8*)(lds + PG8_SB(b, h) + boff + n * 2048 + k * 1024); } while (0)
#define PG8_MMA(ai, bj, At, Bt) do { __builtin_amdgcn_s_setprio(1); _Pragma("unroll") for (int m = 0; m < 4; ++m) _Pragma("unroll") for (int n = 0; n < 2; ++n) _Pragma("unroll") for (int k = 0; k < 2; ++k) \
        acc[ai][bj][m][n] = __builtin_amdgcn_mfma_f32_16x16x32_bf16(Bt[n][k], At[m][k], acc[ai][bj][m][n], 0, 0, 0); __builtin_amdgcn_s_setprio(0); } while (0)
#define PG8_WAIT_V(n) asm volatile("s_waitcnt vmcnt(" #n ")" ::: "memory")
#define PG8_WAIT_L(n) asm volatile("s_waitcnt lgkmcnt(" #n ")" ::: "memory")
#define PG8_BAR __builtin_amdgcn_s_barrier()
#define PG8_SCHED __builtin_amdgcn_sched_barrier(0)
    Unit cur, nxt; int ui = 0;
    if (!S.next(0, cur)) return;
    f32x4 acc[2][2][4][2];
#pragma unroll
    for (int a = 0; a < 2; ++a)
#pragma unroll
        for (int b = 0; b < 2; ++b)
#pragma unroll
            for (int m = 0; m < 4; ++m)
#pragma unroll
                for (int n = 0; n < 2; ++n) acc[a][b][m][n] = (f32x4){0.f, 0.f, 0.f, 0.f};
    bf16x8 At[4][2], B0[2][2], B1[2][2];
    const char* cA = (const char*)g.A; const char* cB = (const char*)g.Bt + (size_t)cur.pn * tstep;
    PG8_GIDX(vc, 0);
    S.a_ready(cur);
    PG8_STAGE(PG8_SB(0, 0), cB, voffB); PG8_STAGE(PG8_SA(0, 0), cA, vc[0]); PG8_STAGE(PG8_SB(0, 1), cB + hstep, voffB); PG8_STAGE(PG8_SA(0, 1), cA, vc[1]);
    if (wr == 1) PG8_BAR;
    PG8_WAIT_V(4); PG8_BAR;
    PG8_STAGE(PG8_SB(1, 0), cB + kstep, voffB); PG8_STAGE(PG8_SA(1, 0), cA + kstep, vc[0]); PG8_STAGE(PG8_SB(1, 1), cB + hstep + kstep, voffB);
    PG8_WAIT_V(6); PG8_BAR;
    PG8_STAMP();
    for (;;) {
        const bool has_next = S.next(ui + 1, nxt);
        const char* nB = has_next ? (const char*)g.Bt + (size_t)nxt.pn * tstep : cB;
        if (has_next) PG8_GIDX(vn, ui + 1); else {
#pragma unroll
            for (int h_ = 0; h_ < 2; ++h_)
#pragma unroll
                for (int i_ = 0; i_ < 2; ++i_) vn[h_][i_] = vc[h_][i_]; }
        for (int t = 0; t < nt; t += 2) {
            const bool last = (t == nt - 2);
            const char* a1 = cA + (size_t)(t + 1) * kstep;
            const char* a2 = last ? cA : cA + (size_t)(t + 2) * kstep; const char* b2 = last ? nB : cB + (size_t)(t + 2) * kstep;
            const char* a3 = a2 + kstep; const char* b3 = b2 + kstep;
            unsigned v2[2][2];
#pragma unroll
            for (int h_ = 0; h_ < 2; ++h_)
#pragma unroll
                for (int i_ = 0; i_ < 2; ++i_) v2[h_][i_] = last ? vn[h_][i_] : vc[h_][i_];
            if (last && has_next) S.a_ready(nxt);
            PG8_LDB(B0, 0, 0); PG8_SCHED; PG8_LDA(At, 0, 0); PG8_STAGE(PG8_SA(1, 1), a1, vc[1]);
            PG8_WAIT_L(8); PG8_BAR; PG8_WAIT_L(0); PG8_MMA(0, 0, At, B0); PG8_BAR; PG8_SCHED;
            PG8_LDB(B1, 0, 1); PG8_STAGE(PG8_SB(0, 0), b2, voffB);
            PG8_BAR; PG8_WAIT_L(0); PG8_MMA(0, 1, At, B1); PG8_BAR;
            PG8_LDA(At, 0, 1); PG8_STAGE(PG8_SA(0, 0), a2, v2[0]);
            PG8_BAR; PG8_WAIT_L(0); PG8_MMA(1, 0, At, B0); PG8_BAR; PG8_SCHED;
            PG8_STAGE(PG8_SB(0, 1), b2 + hstep, voffB);
            PG8_WAIT_V(6); PG8_BAR; PG8_MMA(1, 1, At, B1); PG8_BAR;
            PG8_LDB(B0, 1, 0); PG8_SCHED; PG8_LDA(At, 1, 0); PG8_STAGE(PG8_SA(0, 1), a2, v2[1]);
            PG8_WAIT_L(8); PG8_BAR; PG8_WAIT_L(0); PG8_MMA(0, 0, At, B0); PG8_BAR; PG8_SCHED;
            PG8_LDB(B1, 1, 1); PG8_STAGE(PG8_SB(1, 0), b3, voffB);
            PG8_BAR; PG8_WAIT_L(0); PG8_MMA(0, 1, At, B1); PG8_BAR;
            PG8_LDA(At, 1, 1); PG8_STAGE(PG8_SA(1, 0), a3, v2[0]);
            PG8_BAR; PG8_WAIT_L(0); PG8_MMA(1, 0, At, B0); PG8_BAR; PG8_SCHED;
            PG8_STAGE(PG8_SB(1, 1), b3 + hstep, voffB);
            PG8_WAIT_V(6); PG8_BAR; PG8_MMA(1, 1, At, B1); PG8_BAR;
        }
        PG8_STAMP();
        if constexpr (!Epi::AFTER_DRAIN) { E(acc, cur, wr, wc, fr, fq); S.done(cur); }
        PG8_STAMP();
        if (!has_next) break;
#pragma unroll
        for (int a = 0; a < 2; ++a)
#pragma unroll
            for (int b = 0; b < 2; ++b)
#pragma unroll
                for (int m = 0; m < 4; ++m)
#pragma unroll
                    for (int n = 0; n < 2; ++n) acc[a][b][m][n] = (f32x4){0.f, 0.f, 0.f, 0.f};
        cur = nxt; cB = nB; ++ui;
#pragma unroll
        for (int h_ = 0; h_ < 2; ++h_)
#pragma unroll
            for (int i_ = 0; i_ < 2; ++i_) vc[h_][i_] = vn[h_][i_];
    }
    PG8_WAIT_V(0);
    if (wr == 0) PG8_BAR;
    PG8_BAR;
    if constexpr (Epi::AFTER_DRAIN) { E.fused(acc, cur, wr, wc, fr, fq, lds, wid, lane); S.done(cur); }
    PG8_STAMP();
    if (STAMP && wid == 0) { stamps[lane] = lane < nts ? (((unsigned long long)(unsigned)ts_hi << 32) | (unsigned)ts_lo) : 0ull;
        if (lane == 62) stamps[62] = rt_entry; if (lane == 63) stamps[63] = (unsigned long long)wall_clock64(); }
#undef PG8_STAMP
#undef PG8_GIDX
#undef PG8_SA
#undef PG8_SB
#undef PG8_STAGE
#undef PG8_LDA
#undef PG8_LDB
#undef PG8_MMA
#undef PG8_WAIT_V
#undef PG8_WAIT_L
#undef PG8_BAR
#undef PG8_SCHED
}
}

using pg8::bf16_t; using pg8::bf16x8; using pg8::f32x4;
typedef float f32x16 __attribute__((ext_vector_type(16)));
typedef float f32x2v __attribute__((ext_vector_type(2)));
typedef __bf16 bf16x2v __attribute__((ext_vector_type(2)));
typedef short s16x4 __attribute__((ext_vector_type(4)));
typedef unsigned u32x4 __attribute__((ext_vector_type(4)));
typedef unsigned u32x2 __attribute__((ext_vector_type(2)));
typedef PG8_LAS unsigned char* LDSP;
typedef PG8_LAS float* LASF;

constexpr int NTH = 512;
constexpr int LDS_BYTES = 156 * 1024;
constexpr int DM = 1024, LL = 8192, LC = 256, SEQB = 8448, TT = 16896, NPAN = 66, TPAD = 41984;
constexpr size_t UU = (size_t)TT * 1024 * 2;
constexpr float EPS_ = 1e-6f;
constexpr float INV2PI = 0.15915494309189535f;

template <class T> __device__ __forceinline__ T* UP(T* q) { const unsigned long long v = (unsigned long long)q;
    const unsigned lo = (unsigned)__builtin_amdgcn_readfirstlane((int)(unsigned)v), hi = (unsigned)__builtin_amdgcn_readfirstlane((int)(unsigned)(v >> 32));
    return (T*)(__attribute__((address_space(1))) T*)(((unsigned long long)hi << 32) | lo); }
__device__ __forceinline__ int ltid() { int t = (int)threadIdx.x; asm volatile("" : "+v"(t)); return t; }
__device__ __forceinline__ f32x2v mk2_(float x, float y) { f32x2v r; r.x = x; r.y = y; return r; }
__device__ __forceinline__ float bf2f(bf16_t v) { return __uint_as_float(((unsigned)v) << 16); }
__device__ __forceinline__ unsigned pk2(float lo, float hi) { f32x2v v = {lo, hi}; bf16x2v b = __builtin_convertvector(v, bf16x2v); return __builtin_bit_cast(unsigned, b); }
__device__ __forceinline__ bf16_t f2bf(float f) { return (bf16_t)(pk2(f, 0.f) & 0xffffu); }
__device__ __forceinline__ float lo16(unsigned w) { return __uint_as_float(w << 16); }
__device__ __forceinline__ float hi16(unsigned w) { return __uint_as_float(w & 0xffff0000u); }
__device__ __forceinline__ float sigmoidf_(float x) { return __builtin_amdgcn_rcpf(1.0f + __expf(-x)); }
__device__ __forceinline__ float siluf_(float x) { return x * __builtin_amdgcn_rcpf(1.0f + __expf(-x)); }
__device__ __forceinline__ float logsigf_(float x) { return fminf(x, 0.f) - log1pf(__expf(-fabsf(x))); }
__device__ __forceinline__ float sin2pi(float rev) { return __builtin_amdgcn_sinf(rev); }
__device__ __forceinline__ float cos2pi(float rev) { return __builtin_amdgcn_cosf(rev); }
__device__ __forceinline__ int crow(int r, int hi) { return (r & 3) + 8 * (r >> 2) + 4 * hi; }
template <int CTRL> __device__ __forceinline__ float dpp_mov(float x) { return __int_as_float(__builtin_amdgcn_update_dpp(0, __float_as_int(x), CTRL, 0xf, 0xf, false)); }
__device__ __forceinline__ float row_sum(float x) { x += dpp_mov<0x128>(x); x += dpp_mov<0x124>(x); x += dpp_mov<0x122>(x); x += dpp_mov<0x121>(x); return x; }
__device__ __forceinline__ float row_max(float x) { x = fmaxf(x, dpp_mov<0x128>(x)); x = fmaxf(x, dpp_mov<0x124>(x)); x = fmaxf(x, dpp_mov<0x122>(x)); x = fmaxf(x, dpp_mov<0x121>(x)); return x; }
__device__ __forceinline__ void swap32_(float& a, float& b) { auto r = __builtin_amdgcn_permlane32_swap(__float_as_uint(a), __float_as_uint(b), false, false); a = __uint_as_float(r[0]); b = __uint_as_float(r[1]); }
__device__ __forceinline__ void swap16_(float& a, float& b) { auto r = __builtin_amdgcn_permlane16_swap(__float_as_uint(a), __float_as_uint(b), false, false); a = __uint_as_float(r[0]); b = __uint_as_float(r[1]); }
__device__ __forceinline__ float wave_sum(float v) { v = row_sum(v); float w = v; swap16_(v, w); v += w; w = v; swap32_(v, w); return v + w; }
__device__ __forceinline__ float wave_max(float v) { v = row_max(v); float w = v; swap16_(v, w); v = fmaxf(v, w); w = v; swap32_(v, w); return fmaxf(v, w); }
__device__ __forceinline__ void wave_sum32(float (&v)[32]) {
#pragma unroll
    for (int i = 0; i < 16; ++i) { swap32_(v[i], v[16 + i]); v[i] += v[16 + i]; }
#pragma unroll
    for (int i = 0; i < 8; ++i) { swap16_(v[i], v[8 + i]); v[i] += v[8 + i]; }
#pragma unroll
    for (int i = 0; i < 8; ++i) v[i] = row_sum(v[i]); }
__device__ __forceinline__ void wave_sum16(float (&v)[16]) {
#pragma unroll
    for (int i = 0; i < 8; ++i) { swap32_(v[i], v[8 + i]); v[i] += v[8 + i]; }
#pragma unroll
    for (int i = 0; i < 4; ++i) { swap16_(v[i], v[4 + i]); v[i] += v[4 + i]; }
#pragma unroll
    for (int i = 0; i < 4; ++i) v[i] = row_sum(v[i]); }
__device__ __forceinline__ float readlane_f(float x, int l) { return __int_as_float(__builtin_amdgcn_readlane(__float_as_int(x), l)); }
__device__ __forceinline__ void unpack8(const u32x4 w, float (&f)[8]) {
    f[0] = lo16(w.x); f[1] = hi16(w.x); f[2] = lo16(w.y); f[3] = hi16(w.y); f[4] = lo16(w.z); f[5] = hi16(w.z); f[6] = lo16(w.w); f[7] = hi16(w.w); }
__device__ __forceinline__ u32x4 pack8(const float (&f)[8]) { u32x4 w; w.x = pk2(f[0], f[1]); w.y = pk2(f[2], f[3]); w.z = pk2(f[4], f[5]); w.w = pk2(f[6], f[7]); return w; }

template <class T> struct GP { __attribute__((address_space(1))) T* p;
    __host__ __device__ __forceinline__ GP& operator=(T* q) { p = (__attribute__((address_space(1))) T*)q; return *this; }
    __device__ __forceinline__ operator T*() const { return (T*)p; } };
struct Params {
    GP<const float> x, c, ctx, c_ctx, mod_w, mod_b, norm1_g, norm2_g, w_in, merge_b, m_conv_w, m_conv_b, m_gate_b, m_norm_g;
    GP<const float> a_qnorm_g, a_knorm_g, a_lambda, a_subln_g, h_conv_w, h_conv_b, h_ffn_w1, h_ffn_b1, h_ffn_w2, h_ffn_b2, h_ffn_w3;
    GP<const float> h_freq, h_decay, h_bias, w_br_m, w_br_a, w_br_h, w_out, router_w, router_b, e_w1, e_w3, e_w2;
    GP<float> out;
    GP<unsigned> bar; GP<int> cnt; GP<int> cur; GP<float> sumsq; GP<float> sumsqC;
    GP<float> modv; GP<float> hdn2; GP<float> G; GP<float> xc; GP<int> sel_e; GP<float> sel_w; GP<int> posbuf; GP<int> rowidx;
    GP<float> scal; GP<float> ms; GP<float> dn; GP<float> nst; GP<float> hfC; GP<float> hbC;
    GP<bf16_t> Wt_in, Wt_br, Wt_out, hn, Y3;
    GP<unsigned char> R;
};

__device__ __forceinline__ const float* resid_row_in(const Params& p, int layer, int s) {
    const int b = s / SEQB, pos = s - b * SEQB;
    if (pos < LC) return (layer == 0 ? p.ctx : p.xc) + (size_t)(b * LC + pos) * DM;
    return (layer == 0 ? p.x : p.out) + (size_t)(b * LL + pos - LC) * DM; }
__device__ __forceinline__ float* resid_row(const Params& p, int s) {
    const int b = s / SEQB, pos = s - b * SEQB;
    if (pos < LC) return p.xc + (size_t)(b * LC + pos) * DM;
    return p.out + (size_t)(b * LL + pos - LC) * DM; }
__device__ __forceinline__ const float* modvec(const Params& p, int layer, int s) { const int b = s / SEQB, pos = s - b * SEQB; return p.modv + (size_t)(layer * 3 + (pos < LC ? 2 : b)) * 6144; }

struct MapWin { const float* w;
    __device__ __forceinline__ const float* operator()(int n0, int cb, int k) const { int col;
        if (n0 < 6144) col = 4112 + n0;
        else if (n0 < 6656) col = 12304 + (n0 - 6144);
        else if (n0 < 12800) { const int m = n0 - 6656, d = m >> 10; col = (d < 4 ? 1024 * d : (d == 4 ? 10256 : 11280)) + (m & 1023); }
        else col = 12304 + 512 + (n0 - 12800);
        return w + (size_t)k * 13328 + col + cb * 4; } };
struct MapPlain { const float* w; int ld;
    __device__ __forceinline__ const float* operator()(int n0, int cb, int k) const { return w + (size_t)k * ld + n0 + cb * 4; } };
struct MapE13 { const float* w1; long d31;
    __device__ __forceinline__ const float* operator()(int n0, int cb, int k) const { return w1 + ((cb & 1) ? d31 : 0l) + (size_t)k * 512 + (n0 >> 1) + 4 * (cb >> 1); } };
template <class MAP> __device__ __forceinline__ void xpose_tile(const MAP& map, int n0, int k0, bf16_t* dst, int K, LDSP lds) {
    LASF tl = (LASF)lds; const int tid = ltid();
    float4 v[4];
#pragma unroll
    for (int pass = 0; pass < 4; ++pass) v[pass] = *(const float4*)map(n0, tid & 15, k0 + pass * 32 + (tid >> 4));
#pragma unroll
    for (int pass = 0; pass < 4; ++pass) { const int k = pass * 32 + (tid >> 4), cb = tid & 15;
        tl[k * 65 + cb * 4 + 0] = v[pass].x; tl[k * 65 + cb * 4 + 1] = v[pass].y; tl[k * 65 + cb * 4 + 2] = v[pass].z; tl[k * 65 + cb * 4 + 3] = v[pass].w; }
    __syncthreads();
    { const int n = tid >> 3, kq = (tid & 7) * 16; float f[8], g[8];
#pragma unroll
      for (int i = 0; i < 8; ++i) { f[i] = tl[(kq + i) * 65 + n]; g[i] = tl[(kq + 8 + i) * 65 + n]; }
      bf16_t* d = dst + (size_t)(n0 + n) * K + k0 + kq;
      *(u32x4*)d = pack8(f); *(u32x4*)(d + 8) = pack8(g); }
    __syncthreads();
}
template <class MAP> __device__ __forceinline__ void xpose_mat(const MAP& map, int N, int K, bf16_t* dst, LDSP lds, int bid, int nb) {
    const int ntn = N / 64, ntk = K / 128;
    for (int ti = bid; ti < ntn * ntk; ti += nb) { const int nt = ti / ntk, kt = ti - nt * ntk; xpose_tile(map, nt * 64, kt * 128, dst, K, lds); }
}
__device__ __forceinline__ void phase_conv_small(const Params& p, int layer, LDSP lds, int bid, int nb) {
    { MapWin m{p.w_in + (size_t)layer * 1024 * 13328}; xpose_mat(m, 13312, 1024, p.Wt_in, lds, bid, nb); }
    { MapPlain m{p.w_br_m + (size_t)layer * 1048576, 1024}; xpose_mat(m, 1024, 1024, p.Wt_br + (size_t)layer * 3 * 1048576, lds, bid, nb); }
    { MapPlain m{p.w_br_a + (size_t)layer * 1048576, 1024}; xpose_mat(m, 1024, 1024, p.Wt_br + (size_t)layer * 3 * 1048576 + 1048576, lds, bid, nb); }
    { MapPlain m{p.w_br_h + (size_t)layer * 1048576, 1024}; xpose_mat(m, 1024, 1024, p.Wt_br + (size_t)layer * 3 * 1048576 + 2 * 1048576, lds, bid, nb); }
    { MapPlain m{p.w_out + (size_t)layer * 1048576, 1024}; xpose_mat(m, 1024, 1024, p.Wt_out + (size_t)layer * 1048576, lds, bid, nb); }
}
__device__ __forceinline__ void phase_conv_experts(const Params& p, int layer, bf16_t* Wt13, bf16_t* Wt2, LDSP lds, int bid, int nb) {
    for (int ti = bid; ti < 32 * 128; ti += nb) { const int e = ti >> 7, r = ti & 127, nt = r >> 3, kt = r & 7;
        MapE13 m{p.e_w1 + ((size_t)layer * 32 + e) * 524288, (long)(p.e_w3 - p.e_w1)};
        xpose_tile(m, nt * 64, kt * 128, Wt13 + (size_t)e * 1048576, 1024, lds); }
    for (int ti = bid; ti < 32 * 64; ti += nb) { const int e = ti >> 6, r = ti & 63, nt = r >> 2, kt = r & 3;
        MapPlain m{p.e_w2 + ((size_t)layer * 32 + e) * 524288, 1024};
        xpose_tile(m, nt * 64, kt * 128, Wt2 + (size_t)e * 524288, 512, lds); }
}

__device__ __forceinline__ void phase_modvec(const Params& p, LDSP lds, int bid, int nb) {
    LASF red = (LASF)lds; const int tid = ltid();
    for (int u = bid; u < 192; u += nb) {
        const int l = u / 96, cg = u - l * 96, col = tid & 63, ks = tid >> 6;
        const float* W = p.mod_w + (size_t)l * 1024 * 6144 + cg * 64 + col;
        float a0 = 0.f, a1 = 0.f, a2 = 0.f;
        for (int k0 = ks * 128; k0 < ks * 128 + 128; k0 += 16) { float w[16], c0[16], c1[16], c2[16];
#pragma unroll
            for (int j = 0; j < 16; ++j) { w[j] = W[(size_t)(k0 + j) * 6144]; c0[j] = p.c[k0 + j]; c1[j] = p.c[1024 + k0 + j]; c2[j] = p.c_ctx[k0 + j]; }
#pragma unroll
            for (int j = 0; j < 16; ++j) { a0 += siluf_(c0[j]) * w[j]; a1 += siluf_(c1[j]) * w[j]; a2 += siluf_(c2[j]) * w[j]; } }
        red[(ks * 3 + 0) * 64 + col] = a0; red[(ks * 3 + 1) * 64 + col] = a1; red[(ks * 3 + 2) * 64 + col] = a2;
        __syncthreads();
        if (tid < 192) { const int v = tid >> 6, cc = tid & 63; float s = p.mod_b[l * 6144 + cg * 64 + cc];
#pragma unroll
            for (int q = 0; q < 8; ++q) s += red[(q * 3 + v) * 64 + cc];
            p.modv[(size_t)(l * 3 + v) * 6144 + cg * 64 + cc] = s; }
        __syncthreads();
    }
}

__device__ __forceinline__ void phase_hdn(const Params& p, LDSP lds, int bid, int nb) {
    LASF w1s = (LASF)lds, b1s = w1s + 33 * 64, w2s = b1s + 64, b2s = w2s + 64 * 64, frs = b2s + 64, hbuf = frs + 64;
    const int tid = ltid();
    for (int u = bid; u < 132; u += nb) {
        const int l = u / 66, pu = u - l * 66;
        for (int i = tid; i < 33 * 64; i += NTH) w1s[i] = p.h_ffn_w1[l * 33 * 64 + i];
        for (int i = tid; i < 64 * 64; i += NTH) w2s[i] = p.h_ffn_w2[l * 4096 + i];
        if (tid < 64) { b1s[tid] = p.h_ffn_b1[l * 64 + tid]; b2s[tid] = p.h_ffn_b2[l * 64 + tid]; frs[tid] = p.h_freq[l * 64 + tid]; }
        __syncthreads();
        const int pos = tid >> 2, qd = tid & 3, q = pu * 128 + pos;
        const int Lf = q < 8192 ? 8192 : 256, t = q < 8192 ? q : q - 8192;
        float z[33];
        z[0] = (float)t / (float)(Lf - 1);
        const float wrev = (float)t / (float)Lf;
#pragma unroll
        for (int j = 0; j < 16; ++j) { const float f = 1e-4f + (float)j * ((15.0f - 1e-4f) / 15.0f); float ph = f * wrev; ph -= floorf(ph); z[1 + j] = cos2pi(ph); z[17 + j] = -sin2pi(ph); }
#pragma unroll
        for (int jj = 0; jj < 16; ++jj) { const int j = qd * 16 + jj; float a = b1s[j];
#pragma unroll
            for (int i = 0; i < 33; ++i) a += z[i] * w1s[i * 64 + j];
            hbuf[pos * 65 + j] = sinf(frs[j] * a); }
        __syncthreads();
        float acc[16];
#pragma unroll
        for (int jj = 0; jj < 16; ++jj) acc[jj] = b2s[qd * 16 + jj];
        for (int i = 0; i < 64; ++i) { const float hv = hbuf[pos * 65 + i];
#pragma unroll
            for (int jj = 0; jj < 16; ++jj) acc[jj] += hv * w2s[i * 64 + qd * 16 + jj]; }
#pragma unroll
        for (int jj = 0; jj < 16; ++jj) p.hdn2[((size_t)l * 8448 + q) * 64 + qd * 16 + jj] = sinf(frs[qd * 16 + jj] * acc[jj]);
        __syncthreads();
    }
}
__device__ __forceinline__ void phase_taps(const Params& p, int layer, bf16_t* tapsT, LDSP lds, int bid, int nb) {
    LASF wsum = (LASF)lds;
    const int nunits = 512 + (layer == 0 ? 64 : 0);
    const float* w3 = UP((const float*)p.h_ffn_w3 + (size_t)layer * 64 * 2048); const float* hd = UP((const float*)p.hdn2 + (size_t)layer * 8448 * 64);
    const float* decp = UP((const float*)p.h_decay + layer * 2048);
    for (int u = bid; u < nunits; u += nb) {
        const int tid = ltid(), lane = tid & 63, r32 = lane & 31, hi = lane >> 5; const int wid = __builtin_amdgcn_readfirstlane(tid >> 6);
        const bool isc = u >= 512; const int cgp = isc ? u - 512 : (u >> 3), tch = isc ? 0 : (u & 7);
        const int Lf = isc ? 256 : 8192; const float rL = 1.0f / (float)(Lf - 1);
        bf16x8 afh[4], afl[4];
#pragma unroll
        for (int kk = 0; kk < 4; ++kk) { float a[8], lo[8]; u32x4 wh, wl;
#pragma unroll
            for (int j = 0; j < 8; ++j) a[j] = w3[(size_t)(16 * kk + 8 * hi + j) * 2048 + 32 * cgp + r32];
            wh = pack8(a);
            { float ah[8]; unpack8(wh, ah);
#pragma unroll
              for (int j = 0; j < 8; ++j) lo[j] = a[j] - ah[j]; }
            wl = pack8(lo); afh[kk] = __builtin_bit_cast(bf16x8, wh); afl[kk] = __builtin_bit_cast(bf16x8, wl); }
        float dcy[16], ss[16];
#pragma unroll
        for (int r = 0; r < 16; ++r) { dcy[r] = fabsf(decp[32 * cgp + crow(r, hi)]); ss[r] = 0.f; }
        const int ntb = isc ? 1 : 4;
        for (int tb = 0; tb < ntb; ++tb) {
            const int t0 = isc ? 32 * wid : tch * 1024 + (4 * wid + tb) * 32, t = t0 + r32;
            const float* hr = hd + (size_t)(isc ? 8192 + t : t) * 64;
            f32x4 hv[8];
#pragma unroll
            for (int i = 0; i < 4; ++i) { hv[2 * i] = *(const f32x4*)(hr + 16 * i + 8 * hi); hv[2 * i + 1] = *(const f32x4*)(hr + 16 * i + 8 * hi + 4); }
            f32x16 acc;
#pragma unroll
            for (int r = 0; r < 16; ++r) acc[r] = 0.f;
#pragma unroll
            for (int kk = 0; kk < 4; ++kk) { float b[8], lo[8];
                const f32x4 q0 = hv[2 * kk], q1 = hv[2 * kk + 1];
                b[0] = q0.x; b[1] = q0.y; b[2] = q0.z; b[3] = q0.w; b[4] = q1.x; b[5] = q1.y; b[6] = q1.z; b[7] = q1.w;
                const u32x4 wh = pack8(b); float bh[8]; unpack8(wh, bh);
#pragma unroll
                for (int j = 0; j < 8; ++j) lo[j] = b[j] - bh[j];
                const u32x4 wl = pack8(lo); const bf16x8 bfh = __builtin_bit_cast(bf16x8, wh), bfl = __builtin_bit_cast(bf16x8, wl);
                acc = __builtin_amdgcn_mfma_f32_32x32x16_bf16(afh[kk], bfh, acc, 0, 0, 0);
                acc = __builtin_amdgcn_mfma_f32_32x32x16_bf16(afh[kk], bfl, acc, 0, 0, 0);
                acc = __builtin_amdgcn_mfma_f32_32x32x16_bf16(afl[kk], bfh, acc, 0, 0, 0); }
            const float tl = (float)t * rL;
#pragma unroll
            for (int r = 0; r < 16; ++r) { const float a = acc[r] * __expf(-tl * dcy[r]); ss[r] += a * a;
                const int col = 32 * cgp + crow(r, hi);
                if (isc) { if (col < 1024) p.hfC[col * 256 + t] = a; else p.hbC[(col - 1024) * 256 + t] = a; }
                else if (col < 1024) tapsT[(size_t)col * 16384 + t] = f2bf(a);
                else { if (t > 0) tapsT[(size_t)(col - 1024) * 16384 + 16384 - t] = f2bf(a); else tapsT[(size_t)(col - 1024) * 16384 + 8192] = 0; } }
        }
#pragma unroll
        for (int r = 0; r < 16; ++r) { float v = ss[r];
#pragma unroll
            for (int o = 16; o >= 1; o >>= 1) v += __shfl_xor(v, o);
            if (r32 == 0) wsum[wid * 32 + crow(r, hi)] = v; }
        __syncthreads();
        if (tid < 32) { float tot = 0.f;
#pragma unroll
            for (int w = 0; w < 8; ++w) tot += wsum[w * 32 + tid];
            if (isc) p.sumsqC[2048 + 32 * cgp + tid] = tot; else p.sumsq[((size_t)(layer * 64 + cgp) * 8 + tch) * 32 + tid] = tot; }
        __syncthreads();
    }
}

__device__ __forceinline__ void phase_norm1(const Params& p, int layer, LDSP lds, int bid, int nb) {
    LASF wg = (LASF)lds;
    const int tid = ltid(), lane = tid & 63, wid = tid >> 6;
    { float4 wv[8];
#pragma unroll
      for (int j = 0; j < 8; ++j) { const int i = tid + NTH * j; wv[j] = *(const float4*)(p.w_in + (size_t)layer * 1024 * 13328 + (size_t)(i >> 2) * 13328 + 4096 + (i & 3) * 4); }
#pragma unroll
      for (int j = 0; j < 8; ++j) { const int i = tid + NTH * j, n = i >> 2, j4 = (i & 3) * 4; wg[n * 20 + j4] = wv[j].x; wg[n * 20 + j4 + 1] = wv[j].y; wg[n * 20 + j4 + 2] = wv[j].z; wg[n * 20 + j4 + 3] = wv[j].w; } }
    __syncthreads();
    const float* gn = p.norm1_g + layer * 1024;
    for (int s = bid * 8 + wid; s < TT; s += nb * 8) {
        const float* xr = resid_row_in(p, layer, s); const float* mv = modvec(p, layer, s);
        float xv[16], gv[16], scv[16], shv[16]; float ssq = 0.f;
#pragma unroll
        for (int i = 0; i < 16; ++i) { const int n = lane + 64 * i; xv[i] = xr[n]; gv[i] = gn[n]; scv[i] = mv[1024 + n]; shv[i] = mv[n]; }
#pragma unroll
        for (int i = 0; i < 16; ++i) ssq += xv[i] * xv[i];
        ssq = wave_sum(ssq); const float rstd = rsqrtf(ssq * (1.0f / 1024.0f) + EPS_);
        float acc[16];
#pragma unroll
        for (int j = 0; j < 16; ++j) acc[j] = 0.f;
#pragma unroll
        for (int i = 0; i < 16; ++i) { const int n = lane + 64 * i; const float hv = xv[i] * rstd * gv[i] * (1.0f + scv[i]) + shv[i];
            p.hn[(size_t)s * 1024 + n] = f2bf(hv);
#pragma unroll
            for (int j4 = 0; j4 < 4; ++j4) { const f32x4 w = *(const PG8_LAS f32x4*)(wg + n * 20 + 4 * j4); acc[4 * j4] += hv * w.x; acc[4 * j4 + 1] += hv * w.y; acc[4 * j4 + 2] += hv * w.z; acc[4 * j4 + 3] += hv * w.w; }
            if (i & 1) __builtin_amdgcn_sched_barrier(0); }
        wave_sum16(acc);
        if ((lane & 15) == 0) { f32x4 g4; g4[0] = acc[0]; g4[1] = acc[1]; g4[2] = acc[2]; g4[3] = acc[3]; *(f32x4*)(p.G + (size_t)s * 16 + (lane >> 4) * 4) = g4; }
    }
    __syncthreads();
}

__device__ __forceinline__ void phase_attn_prep(const Params& p, int layer, bf16_t* aq, bf16_t* ak, int bid, int nb) {
    const int tid = ltid(), lane = tid & 63, wid = tid >> 6;
    const int grp = lane >> 2, i4 = lane & 3;
    const float* qg = p.a_qnorm_g + layer * 64; const float* kg = p.a_knorm_g + layer * 64;
    float gq[16], gk[16];
#pragma unroll
    for (int c = 0; c < 4; ++c)
#pragma unroll
        for (int e = 0; e < 4; ++e) { gq[c * 4 + e] = qg[16 * c + 4 * i4 + e]; gk[c * 4 + e] = kg[16 * c + 4 * i4 + e]; }
    float inv[4];
#pragma unroll
    for (int e = 0; e < 4; ++e) inv[e] = exp2f(-(float)(4 * i4 + e) * (13.287712379549449f / 16.0f));
    const float qscale = 0.125f * 1.4426950408889634f;
    for (int s = bid * 8 + wid; s < TT; s += nb * 8) {
        const int b = s / SEQB, pos = s - b * SEQB; const bool lat = pos >= LC; const int t = pos - LC;
        float cs[8], sn[8];
        if (lat) { const float rowf = (float)(t >> 6), colf = (float)(t & 63);
#pragma unroll
            for (int e = 0; e < 4; ++e) { float ar = rowf * inv[e] * INV2PI, ac = colf * inv[e] * INV2PI; ar -= floorf(ar); ac -= floorf(ac);
                cs[e] = cos2pi(ar); sn[e] = sin2pi(ar); cs[4 + e] = cos2pi(ac); sn[4 + e] = sin2pi(ac); } }
        u32x2 wqk[2][4];
#pragma unroll
        for (int which = 0; which < 2; ++which)
#pragma unroll
            for (int c = 0; c < 4; ++c) wqk[which][c] = *(const u32x2*)((which ? ak : aq) + (size_t)s * 1024 + grp * 64 + 4 * i4 + 16 * c);
#pragma unroll
        for (int which = 0; which < 2; ++which) {
            bf16_t* base = (which ? ak : aq) + (size_t)s * 1024 + grp * 64 + 4 * i4;
            float v[16]; float ssq = 0.f;
#pragma unroll
            for (int c = 0; c < 4; ++c) { const u32x2 w = wqk[which][c]; v[4 * c] = lo16(w.x); v[4 * c + 1] = hi16(w.x); v[4 * c + 2] = lo16(w.y); v[4 * c + 3] = hi16(w.y); }
#pragma unroll
            for (int i = 0; i < 16; ++i) ssq += v[i] * v[i];
            ssq += __shfl_xor(ssq, 1); ssq += __shfl_xor(ssq, 2);
            const float rstd = rsqrtf(ssq * (1.0f / 64.0f) + EPS_) * (which ? 1.0f : qscale);
#pragma unroll
            for (int i = 0; i < 16; ++i) v[i] = v[i] * rstd * (which ? gk[i] : gq[i]);
            if (lat) {
#pragma unroll
                for (int hf = 0; hf < 2; ++hf)
#pragma unroll
                    for (int e = 0; e < 4; ++e) { const float x1 = v[8 * hf + e], x2 = v[8 * hf + 4 + e], cc = cs[4 * hf + e], sv = sn[4 * hf + e];
                        v[8 * hf + e] = x1 * cc - x2 * sv; v[8 * hf + 4 + e] = x2 * cc + x1 * sv; }
            }
#pragma unroll
            for (int c = 0; c < 4; ++c) { u32x2 w; w.x = pk2(v[4 * c], v[4 * c + 1]); w.y = pk2(v[4 * c + 2], v[4 * c + 3]); *(u32x2*)(base + 16 * c) = w; }
        }
    }
}

__device__ __forceinline__ s16x4 vtr16(const PG8_LAS unsigned char* ptr) {
    typedef short v4i16_t __attribute__((ext_vector_type(4)));
    return __builtin_bit_cast(s16x4, __builtin_amdgcn_ds_read_tr16_b64_v4i16((PG8_LAS v4i16_t*)ptr)); }

__device__ __forceinline__ void glds16(const void* gsrc, unsigned lds_dst) { unsigned keep;
    asm volatile("s_mov_b32 %0, m0\n\ts_mov_b32 m0, %2\n\ts_nop 0\n\tglobal_load_lds_dwordx4 %1, off\n\ts_mov_b32 m0, %0" : "=&s"(keep) : "v"(gsrc), "s"(lds_dst) : "memory"); }
__device__ __forceinline__ float max3f_(float a, float b, float c) { float r; asm("v_max3_f32 %0, %1, %2, %3" : "=v"(r) : "v"(a), "v"(b), "v"(c)); return r; }
#define ATT_WAIT_BAR(N) asm volatile("s_waitcnt vmcnt(" #N ") lgkmcnt(0)\n\ts_barrier" ::: "memory")
__device__ __forceinline__ void attn_unit(const Params& p, int layer, const bf16_t* Q, const bf16_t* K, const bf16_t* V, bf16_t* O, int b, int h, int q0pos, int nkeys, float lam, float lam_init, LDSP lds) {
    const int tid = ltid(), lane = tid & 63, r32 = lane & 31, hi = lane >> 5; const int wid = __builtin_amdgcn_readfirstlane(tid >> 6), comp = wid >> 2, qblk = wid & 3;
    const size_t rowb = (size_t)b * SEQB;
    const bf16_t* qrow = Q + (rowb + q0pos + 32 * qblk + r32) * 1024 + h * 128 + comp * 64 + hi * 8;
    bf16x8 qf[4];
#pragma unroll
    for (int d0 = 0; d0 < 4; ++d0) qf[d0] = *(const bf16x8*)(qrow + d0 * 16);
    f32x16 o[4];
#pragma unroll
    for (int d0 = 0; d0 < 4; ++d0)
#pragma unroll
        for (int r = 0; r < 16; ++r) o[d0][r] = 0.f;
    float l = 0.f;
    const f32x16 zero16 = {0.f, 0.f, 0.f, 0.f, 0.f, 0.f, 0.f, 0.f, 0.f, 0.f, 0.f, 0.f, 0.f, 0.f, 0.f, 0.f};
    const int ntiles = nkeys >> 6;
    const unsigned lds0 = (unsigned)(uintptr_t)(unsigned char*)lds;
    const int krow0 = 8 * wid + (lane >> 4), krow1 = krow0 + 4, kpos = lane & 15;
    const unsigned kvo0 = (unsigned)(krow0 * 1024 + ((kpos ^ (krow0 & 15)) * 8)) * 2u, kvo1 = (unsigned)(krow1 * 1024 + ((kpos ^ (krow1 & 15)) * 8)) * 2u - 1024u;
    const unsigned vvo0 = (unsigned)((16 * ((2 * wid) & 3) + (lane >> 2)) * 1024 + ((2 * wid) >> 2) * 32 + (lane & 3) * 8) * 2u;
    const unsigned vvo1 = (unsigned)((16 * ((2 * wid + 1) & 3) + (lane >> 2)) * 1024 + ((2 * wid + 1) >> 2) * 32 + (lane & 3) * 8) * 2u - 1024u;
    const bf16_t* kub = K + rowb * 1024 + h * 128; const bf16_t* vub = V + rowb * 1024 + h * 128;
    const unsigned kd0 = lds0 + (2 * wid) * 1024, vd0 = lds0 + 16384 + (2 * wid) * 1024;
#define ATT_DMA2(sb, va, vb_, m0v) asm volatile("s_mov_b32 m0, %3\n\ts_nop 0\n\tglobal_load_lds_dwordx4 %0, %2\n\tglobal_load_lds_dwordx4 %1, %2 offset:1024" :: "v"(va), "v"(vb_), "s"(sb), "s"(m0v) : "memory", "m0")
#define ATT_DMA(t, slot) do { const size_t to_ = (size_t)(t) * 64 * 1024; const unsigned so_ = (unsigned)(slot) * 32768u; \
        ATT_DMA2(kub + to_, kvo0, kvo1, (unsigned)__builtin_amdgcn_readfirstlane(kd0 + so_)); ATT_DMA2(vub + to_, vvo0, vvo1, (unsigned)__builtin_amdgcn_readfirstlane(vd0 + so_)); } while (0)
    asm volatile("" : "+v"(qf[0]), "+v"(qf[1]), "+v"(qf[2]), "+v"(qf[3]));
    ATT_DMA(0, 0); ATT_DMA(1, 1); ATT_DMA(2, 2);
    ATT_WAIT_BAR(4);
    const PG8_LAS unsigned char* kbase = lds + r32 * 256; const int kx0 = ((comp * 8 + hi) ^ (r32 & 15)) << 4;
    const PG8_LAS unsigned char* vbase = lds + 16384 + ((lane >> 4) & 1) * 32 + (lane & 3) * 8 + (4 * hi + ((lane & 15) >> 2)) * 64;
    bf16x8 vbA[4], vbB[4], kb[4], pfA, pfB; f32x16 S0, S1; float la = 0.f, lb = 0.f;
#define ATT_SB __builtin_amdgcn_sched_barrier(0)
#define ATT_VLD(vb, Vp, ks) do { _Pragma("unroll") for (int d0 = 0; d0 < 4; ++d0) { const s16x4 lo = vtr16((Vp) + d0 * 4096 + (ks) * 1024), hh = vtr16((Vp) + d0 * 4096 + (ks) * 1024 + 512); \
        vb[d0] = (bf16x8){lo[0], lo[1], lo[2], lo[3], hh[0], hh[1], hh[2], hh[3]}; } } while (0)
#define ATT_KLD(Kp, half) do { _Pragma("unroll") for (int d0 = 0; d0 < 4; ++d0) kb[d0] = *(const PG8_LAS bf16x8*)((Kp) + (kx0 ^ (d0 << 5)) + (half) * 8192); } while (0)
#define ATT_STAGE(vbU, pfU, DOQK, QS, DOEXP, ES, off, pfN) do { unsigned w_[4]; \
        _Pragma("unroll") for (int g = 0; g < 4; ++g) { \
            o[g] = __builtin_amdgcn_mfma_f32_32x32x16_bf16(vbU[g], pfU, o[g], 0, 0, 0); \
            if (DOQK) QS = __builtin_amdgcn_mfma_f32_32x32x16_bf16(kb[g], qf[g], g ? QS : zero16, 0, 0, 0); \
            if (DOEXP) { const float ea_ = __builtin_amdgcn_exp2f(ES[(off) + 2 * g]), eb_ = __builtin_amdgcn_exp2f(ES[(off) + 2 * g + 1]); la += ea_; lb += eb_; w_[g] = pk2(ea_, eb_); } \
              \
            asm volatile("" : "+v"(o[g]), "+v"(pfU)); \
            if (DOQK) asm volatile("" : "+v"(QS)); \
            if (DOEXP) asm volatile("" : "+v"(w_[g]), "+v"(ES), "+v"(la), "+v"(lb)); \
            ATT_SB; } \
        if (DOEXP) { u32x4 wv_; wv_.x = w_[0]; wv_.y = w_[1]; wv_.z = w_[2]; wv_.w = w_[3]; pfN = __builtin_bit_cast(bf16x8, wv_); } } while (0)
    { ATT_KLD(kbase, 0);
#pragma unroll
      for (int d0 = 0; d0 < 4; ++d0) S0 = __builtin_amdgcn_mfma_f32_32x32x16_bf16(kb[d0], qf[d0], d0 ? S0 : zero16, 0, 0, 0);
      ATT_KLD(kbase, 1);
#pragma unroll
      for (int d0 = 0; d0 < 4; ++d0) S1 = __builtin_amdgcn_mfma_f32_32x32x16_bf16(kb[d0], qf[d0], d0 ? S1 : zero16, 0, 0, 0);
      ATT_VLD(vbA, vbase, 0);
      u32x4 w_;
#pragma unroll
      for (int g = 0; g < 4; ++g) { const float ea_ = __builtin_amdgcn_exp2f(S0[2 * g]), eb_ = __builtin_amdgcn_exp2f(S0[2 * g + 1]); la += ea_; lb += eb_; w_[g] = pk2(ea_, eb_); }
      pfA = __builtin_bit_cast(bf16x8, w_); ATT_SB; }
#define ATT_TILE(NX) do { const PG8_LAS unsigned char* Vs_ = vbase + (t & 3) * 32768; const PG8_LAS unsigned char* Vn_ = vbase + ((t + 1) & 3) * 32768; const PG8_LAS unsigned char* Kn_ = kbase + ((t + 1) & 3) * 32768; \
        ATT_VLD(vbB, Vs_, 1); if (NX) ATT_KLD(Kn_, 0); \
        { const int td = t + 3 < ntiles ? t + 3 : ntiles - 1; ATT_DMA(td, (t + 3) & 3); } ATT_SB; \
        ATT_STAGE(vbA, pfA, 0, S0, 1, S0, 8, pfB); \
        ATT_VLD(vbA, Vs_, 2); ATT_SB; \
        ATT_STAGE(vbB, pfB, NX, S0, 1, S1, 0, pfA); \
        ATT_VLD(vbB, Vs_, 3); if (NX) ATT_KLD(Kn_, 1); ATT_SB; \
        ATT_STAGE(vbA, pfA, 0, S1, 1, S1, 8, pfB); \
        if (NX) ATT_VLD(vbA, Vn_, 0); ATT_SB; \
        ATT_STAGE(vbB, pfB, NX, S1, NX, S0, 0, pfA); \
        ATT_WAIT_BAR(4); } while (0)
    int t = 0;
    for (; t < ntiles - 1; ++t) ATT_TILE(1);
    ATT_TILE(0);
    ATT_WAIT_BAR(0);
    l = la + lb;
#undef ATT_SB
#undef ATT_VLD
#undef ATT_KLD
#undef ATT_STAGE
#undef ATT_TILE
#undef ATT_DMA
#undef ATT_DMA2
    l += __shfl_xor(l, 32);
    const float rl = 1.0f / l;
    LASF xch = (LASF)(lds) + qblk * 4096;
    if (comp == 1) {
#pragma unroll
        for (int d0 = 0; d0 < 4; ++d0)
#pragma unroll
            for (int r = 0; r < 16; ++r) xch[(32 * d0 + crow(r, hi)) * 32 + r32] = o[d0][r] * rl;
    }
    __syncthreads();
    if (comp == 0) {
        float ssq = 0.f;
#pragma unroll
        for (int d0 = 0; d0 < 4; ++d0)
#pragma unroll
            for (int r = 0; r < 16; ++r) { const float y = o[d0][r] * rl - lam * xch[(32 * d0 + crow(r, hi)) * 32 + r32]; o[d0][r] = y; ssq += y * y; }
        ssq += __shfl_xor(ssq, 32);
        const float sc = rsqrtf(ssq * (1.0f / 128.0f) + EPS_) * (1.0f - lam_init);
        const float* sg = p.a_subln_g + layer * 128;
        bf16_t* orow = O + (rowb + q0pos + 32 * qblk + r32) * 1024 + h * 128;
#pragma unroll
        for (int d0 = 0; d0 < 4; ++d0)
#pragma unroll
            for (int r4 = 0; r4 < 4; ++r4) { const int d = 32 * d0 + 8 * r4 + 4 * hi; u32x2 w;
                w.x = pk2(o[d0][4 * r4] * sc * sg[d], o[d0][4 * r4 + 1] * sc * sg[d + 1]); w.y = pk2(o[d0][4 * r4 + 2] * sc * sg[d + 2], o[d0][4 * r4 + 3] * sc * sg[d + 3]);
                *(u32x2*)(orow + d) = w; }
    }
    __syncthreads();
}
__device__ __forceinline__ void phase_attn(const Params& p, int layer, const bf16_t* Q, const bf16_t* K, const bf16_t* V, bf16_t* O, LDSP lds, int bid, int nb) {
    const float lam_init = 0.8f - 0.6f * expf(-0.3f * (float)layer);
    const float* lp = p.a_lambda + layer * 256; float d1 = 0.f, d2 = 0.f;
    for (int i = 0; i < 64; ++i) { d1 += lp[i] * lp[64 + i]; d2 += lp[128 + i] * lp[192 + i]; }
    const float lam = expf(d1) - expf(d2) + lam_init;
    const int nunits = 1024 + (layer == 0 ? 32 : 0);
    for (int u = bid; u < nunits; u += nb) {
        if (u < 1024) { int bh = u >> 6, qb = u & 63;
            if (nb == 256) { const int x = bid & 7; bh = (x >> 1) + 4 * (u >> 8); qb = (x & 1) * 32 + (bid >> 3); }
            attn_unit(p, layer, Q, K, V, O, bh >> 3, bh & 7, LC + qb * 128, SEQB, lam, lam_init, lds); }
        else { const int v = u - 1024, bh = v >> 1, qb = v & 1; attn_unit(p, layer, Q, K, V, O, bh >> 3, bh & 7, qb * 128, LC, lam, lam_init, lds); }
    }
}

__device__ __forceinline__ int scan_idx(int dir, int c) { return dir == 0 ? c : (c < 2 ? 1 - c : 67 - c); }

__device__ __forceinline__ void load_gates(const Params& p, int layer, size_t row0, int h, LASF tb) {
    const int tid = ltid();
    if (tid < 128) { const float* g = p.G + (row0 + tid) * 16; const float* gb = p.m_gate_b + layer * 16;
        tb[tid] = g[h] + gb[h]; tb[128 + tid] = logsigf_(g[4 + h] + gb[4 + h]); tb[256 + tid] = g[8 + h] + gb[8 + h]; tb[384 + tid] = logsigf_(g[12 + h] + gb[12 + h]); }
}

__device__ __forceinline__ float wave_scan_sum(float v, int lane) {
#pragma unroll
    for (int o = 1; o < 64; o <<= 1) { const float y = __shfl_up(v, o); if (lane >= o) v += y; }
    return v; }
__device__ __forceinline__ float wave_scan_max(float v, int lane) {
#pragma unroll
    for (int o = 1; o < 64; o <<= 1) { const float y = __shfl_up(v, o); if (lane >= o) v = fmaxf(v, y); }
    return v; }

__device__ __forceinline__ void mconv8(const u32x4 rp, const u32x4 rc, const u32x4 rn, const float* cw, const float* cb, int cc, float scale, float (&o)[8]) {
    float up[8], uc[8], un[8]; unpack8(rp, up); unpack8(rc, uc); unpack8(rn, un);
    const f32x4 b0 = *(const f32x4*)(cb + cc), b1 = *(const f32x4*)(cb + cc + 4), w00 = *(const f32x4*)(cw + cc), w01 = *(const f32x4*)(cw + cc + 4);
    const f32x4 w10 = *(const f32x4*)(cw + 2048 + cc), w11 = *(const f32x4*)(cw + 2048 + cc + 4), w20 = *(const f32x4*)(cw + 4096 + cc), w21 = *(const f32x4*)(cw + 4096 + cc + 4);
#pragma unroll
    for (int i = 0; i < 4; ++i) { o[i] = siluf_(b0[i] + up[i] * w00[i] + uc[i] * w10[i] + un[i] * w20[i]) * scale; o[4 + i] = siluf_(b1[i] + up[4 + i] * w01[i] + uc[4 + i] * w11[i] + un[4 + i] * w21[i]) * scale; }
}
__device__ __forceinline__ void phase_mA(const Params& p, int layer, const bf16_t* mk_, const bf16_t* mv_, bf16_t* vT_, bf16_t* ST_, LDSP lds, int bid, int nb) {
    const bf16_t* mk = UP(mk_); const bf16_t* mv = UP(mv_); bf16_t* vT = UP(vT_); bf16_t* ST = UP(ST_);
    constexpr int RS = 576;
    LDSP Kt = lds; LDSP Vt = lds + 128 * RS;
    LASF tb = (LASF)(lds + 256 * RS);
    LASF part = tb + 512;
    const float* gbias = UP((const float*)p.m_gate_b + layer * 16); const float* Gp = UP((const float*)p.G);
    const float* cw = UP((const float*)p.m_conv_w + (size_t)layer * 3 * 2048); const float* cb = UP((const float*)p.m_conv_b + layer * 2048);
    float* scalp = UP((float*)p.scal); float* dnp = UP((float*)p.dn);
    for (int u = bid; u < 8 * 66; u += nb) {
        const int tid = ltid(), lane = tid & 63, r32 = lane & 31, hi = lane >> 5; const int wid = __builtin_amdgcn_readfirstlane(tid >> 6);
        const int c = u % 66, bh = u / 66, b = bh >> 2, h = bh & 3;
        const size_t row0 = (size_t)b * SEQB + 128 * c;
        const int idxf = scan_idx(0, c), idxb = scan_idx(1, c);
        const int tq = tid & 127, dsel = (tid >> 7) & 1;
        float li = 0.f, lf = 0.f;
        if (tid < 256) { const float* g = Gp + (row0 + tq) * 16; li = g[8 * dsel + h] + gbias[8 * dsel + h]; lf = logsigf_(g[8 * dsel + 4 + h] + gbias[8 * dsel + 4 + h]); }
        float inc = wave_scan_sum(lf, lane);
        if (lane == 63 && wid < 4) tb[256 + wid] = inc;
        __syncthreads();
        const float tot = tb[256 + 2 * dsel] + tb[257 + 2 * dsel]; if (wid == 1 || wid == 3) inc += tb[256 + wid - 1];
        const float wsv = (dsel == 0 ? tot - inc : inc - lf) + li;
        const float mxw = wave_max(tid < 256 ? wsv : -1e30f);
        if (lane == 0 && wid < 4) tb[272 + wid] = mxw;
        __syncthreads();
        { const float mloc = fmaxf(tb[272 + 2 * dsel], tb[273 + 2 * dsel]);
          if (tid < 256) tb[128 * dsel + tq] = __expf(wsv - mloc);
          if (tq == 0 && tid < 256) { float* s0 = scalp + ((size_t)(bh * 2 + dsel) * 66 + (dsel ? idxb : idxf)) * 2; s0[0] = tot; s0[1] = mloc; } }
        __syncthreads();
        const int ch8 = (tid & 31) * 8; float dnf[8], dnb[8];
#pragma unroll
        for (int e = 0; e < 8; ++e) { dnf[e] = 0.f; dnb[e] = 0.f; }
#pragma unroll
        for (int jb = 0; jb < 4; ++jb) { u32x4 rk[2][3], rv[2];
#pragma unroll
            for (int jj = 0; jj < 2; ++jj) { const int t = (tid >> 5) + 16 * (2 * jb + jj), pos = 128 * c + t; const bf16_t* src = mk + (row0 + t) * 1024 + h * 256 + ch8;
                const bool hasp = (pos != 0) && (pos != LC), hasn = (pos != LC - 1) && (pos != SEQB - 1);
                rk[jj][1] = *(const u32x4*)src; rk[jj][0] = hasp ? *(const u32x4*)(src - 1024) : (u32x4){0u, 0u, 0u, 0u}; rk[jj][2] = hasn ? *(const u32x4*)(src + 1024) : (u32x4){0u, 0u, 0u, 0u};
                rv[jj] = *(const u32x4*)(mv + (row0 + t) * 1024 + h * 256 + ch8); }
#pragma unroll
            for (int jj = 0; jj < 2; ++jj) { const int t = (tid >> 5) + 16 * (2 * jb + jj); float o[8];
                mconv8(rk[jj][0], rk[jj][1], rk[jj][2], cw, cb, 1024 + h * 256 + ch8, 0.0625f, o);
                const u32x4 kk = pack8(o); unpack8(kk, o);
                const float wf = tb[t], wb = tb[128 + t];
#pragma unroll
                for (int e = 0; e < 8; ++e) { dnf[e] += wf * o[e]; dnb[e] += wb * o[e]; }
                *(PG8_LAS u32x4*)(Kt + t * RS + ch8 * 2) = kk; *(PG8_LAS u32x4*)(Vt + t * RS + ch8 * 2) = rv[jj]; } }
#pragma unroll
        for (int e = 0; e < 8; ++e) { dnf[e] += __shfl_xor(dnf[e], 32); dnb[e] += __shfl_xor(dnb[e], 32); }
        if (hi == 0) {
#pragma unroll
            for (int e = 0; e < 8; ++e) part[wid * 256 + ch8 + e] = dnf[e]; }
        __syncthreads();
        if (tid < 256) { float sm = 0.f;
#pragma unroll
            for (int w = 0; w < 8; ++w) sm += part[w * 256 + tid];
            dnp[((size_t)(bh * 2) * 66 + idxf) * 256 + tid] = sm; }
        __syncthreads();
        if (hi == 0) {
#pragma unroll
            for (int e = 0; e < 8; ++e) part[wid * 256 + ch8 + e] = dnb[e]; }
#pragma unroll
        for (int it = 0; it < 2; ++it) { const int item = tid + NTH * it, dp = item >> 3, tg = item & 7;
            const PG8_LAS unsigned* srcl = (const PG8_LAS unsigned*)(Vt + (16 * tg) * RS + 4 * dp);
            bf16_t* dst = vT + ((size_t)(bh * 256 + 2 * dp)) * SEQB + 128 * c + 16 * tg;
            unsigned w[16];
#pragma unroll
            for (int i = 0; i < 16; ++i) w[i] = srcl[i * (RS / 4)];
            u32x4 lo0, lo1, hi0, hi1;
            lo0.x = __builtin_amdgcn_perm(w[1], w[0], 0x05040100u); lo0.y = __builtin_amdgcn_perm(w[3], w[2], 0x05040100u); lo0.z = __builtin_amdgcn_perm(w[5], w[4], 0x05040100u); lo0.w = __builtin_amdgcn_perm(w[7], w[6], 0x05040100u);
            lo1.x = __builtin_amdgcn_perm(w[9], w[8], 0x05040100u); lo1.y = __builtin_amdgcn_perm(w[11], w[10], 0x05040100u); lo1.z = __builtin_amdgcn_perm(w[13], w[12], 0x05040100u); lo1.w = __builtin_amdgcn_perm(w[15], w[14], 0x05040100u);
            hi0.x = __builtin_amdgcn_perm(w[1], w[0], 0x07060302u); hi0.y = __builtin_amdgcn_perm(w[3], w[2], 0x07060302u); hi0.z = __builtin_amdgcn_perm(w[5], w[4], 0x07060302u); hi0.w = __builtin_amdgcn_perm(w[7], w[6], 0x07060302u);
            hi1.x = __builtin_amdgcn_perm(w[9], w[8], 0x07060302u); hi1.y = __builtin_amdgcn_perm(w[11], w[10], 0x07060302u); hi1.z = __builtin_amdgcn_perm(w[13], w[12], 0x07060302u); hi1.w = __builtin_amdgcn_perm(w[15], w[14], 0x07060302u);
            *(u32x4*)(dst) = lo0; *(u32x4*)(dst + 8) = lo1; *(u32x4*)(dst + SEQB) = hi0; *(u32x4*)(dst + SEQB + 8) = hi1; }
        const int troff = ((lane >> 4) & 1) * 32 + (lane & 3) * 8 + (4 * hi + ((lane & 15) >> 2)) * RS;
        bf16x8 Bf[8];
#pragma unroll
        for (int ks = 0; ks < 8; ++ks) { const s16x4 lo = vtr16(Vt + troff + ks * 16 * RS + wid * 64), hh = vtr16(Vt + troff + (ks * 16 + 8) * RS + wid * 64);
            Bf[ks] = (bf16x8){lo[0], lo[1], lo[2], lo[3], hh[0], hh[1], hh[2], hh[3]}; }
        __syncthreads();
        if (tid < 256) { float sm = 0.f;
#pragma unroll
            for (int w = 0; w < 8; ++w) sm += part[w * 256 + tid];
            dnp[((size_t)(bh * 2 + 1) * 66 + idxb) * 256 + tid] = sm; }
        LDSP stg = Vt + wid * 8704;
#pragma unroll 1
        for (int dir = 0; dir < 2; ++dir) {
            bf16x8 Bs[8];
#pragma unroll
            for (int ks = 0; ks < 8; ++ks) { float f[8]; unpack8(__builtin_bit_cast(u32x4, Bf[ks]), f);
#pragma unroll
                for (int j = 0; j < 8; ++j) f[j] *= tb[128 * dir + 16 * ks + 8 * (j >> 2) + 4 * hi + (j & 3)];
                Bs[ks] = __builtin_bit_cast(bf16x8, pack8(f)); }
            bf16_t* st = ST + ((size_t)(bh * 2 + dir) * 66 + (dir ? idxb : idxf)) * 65536 + (size_t)(32 * wid) * 256;
#pragma unroll 1
            for (int kh = 0; kh < 2; ++kh) {
                f32x16 acc[4];
#pragma unroll
                for (int kb = 0; kb < 4; ++kb)
#pragma unroll
                    for (int r = 0; r < 16; ++r) acc[kb][r] = 0.f;
#pragma unroll
                for (int ks = 0; ks < 8; ++ks) {
#pragma unroll
                    for (int kb = 0; kb < 4; ++kb) { const s16x4 lo = vtr16(Kt + troff + ks * 16 * RS + (4 * kh + kb) * 64), hh = vtr16(Kt + troff + (ks * 16 + 8) * RS + (4 * kh + kb) * 64);
                        const bf16x8 aa = (bf16x8){lo[0], lo[1], lo[2], lo[3], hh[0], hh[1], hh[2], hh[3]};
                        acc[kb] = __builtin_amdgcn_mfma_f32_32x32x16_bf16(aa, Bs[ks], acc[kb], 0, 0, 0); }
                    if (ks & 1) __builtin_amdgcn_sched_barrier(0); }
#pragma unroll
                for (int kb = 0; kb < 4; ++kb)
#pragma unroll
                    for (int r4 = 0; r4 < 4; ++r4) { u32x2 w; w.x = pk2(acc[kb][4 * r4], acc[kb][4 * r4 + 1]); w.y = pk2(acc[kb][4 * r4 + 2], acc[kb][4 * r4 + 3]);
                        *(PG8_LAS u32x2*)(stg + r32 * 272 + (32 * kb + 8 * r4 + 4 * hi) * 2) = w; }
                asm volatile("s_waitcnt lgkmcnt(0)" ::: "memory");
#pragma unroll
                for (int i = 0; i < 8; ++i) { const int row = 4 * i + (lane >> 4), ch = lane & 15;
                    *(u32x4*)(st + (size_t)row * 256 + 128 * kh + 8 * ch) = *(const PG8_LAS u32x4*)(stg + row * 272 + ch * 16); }
            }
        }
        __syncthreads();
    }
}

__device__ __forceinline__ void phase_mB(const Params& p, bf16_t* ST, int bid, int nb) {
    const int tid = ltid();
    { const int ipb = (16 * 256 + nb - 1) / nb, it = bid * ipb + tid;
      if (tid < ipb && it < 16 * 256) {
          const int bhd = it >> 8, kd = it & 255; const float* sc = p.scal + (size_t)bhd * 132; float n = 0.f, m = 0.f;
          if (kd == 0) p.ms[bhd * 67] = 0.f;
          for (int i0 = 0; i0 < 66; i0 += 11) { float dv[11], bqv[11], mlv[11];
#pragma unroll
              for (int j = 0; j < 11; ++j) { dv[j] = p.dn[((size_t)bhd * 66 + i0 + j) * 256 + kd]; bqv[j] = sc[2 * (i0 + j)]; mlv[j] = sc[2 * (i0 + j) + 1]; }
#pragma unroll
              for (int j = 0; j < 11; ++j) { const float mn = fmaxf(bqv[j] + m, mlv[j]), a = __expf(bqv[j] + m - mn), bb = __expf(mlv[j] - mn);
                  n = a * n + bb * dv[j]; p.nst[((size_t)bhd * 66 + i0 + j) * 256 + kd] = n; m = mn; if (kd == 0) p.ms[bhd * 67 + i0 + j + 1] = mn; } } } }
    for (int it = bid * NTH + tid; it < 16 * 8192; it += nb * NTH) {
        const int bhd = it >> 13; bf16_t* st = ST + (size_t)bhd * 66 * 65536 + (size_t)(it & 8191) * 8; const float* sc = p.scal + (size_t)bhd * 132;
        float C[8];
#pragma unroll
        for (int e = 0; e < 8; ++e) C[e] = 0.f;
        float m = 0.f;
        for (int i0 = 0; i0 < 66; i0 += 11) {
            u32x4 v[11];
#pragma unroll
            for (int j = 0; j < 11; ++j) v[j] = *(const u32x4*)(st + (size_t)(i0 + j) * 65536);
#pragma unroll
            for (int j = 0; j < 11; ++j) { const float bq = sc[2 * (i0 + j)], ml = sc[2 * (i0 + j) + 1]; const float mn = fmaxf(bq + m, ml), a = __expf(bq + m - mn), bb = __expf(ml - mn);
                float f[8]; unpack8(v[j], f);
#pragma unroll
                for (int e = 0; e < 8; ++e) C[e] = a * C[e] + bb * f[e];
                *(u32x4*)(st + (size_t)(i0 + j) * 65536) = pack8(C); m = mn; }
        }
    }
}

__device__ __forceinline__ void phase_mC(const Params& p, int layer, const bf16_t* mq_, const bf16_t* mk_, const bf16_t* vT_, const bf16_t* mo_, const bf16_t* ST_, bf16_t* ym_, LDSP lds, int bid, int nb) {
    const bf16_t* mq = UP(mq_); const bf16_t* mk = UP(mk_); const bf16_t* vT = UP(vT_);
    const float* cw = UP((const float*)p.m_conv_w + (size_t)layer * 3 * 2048); const float* cb = UP((const float*)p.m_conv_b + layer * 2048); const bf16_t* mo = UP(mo_); const bf16_t* ST = UP(ST_); bf16_t* ym = UP(ym_);
    LDSP qs = lds; LDSP ksm = lds + 67584; LDSP Wf = ksm; LDSP Wb = ksm + 34816;
    LASF T = (LASF)(lds + 67584 + 69632);
    LASF red = T + 2048; LASF den2 = red + 1024; LASF qn2 = den2 + 512;
    const int skip = layer == 0 ? 0 : 2;
    const int nun = 8 * (66 - skip);
    const float* gbias = UP((const float*)p.m_gate_b + layer * 16); const float* mng = UP((const float*)p.m_norm_g + layer * 256);
    const float* Gp = UP((const float*)p.G); const float* msp = UP((const float*)p.ms); const float* nstp = UP((const float*)p.nst);
    for (int u = bid; u < nun; u += nb) {
        const int tid = ltid(), lane = tid & 63, r32 = lane & 31, hi = lane >> 5; const int wid = __builtin_amdgcn_readfirstlane(tid >> 6);
        const int c = skip + u % (66 - skip), bh = u / (66 - skip), b = bh >> 2, h = bh & 3;
        const size_t row0 = (size_t)b * SEQB + 128 * c;
        const int idxf = scan_idx(0, c), idxb = scan_idx(1, c);
        const bf16_t* vp = vT + ((size_t)(bh * 256 + 32 * wid + r32)) * SEQB + 128 * c + 8 * hi;
        const int tq = tid & 127, dsel = (tid >> 7) & 1, tok = dsel ? 127 - tq : tq;
        float li = 0.f, lf = 0.f;
        if (tid < 256) { const float* g = Gp + (row0 + tok) * 16; li = g[8 * dsel + h] + gbias[8 * dsel + h]; lf = logsigf_(g[8 * dsel + 4 + h] + gbias[8 * dsel + 4 + h]); }
        const float mpf = msp[(bh * 2 + 0) * 67 + idxf], mpb = msp[(bh * 2 + 1) * 67 + idxb];
        { const int ch8 = (tid & 31) * 8;
#pragma unroll
          for (int jb = 0; jb < 4; ++jb) { u32x4 rq[2][3], rk[2][3];
#pragma unroll
              for (int jj = 0; jj < 2; ++jj) { const int t = (tid >> 5) + 16 * (2 * jb + jj), pos = 128 * c + t; const size_t off = (row0 + t) * 1024 + h * 256 + ch8;
                  const bool hasp = (pos != 0) && (pos != LC), hasn = (pos != LC - 1) && (pos != SEQB - 1); const u32x4 zz = {0u, 0u, 0u, 0u};
                  rq[jj][1] = *(const u32x4*)(mq + off); rq[jj][0] = hasp ? *(const u32x4*)(mq + off - 1024) : zz; rq[jj][2] = hasn ? *(const u32x4*)(mq + off + 1024) : zz;
                  rk[jj][1] = *(const u32x4*)(mk + off); rk[jj][0] = hasp ? *(const u32x4*)(mk + off - 1024) : zz; rk[jj][2] = hasn ? *(const u32x4*)(mk + off + 1024) : zz; }
#pragma unroll
              for (int jj = 0; jj < 2; ++jj) { const int t = (tid >> 5) + 16 * (2 * jb + jj); float o[8];
                  mconv8(rq[jj][0], rq[jj][1], rq[jj][2], cw, cb, h * 256 + ch8, 1.0f, o); *(PG8_LAS u32x4*)(qs + t * 528 + ch8 * 2) = pack8(o);
                  mconv8(rk[jj][0], rk[jj][1], rk[jj][2], cw, cb, 1024 + h * 256 + ch8, 0.0625f, o); *(PG8_LAS u32x4*)(ksm + t * 528 + ch8 * 2) = pack8(o); } } }
        float inc = wave_scan_sum(lf, lane);
        if (lane == 63 && wid < 4) red[wid] = inc;
        __syncthreads();
        if (wid == 1 || wid == 3) inc += red[wid - 1];
        const float av = li - inc;
        float pmx = wave_scan_max(tid < 256 ? av : -1e30f, lane);
        if (lane == 63 && wid < 4) red[8 + wid] = pmx;
        __syncthreads();
        if (wid == 1 || wid == 3) pmx = fmaxf(pmx, red[8 + wid - 1]);
        if (tid < 256) { const float mp = dsel ? mpb : mpf, g = fmaxf(mp, pmx);
            T[512 + 128 * dsel + tok] = av; T[768 + 128 * dsel + tok] = g; T[1024 + 128 * dsel + tok] = __expf(mp - g); T[1280 + 128 * dsel + tok] = __expf(-(inc + g)); }
        { const int t = tid & 127, part = tid >> 7; float sf = 0.f, sb = 0.f;
          if (idxf > 0 || idxb > 0) {
              const float* nf = nstp + ((size_t)(bh * 2 + 0) * 66 + (idxf > 0 ? idxf - 1 : 0)) * 256 + part * 64; const float* nbk = nstp + ((size_t)(bh * 2 + 1) * 66 + (idxb > 0 ? idxb - 1 : 0)) * 256 + part * 64;
              for (int d8 = 0; d8 < 8; ++d8) { float f[8]; unpack8(*(const PG8_LAS u32x4*)(qs + t * 528 + (part * 64 + d8 * 8) * 2), f);
#pragma unroll
                  for (int e = 0; e < 8; ++e) { sf += f[e] * nf[d8 * 8 + e]; sb += f[e] * nbk[d8 * 8 + e]; } } }
          qn2[(part * 2 + 0) * 128 + t] = idxf > 0 ? sf : 0.f; qn2[(part * 2 + 1) * 128 + t] = idxb > 0 ? sb : 0.f; }
        const int tj = wid & 3, sg = wid >> 2;
        f32x16 sacc[2];
#pragma unroll
        for (int e = 0; e < 2; ++e)
#pragma unroll
            for (int r = 0; r < 16; ++r) sacc[e][r] = 0.f;
#pragma unroll 4
        for (int kk = 0; kk < 16; ++kk) { const bf16x8 bq = *(const PG8_LAS bf16x8*)(qs + (32 * tj + r32) * 528 + (16 * kk + 8 * hi) * 2);
#pragma unroll
            for (int e = 0; e < 2; ++e) { const bf16x8 ak = *(const PG8_LAS bf16x8*)(ksm + (32 * (2 * sg + e) + r32) * 528 + (16 * kk + 8 * hi) * 2);
                sacc[e] = __builtin_amdgcn_mfma_f32_32x32x16_bf16(ak, bq, sacc[e], 0, 0, 0); } }
        __syncthreads();
        { const int tz2 = ltid(), r32b = tz2 & 31, hib = (tz2 >> 5) & 1;
          const int t = 32 * tj + r32b; const float gf = T[768 + t], gb = T[896 + t]; float denf = 0.f, denb = 0.f;
          const LASF Taf = T + 512 + 64 * sg + 4 * hib; const LASF Tab = T + 640 + 64 * sg + 4 * hib;
          LDSP wfp = Wf + t * 272 + (64 * sg + 4 * hib) * 2; LDSP wbp = Wb + t * 272 + (64 * sg + 4 * hib) * 2;
#pragma unroll
          for (int e = 0; e < 2; ++e)
#pragma unroll
              for (int r4 = 0; r4 < 4; ++r4) { const int s0 = 32 * (2 * sg + e) + 8 * r4 + 4 * hib; float wf[4], wb[4];
#pragma unroll
                  for (int i = 0; i < 4; ++i) { const int s = s0 + i; const float sv = sacc[e][4 * r4 + i];
                      wf[i] = (s <= t) ? sv * __expf(Taf[32 * e + 8 * r4 + i] - gf) : 0.f; wb[i] = (s >= t) ? sv * __expf(Tab[32 * e + 8 * r4 + i] - gb) : 0.f; denf += wf[i]; denb += wb[i]; }
                  u32x2 w; w.x = pk2(wf[0], wf[1]); w.y = pk2(wf[2], wf[3]); *(PG8_LAS u32x2*)(wfp + (32 * e + 8 * r4) * 2) = w;
                  w.x = pk2(wb[0], wb[1]); w.y = pk2(wb[2], wb[3]); *(PG8_LAS u32x2*)(wbp + (32 * e + 8 * r4) * 2) = w; }
          denf += __shfl_xor(denf, 32); denb += __shfl_xor(denb, 32);
          if (hib == 0) { den2[(sg * 2 + 0) * 128 + t] = denf; den2[(sg * 2 + 1) * 128 + t] = denb; } }
        __syncthreads();
        f32x16 hs[4]; unsigned hp[4][8];
#pragma unroll
        for (int dir = 0; dir < 2; ++dir) {
            const int idx = dir ? idxb : idxf;
            f32x16 acc[4];
#pragma unroll
            for (int j = 0; j < 4; ++j)
#pragma unroll
                for (int r = 0; r < 16; ++r) acc[j][r] = 0.f;
            if (idx > 0) {
                const bf16_t* Cp = ST + ((size_t)(bh * 2 + dir) * 66 + idx - 1) * 65536 + (32 * wid + r32) * 256 + 8 * hi;
#pragma unroll
                for (int hb = 0; hb < 2; ++hb) {
                    bf16x8 Cf[8];
#pragma unroll
                    for (int k8 = 0; k8 < 8; ++k8) Cf[k8] = *(const bf16x8*)(Cp + 16 * (8 * hb + k8));
#pragma unroll
                    for (int k8 = 0; k8 < 8; ++k8) {
#pragma unroll
                        for (int j = 0; j < 4; ++j) { const bf16x8 bq = *(const PG8_LAS bf16x8*)(qs + (32 * j + r32) * 528 + (16 * (8 * hb + k8) + 8 * hi) * 2);
                            acc[j] = __builtin_amdgcn_mfma_f32_32x32x16_bf16(Cf[k8], bq, acc[j], 0, 0, 0); }
                        if (k8 & 1) __builtin_amdgcn_sched_barrier(0); } }
                const LASF Tw = T + 1024 + 128 * dir + (ltid() & 31);
#pragma unroll
                for (int j = 0; j < 4; ++j) { const float wi = Tw[32 * j];
#pragma unroll
                    for (int r = 0; r < 16; ++r) acc[j][r] *= wi; }
            }
            { bf16x8 Vf[8];
#pragma unroll
              for (int ks = 0; ks < 8; ++ks) Vf[ks] = *(const bf16x8*)(vp + 16 * ks);
              const LDSP W = dir ? Wb : Wf;
#pragma unroll
              for (int ks = 0; ks < 8; ++ks) {
#pragma unroll
                  for (int j = 0; j < 4; ++j) { const bf16x8 bw = *(const PG8_LAS bf16x8*)(W + (32 * j + r32) * 272 + (16 * ks + 8 * hi) * 2);
                      acc[j] = __builtin_amdgcn_mfma_f32_32x32x16_bf16(Vf[ks], bw, acc[j], 0, 0, 0); }
                  if (ks & 1) __builtin_amdgcn_sched_barrier(0); } }
            const int r32c = ltid() & 31;
            const LASF qnp = qn2 + dir * 128 + r32c; const LASF dnp = den2 + dir * 128 + r32c; const LASF Tp = T + 1024 + 128 * dir + r32c;
#pragma unroll
            for (int j = 0; j < 4; ++j) {
                const float qn = qnp[32 * j] + qnp[256 + 32 * j] + qnp[512 + 32 * j] + qnp[768 + 32 * j];
                const float den = dnp[32 * j] + dnp[256 + 32 * j] + Tp[32 * j] * qn;
                const float inv = 1.0f / fmaxf(fabsf(den), Tp[256 + 32 * j]);
                if (dir == 0) {
#pragma unroll
                    for (int r = 0; r < 16; r += 2) hp[j][r >> 1] = pk2(acc[j][r] * inv, acc[j][r + 1] * inv); }
                else {
#pragma unroll
                    for (int r = 0; r < 16; r += 2) { hs[j][r] = lo16(hp[j][r >> 1]) + acc[j][r] * inv; hs[j][r + 1] = hi16(hp[j][r >> 1]) + acc[j][r + 1] * inv; } } }
        }
        u32x2 gg[4][4];
        { const int tz = ltid(), r32o = tz & 31, hio = (tz >> 5) & 1, wido = tz >> 6; const size_t obase = (row0 + r32o) * 1024 + h * 256 + 32 * wido + 4 * hio;
#pragma unroll
          for (int j = 0; j < 4; ++j)
#pragma unroll
              for (int r4 = 0; r4 < 4; ++r4) gg[j][r4] = *(const u32x2*)(mo + obase + (size_t)j * 32 * 1024 + 8 * r4); }
#pragma unroll
        for (int j = 0; j < 4; ++j) { float ssq = 0.f;
#pragma unroll
            for (int r = 0; r < 16; ++r) ssq += hs[j][r] * hs[j][r];
            ssq += __shfl_xor(ssq, 32); const int tzr = ltid(); if (((tzr >> 5) & 1) == 0) red[(tzr >> 6) * 128 + 32 * j + (tzr & 31)] = ssq; }
        __syncthreads();
        {
          const int tz = ltid(), r32o = tz & 31, hio = (tz >> 5) & 1, wido = tz >> 6;
          const size_t obase = (row0 + r32o) * 1024 + h * 256 + 32 * wido + 4 * hio;
#pragma unroll
          for (int j = 0; j < 4; ++j) { const int t = 32 * j + r32o; float tot = 0.f;
#pragma unroll
              for (int w = 0; w < 8; ++w) tot += red[w * 128 + t];
              const float rstd = rsqrtf(tot * (1.0f / 256.0f) + EPS_);
#pragma unroll
              for (int r4 = 0; r4 < 4; ++r4) { const int v0 = 32 * wido + 8 * r4 + 4 * hio; const size_t off = obase + (size_t)j * 32 * 1024 + 8 * r4;
                  const u32x2 g = gg[j][r4]; u32x2 w;
                  w.x = pk2(hs[j][4 * r4] * rstd * mng[v0] * sigmoidf_(lo16(g.x)), hs[j][4 * r4 + 1] * rstd * mng[v0 + 1] * sigmoidf_(hi16(g.x)));
                  w.y = pk2(hs[j][4 * r4 + 2] * rstd * mng[v0 + 2] * sigmoidf_(lo16(g.y)), hs[j][4 * r4 + 3] * rstd * mng[v0 + 3] * sigmoidf_(hi16(g.y)));
                  *(u32x2*)(ym + off) = w; } } }
        __syncthreads();
    }
}

__device__ __forceinline__ void hconv8(const bf16_t* src, bool hasp, bool hasn, const float* cw, const float* cb, int cch, float (&o)[8]) {
    float up[8], uc[8], un[8];
    unpack8(*(const u32x4*)src, uc);
    if (hasp) unpack8(*(const u32x4*)(src - 1024), up); else {
#pragma unroll
        for (int i = 0; i < 8; ++i) up[i] = 0.f; }
    if (hasn) unpack8(*(const u32x4*)(src + 1024), un); else {
#pragma unroll
        for (int i = 0; i < 8; ++i) un[i] = 0.f; }
#pragma unroll
    for (int i = 0; i < 8; ++i) o[i] = cb[cch + i] + up[i] * cw[cch + i] + uc[i] * cw[3072 + cch + i] + un[i] * cw[6144 + cch + i];
}
struct H3 { u32x4 p, c, n; };
__device__ __forceinline__ H3 hload3(const bf16_t* src, bool hasp, bool hasn) { H3 r; const u32x4 z4 = {0u, 0u, 0u, 0u};
    r.c = *(const u32x4*)src; r.p = hasp ? *(const u32x4*)(src - 1024) : z4; r.n = hasn ? *(const u32x4*)(src + 1024) : z4; return r; }
__device__ __forceinline__ void hcomp8(const H3& r, const float* cw, const float* cb, int cch, float (&o)[8]) {
    float up[8], uc[8], un[8]; unpack8(r.p, up); unpack8(r.c, uc); unpack8(r.n, un);
#pragma unroll
    for (int i = 0; i < 8; ++i) o[i] = cb[cch + i] + up[i] * cw[cch + i] + uc[i] * cw[3072 + cch + i] + un[i] * cw[6144 + cch + i];
}
__device__ __forceinline__ void phase_hprep(const Params& p, int layer, const bf16_t* hx1, const bf16_t* hv, bf16_t* zT, LDSP lds, int bid, int nb) {
    const int tid = ltid(); LASF zt = (LASF)lds;
    const float* cw = p.h_conv_w + (size_t)layer * 3 * 3072; const float* cb = p.h_conv_b + layer * 3072;
    constexpr int NU = 2 * 128 * 4;
    u32x4 ra[4], rb[4];
#define HP_LOAD(u_) do { const int cg_ = (u_) & 3, tb_ = ((u_) >> 2) & 127, b_ = (u_) >> 9; const int tl_ = tb_ * 64 + (tid >> 3); const size_t row_ = (size_t)b_ * SEQB + LC + tl_; const bool hp_ = tl_ != 0, hn_ = tl_ != LL - 1; \
        _Pragma("unroll") for (int v8 = 0; v8 < 4; ++v8) { const int c_ = cg_ * 256 + v8 * 64 + (tid & 7) * 8; ra[v8] = *(const u32x4*)(hx1 + row_ * 1024 + c_); rb[v8] = *(const u32x4*)(hv + row_ * 1024 + c_); } } while (0)
    int u = bid;
    if (u < NU) HP_LOAD(u);
    for (; u < NU; u += nb) {
        const int cg = u & 3, tb = (u >> 2) & 127, b = u >> 9;
        const int t = tid >> 3, tl = tb * 64 + t; const size_t row = (size_t)b * SEQB + LC + tl; const bool hasp = tl != 0, hasn = tl != LL - 1; const u32x4 z4 = {0u, 0u, 0u, 0u};
#pragma unroll
        for (int v8 = 0; v8 < 4; ++v8) { const int cl = v8 * 64 + (tid & 7) * 8, c = cg * 256 + cl; float x1[8], vv[8];
            H3 ha, hb; ha.c = ra[v8]; hb.c = rb[v8];
            ha.p = hasp ? *(const u32x4*)(hx1 + (row - 1) * 1024 + c) : z4; ha.n = hasn ? *(const u32x4*)(hx1 + (row + 1) * 1024 + c) : z4;
            hb.p = hasp ? *(const u32x4*)(hv + (row - 1) * 1024 + c) : z4; hb.n = hasn ? *(const u32x4*)(hv + (row + 1) * 1024 + c) : z4;
            hcomp8(ha, cw, cb, 1024 + c, x1); hcomp8(hb, cw, cb, 2048 + c, vv);
#pragma unroll
            for (int i = 0; i < 8; ++i) zt[t * 257 + cl + i] = vv[i] * x1[i]; }
        __syncthreads();
        if (u + nb < NU) HP_LOAD(u + nb);
        __builtin_amdgcn_sched_barrier(0);
        { const int cl = tid >> 1, th = tid & 1; bf16_t* dst = zT + ((size_t)(b * 1024 + cg * 256 + cl)) * LL + tb * 64 + 32 * th;
#pragma unroll
          for (int q = 0; q < 4; ++q) { float f[8];
#pragma unroll
              for (int e = 0; e < 8; ++e) f[e] = zt[(32 * th + 8 * q + e) * 257 + cl];
              *(u32x4*)(dst + 8 * q) = pack8(f); } }
        __syncthreads();
    }
#undef HP_LOAD
}

__device__ __forceinline__ f32x2v cmul_(f32x2v a, f32x2v b) { return mk2_(a.x * b.x - a.y * b.y, a.x * b.y + a.y * b.x); }
__device__ __forceinline__ f32x2v cmulc_(f32x2v a, f32x2v b) { return mk2_(a.x * b.x + a.y * b.y, a.y * b.x - a.x * b.y); }
__device__ __forceinline__ f32x2v cadd_(f32x2v a, f32x2v b) { return mk2_(a.x + b.x, a.y + b.y); }
__device__ __forceinline__ f32x2v csub_(f32x2v a, f32x2v b) { return mk2_(a.x - b.x, a.y - b.y); }
__device__ __forceinline__ int fphys(int i) { return i + (i >> 5); }
template <bool INV> __device__ __forceinline__ void bfly16(f32x2v (&v)[16], const f32x2v w1) {
    const f32x2v w2 = cmul_(w1, w1), w4 = cmul_(w2, w2), w8 = cmul_(w4, w4);
    const float C1 = 0.92387953251128674f, S1 = 0.38268343236508977f, R2 = 0.70710678118654752f;
    const f32x2v c16[8] = {mk2_(1.f, 0.f), mk2_(C1, -S1), mk2_(R2, -R2), mk2_(S1, -C1), mk2_(0.f, -1.f), mk2_(-S1, -C1), mk2_(-R2, -R2), mk2_(-C1, -S1)};
    if (!INV) {
#pragma unroll
        for (int m = 0; m < 8; ++m) { const f32x2v W = cmul_(w1, c16[m]); const f32x2v a = v[m], b = v[m + 8]; v[m] = cadd_(a, b); v[m + 8] = cmul_(csub_(a, b), W); }
#pragma unroll
        for (int g = 0; g < 16; g += 8)
#pragma unroll
            for (int m = 0; m < 4; ++m) { const f32x2v W = cmul_(w2, c16[2 * m]); const f32x2v a = v[g + m], b = v[g + m + 4]; v[g + m] = cadd_(a, b); v[g + m + 4] = cmul_(csub_(a, b), W); }
#pragma unroll
        for (int g = 0; g < 16; g += 4)
#pragma unroll
            for (int m = 0; m < 2; ++m) { const f32x2v W = cmul_(w4, c16[4 * m]); const f32x2v a = v[g + m], b = v[g + m + 2]; v[g + m] = cadd_(a, b); v[g + m + 2] = cmul_(csub_(a, b), W); }
#pragma unroll
        for (int g = 0; g < 16; g += 2) { const f32x2v a = v[g], b = v[g + 1]; v[g] = cadd_(a, b); v[g + 1] = cmul_(csub_(a, b), w8); }
    } else {
#pragma unroll
        for (int g = 0; g < 16; g += 2) { const f32x2v a = v[g], b = cmulc_(v[g + 1], w8); v[g] = cadd_(a, b); v[g + 1] = csub_(a, b); }
#pragma unroll
        for (int g = 0; g < 16; g += 4)
#pragma unroll
            for (int m = 0; m < 2; ++m) { const f32x2v W = cmul_(w4, c16[4 * m]); const f32x2v a = v[g + m], b = cmulc_(v[g + m + 2], W); v[g + m] = cadd_(a, b); v[g + m + 2] = csub_(a, b); }
#pragma unroll
        for (int g = 0; g < 16; g += 8)
#pragma unroll
            for (int m = 0; m < 4; ++m) { const f32x2v W = cmul_(w2, c16[2 * m]); const f32x2v a = v[g + m], b = cmulc_(v[g + m + 4], W); v[g + m] = cadd_(a, b); v[g + m + 4] = csub_(a, b); }
#pragma unroll
        for (int m = 0; m < 8; ++m) { const f32x2v W = cmul_(w1, c16[m]); const f32x2v a = v[m], b = cmulc_(v[m + 8], W); v[m] = cadd_(a, b); v[m + 8] = csub_(a, b); }
    }
}
template <bool INV, int S, bool SYNC = true> __device__ __forceinline__ void fft_pass16(PG8_LAS f32x2v* cb) {
    constexpr int STR = S / 16;
    int tz = ltid();
#pragma unroll 2
    for (int k = 0; k < 2; ++k) { const int q = tz + NTH * k; const int j = q & (STR - 1), base = (q / STR) * S + j;
        f32x2v v[16];
#pragma unroll
        for (int m = 0; m < 16; ++m) v[m] = cb[fphys(base + STR * m)];
        const float rev = (float)j * (1.0f / (float)S); const f32x2v w1 = mk2_(cos2pi(rev), -sin2pi(rev));
        bfly16<INV>(v, w1);
#pragma unroll
        for (int m = 0; m < 16; ++m) cb[fphys(base + STR * m)] = v[m]; }
    if (SYNC) __syncthreads();
}
template <int NM> __device__ __forceinline__ void fft_pass_first(PG8_LAS f32x2v* cb, const bf16_t* s0, const bf16_t* s1) {
    const int tz = ltid();
    bf16_t r0[2][NM], r1[2][NM];
#pragma unroll
    for (int k = 0; k < 2; ++k)
#pragma unroll
        for (int m = 0; m < NM; ++m) { r0[k][m] = s0[tz + NTH * k + 1024 * m]; r1[k][m] = s1 ? s1[tz + NTH * k + 1024 * m] : (bf16_t)0; }
#pragma unroll
    for (int k = 0; k < 2; ++k) { const int j = tz + NTH * k;
        f32x2v v[16];
#pragma unroll
        for (int m = 0; m < 16; ++m) v[m] = m < NM ? mk2_(bf2f(r0[k][m]), bf2f(r1[k][m])) : mk2_(0.f, 0.f);
        const float rev = (float)j * (1.0f / 16384.0f); const f32x2v w1 = mk2_(cos2pi(rev), -sin2pi(rev));
        bfly16<false>(v, w1);
#pragma unroll
        for (int m = 0; m < 16; ++m) cb[fphys(j + 1024 * m)] = v[m]; }
    __syncthreads();
}
__device__ __forceinline__ void fft_pass_last(PG8_LAS f32x2v* cb, bf16_t* d0, bf16_t* d1) {
    const int tz = ltid();
#pragma unroll 1
    for (int k = 0; k < 2; ++k) { const int j = tz + NTH * k;
        f32x2v v[16];
#pragma unroll
        for (int m = 0; m < 16; ++m) v[m] = cb[fphys(j + 1024 * m)];
        const float rev = (float)j * (1.0f / 16384.0f); const f32x2v w1 = mk2_(cos2pi(rev), -sin2pi(rev));
        bfly16<true>(v, w1);
#pragma unroll
        for (int m = 0; m < 8; ++m) { d0[j + 1024 * m] = f2bf(v[m].x); d1[j + 1024 * m] = f2bf(v[m].y); } }
    __syncthreads();
}
__device__ __forceinline__ void r4_dif(f32x2v (&a)[4]) {
    const f32x2v b0 = cadd_(a[0], a[2]), b2 = csub_(a[0], a[2]), b1 = cadd_(a[1], a[3]); const f32x2v d = csub_(a[1], a[3]); const f32x2v b3 = mk2_(d.y, -d.x);
    a[0] = cadd_(b0, b1); a[1] = csub_(b0, b1); a[2] = cadd_(b2, b3); a[3] = csub_(b2, b3); }
__device__ __forceinline__ void r4_dit(f32x2v (&c)[4]) {
    const f32x2v b0 = cadd_(c[0], c[1]), b1 = csub_(c[0], c[1]), b2 = cadd_(c[2], c[3]), b3 = csub_(c[2], c[3]); const f32x2v ib3 = mk2_(-b3.y, b3.x);
    c[0] = cadd_(b0, b2); c[2] = csub_(b0, b2); c[1] = cadd_(b1, ib3); c[3] = csub_(b1, ib3); }

__device__ __forceinline__ void phase_fft(const Params& p, int layer, const bf16_t* tapsT, bf16_t* zT, float* Hscr, LDSP lds, int bid, int nb) {
    PG8_LAS f32x2v* cb = (PG8_LAS f32x2v*)lds; const int tid = ltid();
    for (int c = bid; c < 1024; c += nb) {
        fft_pass_first<16>(cb, tapsT + (size_t)c * 16384, nullptr); fft_pass16<false, 1024, false>(cb); fft_pass16<false, 64, false>(cb);
        float ssq_c = 0.f;
#pragma unroll
        for (int q = 0; q < 8; ++q) ssq_c += p.sumsq[((size_t)(layer * 64 + (c >> 5)) * 8 + q) * 32 + (c & 31)];
#pragma unroll
        for (int q = 0; q < 8; ++q) ssq_c += p.sumsq[((size_t)(layer * 64 + 32 + (c >> 5)) * 8 + q) * 32 + (c & 31)];
        const float scale = rsqrtf(ssq_c + EPS_) * (1.0f / 16384.0f);
        f32x2v H[8][4];
        { const int tz = ltid();
#pragma unroll
          for (int k = 0; k < 8; ++k) { const int q = 256 * (tz >> 6) + 2048 * (k >> 2) + 64 * (k & 3) + (tz & 63); f32x2v a[4];
#pragma unroll
              for (int m = 0; m < 4; ++m) a[m] = cb[fphys(4 * q + m)];
              r4_dif(a);
#pragma unroll
              for (int m = 0; m < 4; ++m) H[k][m] = mk2_(a[m].x * scale, a[m].y * scale); } }
        __syncthreads();
        fft_pass_first<8>(cb, zT + (size_t)c * LL, zT + (size_t)(1024 + c) * LL); fft_pass16<false, 1024, false>(cb); fft_pass16<false, 64, false>(cb);
        { const int tz = ltid();
#pragma unroll
          for (int k = 0; k < 8; ++k) { const int q = 256 * (tz >> 6) + 2048 * (k >> 2) + 64 * (k & 3) + (tz & 63); f32x2v a[4];
#pragma unroll
              for (int m = 0; m < 4; ++m) a[m] = cb[fphys(4 * q + m)];
              r4_dif(a);
#pragma unroll
              for (int m = 0; m < 4; ++m) a[m] = cmul_(a[m], H[k][m]);
              r4_dit(a);
#pragma unroll
              for (int m = 0; m < 4; ++m) cb[fphys(4 * q + m)] = a[m]; } }
        fft_pass16<true, 64, false>(cb); fft_pass16<true, 1024>(cb);
        fft_pass_last(cb, zT + (size_t)c * LL, zT + (size_t)(1024 + c) * LL);
    }
}
__device__ __forceinline__ void phase_hfin(const Params& p, int layer, const bf16_t* __restrict__ hx0, const bf16_t* __restrict__ hx1, const bf16_t* __restrict__ hv, const bf16_t* __restrict__ yT, bf16_t* __restrict__ yh, LDSP lds, int bid, int nb) {
    const int tid = ltid(); LASF yt = (LASF)lds;
    const float* cw = p.h_conv_w + (size_t)layer * 3 * 3072; const float* cb = p.h_conv_b + layer * 3072; const float* hb = p.h_bias + layer * 1024;
    for (int u = bid; u < 2 * 128 * 4; u += nb) {
        const int cg = u & 3, tb = (u >> 2) & 127, b = u >> 9;
        u32x4 rc0[4], rc1[4], rc2[4];
        { const size_t ro = ((size_t)b * SEQB + LC + tb * 64 + (tid >> 3)) * 1024 + cg * 256 + (tid & 7) * 8;
#pragma unroll
          for (int v8 = 0; v8 < 4; ++v8) { rc0[v8] = *(const u32x4*)(hx0 + ro + v8 * 64); rc1[v8] = *(const u32x4*)(hx1 + ro + v8 * 64); rc2[v8] = *(const u32x4*)(hv + ro + v8 * 64); } }
        { const int cl = tid >> 1, th = tid & 1; const bf16_t* src = yT + ((size_t)(b * 1024 + cg * 256 + cl)) * LL + tb * 64 + 32 * th;
          u32x4 yv[4];
#pragma unroll
          for (int q = 0; q < 4; ++q) yv[q] = *(const u32x4*)(src + 8 * q);
#pragma unroll
          for (int q = 0; q < 4; ++q) { float f[8]; unpack8(yv[q], f);
#pragma unroll
              for (int e = 0; e < 8; ++e) yt[cl * 65 + 32 * th + 8 * q + e] = f[e]; } }
        __syncthreads();
        const int t = tid >> 3, tl = tb * 64 + t; const size_t row = (size_t)b * SEQB + LC + tl; const bool hasp = tl != 0, hasn = tl != LL - 1;
#pragma unroll
        for (int v8 = 0; v8 < 4; ++v8) { const int cl = v8 * 64 + (tid & 7) * 8, c = cg * 256 + cl; float x0[8], x1[8], vv[8], o[8]; const u32x4 z4 = {0u, 0u, 0u, 0u};
            H3 h0, h1, h2; h0.c = rc0[v8]; h1.c = rc1[v8]; h2.c = rc2[v8];
            h0.p = hasp ? *(const u32x4*)(hx0 + (row - 1) * 1024 + c) : z4; h0.n = hasn ? *(const u32x4*)(hx0 + (row + 1) * 1024 + c) : z4;
            h1.p = hasp ? *(const u32x4*)(hx1 + (row - 1) * 1024 + c) : z4; h1.n = hasn ? *(const u32x4*)(hx1 + (row + 1) * 1024 + c) : z4;
            h2.p = hasp ? *(const u32x4*)(hv + (row - 1) * 1024 + c) : z4; h2.n = hasn ? *(const u32x4*)(hv + (row + 1) * 1024 + c) : z4;
            hcomp8(h0, cw, cb, c, x0); hcomp8(h1, cw, cb, 1024 + c, x1); hcomp8(h2, cw, cb, 2048 + c, vv);
#pragma unroll
            for (int i = 0; i < 8; ++i) o[i] = x0[i] * (yt[(cl + i) * 65 + t] + hb[c + i] * vv[i] * x1[i]);
            *(u32x4*)(yh + row * 1024 + c) = pack8(o); }
        __syncthreads();
    }
}
__device__ __forceinline__ void phase_hctx(const Params& p, int layer, const bf16_t* hx0, const bf16_t* hx1, const bf16_t* hv, bf16_t* yh, LDSP lds, int bid, int nb) {
    const int tid = ltid(); LASF zc = (LASF)lds, x0c = zc + 2048, hf = x0c + 2048, hbk = hf + 2048;
    const float* cw = p.h_conv_w + (size_t)layer * 3 * 3072; const float* cb = p.h_conv_b + layer * 3072; const float* hbias = p.h_bias + layer * 1024;
    for (int u = bid; u < 256; u += nb) {
        const int b = u >> 7, c0 = (u & 127) * 8;
        if (tid < 256) { const int t = tid; const size_t row = (size_t)b * SEQB + t; const bool hasp = t != 0, hasn = t != LC - 1; float x0[8], x1[8], vv[8];
            hconv8(hx0 + row * 1024 + c0, hasp, hasn, cw, cb, c0, x0); hconv8(hx1 + row * 1024 + c0, hasp, hasn, cw, cb, 1024 + c0, x1); hconv8(hv + row * 1024 + c0, hasp, hasn, cw, cb, 2048 + c0, vv);
#pragma unroll
            for (int i = 0; i < 8; ++i) { zc[t * 8 + i] = vv[i] * x1[i]; x0c[t * 8 + i] = x0[i]; } }
        for (int i = tid; i < 256 * 8; i += NTH) { const int j = i & 255, cl = i >> 8; const float rs = rsqrtf(p.sumsqC[2048 + c0 + cl] + p.sumsqC[2048 + 1024 + c0 + cl] + EPS_);
            hf[j * 8 + cl] = p.hfC[(size_t)(c0 + cl) * 256 + j] * rs; hbk[j * 8 + cl] = p.hbC[(size_t)(c0 + cl) * 256 + j] * rs; }
        __syncthreads();
        { const int cl = tid & 7, tg = tid >> 3;
#pragma unroll 1
          for (int ti = 0; ti < 4; ++ti) { const int t = tg + 64 * ti; float y = 0.f;
#pragma unroll 4
              for (int j = 0; j <= t; ++j) y += hf[j * 8 + cl] * zc[(t - j) * 8 + cl];
#pragma unroll 4
              for (int j = 1; j <= 255 - t; ++j) y += hbk[j * 8 + cl] * zc[(t + j) * 8 + cl];
              const float o = x0c[t * 8 + cl] * (y + hbias[c0 + cl] * zc[t * 8 + cl]);
              yh[((size_t)b * SEQB + t) * 1024 + c0 + cl] = f2bf(o); } }
        __syncthreads();
    }
}

__device__ __forceinline__ bool xcd_tile(int i, int c, int G, int T, int& tile) {
    if (G & 7) { tile = i * G + c; return tile < T; }
    const int per = G >> 3, x = c & 7, j = c >> 3, q = i * per + j, base = T >> 3, rem = T & 7;
    const int start = x * base + (x < rem ? x : rem), size = base + (x < rem ? 1 : 0);
    tile = start + q; return q < size; }
struct MergeOrder { int ntile, G, c, lat_only;
    __device__ __forceinline__ bool next(int i, pg8::Unit& u) const { const int tile = (i / 3) * G + c, j = i - (i / 3) * 3; if (tile >= ntile) return false;
        int pi = tile >> 2; const int n = tile & 3; if (lat_only) pi = (pi >> 5) * 33 + 1 + (pi & 31);
        u.pm = j * NPAN + pi; u.pn = j * 4 + n; return true; }
    __device__ __forceinline__ void a_ready(const pg8::Unit&) const {}
    __device__ __forceinline__ void done(const pg8::Unit&) const {} };
struct MergeEpi { static constexpr bool PERM = true, AFTER_DRAIN = false;
    const bf16_t* gates; const float* mb; bf16_t* ysum;
    __device__ __forceinline__ void operator()(const f32x4 (&acc)[2][2][4][2], const pg8::Unit& u, int wr, int wc, int fr, int fq) const {
        const int j = u.pn >> 2, pi = u.pm - j * NPAN, nt = u.pn & 3;
        const int row0 = pi * 256 + wr * 64 + fr, col0 = nt * 256 + wc * 32 + 8 * fq;
        const bf16_t* gj = gates + (size_t)j * TT * 1024;
#pragma unroll
        for (int bj = 0; bj < 2; ++bj) { const int col = col0 + bj * 128; float mbv[8];
#pragma unroll
            for (int i = 0; i < 8; ++i) mbv[i] = mb[j * 1024 + col + i];
#pragma unroll
            for (int ai = 0; ai < 2; ++ai) {
                u32x4 gv[4], ov[4];
#pragma unroll
                for (int m = 0; m < 4; ++m) { const size_t off = (size_t)(row0 + ai * 128 + m * 16) * 1024 + col; gv[m] = *(const u32x4*)(gj + off); if (j > 0) ov[m] = *(const u32x4*)(ysum + off); }
                __builtin_amdgcn_sched_barrier(0);
#pragma unroll
                for (int m = 0; m < 4; ++m) { const size_t off = (size_t)(row0 + ai * 128 + m * 16) * 1024 + col;
                    float g[8], o[8]; unpack8(gv[m], g);
#pragma unroll
                    for (int i = 0; i < 8; ++i) o[i] = sigmoidf_(g[i] + mbv[i]) * acc[ai][bj][m][i >> 2][i & 3];
                    if (j > 0) { float old[8]; unpack8(ov[m], old);
#pragma unroll
                        for (int i = 0; i < 8; ++i) o[i] += old[i]; }
                    *(u32x4*)(ysum + off) = pack8(o); }
                __builtin_amdgcn_sched_barrier(0); } }
    } };
struct OutOrder { int ntile, G, c, lat_only;
    __device__ __forceinline__ bool next(int i, pg8::Unit& u) const { const int tile = i * G + c; if (tile >= ntile) return false;
        int pi = tile >> 2; if (lat_only) pi = (pi >> 5) * 33 + 1 + (pi & 31); u.pm = pi; u.pn = tile & 3; return true; }
    __device__ __forceinline__ void a_ready(const pg8::Unit&) const {}
    __device__ __forceinline__ void done(const pg8::Unit&) const {} };
struct OutEpi { static constexpr bool PERM = false, AFTER_DRAIN = false;
    const Params* p; int layer;
    __device__ __forceinline__ void operator()(const f32x4 (&acc)[2][2][4][2], const pg8::Unit& u, int wr, int wc, int fr, int fq) const {
        const int row0 = u.pm * 256 + wr * 64 + fr, col0 = u.pn * 256 + wc * 32 + 4 * fq;
        const float* g1 = modvec(*p, layer, u.pm * 256) + 2048;
        f32x4 gq[4];
#pragma unroll
        for (int q = 0; q < 4; ++q) gq[q] = *(const f32x4*)(g1 + col0 + (q >> 1) * 128 + (q & 1) * 16);
#pragma unroll
        for (int ai = 0; ai < 2; ++ai) { f32x4 xv[16];
#pragma unroll
            for (int m = 0; m < 4; ++m) { const float* rin = resid_row_in(*p, layer, row0 + ai * 128 + m * 16);
#pragma unroll
                for (int q = 0; q < 4; ++q) xv[m * 4 + q] = *(const f32x4*)(rin + col0 + (q >> 1) * 128 + (q & 1) * 16); }
            __builtin_amdgcn_sched_barrier(0);
#pragma unroll
            for (int m = 0; m < 4; ++m) { float* ro = resid_row(*p, row0 + ai * 128 + m * 16);
#pragma unroll
                for (int q = 0; q < 4; ++q) *(f32x4*)(ro + col0 + (q >> 1) * 128 + (q & 1) * 16) = xv[m * 4 + q] + gq[q] * acc[ai][q >> 1][m][q & 1]; }
            __builtin_amdgcn_sched_barrier(0); }
    } };
struct MoeOrder { const PG8_LAS int* te; int ntl, G, c;
    __device__ __forceinline__ bool next(int i, pg8::Unit& u) const { int L; if (!xcd_tile(i, c, G, ntl * 4, L)) return false; const int tile = L >> 2; u.pm = tile; u.pn = te[tile] * 4 + (L & 3); return true; }
    __device__ __forceinline__ void a_ready(const pg8::Unit&) const {}
    __device__ __forceinline__ void done(const pg8::Unit&) const {} };
struct E1Epi { static constexpr bool PERM = true, AFTER_DRAIN = false;
    bf16_t* H;
    __device__ __forceinline__ void operator()(const f32x4 (&acc)[2][2][4][2], const pg8::Unit& u, int wr, int wc, int fr, int fq) const {
        const int row0 = u.pm * 256 + wr * 64 + fr, hid0 = ((u.pn & 3) * 256 + wc * 32 + 8 * fq) >> 1;
#pragma unroll
        for (int ai = 0; ai < 2; ++ai)
#pragma unroll
            for (int m = 0; m < 4; ++m)
#pragma unroll
                for (int bj = 0; bj < 2; ++bj) { const f32x4 a = acc[ai][bj][m][0], b = acc[ai][bj][m][1]; u32x2 w;
                    w.x = pk2(siluf_(a[0]) * b[0], siluf_(a[1]) * b[1]); w.y = pk2(siluf_(a[2]) * b[2], siluf_(a[3]) * b[3]);
                    *(u32x2*)(H + (size_t)(row0 + ai * 128 + m * 16) * 512 + hid0 + bj * 64) = w; }
    } };

struct EpiReg { static constexpr bool PERM = true, AFTER_DRAIN = false;
    bf16_t* O; size_t stride; bf16_t* O6; int col6;
    __device__ __forceinline__ void operator()(const f32x4 (&acc)[2][2][4][2], const pg8::Unit& u, int wr, int wc, int fr, int fq) const {
        const int row0 = u.pm * 256 + wr * 64 + fr; const int colt = u.pn * 256, reg = colt >> 10;
        bf16_t* base = reg < 6 ? O + (size_t)reg * stride : O6; const int col0 = (reg < 6 ? colt - (reg << 10) : col6 + colt - 6144) + wc * 32 + 8 * fq;
#pragma unroll
        for (int ai = 0; ai < 2; ++ai)
#pragma unroll
            for (int m = 0; m < 4; ++m) { bf16_t* rowp = base + (size_t)(row0 + ai * 128 + m * 16) * 1024 + col0;
#pragma unroll
                for (int bj = 0; bj < 2; ++bj) { const f32x4 v0 = acc[ai][bj][m][0], v1 = acc[ai][bj][m][1]; u32x4 w;
                    w.x = pk2(v0[0], v0[1]); w.y = pk2(v0[2], v0[3]); w.z = pk2(v1[0], v1[1]); w.w = pk2(v1[2], v1[3]);
                    *(u32x4*)(rowp + bj * 128) = w; } }
    } };

__device__ __forceinline__ void phase_norm2_router(const Params& p, int layer, LDSP lds, int bid, int nb, bool count = true) {
    LASF rw = (LASF)lds;
    const int tid = ltid(), lane = tid & 63, wid = tid >> 6;
    for (int i = bid * NTH + tid; i < TPAD; i += nb * NTH) p.rowidx[i] = 0;
    PG8_LAS int* hist = (PG8_LAS int*)(lds + 148 * 1024);
    if (tid < 32) hist[tid] = 0;
    { float4 wv[16];
#pragma unroll
      for (int j = 0; j < 16; ++j) { const int i = tid + NTH * j; wv[j] = *(const float4*)(p.router_w + (i >> 3) * 32 + (i & 7) * 4); }
#pragma unroll
      for (int j = 0; j < 16; ++j) { const int i = tid + NTH * j, n = i >> 3, e4 = (i & 7) * 4; rw[n * 36 + e4] = wv[j].x; rw[n * 36 + e4 + 1] = wv[j].y; rw[n * 36 + e4 + 2] = wv[j].z; rw[n * 36 + e4 + 3] = wv[j].w; } }
    __syncthreads();
    const float* gn = p.norm2_g + layer * 1024;
    float rb[8];
    { const f32x4 r0 = *(const f32x4*)(p.router_b + 8 * (lane >> 4)), r1 = *(const f32x4*)(p.router_b + 8 * (lane >> 4) + 4);
      rb[0] = r0[0]; rb[1] = r0[1]; rb[2] = r0[2]; rb[3] = r0[3]; rb[4] = r1[0]; rb[5] = r1[1]; rb[6] = r1[2]; rb[7] = r1[3]; }
    for (int s = bid * 8 + wid; s < TT; s += nb * 8) {
        const int pos = s % SEQB; if (layer == 1 && pos < LC) continue;
        const float* xr = resid_row(p, s); const float* mv = modvec(p, layer, s);
        float xv[16], gv[16], scv[16], shv[16]; float ssq = 0.f;
#pragma unroll
        for (int i = 0; i < 16; ++i) { const int n = lane + 64 * i; xv[i] = xr[n]; gv[i] = gn[n]; scv[i] = mv[4096 + n]; shv[i] = mv[3072 + n]; }
#pragma unroll
        for (int i = 0; i < 16; ++i) ssq += xv[i] * xv[i];
        ssq = wave_sum(ssq); const float rstd = rsqrtf(ssq * (1.0f / 1024.0f) + EPS_);
        float acc[32];
#pragma unroll
        for (int e = 0; e < 32; ++e) acc[e] = 0.f;
#pragma unroll
        for (int i = 0; i < 16; ++i) { const int n = lane + 64 * i; const float hv = xv[i] * rstd * gv[i] * (1.0f + scv[i]) + shv[i];
            p.hn[(size_t)s * 1024 + n] = f2bf(hv);
#pragma unroll
            for (int e4 = 0; e4 < 8; ++e4) { const f32x4 w = *(const PG8_LAS f32x4*)(rw + n * 36 + 4 * e4); acc[4 * e4] += hv * w.x; acc[4 * e4 + 1] += hv * w.y; acc[4 * e4 + 2] += hv * w.z; acc[4 * e4 + 3] += hv * w.w; }
            __builtin_amdgcn_sched_barrier(0); }
        wave_sum32(acc);
        float v1 = -1e30f, v2 = -1e30f, s1 = 0.f, s2 = 0.f; int i1 = 0, i2 = 0;
#pragma unroll
        for (int q = 0; q < 8; ++q) { const float sve = sigmoidf_(acc[q]), v = sve + rb[q];
            if (v > v1) { v2 = v1; i2 = i1; s2 = s1; v1 = v; i1 = q; s1 = sve; } else if (v > v2) { v2 = v; i2 = q; s2 = sve; } }
        const float gsc = v1 + v2; float best = readlane_f(gsc, 0); int bg = 0;
        { const float g1 = readlane_f(gsc, 16), g2 = readlane_f(gsc, 32), g3 = readlane_f(gsc, 48);
          if (g1 > best) { best = g1; bg = 1; } if (g2 > best) { best = g2; bg = 2; } if (g3 > best) { best = g3; bg = 3; } }
        if (lane == 16 * bg) { const float inv = 1.0f / (s1 + s2); const int be1 = 8 * bg + i1, be2 = 8 * bg + i2;
            p.sel_e[s * 2] = be1; p.sel_e[s * 2 + 1] = be2; p.sel_w[s * 2] = s1 * inv; p.sel_w[s * 2 + 1] = s2 * inv;
            atomicAdd((int*)(hist + be1), 1); atomicAdd((int*)(hist + be2), 1); }
    }
    __syncthreads();
    if (count && tid < 32 && hist[tid] != 0) atomicAdd(p.cnt + layer * 32 + tid, hist[tid]);
    __syncthreads();
}
__device__ __forceinline__ int moe_plan(const Params& p, int layer, PG8_LAS int* pstart, PG8_LAS int* te) {
    if (ltid() == 0) { int tl = 0; for (int e = 0; e < 32; ++e) { const int cn = p.cnt[layer * 32 + e]; pstart[e] = tl * 256; const int nt = (cn + 255) >> 8; for (int q = 0; q < nt; ++q) te[tl + q] = e; tl += nt; } pstart[32] = tl; }
    __syncthreads();
    return pstart[32];
}
__device__ __forceinline__ void phase_moe_assign(const Params& p, int layer, LDSP lds, int bid, int nb) {
    PG8_LAS int* pstart = (PG8_LAS int*)lds; PG8_LAS int* te = pstart + 64; PG8_LAS int* hist = pstart + 512; PG8_LAS int* base = hist + 32;
    const int tid = ltid();
    if (tid < 32) hist[tid] = 0;
    moe_plan(p, layer, pstart, te);
    const int per = (TT + nb - 1) / nb, s = bid * per + tid; const bool act = tid < per && s < TT && !(layer == 1 && (s % SEQB) < LC);
    int e0 = 0, e1 = 0, r0 = 0, r1 = 0;
    if (act) { e0 = p.sel_e[s * 2]; e1 = p.sel_e[s * 2 + 1]; r0 = atomicAdd((int*)(hist + e0), 1); r1 = atomicAdd((int*)(hist + e1), 1); }
    __syncthreads();
    if (tid < 32) base[tid] = hist[tid] ? atomicAdd(p.cur + layer * 32 + tid, hist[tid]) : 0;
    __syncthreads();
    if (act) { const int p0 = pstart[e0] + base[e0] + r0, p1 = pstart[e1] + base[e1] + r1;
        p.posbuf[s * 2] = p0; p.posbuf[s * 2 + 1] = p1; p.rowidx[p0] = s; p.rowidx[p1] = s; }
    __syncthreads();
}
template <bool NEXT_NORM> __device__ __forceinline__ void phase_moe_combine(const Params& p, int layer, const bf16_t* Yb_, LDSP lds, int bid, int nb) {
    const bf16_t* Yb = UP(Yb_);
    LASF wg = (LASF)lds;
    const int tid = ltid(), lane = tid & 63, wid = tid >> 6;
    if (NEXT_NORM) {
        float4 wv[8];
#pragma unroll
        for (int j = 0; j < 8; ++j) { const int i = tid + NTH * j; wv[j] = *(const float4*)(p.w_in + (size_t)(layer + 1) * 1024 * 13328 + (size_t)(i >> 2) * 13328 + 4096 + (i & 3) * 4); }
#pragma unroll
        for (int j = 0; j < 8; ++j) { const int i = tid + NTH * j, n = i >> 2, j4 = (i & 3) * 4; wg[n * 20 + j4] = wv[j].x; wg[n * 20 + j4 + 1] = wv[j].y; wg[n * 20 + j4 + 2] = wv[j].z; wg[n * 20 + j4 + 3] = wv[j].w; }
        __syncthreads();
    }
    const float* gn = p.norm1_g + (layer + 1) * 1024;
    for (int s = bid * 8 + wid; s < TT; s += nb * 8) {
        const int pos = s % SEQB; if (layer == 1 && pos < LC) continue;
        const int p0 = p.posbuf[s * 2], p1 = p.posbuf[s * 2 + 1]; const float w0 = p.sel_w[s * 2], w1 = p.sel_w[s * 2 + 1];
        float* xr = resid_row(p, s); const float* g2 = modvec(p, layer, s) + 5120;
        f32x4 xn[4]; float ssq = 0.f;
#pragma unroll
        for (int i = 0; i < 4; ++i) { const int col = 4 * lane + 256 * i; const u32x2 a = *(const u32x2*)(Yb + (size_t)p0 * 1024 + col), b = *(const u32x2*)(Yb + (size_t)p1 * 1024 + col);
            f32x4 x = *(const f32x4*)(xr + col); const f32x4 g = *(const f32x4*)(g2 + col);
            x[0] += g[0] * (w0 * lo16(a.x) + w1 * lo16(b.x)); x[1] += g[1] * (w0 * hi16(a.x) + w1 * hi16(b.x)); x[2] += g[2] * (w0 * lo16(a.y) + w1 * lo16(b.y)); x[3] += g[3] * (w0 * hi16(a.y) + w1 * hi16(b.y));
            *(f32x4*)(xr + col) = x; xn[i] = x; ssq += x[0] * x[0] + x[1] * x[1] + x[2] * x[2] + x[3] * x[3]; }
        if (NEXT_NORM) {
            const float* mv = modvec(p, layer + 1, s);
            ssq = wave_sum(ssq); const float rstd = rsqrtf(ssq * (1.0f / 1024.0f) + EPS_);
            float acc[16];
#pragma unroll
            for (int j = 0; j < 16; ++j) acc[j] = 0.f;
#pragma unroll
            for (int i = 0; i < 4; ++i) { const int col = 4 * lane + 256 * i; const f32x4 gv = *(const f32x4*)(gn + col), sc = *(const f32x4*)(mv + 1024 + col), sh = *(const f32x4*)(mv + col); float hv[4];
#pragma unroll
                for (int e = 0; e < 4; ++e) hv[e] = xn[i][e] * rstd * gv[e] * (1.0f + sc[e]) + sh[e];
                u32x2 w; w.x = pk2(hv[0], hv[1]); w.y = pk2(hv[2], hv[3]); *(u32x2*)(p.hn + (size_t)s * 1024 + col) = w;
#pragma unroll
                for (int e = 0; e < 4; ++e)
#pragma unroll
                    for (int j4 = 0; j4 < 4; ++j4) { const f32x4 wq = *(const PG8_LAS f32x4*)(wg + (col + e) * 20 + 4 * j4); acc[4 * j4] += hv[e] * wq.x; acc[4 * j4 + 1] += hv[e] * wq.y; acc[4 * j4 + 2] += hv[e] * wq.z; acc[4 * j4 + 3] += hv[e] * wq.w; }
                __builtin_amdgcn_sched_barrier(0); }
            wave_sum16(acc);
            if ((lane & 15) == 0) { f32x4 g4; g4[0] = acc[0]; g4[1] = acc[1]; g4[2] = acc[2]; g4[3] = acc[3]; *(f32x4*)(p.G + (size_t)s * 16 + (lane >> 4) * 4) = g4; }
        }
    }
    if (NEXT_NORM) __syncthreads();
}

constexpr size_t R_BYTES = 12 * UU;
constexpr size_t OFF_WT13 = 0, OFF_WT2 = OFF_WT13 + (size_t)32 * 1024 * 1024 * 2, OFF_XG = OFF_WT2 + (size_t)32 * 1024 * 512 * 2, OFF_H = OFF_XG + (size_t)TPAD * 1024 * 2, OFF_YB = OFF_H + (size_t)TPAD * 512 * 2;
static_assert(OFF_YB + (size_t)TPAD * 1024 * 2 <= R_BYTES, "MoE buffers must fit the big region");

#ifndef REPEAT_MASK
#define REPEAT_MASK 0
#endif
#define REP(bit) for (int rep_ = 0; rep_ < (((REPEAT_MASK) >> (bit)) & 1) + 1; ++rep_)
#define GRID_BAR() do { xcd_barrier(bar); if ((REPEAT_MASK >> 15) & 1) xcd_barrier(bar); asm volatile("" : "+s"(bid), "+s"(nb)); } while (0)

constexpr int PW = (int)(sizeof(Params) / 8);
static_assert(sizeof(Params) % 8 == 0 && sizeof(Params) <= 1024, "Params is a block of 8-byte words");
struct ParamsRaw { unsigned long long w[PW]; };
template <int layer> __device__ __forceinline__ void layer_body(const Params& p, const XcdBarrier& bar, LDSP lds, int& bid, int& nb);
__global__ void __launch_bounds__(512, 2) fwd_kernel(ParamsRaw raw, unsigned long long* gp, unsigned* barw) {
    extern __shared__ __attribute__((aligned(16))) unsigned char shm[];
    LDSP lds = (LDSP)shm;
    int bid = blockIdx.x, nb = gridDim.x; const int tid = threadIdx.x;
    unsigned long long* mygp = gp + (size_t)bid * 128;
    if (tid == 0) {
#pragma unroll
        for (int k = 0; k < PW; ++k) mygp[k] = raw.w[k];
        *(PG8_LAS u32x4*)(lds + LDS_BYTES - 16) = (u32x4){0u, 0u, 0u, 0u};
        asm volatile("s_waitcnt vmcnt(0)" ::: "memory"); }
    __syncthreads();
    const Params& p = *(const Params*)mygp;
    XcdBarrier bar = xcd_barrier_post(barw, (volatile LAS unsigned*)(lds + LDS_BYTES - 16));

#define RB ((unsigned char*)p.R)
#define aq ((bf16_t*)(RB))
#define ak ((bf16_t*)(RB + UU))
#define av ((bf16_t*)(RB + 2 * UU))
#define hx0 ((bf16_t*)(RB + 3 * UU))
#define hx1 ((bf16_t*)(RB + 4 * UU))
#define hv ((bf16_t*)(RB + 5 * UU))
#define zT ((bf16_t*)(RB + 6 * UU))
#define tapsT ((bf16_t*)(RB + 11 * UU))
#define ST ((bf16_t*)(RB))
#define mq ((bf16_t*)(RB + 4 * UU))
#define mk ((bf16_t*)(RB + 5 * UU))
#define mv ((bf16_t*)(RB + 6 * UU))
#define mo ((bf16_t*)(RB + 7 * UU))
#define gates ((bf16_t*)(RB + 8 * UU))
#define qc ((bf16_t*)(RB + 8 * UU))
#define kc ((bf16_t*)(RB + 9 * UU))
#define kT ((bf16_t*)(RB + 10 * UU))
#define vT ((bf16_t*)(RB + 11 * UU))
#define Wt13 ((bf16_t*)(RB + OFF_WT13))
#define Wt2 ((bf16_t*)(RB + OFF_WT2))
#define Xg ((bf16_t*)(RB + OFF_XG))
#define Hb ((bf16_t*)(RB + OFF_H))
#define Yb ((bf16_t*)(RB + OFF_YB))
#define ym ((bf16_t*)p.Y3)
#define ya ((bf16_t*)p.Y3 + (size_t)TT * 1024)
#define yh ((bf16_t*)p.Y3 + (size_t)2 * TT * 1024)

    REP(12) phase_conv_small(p, 0, lds, bid, nb);
    REP(7) { phase_modvec(p, lds, bid, nb);
    phase_hdn(p, lds, bid, nb); }
    GRID_BAR();
    layer_body<0>(p, bar, lds, bid, nb);
#if defined(PROBE_LEVEL) && (PROBE_LEVEL == 1 || PROBE_LEVEL == 2)
    return;
#endif
    layer_body<1>(p, bar, lds, bid, nb);
    if (bid == 0 && tid == 0 && xb_ld(&barw[XB_TMO]) != 0u) p.out[0] = __builtin_nanf("");
}
template <int layer> __device__ __forceinline__ void layer_body(const Params& p, const XcdBarrier& bar, LDSP lds, int& bid, int& nb) {
        if (layer == 0) {
            REP(10) phase_norm1(p, layer, lds, bid, nb);
            REP(13) phase_taps(p, layer, tapsT, lds, bid, nb);
            GRID_BAR(); }
        REP(0) { pg8::Gemm g{UP((const bf16_t*)p.hn), UP((const bf16_t*)p.Wt_in), TT, 6656, 1024}; pg8::StaticOrder S; S.init(TT, 6656, nb, bid);
          EpiReg E{UP(aq), (size_t)TT * 1024, UP(gates + (size_t)2 * TT * 1024), 0};
          pg8::gemm_phase<EpiReg, pg8::StaticOrder, false>(lds, g, S, E, nullptr);
        GRID_BAR(); }
        phase_attn_prep(p, layer, aq, ak, bid, nb);
        phase_hprep(p, layer, hx1, hv, zT, lds, bid, nb);
        if (layer == 0) REP(6) phase_hctx(p, layer, hx0, hx1, hv, yh, lds, bid, nb);
        GRID_BAR();
        phase_fft(p, layer, tapsT, zT, (float*)(RB + 10 * UU), lds, bid, nb);
        REP(1) phase_attn(p, layer, aq, ak, av, ya, lds, bid, nb);
        GRID_BAR();
        if ((REPEAT_MASK >> 3) & 1) { phase_hprep(p, layer, hx1, hv, zT, lds, bid, nb); GRID_BAR(); phase_fft(p, layer, tapsT, zT, (float*)(RB + 10 * UU), lds, bid, nb); GRID_BAR(); }
        REP(11) phase_hfin(p, layer, hx0, hx1, hv, zT, yh, lds, bid, nb);
        GRID_BAR();
        REP(0) { pg8::Gemm g{UP((const bf16_t*)p.hn), UP((const bf16_t*)p.Wt_in + (size_t)6656 * 1024), TT, 6656, 1024}; pg8::StaticOrder S; S.init(TT, 6656, nb, bid);
          EpiReg E{UP(mq), (size_t)TT * 1024, UP(gates + (size_t)2 * TT * 1024), 512};
          pg8::gemm_phase<EpiReg, pg8::StaticOrder, false>(lds, g, S, E, nullptr);
        GRID_BAR(); }
        REP(2) { phase_mA(p, layer, mk, mv, vT, ST, lds, bid, nb);
        GRID_BAR(); }
        phase_mB(p, ST, bid, nb);
        GRID_BAR();
        REP(14) { phase_mC(p, layer, mq, mk, vT, mo, ST, ym, lds, bid, nb);
        GRID_BAR(); }
        REP(4) { pg8::Gemm g{UP((const bf16_t*)p.Y3), UP((const bf16_t*)p.Wt_br + (size_t)layer * 3 * 1048576), 3 * TT, 3072, 1024}; MergeOrder S{layer == 0 ? 264 : 256, nb, bid, layer == 0 ? 0 : 1};
          MergeEpi E{UP((const bf16_t*)gates), UP((const float*)p.merge_b + layer * 3072), UP((bf16_t*)p.hn)};
          pg8::gemm_phase<MergeEpi, MergeOrder, false>(lds, g, S, E, nullptr);
          if (layer == 0 && rep_ == 0) {
              int me = bid, nl = nb; bool runf = true;
              if ((nb & 7) == 0) { const int per = nb >> 3, hx = 33 - per; if (hx > 0 && hx < per) { const int j = bid >> 3; runf = j >= hx; me = (j - hx) * 8 + (bid & 7); nl = nb - 8 * hx; } }
              if (runf) { __syncthreads();
                  phase_conv_experts(p, 0, Wt13, Wt2, lds, me, nl);
                  phase_taps(p, 1, tapsT, lds, me, nl);
                  phase_conv_small(p, 1, lds, me, nl); } }
        GRID_BAR(); }
        { pg8::Gemm g{UP((const bf16_t*)p.hn), UP((const bf16_t*)p.Wt_out + (size_t)layer * 1048576), TT, 1024, 1024}; OutOrder S{layer == 0 ? 264 : 256, nb, bid, layer == 0 ? 0 : 1};
          OutEpi E{&p, layer};
          pg8::gemm_phase<OutEpi, OutOrder, false>(lds, g, S, E, nullptr); }
        __syncthreads();
#if defined(PROBE_LEVEL) && PROBE_LEVEL == 1
        if (layer == 0) return;
#endif
#if defined(PROBE_LEVEL) && PROBE_LEVEL == 3
        if (layer == 1) return;
#endif
        if (layer == 1) REP(9) phase_conv_experts(p, layer, Wt13, Wt2, lds, bid, nb);
        GRID_BAR();
        REP(5) phase_norm2_router(p, layer, lds, bid, nb, rep_ == 0);
        GRID_BAR();
        phase_moe_assign(p, layer, lds, bid, nb);
        GRID_BAR();
        { PG8_LAS int* pstart = (PG8_LAS int*)(lds + 132 * 1024); PG8_LAS int* te = pstart + 64;
          const int ntl = moe_plan(p, layer, pstart, te);
          REP(16) { pg8::Gemm g{UP((const bf16_t*)p.hn), UP((const bf16_t*)Wt13), TT, 32 * 1024, 1024}; MoeOrder S{te, ntl, nb, bid}; E1Epi E{UP(Hb)};
            PG8_LAS int* rtab = (PG8_LAS int*)(lds + 133 * 1024);
            { pg8::Unit uu; const int tz = ltid();
#pragma unroll
              for (int i = 0; i < 4; ++i) { if (S.next(i, uu) && tz < 256) rtab[i * 256 + tz] = p.rowidx[uu.pm * 256 + tz]; } }
            __syncthreads();
            pg8::gemm_phase_g<E1Epi, MoeOrder, false>(lds, g, S, E, rtab);
          GRID_BAR(); }
          REP(17) { pg8::Gemm g{UP((const bf16_t*)Hb), UP((const bf16_t*)Wt2), TPAD, 32 * 1024, 512}; MoeOrder S{te, ntl, nb, bid}; pg8::EpiBf16<0> E{UP(Yb), 1024, nullptr, 1024, (size_t)0};
            pg8::gemm_phase<pg8::EpiBf16<0>, MoeOrder, false>(lds, g, S, E, nullptr);
          GRID_BAR(); } }
        if (layer == 0) phase_moe_combine<true>(p, layer, Yb, lds, bid, nb);
        else phase_moe_combine<false>(p, layer, Yb, lds, bid, nb);
        GRID_BAR();
}

extern "C" void kernel_launch(void* const* d_in, const int* in_sizes, int n_in, void* d_out, int out_size, void* d_ws, size_t ws_size, hipStream_t stream) {
    (void)in_sizes; (void)n_in; (void)out_size;
    Params p; memset(&p, 0, sizeof(p));
    const float* const* in = (const float* const*)d_in;
    p.x = in[0]; p.c = in[1]; p.ctx = in[2]; p.c_ctx = in[3]; p.mod_w = in[4]; p.mod_b = in[5]; p.norm1_g = in[6]; p.norm2_g = in[7]; p.w_in = in[8]; p.merge_b = in[9];
    p.m_conv_w = in[10]; p.m_conv_b = in[11]; p.m_gate_b = in[12]; p.m_norm_g = in[13]; p.a_qnorm_g = in[14]; p.a_knorm_g = in[15]; p.a_lambda = in[16]; p.a_subln_g = in[17];
    p.h_conv_w = in[18]; p.h_conv_b = in[19]; p.h_ffn_w1 = in[20]; p.h_ffn_b1 = in[21]; p.h_ffn_w2 = in[22]; p.h_ffn_b2 = in[23]; p.h_ffn_w3 = in[24]; p.h_freq = in[25]; p.h_decay = in[26]; p.h_bias = in[27];
    p.w_br_m = in[28]; p.w_br_a = in[29]; p.w_br_h = in[30]; p.w_out = in[31]; p.router_w = in[32]; p.router_b = in[33]; p.e_w1 = in[34]; p.e_w3 = in[35]; p.e_w2 = in[36];
    p.out = (float*)d_out;
    unsigned char* w = (unsigned char*)d_ws; size_t off = 0;
    auto take = [&](size_t bytes) { unsigned char* r = w + off; off += (bytes + 255) & ~(size_t)255; return r; };
    constexpr size_t ZERO_BYTES = 32768;
    unsigned char* z = take(ZERO_BYTES);
    p.bar = (unsigned*)z; p.cnt = (int*)(z + 16384); p.cur = (int*)(z + 16384 + 256); p.sumsq = (float*)take((size_t)2 * 64 * 8 * 32 * 4); p.sumsqC = (float*)take((size_t)4096 * 4);
    p.modv = (float*)take((size_t)6 * 6144 * 4); p.hdn2 = (float*)take((size_t)2 * 8448 * 64 * 4); p.G = (float*)take((size_t)TT * 16 * 4); p.xc = (float*)take((size_t)512 * 1024 * 4);
    p.sel_e = (int*)take((size_t)TT * 2 * 4); p.sel_w = (float*)take((size_t)TT * 2 * 4); p.posbuf = (int*)take((size_t)TT * 2 * 4); p.rowidx = (int*)take((size_t)TPAD * 4);
    p.scal = (float*)take((size_t)16 * 66 * 2 * 4); p.ms = (float*)take((size_t)16 * 67 * 4); p.dn = (float*)take((size_t)16 * 66 * 256 * 4); p.nst = (float*)take((size_t)16 * 66 * 256 * 4);
    p.hfC = (float*)take((size_t)1024 * 256 * 4); p.hbC = (float*)take((size_t)1024 * 256 * 4);
    p.Wt_in = (bf16_t*)take((size_t)13312 * 1024 * 2); p.Wt_br = (bf16_t*)take((size_t)2 * 3072 * 1024 * 2); p.Wt_out = (bf16_t*)take((size_t)2 * 1024 * 1024 * 2);
    unsigned long long* gpbuf = (unsigned long long*)take((size_t)1024 * 1024);
    p.hn = (bf16_t*)take(UU); p.Y3 = (bf16_t*)take(3 * UU); p.R = take(R_BYTES);
    if (off > ws_size) { fprintf(stderr, "kernel_launch: workspace too small: need %zu, have %zu\n", off, ws_size); return; }
    static int grid = 0;
    if (!grid) {
        int dev = 0, cus = 0; (void)hipGetDevice(&dev); (void)hipDeviceGetAttribute(&cus, hipDeviceAttributeMultiprocessorCount, dev);
        if (hipFuncSetAttribute((const void*)fwd_kernel, hipFuncAttributeMaxDynamicSharedMemorySize, LDS_BYTES) != hipSuccess) { fprintf(stderr, "kernel_launch: hipFuncSetAttribute failed\n"); return; }
        int per_cu = 0; (void)hipOccupancyMaxActiveBlocksPerMultiprocessor(&per_cu, (const void*)fwd_kernel, NTH, LDS_BYTES);
        if (per_cu < 1) fprintf(stderr, "kernel_launch: occupancy query reports %d blocks per CU\n", per_cu);
        grid = cus > 0 ? (cus > 1024 ? 1024 : cus) : 256;
    }
    (void)hipMemsetAsync(z, 0, ZERO_BYTES, stream);
    ParamsRaw raw; memcpy(&raw, &p, sizeof(raw));
    hipLaunchKernelGGL(fwd_kernel, dim3(grid), dim3(NTH), LDS_BYTES, stream, raw, gpbuf, (unsigned*)z);
}
```

```cpp
#include <hip/hip_runtime.h>
#include <cstdio>
#include <cstdint>
#include <cstring>
#define REPEAT_MASK 0
#define XB_TMO      128
#define XB_XCNT(j)  (256  + 64 * (j))
#define XB_XSUB(j)  (1280 + 64 * (j))
#define XB_XGEN(j)  (2304 + 64 * (j))
#define XB_TOP      3328
#define XB_TOPGEN   3392
#define XCD_BAR_WORDS 3456
#define XB_SPIN_CAP (1u << 24)
#define LAS __attribute__((address_space(3)))

__device__ __forceinline__ unsigned xb_ld(unsigned* p)              { return __hip_atomic_load(p, __ATOMIC_RELAXED, __HIP_MEMORY_SCOPE_AGENT); }
__device__ __forceinline__ unsigned xb_add(unsigned* p, unsigned v) { return __hip_atomic_fetch_add(p, v, __ATOMIC_RELAXED, __HIP_MEMORY_SCOPE_AGENT); }
__device__ __forceinline__ unsigned xb_xcc_id() { return (unsigned)__builtin_amdgcn_s_getreg((3 << 11) | 20) & 0xFu; }
#define XB_SPIN(cond, bar) do { unsigned _sp = 0; while (cond) { __builtin_amdgcn_s_sleep(1); \
    if ((++_sp & 255u) == 0u) { if (xb_ld(&(bar)[XB_TMO])) break; if (_sp > XB_SPIN_CAP) { atomicAdd(&(bar)[XB_TMO], 1u); break; } } } } while (0)

struct XcdBarrier {
    unsigned* bar; unsigned x;
    volatile LAS unsigned* st;
};

__device__ __forceinline__ XcdBarrier xcd_barrier_post(unsigned* bar, volatile LAS unsigned* st) {
    XcdBarrier b; b.bar = bar; b.x = xb_xcc_id(); b.st = st;
    if (threadIdx.x == 0) (void)xb_add(&bar[XB_XCNT(b.x)], 1u);
    return b;
}
__device__ __forceinline__ void xcd_barrier_complete(unsigned* bar, unsigned x, unsigned& nloc, unsigned& nx) {
    const unsigned G = gridDim.x * gridDim.y * gridDim.z;
    unsigned sum, cnt, mine, sp = 0u;
    for (;;) {
        sum = 0u; cnt = 0u; mine = 0u;
#pragma unroll
        for (unsigned j = 0; j < 16; ++j) { const unsigned c = xb_ld(&bar[XB_XCNT(j)]); sum += c; cnt += (c > 0u) ? 1u : 0u; mine = (j == x) ? c : mine; }
        if (sum == G) break;
        __builtin_amdgcn_s_sleep(1);
        if ((++sp & 255u) == 0u) { if (xb_ld(&bar[XB_TMO])) break; if (sp > XB_SPIN_CAP) { atomicAdd(&bar[XB_TMO], 1u); break; } }
    }
    nloc = mine > 0u ? mine : 1u; nx = cnt > 0u ? cnt : 1u;
}

__device__ __forceinline__ void xcd_barrier(const XcdBarrier& b) {
    asm volatile("s_waitcnt vmcnt(0)" ::: "memory");
    __syncthreads();
    if (threadIdx.x == 0) {
        unsigned* bar = b.bar;
        __builtin_amdgcn_s_waitcnt(0);
        unsigned nloc = b.st[0], nx = b.st[1];
        if (nloc == 0u) { xcd_barrier_complete(bar, b.x, nloc, nx); b.st[0] = nloc; b.st[1] = nx; }
        const unsigned old = xb_add(&bar[XB_XSUB(b.x)], 1u);
        const unsigned gen = old / nloc;
        if (old + 1u == (gen + 1u) * nloc) {
            __builtin_amdgcn_fence(__ATOMIC_RELEASE, "agent");
            asm volatile("s_waitcnt vmcnt(0)" ::: "memory");
            const unsigned og = xb_add(&bar[XB_TOP], 1u);
            const unsigned tg = og / nx;
            if (og + 1u == (tg + 1u) * nx) xb_add(&bar[XB_TOPGEN], 1u);
            else XB_SPIN(xb_ld(&bar[XB_TOPGEN]) == tg, bar);
            __builtin_amdgcn_fence(__ATOMIC_ACQUIRE, "agent");
            xb_add(&bar[XB_XGEN(b.x)], 1u);
            asm volatile("s_waitcnt vmcnt(0)" ::: "memory");
        } else {
            XB_SPIN(xb_ld(&bar[XB_XGEN(b.x)]) == gen, bar);
            __builtin_amdgcn_fence(__ATOMIC_ACQUIRE, "agent");
            asm volatile("s_waitcnt vmcnt(0)" ::: "memory");
        }
    }
    __syncthreads();
}
namespace pg8 {
#define PG8_LAS __attribute__((address_space(3)))
typedef unsigned short bf16_t;
typedef short bf16x8 __attribute__((ext_vector_type(8)));
typedef float f32x4 __attribute__((ext_vector_type(4)));
typedef unsigned u32x4 __attribute__((ext_vector_type(4)));
constexpr int BM = 256, BK = 64, HALF = 128, HTB = HALF * BK * 2  , STAGE_BYTES = 8 * HTB, NXCD = 8, WGM = 8;

__host__ __device__ __forceinline__ int lds_byte(int r, int c) { const int st = (r >> 4) * 2 + (c >> 5), rr = r & 15, cc = c & 31, ob = rr * 64 + cc * 2; return st * 1024 + (ob ^ (((ob >> 9) & 1) << 5)); }
__host__ __device__ __forceinline__ void stage_rc(int b, int& R, int& C) { const int st = b / 1024, sb = b % 1024, swz = sb ^ (((sb >> 9) & 1) << 5); R = (st >> 1) * 16 + swz / 64; C = (st & 1) * 32 + (swz % 64) / 2; }
__host__ __device__ __forceinline__ int perm32(int rho) { const int n = rho >> 4, i = rho & 15; return 8 * (i >> 2) + 4 * n + (i & 3); }

struct Unit { int pm, pn; };
struct Gemm { const bf16_t* A; const bf16_t* Bt; int M, N, K; };

struct StaticOrder {
    int nM, nN, nwg, G, c;
    __host__ __device__ void init(int M, int N, int G_, int c_) { nM = M / BM; nN = N / BM; nwg = nM * nN; G = G_; c = c_; }
    __host__ __device__ bool next(int i, Unit& u) const {
        const long L = (long)i * G + c; if (L >= nwg) return false;
        int wgid = (int)L; { const int q = nwg / NXCD, r = nwg % NXCD, xcd = wgid % NXCD, off = wgid / NXCD; wgid = (xcd < r ? xcd * (q + 1) : r * (q + 1) + (xcd - r) * q) + off; }
        const int nig = WGM * nN, gid = wgid / nig, fm = gid * WGM, gsz = (nM - fm) < WGM ? (nM - fm) : WGM;
        u.pm = fm + ((wgid % nig) % gsz); u.pn = (wgid % nig) / gsz; return true;
    }
    __device__ __forceinline__ void a_ready(const Unit&) const {}
    __device__ __forceinline__ void done(const Unit&) const {}
};
struct CountedOrder : StaticOrder {
    const unsigned* ready; unsigned need; unsigned* tmo;
    __device__ __forceinline__ void a_ready(const Unit& u) const {
        if (threadIdx.x < 64) {
            const unsigned long long t0 = __builtin_amdgcn_s_memrealtime(); unsigned polls = 0;
            while ((unsigned)__builtin_amdgcn_readfirstlane(__hip_atomic_load(ready + 64 * u.pm, __ATOMIC_RELAXED, __HIP_MEMORY_SCOPE_AGENT)) < need) {
                if ((++polls & 255u) == 0u && __builtin_amdgcn_readfirstlane(__hip_atomic_load(tmo, __ATOMIC_RELAXED, __HIP_MEMORY_SCOPE_AGENT)) != 0u) break;
                if (__builtin_amdgcn_s_memrealtime() - t0 > 2000000ull) {
                    if (threadIdx.x == 0) { unsigned expect = 0u; __hip_atomic_compare_exchange_strong(tmo + 1, &expect, 0x600u | (unsigned)(u.pm & 0xff), __ATOMIC_RELAXED, __ATOMIC_RELAXED, __HIP_MEMORY_SCOPE_AGENT); __hip_atomic_store(tmo, 1u, __ATOMIC_RELAXED, __HIP_MEMORY_SCOPE_AGENT); }
                    break; }
                __builtin_amdgcn_s_sleep(2); }
            __builtin_amdgcn_fence(__ATOMIC_ACQUIRE, "agent");
            asm volatile("s_waitcnt vmcnt(0)" ::: "memory");
        }
#if !defined(BROKEN_HOOK_NO_BARRIER)
        asm volatile("" ::: "memory"); __builtin_amdgcn_s_barrier(); asm volatile("" ::: "memory");
#endif
    }
};

__device__ __forceinline__ unsigned cvt_pk_bf16(float lo, float hi) { unsigned r; asm volatile("v_cvt_pk_bf16_f32 %0, %1, %2" : "=v"(r) : "v"(lo), "v"(hi)); return r; }
typedef float f32x2 __attribute__((ext_vector_type(2)));
__device__ __forceinline__ f32x2 gelu_pk(f32x2 v) {
    const f32x2 av = __builtin_elementwise_abs(v), d = av * 0.2316418882f + 1.0f;
    f32x2 t; t.x = __builtin_amdgcn_rcpf(d.x); t.y = __builtin_amdgcn_rcpf(d.y);
    f32x2 q = t * 0.5307027145f + (-0.7265760135f); q = q * t + 0.7107068705f; q = q * t + (-0.142248368f); q = q * t + 0.127414796f; q = q * t;
    const f32x2 s = (v * v) * (-0.72134752044f);
    f32x2 e; e.x = __builtin_amdgcn_exp2f(s.x); e.y = __builtin_amdgcn_exp2f(s.y);
    const f32x2 m = v * (q * e), r = v - m;
    f32x2 o; o.x = v.x < 0.f ? m.x : r.x; o.y = v.y < 0.f ? m.y : r.y; return o;
}

struct EpiF32 {
    static constexpr bool PERM = false, AFTER_DRAIN = false;
    float* C; int ldc; const float* bias;
    __device__ __forceinline__ void operator()(const f32x4 (&acc)[2][2][4][2], const Unit& u, int wr, int wc, int fr, int fq) const {
        const int row0 = u.pm * BM + wr * 64 + fr, col0 = u.pn * BM + wc * 32 + 4 * fq;
        f32x4 bv[2][2];
#pragma unroll
        for (int bj = 0; bj < 2; ++bj)
#pragma unroll
            for (int n = 0; n < 2; ++n) bv[bj][n] = bias ? *(const f32x4*)(bias + col0 + bj * HALF + n * 16) : (f32x4){0.f, 0.f, 0.f, 0.f};
#pragma unroll
        for (int ai = 0; ai < 2; ++ai)
#pragma unroll
            for (int m = 0; m < 4; ++m) { float* rowp = C + (size_t)(row0 + ai * HALF + m * 16) * ldc + col0;
#pragma unroll
                for (int bj = 0; bj < 2; ++bj)
#pragma unroll
                    for (int n = 0; n < 2; ++n) *(f32x4*)(rowp + bj * HALF + n * 16) = acc[ai][bj][m][n] + bv[bj][n]; }
    }
};
template <int ACT  > struct EpiBf16 {
    static constexpr bool PERM = true, AFTER_DRAIN = false;
    bf16_t* O; int ldc; const float* bias; int split_cols; size_t split_stride;
    __device__ __forceinline__ void operator()(const f32x4 (&acc)[2][2][4][2], const Unit& u, int wr, int wc, int fr, int fq) const {
        const int row0 = u.pm * BM + wr * 64 + fr; int colt = u.pn * BM; bf16_t* base = O;
        if (split_cols) { const int t = colt / split_cols; base += (size_t)t * split_stride; colt -= t * split_cols; }
        const int col0 = colt + wc * 32 + 8 * fq, bcol0 = u.pn * BM + wc * 32 + 8 * fq;
        f32x4 bv[2][2];
#pragma unroll
        for (int bj = 0; bj < 2; ++bj)
#pragma unroll
            for (int n = 0; n < 2; ++n) bv[bj][n] = bias ? *(const f32x4*)(bias + bcol0 + bj * HALF + 4 * n) : (f32x4){0.f, 0.f, 0.f, 0.f};
#pragma unroll
        for (int ai = 0; ai < 2; ++ai)
#pragma unroll
            for (int m = 0; m < 4; ++m) { bf16_t* rowp = base + (size_t)(row0 + ai * HALF + m * 16) * ldc + col0;
#pragma unroll
                for (int bj = 0; bj < 2; ++bj) { f32x4 v0 = acc[ai][bj][m][0] + bv[bj][0], v1 = acc[ai][bj][m][1] + bv[bj][1];
                    if (ACT == 1) { f32x2 a = gelu_pk((f32x2){v0[0], v0[1]}), b = gelu_pk((f32x2){v0[2], v0[3]}), c = gelu_pk((f32x2){v1[0], v1[1]}), d = gelu_pk((f32x2){v1[2], v1[3]});
                        v0 = (f32x4){a.x, a.y, b.x, b.y}; v1 = (f32x4){c.x, c.y, d.x, d.y}; }
                    if (ACT == 2) {
#pragma unroll
                        for (int j = 0; j < 4; ++j) { v0[j] = 0.5f * v0[j] * (1.0f + erff(v0[j] * 0.70710678f)); v1[j] = 0.5f * v1[j] * (1.0f + erff(v1[j] * 0.70710678f)); } }
                    u32x4 w; w.x = cvt_pk_bf16(v0[0], v0[1]); w.y = cvt_pk_bf16(v0[2], v0[3]); w.z = cvt_pk_bf16(v1[0], v1[1]); w.w = cvt_pk_bf16(v1[2], v1[3]);
                    *(u32x4*)(rowp + bj * HALF) = w; } }
    }
};

struct PanelStats {
    unsigned* xbuf;
    unsigned* cnt;
    unsigned* tmo;
    int ntn; float eps;
    unsigned code;
    __device__ __forceinline__ bool run(const f32x4 (&v)[2][2][4][2], const Unit& u, int wr, int wc, int fr, int fq, PG8_LAS unsigned char* lds, int wid, int lane) const {
        typedef float f32x2v __attribute__((ext_vector_type(2)));
        PG8_LAS f32x2v* P = (PG8_LAS f32x2v*)lds;
        PG8_LAS f32x2v* S = (PG8_LAS f32x2v*)(lds + 8192);
        PG8_LAS unsigned* flag = (PG8_LAS unsigned*)(lds + 8192 + 2048);
#pragma unroll
        for (int ai = 0; ai < 2; ++ai)
#pragma unroll
            for (int m = 0; m < 4; ++m) {
                float s = 0.f;
#pragma unroll
                for (int bj = 0; bj < 2; ++bj)
#pragma unroll
                    for (int n = 0; n < 2; ++n) { const f32x4 x = v[ai][bj][m][n]; s += (x[0] + x[1]) + (x[2] + x[3]); }
                s += __shfl_xor(s, 16); s += __shfl_xor(s, 32);
                const float mw = s * (1.0f / 64.0f); float q = 0.f;
#pragma unroll
                for (int bj = 0; bj < 2; ++bj)
#pragma unroll
                    for (int n = 0; n < 2; ++n) { const f32x4 d = v[ai][bj][m][n] - mw; q += (d[0] * d[0] + d[1] * d[1]) + (d[2] * d[2] + d[3] * d[3]); }
                q += __shfl_xor(q, 16); q += __shfl_xor(q, 32);
                if (fq == 0) P[(ai * HALF + wr * 64 + m * 16 + fr) * 4 + wc] = (f32x2v){mw, q};
            }
        asm volatile("s_waitcnt lgkmcnt(0)" ::: "memory"); __builtin_amdgcn_s_barrier(); asm volatile("" ::: "memory");
#if defined(BROKEN_NO_WAIT)
        if (blockIdx.x >= 64) { const long long t0 = clock64(); while (clock64() - t0 < 60000) __builtin_amdgcn_s_sleep(8); }
#endif
        const int row = wid * 32 + (lane & 31);
        if (lane < 32) {
            const f32x2v a = P[row * 4 + 0], b = P[row * 4 + 1], c = P[row * 4 + 2], d = P[row * 4 + 3];
            const float mt = (a.x + b.x + c.x + d.x) * 0.25f;
            const float da = a.x - mt, db = b.x - mt, dc = c.x - mt, dd = d.x - mt;
            const float m2 = (a.y + b.y) + (c.y + d.y) + 64.0f * ((da * da + db * db) + (dc * dc + dd * dd));
            unsigned long long* slot = (unsigned long long*)xbuf + ((size_t)(u.pm * BM + row) * 4 + u.pn);
            __hip_atomic_store(slot, ((unsigned long long)__float_as_uint(m2) << 32) | __float_as_uint(mt), __ATOMIC_RELAXED, __HIP_MEMORY_SCOPE_AGENT);
        }
        asm volatile("s_waitcnt vmcnt(0)" ::: "memory");
        if (lane == 0) __hip_atomic_fetch_add(cnt + 64 * u.pm, 1u, __ATOMIC_RELAXED, __HIP_MEMORY_SCOPE_AGENT);
        if (wid == 0) {
            bool dead = false; const unsigned long long t0 = __builtin_amdgcn_s_memrealtime(); const unsigned want = 8u * (unsigned)ntn;
            for (;;) {
#if defined(BROKEN_NO_WAIT)
                break;
#endif
                if ((unsigned)__builtin_amdgcn_readfirstlane(__hip_atomic_load(cnt + 64 * u.pm, __ATOMIC_RELAXED, __HIP_MEMORY_SCOPE_AGENT)) >= want) break;
                if (__builtin_amdgcn_s_memrealtime() - t0 > 2000000ull) {
                    if (lane == 0) { unsigned expect = 0u; __hip_atomic_compare_exchange_strong(tmo + 1, &expect, code | (unsigned)(u.pm & 0xff), __ATOMIC_RELAXED, __ATOMIC_RELAXED, __HIP_MEMORY_SCOPE_AGENT);
                                     __hip_atomic_store(tmo, 1u, __ATOMIC_RELAXED, __HIP_MEMORY_SCOPE_AGENT); }
                    dead = true; break; }
                __builtin_amdgcn_s_sleep(2);
            }
            __builtin_amdgcn_fence(__ATOMIC_ACQUIRE, "agent");
            if (lane == 0) flag[0] = dead ? 1u : 0u;
        }
        asm volatile("s_waitcnt vmcnt(0) lgkmcnt(0)" ::: "memory"); __builtin_amdgcn_s_barrier(); asm volatile("" ::: "memory");
        const bool bad = flag[0] != 0u;
        if (lane < 32) {
            const unsigned long long* slot = (const unsigned long long*)xbuf + (size_t)(u.pm * BM + row) * 4; float mt[4], m2[4]; float ms = 0.f;
#pragma unroll
            for (int t = 0; t < 4; ++t) { if (t < ntn) { const unsigned long long w = __hip_atomic_load(slot + t, __ATOMIC_RELAXED, __HIP_MEMORY_SCOPE_AGENT); mt[t] = __uint_as_float((unsigned)w); m2[t] = __uint_as_float((unsigned)(w >> 32)); } else { mt[t] = 0.f; m2[t] = 0.f; } ms += mt[t]; }
            const float mean = ms / (float)ntn; float q = 0.f;
#pragma unroll
            for (int t = 0; t < 4; ++t) if (t < ntn) { const float dm = mt[t] - mean; q += m2[t] + 256.0f * dm * dm; }
            S[row] = (f32x2v){mean, 1.0f / sqrtf(q / (256.0f * (float)ntn) + eps)};
        }
        asm volatile("s_waitcnt lgkmcnt(0)" ::: "memory"); __builtin_amdgcn_s_barrier(); asm volatile("" ::: "memory");
        return bad;
    }
};
struct EpiLnRes {
    static constexpr bool PERM = false, AFTER_DRAIN = true;
    const float* base; float* out; int ldc; const float* bias; PanelStats st; unsigned poison;
    __device__ __forceinline__ void refuse(size_t i0, size_t stride, int M, int N) const { const float q = __builtin_nanf(""); for (size_t i = i0; i < (size_t)M * N; i += stride) out[(i / N) * ldc + i % N] = q;
        if (i0 == 0) { unsigned expect = 0u; __hip_atomic_compare_exchange_strong(st.tmo + 1, &expect, 0x7f0u, __ATOMIC_RELAXED, __ATOMIC_RELAXED, __HIP_MEMORY_SCOPE_AGENT); __hip_atomic_store(st.tmo, 1u, __ATOMIC_RELAXED, __HIP_MEMORY_SCOPE_AGENT); } }
    __device__ __forceinline__ void fused(f32x4 (&acc)[2][2][4][2], const Unit& u, int wr, int wc, int fr, int fq, PG8_LAS unsigned char* lds, int wid, int lane) const {
        typedef float f32x2v __attribute__((ext_vector_type(2)));
        const PG8_LAS f32x2v* S = (const PG8_LAS f32x2v*)(lds + 8192);
        const int col0 = u.pn * BM + wc * 32 + 4 * fq;
#pragma unroll
        for (int bj = 0; bj < 2; ++bj)
#pragma unroll
            for (int n = 0; n < 2; ++n) { const f32x4 bv = bias ? *(const f32x4*)(bias + col0 + bj * HALF + n * 16) : (f32x4){0.f, 0.f, 0.f, 0.f};
#pragma unroll
                for (int ai = 0; ai < 2; ++ai)
#pragma unroll
                    for (int m = 0; m < 4; ++m) acc[ai][bj][m][n] += bv; }
        const bool bad = st.run(acc, u, wr, wc, fr, fq, lds, wid, lane) || poison != 0u;
        const float qnan = __builtin_nanf("");
#pragma unroll
        for (int ai = 0; ai < 2; ++ai)
#pragma unroll
            for (int m = 0; m < 4; ++m) { const int r = ai * HALF + wr * 64 + m * 16 + fr; const f32x2v sr = S[r]; const size_t off = (size_t)(u.pm * BM + r) * ldc + col0;
#pragma unroll
                for (int bj = 0; bj < 2; ++bj)
#pragma unroll
                    for (int n = 0; n < 2; ++n) { const f32x4 bs = *(const f32x4*)(base + off + bj * HALF + n * 16); f32x4 o = bs + (acc[ai][bj][m][n] - sr.x) * sr.y;
                        if (bad) o = (f32x4){qnan, qnan, qnan, qnan}; *(f32x4*)(out + off + bj * HALF + n * 16) = o; }
                asm volatile("" ::: "memory"); }
    }
};
struct EpiLnResLn {
    static constexpr bool PERM = false, AFTER_DRAIN = true;
    const float* base; float* out; bf16_t* xn; int ldc; const float* bias; PanelStats st1, st2; unsigned poison;
    __device__ __forceinline__ void refuse(size_t i0, size_t stride, int M, int N) const { const float q = __builtin_nanf(""); for (size_t i = i0; i < (size_t)M * N; i += stride) { const size_t o = (i / N) * ldc + i % N; out[o] = q; xn[o] = (bf16_t)0x7fc0u; }
        if (i0 == 0) { unsigned expect = 0u; __hip_atomic_compare_exchange_strong(st1.tmo + 1, &expect, 0x7f0u, __ATOMIC_RELAXED, __ATOMIC_RELAXED, __HIP_MEMORY_SCOPE_AGENT); __hip_atomic_store(st1.tmo, 1u, __ATOMIC_RELAXED, __HIP_MEMORY_SCOPE_AGENT); } }
    __device__ __forceinline__ void fused(f32x4 (&acc)[2][2][4][2], const Unit& u, int wr, int wc, int fr, int fq, PG8_LAS unsigned char* lds, int wid, int lane) const {
        typedef float f32x2v __attribute__((ext_vector_type(2))); typedef unsigned u32x2v __attribute__((ext_vector_type(2)));
        const PG8_LAS f32x2v* S = (const PG8_LAS f32x2v*)(lds + 8192);
        const int col0 = u.pn * BM + wc * 32 + 4 * fq;
#pragma unroll
        for (int bj = 0; bj < 2; ++bj)
#pragma unroll
            for (int n = 0; n < 2; ++n) { const f32x4 bv = bias ? *(const f32x4*)(bias + col0 + bj * HALF + n * 16) : (f32x4){0.f, 0.f, 0.f, 0.f};
#pragma unroll
                for (int ai = 0; ai < 2; ++ai)
#pragma unroll
                    for (int m = 0; m < 4; ++m) acc[ai][bj][m][n] += bv; }
        bool bad = st1.run(acc, u, wr, wc, fr, fq, lds, wid, lane) || poison != 0u;
        const float qnan = __builtin_nanf("");
#pragma unroll
        for (int ai = 0; ai < 2; ++ai)
#pragma unroll
            for (int m = 0; m < 4; ++m) { const int r = ai * HALF + wr * 64 + m * 16 + fr; const f32x2v sr = S[r]; const size_t off = (size_t)(u.pm * BM + r) * ldc + col0;
#pragma unroll
                for (int bj = 0; bj < 2; ++bj)
#pragma unroll
                    for (int n = 0; n < 2; ++n) { const f32x4 bs = *(const f32x4*)(base + off + bj * HALF + n * 16); acc[ai][bj][m][n] = bs + (acc[ai][bj][m][n] - sr.x) * sr.y; }
                asm volatile("" : "+v"(acc[ai][0][m][0]), "+v"(acc[ai][0][m][1]), "+v"(acc[ai][1][m][0]), "+v"(acc[ai][1][m][1]));
                if (m & 1) asm volatile("" ::: "memory"); }
        const bool bad1 = bad;
        bad = st2.run(acc, u, wr, wc, fr, fq, lds, wid, lane) || bad;
#pragma unroll
        for (int ai = 0; ai < 2; ++ai)
#pragma unroll
            for (int m = 0; m < 4; ++m) { const int r = ai * HALF + wr * 64 + m * 16 + fr; const f32x2v sr = S[r]; const size_t off = (size_t)(u.pm * BM + r) * ldc + col0;
#pragma unroll
                for (int bj = 0; bj < 2; ++bj)
#pragma unroll
                    for (int n = 0; n < 2; ++n) { const f32x4 x1 = acc[ai][bj][m][n]; *(f32x4*)(out + off + bj * HALF + n * 16) = bad1 ? (f32x4){qnan, qnan, qnan, qnan} : x1;
                        const f32x4 o = (x1 - sr.x) * sr.y; u32x2v w; w.x = cvt_pk_bf16(o[0], o[1]); w.y = cvt_pk_bf16(o[2], o[3]);
                        if (bad) { w.x = 0x7fc07fc0u; w.y = 0x7fc07fc0u; } *(u32x2v*)(xn + off + bj * HALF + n * 16) = w; }
                asm volatile("" ::: "memory"); }
    }
};

template <class Epi, class Sched, bool STAMP = false>
__device__ __forceinline__ void gemm_phase(PG8_LAS unsigned char* lds, const Gemm g, const Sched& S, const Epi& E, unsigned long long* stamps) {
    int tid_l_ = (int)threadIdx.x; asm volatile("" : "+v"(tid_l_)); const int tid = tid_l_, wid = __builtin_amdgcn_readfirstlane(tid >> 6), lane = tid & 63, wr = wid >> 2, wc = wid & 3, fr = lane & 15, fq = lane >> 4;
    const int K = g.K, nt = K / BK;
    int ts_lo = 0, ts_hi = 0, nts = 0; const unsigned long long rt_entry = STAMP ? (unsigned long long)wall_clock64() : 0ull;
#define PG8_STAMP() do { if (STAMP && wid == 0 && nts < 64) { const unsigned long long _c = (unsigned long long)clock64(); \
        ts_lo = (lane == nts) ? (int)(unsigned)_c : ts_lo; ts_hi = (lane == nts) ? (int)(unsigned)(_c >> 32) : ts_hi; ++nts; } } while (0)
    PG8_STAMP();
    unsigned voffA[2], voffB[2];
#pragma unroll
    for (int i = 0; i < 2; ++i) { int R, C; stage_rc(tid * 16 + i * 8192, R, C); const int Rb = Epi::PERM ? ((R & ~31) + perm32(R & 31)) : R;
        voffA[i] = (unsigned)(R * K + C) * 2u; voffB[i] = (unsigned)(Rb * K + C) * 2u; }
    const size_t kstep = (size_t)(BK * 2);
    const size_t hstep = (size_t)HALF * K * 2;
    const size_t tstep = 2 * hstep;
    const unsigned ldsw = (unsigned)wid * 1024u;
    const int aoff = lds_byte(wr * 64 + fr, fq * 8), boff = lds_byte(wc * 32 + fr, fq * 8);
#define PG8_SA(b, h) (((b) * 2 + (h)) * HTB)
#define PG8_SB(b, h) ((4 + (b) * 2 + (h)) * HTB)
#define PG8_STAGE(bufoff, gbase, voff) do { _Pragma("unroll") for (int _i = 0; _i < 2; ++_i) \
        __builtin_amdgcn_global_load_lds((const unsigned*)((const char*)(gbase) + (voff)[_i]), (PG8_LAS unsigned*)(lds + (bufoff) + ldsw + _i * 8192), 16, 0, 0); } while (0)
#define PG8_LDA(dst, b, h) do { _Pragma("unroll") for (int m = 0; m < 4; ++m) _Pragma("unroll") for (int k = 0; k < 2; ++k) dst[m][k] = *(const PG8_LAS bf16x8*)(lds + PG8_SA(b, h) + aoff + m * 2048 + k * 1024); } while (0)
#define PG8_LDB(dst, b, h) do { _Pragma("unroll") for (int n = 0; n < 2; ++n) _Pragma("unroll") for (int k = 0; k < 2; ++k) dst[n][k] = *(const PG8_LAS bf16x8*)(lds + PG8_SB(b, h) + boff + n * 2048 + k * 1024); } while (0)
#define PG8_MMA(ai, bj, At, Bt) do { __builtin_amdgcn_s_setprio(1); _Pragma("unroll") for (int m = 0; m < 4; ++m) _Pragma("unroll") for (int n = 0; n < 2; ++n) _Pragma("unroll") for (int k = 0; k < 2; ++k) \
        acc[ai][bj][m][n] = __builtin_amdgcn_mfma_f32_16x16x32_bf16(Bt[n][k], At[m][k], acc[ai][bj][m][n], 0, 0, 0); __builtin_amdgcn_s_setprio(0); } while (0)
#define PG8_WAIT_V(n) asm volatile("s_waitcnt vmcnt(" #n ")" ::: "memory")
#define PG8_WAIT_L(n) asm volatile("s_waitcnt lgkmcnt(" #n ")" ::: "memory")
#define PG8_BAR __builtin_amdgcn_s_barrier()
#define PG8_SCHED __builtin_amdgcn_sched_barrier(0)
    Unit cur, nxt; int ui = 0;
    if (!S.next(0, cur)) return;
    f32x4 acc[2][2][4][2];
#pragma unroll
    for (int a = 0; a < 2; ++a)
#pragma unroll
        for (int b = 0; b < 2; ++b)
#pragma unroll
            for (int m = 0; m < 4; ++m)
#pragma unroll
                for (int n = 0; n < 2; ++n) acc[a][b][m][n] = (f32x4){0.f, 0.f, 0.f, 0.f};
    bf16x8 At[4][2], B0[2][2], B1[2][2];
    const char* cA = (const char*)g.A + (size_t)cur.pm * tstep; const char* cB = (const char*)g.Bt + (size_t)cur.pn * tstep;
    S.a_ready(cur);
    PG8_STAGE(PG8_SB(0, 0), cB, voffB); PG8_STAGE(PG8_SA(0, 0), cA, voffA); PG8_STAGE(PG8_SB(0, 1), cB + hstep, voffB); PG8_STAGE(PG8_SA(0, 1), cA + hstep, voffA);
    if (wr == 1) PG8_BAR;
    PG8_WAIT_V(4); PG8_BAR;
    PG8_STAGE(PG8_SB(1, 0), cB + kstep, voffB); PG8_STAGE(PG8_SA(1, 0), cA + kstep, voffA); PG8_STAGE(PG8_SB(1, 1), cB + hstep + kstep, voffB);
    PG8_WAIT_V(6); PG8_BAR;
    PG8_STAMP();
    for (;;) {
        const bool has_next = S.next(ui + 1, nxt);
        const char* nA = has_next ? (const char*)g.A + (size_t)nxt.pm * tstep : cA; const char* nB = has_next ? (const char*)g.Bt + (size_t)nxt.pn * tstep : cB;
        for (int t = 0; t < nt; t += 2) {
            const bool last = (t == nt - 2);
            const char* a1 = cA + (size_t)(t + 1) * kstep;
            const char* a2 = last ? nA : cA + (size_t)(t + 2) * kstep; const char* b2 = last ? nB : cB + (size_t)(t + 2) * kstep;
            const char* a3 = a2 + kstep; const char* b3 = b2 + kstep;
            if (last && has_next) S.a_ready(nxt);
            PG8_LDB(B0, 0, 0); PG8_SCHED; PG8_LDA(At, 0, 0); PG8_STAGE(PG8_SA(1, 1), a1 + hstep, voffA);
            PG8_WAIT_L(8); PG8_BAR; PG8_WAIT_L(0); PG8_MMA(0, 0, At, B0); PG8_BAR; PG8_SCHED;
            PG8_LDB(B1, 0, 1); PG8_STAGE(PG8_SB(0, 0), b2, voffB);
            PG8_BAR; PG8_WAIT_L(0); PG8_MMA(0, 1, At, B1); PG8_BAR;
            PG8_LDA(At, 0, 1); PG8_STAGE(PG8_SA(0, 0), a2, voffA);
            PG8_BAR; PG8_WAIT_L(0); PG8_MMA(1, 0, At, B0); PG8_BAR; PG8_SCHED;
            PG8_STAGE(PG8_SB(0, 1), b2 + hstep, voffB);
            PG8_WAIT_V(6); PG8_BAR; PG8_MMA(1, 1, At, B1); PG8_BAR;
            PG8_LDB(B0, 1, 0); PG8_SCHED; PG8_LDA(At, 1, 0); PG8_STAGE(PG8_SA(0, 1), a2 + hstep, voffA);
            PG8_WAIT_L(8); PG8_BAR; PG8_WAIT_L(0); PG8_MMA(0, 0, At, B0); PG8_BAR; PG8_SCHED;
            PG8_LDB(B1, 1, 1); PG8_STAGE(PG8_SB(1, 0), b3, voffB);
            PG8_BAR; PG8_WAIT_L(0); PG8_MMA(0, 1, At, B1); PG8_BAR;
            PG8_LDA(At, 1, 1); PG8_STAGE(PG8_SA(1, 0), a3, voffA);
            PG8_BAR; PG8_WAIT_L(0); PG8_MMA(1, 0, At, B0); PG8_BAR; PG8_SCHED;
            PG8_STAGE(PG8_SB(1, 1), b3 + hstep, voffB);
            PG8_WAIT_V(6); PG8_BAR; PG8_MMA(1, 1, At, B1); PG8_BAR;
        }
        PG8_STAMP();
        if constexpr (!Epi::AFTER_DRAIN) { E(acc, cur, wr, wc, fr, fq); S.done(cur); }
        PG8_STAMP();
        if (!has_next) break;
#pragma unroll
        for (int a = 0; a < 2; ++a)
#pragma unroll
            for (int b = 0; b < 2; ++b)
#pragma unroll
                for (int m = 0; m < 4; ++m)
#pragma unroll
                    for (int n = 0; n < 2; ++n) acc[a][b][m][n] = (f32x4){0.f, 0.f, 0.f, 0.f};
        cur = nxt; cA = nA; cB = nB; ++ui;
    }
    PG8_WAIT_V(0);
    if (wr == 0) PG8_BAR;
    PG8_BAR;
    if constexpr (Epi::AFTER_DRAIN) { E.fused(acc, cur, wr, wc, fr, fq, lds, wid, lane); S.done(cur); }
    PG8_STAMP();
    if (STAMP && wid == 0) { stamps[lane] = lane < nts ? (((unsigned long long)(unsigned)ts_hi << 32) | (unsigned)ts_lo) : 0ull;
        if (lane == 62) stamps[62] = rt_entry; if (lane == 63) stamps[63] = (unsigned long long)wall_clock64(); }
#undef PG8_STAMP
#undef PG8_SA
#undef PG8_SB
#undef PG8_STAGE
#undef PG8_LDA
#undef PG8_LDB
#undef PG8_MMA
#undef PG8_WAIT_V
#undef PG8_WAIT_L
#undef PG8_BAR
#undef PG8_SCHED
}
template <class Epi, class Sched, bool STAMP = false>
__device__ __forceinline__ void gemm_phase_g(PG8_LAS unsigned char* lds, const Gemm g, const Sched& S, const Epi& E, const PG8_LAS int* ridx) {
    unsigned long long* stamps = nullptr;
    int tid_l_ = (int)threadIdx.x; asm volatile("" : "+v"(tid_l_)); const int tid = tid_l_, wid = __builtin_amdgcn_readfirstlane(tid >> 6), lane = tid & 63, wr = wid >> 2, wc = wid & 3, fr = lane & 15, fq = lane >> 4;
    const int K = g.K, nt = K / BK;
    int ts_lo = 0, ts_hi = 0, nts = 0; const unsigned long long rt_entry = STAMP ? (unsigned long long)wall_clock64() : 0ull;
#define PG8_STAMP() do { if (STAMP && wid == 0 && nts < 64) { const unsigned long long _c = (unsigned long long)clock64(); \
        ts_lo = (lane == nts) ? (int)(unsigned)_c : ts_lo; ts_hi = (lane == nts) ? (int)(unsigned)(_c >> 32) : ts_hi; ++nts; } } while (0)
    PG8_STAMP();
    unsigned voffB[2]; int rA[2]; unsigned cA2[2];
#pragma unroll
    for (int i = 0; i < 2; ++i) { int R, C; stage_rc(tid * 16 + i * 8192, R, C); const int Rb = Epi::PERM ? ((R & ~31) + perm32(R & 31)) : R;
        rA[i] = R; cA2[i] = (unsigned)C * 2u; voffB[i] = (unsigned)(Rb * K + C) * 2u; }
    unsigned vc[2][2], vn[2][2];
#define PG8_GIDX(dst, ui_) do { _Pragma("unroll") for (int h_ = 0; h_ < 2; ++h_) _Pragma("unroll") for (int i_ = 0; i_ < 2; ++i_) dst[h_][i_] = (unsigned)ridx[(ui_) * 256 + h_ * 128 + rA[i_]] * (unsigned)(K * 2) + cA2[i_]; \
        asm volatile("s_waitcnt lgkmcnt(0)" ::: "memory"); } while (0)
    const size_t kstep = (size_t)(BK * 2);
    const size_t hstep = (size_t)HALF * K * 2;
    const size_t tstep = 2 * hstep;
    const unsigned ldsw = (unsigned)wid * 1024u;
    const int aoff = lds_byte(wr * 64 + fr, fq * 8), boff = lds_byte(wc * 32 + fr, fq * 8);
#define PG8_SA(b, h) (((b) * 2 + (h)) * HTB)
#define PG8_SB(b, h) ((4 + (b) * 2 + (h)) * HTB)
#define PG8_STAGE(bufoff, gbase, voff) do { _Pragma("unroll") for (int _i = 0; _i < 2; ++_i) \
        __builtin_amdgcn_global_load_lds((const unsigned*)((const char*)(gbase) + (voff)[_i]), (PG8_LAS unsigned*)(lds + (bufoff) + ldsw + _i * 8192), 16, 0, 0); } while (0)
#define PG8_LDA(dst, b, h) do { _Pragma("unroll") for (int m = 0; m < 4; ++m) _Pragma("unroll") for (int k = 0; k < 2; ++k) dst[m][k] = *(const PG8_LAS bf16x8*)(lds + PG8_SA(b, h) + aoff + m * 2048 + k * 1024); } while (0)
#define PG8_LDB(dst, b, h) do { _Pragma("unroll") for (int n = 0; n < 2; ++n) _Pragma("unroll") for (int k = 0; k < 2; ++k) dst[n][k] = *(const PG8_LAS bf16x8*)(lds + PG8_SB(b, h) + boff + n * 2048 + k * 1024); } while (0)
#define PG8_MMA(ai, bj, At, Bt) do { __builtin_amdgcn_s_setprio(1); _Pragma("unroll") for (int m = 0; m < 4; ++m) _Pragma("unroll") for (int n = 0; n < 2; ++n) _Pragma("unroll") for (int k = 0; k < 2; ++k) \
        acc[ai][bj][m][n] = __builtin_amdgcn_mfma_f32_16x16x32_bf16(Bt[n][k], At[m][k], acc[ai][bj][m][n], 0, 0, 0); __builtin_amdgcn_s_setprio(0); } while (0)
#define PG8_WAIT_V(n) asm volatile("s_waitcnt vmcnt(" #n ")" ::: "memory")
#define PG8_WAIT_L(n) asm volatile("s_waitcnt lgkmcnt(" #n ")" ::: "memory")
#define PG8_BAR __builtin_amdgcn_s_barrier()
#define PG8_SCHED __builtin_amdgcn_sched_barrier(0)
    Unit cur, nxt; int ui = 0;
    if (!S.next(0, cur)) return;
    f32x4 acc[2][2][4][2];
#pragma unroll
    for (int a = 0; a < 2; ++a)
#pragma unroll
        for (int b = 0; b < 2; ++b)
#pragma unroll
            for (int m = 0; m < 4; ++m)
#pragma unroll
                for (int n = 0; n < 2; ++n) acc[a][b][m][n] = (f32x4){0.f, 0.f, 0.f, 0.f};
    bf16x8 At[4][2], B0[2][2], B1[2][2];
    const char* cA = (const char*)g.A; const char* cB = (const char*)g.Bt + (size_t)cur.pn * tstep;
    PG8_GIDX(vc, 0);
    S.a_ready(cur);
    PG8_STAGE(PG8_SB(0, 0), cB, voffB); PG8_STAGE(PG8_SA(0, 0), cA, vc[0]); PG8_STAGE(PG8_SB(0, 1), cB + hstep, voffB); PG8_STAGE(PG8_SA(0, 1), cA, vc[1]);
    if (wr == 1) PG8_BAR;
    PG8_WAIT_V(4); PG8_BAR;
    PG8_STAGE(PG8_SB(1, 0), cB + kstep, voffB); PG8_STAGE(PG8_SA(1, 0), cA + kstep, vc[0]); PG8_STAGE(PG8_SB(1, 1), cB + hstep + kstep, voffB);
    PG8_WAIT_V(6); PG8_BAR;
    PG8_STAMP();
    for (;;) {
        const bool has_next = S.next(ui + 1, nxt);
        const char* nB = has_next ? (const char*)g.Bt + (size_t)nxt.pn * tstep : cB;
        if (has_next) PG8_GIDX(vn, ui + 1); else {
#pragma unroll
            for (int h_ = 0; h_ < 2; ++h_)
#pragma unroll
                for (int i_ = 0; i_ < 2; ++i_) vn[h_][i_] = vc[h_][i_]; }
        for (int t = 0; t < nt; t += 2) {
            const bool last = (t == nt - 2);
            const char* a1 = cA + (size_t)(t + 1) * kstep;
            const char* a2 = last ? cA : cA + (size_t)(t + 2) * kstep; const char* b2 = last ? nB : cB + (size_t)(t + 2) * kstep;
            const char* a3 = a2 + kstep; const char* b3 = b2 + kstep;
            unsigned v2[2][2];
#pragma unroll
            for (int h_ = 0; h_ < 2; ++h_)
#pragma unroll
                for (int i_ = 0; i_ < 2; ++i_) v2[h_][i_] = last ? vn[h_][i_] : vc[h_][i_];
            if (last && has_next) S.a_ready(nxt);
            PG8_LDB(B0, 0, 0); PG8_SCHED; PG8_LDA(At, 0, 0); PG8_STAGE(PG8_SA(1, 1), a1, vc[1]);
            PG8_WAIT_L(8); PG8_BAR; PG8_WAIT_L(0); PG8_MMA(0, 0, At, B0); PG8_BAR; PG8_SCHED;
            PG8_LDB(B1, 0, 1); PG8_STAGE(PG8_SB(0, 0), b2, voffB);
            PG8_BAR; PG8_WAIT_L(0); PG8_MMA(0, 1, At, B1); PG8_BAR;
            PG8_LDA(At, 0, 1); PG8_STAGE(PG8_SA(0, 0), a2, v2[0]);
            PG8_BAR; PG8_WAIT_L(0); PG8_MMA(1, 0, At, B0); PG8_BAR; PG8_SCHED;
            PG8_STAGE(PG8_SB(0, 1), b2 + hstep, voffB);
            PG8_WAIT_V(6); PG8_BAR; PG8_MMA(1, 1, At, B1); PG8_BAR;
            PG8_LDB(B0, 1, 0); PG8_SCHED; PG8_LDA(At, 1, 0); PG8_STAGE(PG8_SA(0, 1), a2, v2[1]);
            PG8_WAIT_L(8); PG8_BAR; PG8_WAIT_L(0); PG8_MMA(0, 0, At, B0); PG8_BAR; PG8_SCHED;
            PG8_LDB(B1, 1, 1); PG8_STAGE(PG8_SB(1, 0), b3, voffB);
            PG8_BAR; PG8_WAIT_L(0); PG8_MMA(0, 1, At, B1); PG8_BAR;
            PG8_LDA(At, 1, 1); PG8_STAGE(PG8_SA(1, 0), a3, v2[0]);
            PG8_BAR; PG8_WAIT_L(0); PG8_MMA(1, 0, At, B0); PG8_BAR; PG8_SCHED;
            PG8_STAGE(PG8_SB(1, 1), b3 + hstep, voffB);
            PG8_WAIT_V(6); PG8_BAR; PG8_MMA(1, 1, At, B1); PG8_BAR;
        }
        PG8_STAMP();
        if constexpr (!Epi::AFTER_DRAIN) { E(acc, cur, wr, wc, fr, fq); S.done(cur); }
        PG8_STAMP();
        if (!has_next) break;
#pragma unroll
        for (int a = 0; a < 2; ++a)
#pragma unroll
            for (int b = 0; b < 2; ++b)
#pragma unroll
                for (int m = 0; m < 4; ++m)
#pragma unroll
                    for (int n = 0; n < 2; ++n) acc[a][b][m][n] = (f32x4){0.f, 0.f, 0.f, 0.f};
        cur = nxt; cB = nB; ++ui;
#pragma unroll
        for (int h_ = 0; h_ < 2; ++h_)
#pragma unroll
            for (int i_ = 0; i_ < 2; ++i_) vc[h_][i_] = vn[h_][i_];
    }
    PG8_WAIT_V(0);
    if (wr == 0) PG8_BAR;
    PG8_BAR;
    if constexpr (Epi::AFTER_DRAIN) { E.fused(acc, cur, wr, wc, fr, fq, lds, wid, lane); S.done(cur); }
    PG8_STAMP();
    if (STAMP && wid == 0) { stamps[lane] = lane < nts ? (((unsigned long long)(unsigned)ts_hi << 32) | (unsigned)ts_lo) : 0ull;
        if (lane == 62) stamps[62] = rt_entry; if (lane == 63) stamps[63] = (unsigned long long)wall_clock64(); }
#undef PG8_STAMP
#undef PG8_GIDX
#undef PG8_SA
#undef PG8_SB
#undef PG8_STAGE
#undef PG8_LDA
#undef PG8_LDB
#undef PG8_MMA
#undef PG8_WAIT_V
#undef PG8_WAIT_L
#undef PG8_BAR
#undef PG8_SCHED
}
}

using pg8::bf16_t; using pg8::bf16x8; using pg8::f32x4;
typedef float f32x16 __attribute__((ext_vector_type(16)));
typedef float f32x2v __attribute__((ext_vector_type(2)));
typedef __bf16 bf16x2v __attribute__((ext_vector_type(2)));
typedef short s16x4 __attribute__((ext_vector_type(4)));
typedef unsigned u32x4 __attribute__((ext_vector_type(4)));
typedef unsigned u32x2 __attribute__((ext_vector_type(2)));
typedef PG8_LAS unsigned char* LDSP;
typedef PG8_LAS float* LASF;

constexpr int NTH = 512;
constexpr int LDS_BYTES = 156 * 1024;
constexpr int DM = 1024, LL = 8192, LC = 256, SEQB = 8448, TT = 16896, NPAN = 66, TPAD = 41984;
constexpr size_t UU = (size_t)TT * 1024 * 2;
constexpr float EPS_ = 1e-6f;
constexpr float INV2PI = 0.15915494309189535f;

template <class T> __device__ __forceinline__ T* UP(T* q) { const unsigned long long v = (unsigned long long)q;
    const unsigned lo = (unsigned)__builtin_amdgcn_readfirstlane((int)(unsigned)v), hi = (unsigned)__builtin_amdgcn_readfirstlane((int)(unsigned)(v >> 32));
    return (T*)(__attribute__((address_space(1))) T*)(((unsigned long long)hi << 32) | lo); }
__device__ __forceinline__ int ltid() { int t = (int)threadIdx.x; asm volatile("" : "+v"(t)); return t; }
__device__ __forceinline__ f32x2v mk2_(float x, float y) { f32x2v r; r.x = x; r.y = y; return r; }
__device__ __forceinline__ float bf2f(bf16_t v) { return __uint_as_float(((unsigned)v) << 16); }
__device__ __forceinline__ unsigned pk2(float lo, float hi) { f32x2v v = {lo, hi}; bf16x2v b = __builtin_convertvector(v, bf16x2v); return __builtin_bit_cast(unsigned, b); }
__device__ __forceinline__ bf16_t f2bf(float f) { return (bf16_t)(pk2(f, 0.f) & 0xffffu); }
__device__ __forceinline__ float lo16(unsigned w) { return __uint_as_float(w << 16); }
__device__ __forceinline__ float hi16(unsigned w) { return __uint_as_float(w & 0xffff0000u); }
__device__ __forceinline__ float sigmoidf_(float x) { return __builtin_amdgcn_rcpf(1.0f + __expf(-x)); }
__device__ __forceinline__ float siluf_(float x) { return x * __builtin_amdgcn_rcpf(1.0f + __expf(-x)); }
__device__ __forceinline__ float logsigf_(float x) { return fminf(x, 0.f) - log1pf(__expf(-fabsf(x))); }
__device__ __forceinline__ float sin2pi(float rev) { return __builtin_amdgcn_sinf(rev); }
__device__ __forceinline__ float cos2pi(float rev) { return __builtin_amdgcn_cosf(rev); }
__device__ __forceinline__ int crow(int r, int hi) { return (r & 3) + 8 * (r >> 2) + 4 * hi; }
template <int CTRL> __device__ __forceinline__ float dpp_mov(float x) { return __int_as_float(__builtin_amdgcn_update_dpp(0, __float_as_int(x), CTRL, 0xf, 0xf, false)); }
__device__ __forceinline__ float row_sum(float x) { x += dpp_mov<0x128>(x); x += dpp_mov<0x124>(x); x += dpp_mov<0x122>(x); x += dpp_mov<0x121>(x); return x; }
__device__ __forceinline__ float row_max(float x) { x = fmaxf(x, dpp_mov<0x128>(x)); x = fmaxf(x, dpp_mov<0x124>(x)); x = fmaxf(x, dpp_mov<0x122>(x)); x = fmaxf(x, dpp_mov<0x121>(x)); return x; }
__device__ __forceinline__ void swap32_(float& a, float& b) { auto r = __builtin_amdgcn_permlane32_swap(__float_as_uint(a), __float_as_uint(b), false, false); a = __uint_as_float(r[0]); b = __uint_as_float(r[1]); }
__device__ __forceinline__ void swap16_(float& a, float& b) { auto r = __builtin_amdgcn_permlane16_swap(__float_as_uint(a), __float_as_uint(b), false, false); a = __uint_as_float(r[0]); b = __uint_as_float(r[1]); }
__device__ __forceinline__ float wave_sum(float v) { v = row_sum(v); float w = v; swap16_(v, w); v += w; w = v; swap32_(v, w); return v + w; }
__device__ __forceinline__ float wave_max(float v) { v = row_max(v); float w = v; swap16_(v, w); v = fmaxf(v, w); w = v; swap32_(v, w); return fmaxf(v, w); }
__device__ __forceinline__ void wave_sum32(float (&v)[32]) {
#pragma unroll
    for (int i = 0; i < 16; ++i) { swap32_(v[i], v[16 + i]); v[i] += v[16 + i]; }
#pragma unroll
    for (int i = 0; i < 8; ++i) { swap16_(v[i], v[8 + i]); v[i] += v[8 + i]; }
#pragma unroll
    for (int i = 0; i < 8; ++i) v[i] = row_sum(v[i]); }
__device__ __forceinline__ void wave_sum16(float (&v)[16]) {
#pragma unroll
    for (int i = 0; i < 8; ++i) { swap32_(v[i], v[8 + i]); v[i] += v[8 + i]; }
#pragma unroll
    for (int i = 0; i < 4; ++i) { swap16_(v[i], v[4 + i]); v[i] += v[4 + i]; }
#pragma unroll
    for (int i = 0; i < 4; ++i) v[i] = row_sum(v[i]); }
__device__ __forceinline__ float readlane_f(float x, int l) { return __int_as_float(__builtin_amdgcn_readlane(__float_as_int(x), l)); }
__device__ __forceinline__ void unpack8(const u32x4 w, float (&f)[8]) {
    f[0] = lo16(w.x); f[1] = hi16(w.x); f[2] = lo16(w.y); f[3] = hi16(w.y); f[4] = lo16(w.z); f[5] = hi16(w.z); f[6] = lo16(w.w); f[7] = hi16(w.w); }
constexpr float ST_SC = 4.0f, ST_ISC = 0.25f;
__device__ __forceinline__ unsigned pk4_fp8(float a, float b, float c, float d) {
    a = fminf(fmaxf(a, -440.f), 440.f); b = fminf(fmaxf(b, -440.f), 440.f); c = fminf(fmaxf(c, -440.f), 440.f); d = fminf(fmaxf(d, -440.f), 440.f);
    unsigned w = 0u; w = (unsigned)__builtin_amdgcn_cvt_pk_fp8_f32(a, b, (int)w, false); w = (unsigned)__builtin_amdgcn_cvt_pk_fp8_f32(c, d, (int)w, true); return w; }
__device__ __forceinline__ void unpk8_fp8(const u32x2 w, float (&f)[8]) {
    const f32x2v a = __builtin_amdgcn_cvt_pk_f32_fp8((int)w.x, false), b = __builtin_amdgcn_cvt_pk_f32_fp8((int)w.x, true), c = __builtin_amdgcn_cvt_pk_f32_fp8((int)w.y, false), d = __builtin_amdgcn_cvt_pk_f32_fp8((int)w.y, true);
    f[0] = a.x; f[1] = a.y; f[2] = b.x; f[3] = b.y; f[4] = c.x; f[5] = c.y; f[6] = d.x; f[7] = d.y; }
__device__ __forceinline__ u32x4 pack8(const float (&f)[8]) { u32x4 w; w.x = pk2(f[0], f[1]); w.y = pk2(f[2], f[3]); w.z = pk2(f[4], f[5]); w.w = pk2(f[6], f[7]); return w; }

template <class T> struct GP { __attribute__((address_space(1))) T* p;
    __host__ __device__ __forceinline__ GP& operator=(T* q) { p = (__attribute__((address_space(1))) T*)q; return *this; }
    __device__ __forceinline__ operator T*() const { return (T*)p; } };
struct Params {
    GP<const float> x, c, ctx, c_ctx, mod_w, mod_b, norm1_g, norm2_g, w_in, merge_b, m_conv_w, m_conv_b, m_gate_b, m_norm_g;
    GP<const float> a_qnorm_g, a_knorm_g, a_lambda, a_subln_g, h_conv_w, h_conv_b, h_ffn_w1, h_ffn_b1, h_ffn_w2, h_ffn_b2, h_ffn_w3;
    GP<const float> h_freq, h_decay, h_bias, w_br_m, w_br_a, w_br_h, w_out, router_w, router_b, e_w1, e_w3, e_w2;
    GP<float> out;
    GP<unsigned> bar; GP<int> cnt; GP<int> cur; GP<float> sumsq; GP<float> sumsqC;
    GP<float> modv; GP<float> hdn2; GP<float> G; GP<float> xc; GP<int> sel_e; GP<float> sel_w; GP<int> posbuf; GP<int> rowidx;
    GP<float> scal; GP<float> ms; GP<float> dn; GP<float> nst; GP<float> hfC; GP<float> hbC;
    GP<bf16_t> Wt_in, Wt_br, Wt_out, hn, Y3;
    GP<unsigned char> R;
};

__device__ __forceinline__ const float* resid_row_in(const Params& p, int layer, int s) {
    const int b = s / SEQB, pos = s - b * SEQB;
    if (pos < LC) return (layer == 0 ? p.ctx : p.xc) + (size_t)(b * LC + pos) * DM;
    return (layer == 0 ? p.x : p.out) + (size_t)(b * LL + pos - LC) * DM; }
__device__ __forceinline__ float* resid_row(const Params& p, int s) {
    const int b = s / SEQB, pos = s - b * SEQB;
    if (pos < LC) return p.xc + (size_t)(b * LC + pos) * DM;
    return p.out + (size_t)(b * LL + pos - LC) * DM; }
__device__ __forceinline__ const float* modvec(const Params& p, int layer, int s) { const int b = s / SEQB, pos = s - b * SEQB; return p.modv + (size_t)(layer * 3 + (pos < LC ? 2 : b)) * 6144; }

struct MapWin { const float* w;
    __device__ __forceinline__ const float* operator()(int n0, int cb, int k) const { int col;
        if (n0 < 6144) col = 4112 + n0;
        else if (n0 < 6656) col = 12304 + (n0 - 6144);
        else if (n0 < 12800) { const int m = n0 - 6656, d = m >> 10; col = (d < 4 ? 1024 * d : (d == 4 ? 10256 : 11280)) + (m & 1023); }
        else col = 12304 + 512 + (n0 - 12800);
        return w + (size_t)k * 13328 + col + cb * 4; } };
struct MapPlain { const float* w; int ld;
    __device__ __forceinline__ const float* operator()(int n0, int cb, int k) const { return w + (size_t)k * ld + n0 + cb * 4; } };
struct MapE13 { const float* w1; long d31;
    __device__ __forceinline__ const float* operator()(int n0, int cb, int k) const { return w1 + ((cb & 1) ? d31 : 0l) + (size_t)k * 512 + (n0 >> 1) + 4 * (cb >> 1); } };
template <class MAP> __device__ __forceinline__ void xpose_tile(const MAP& map, int n0, int k0, bf16_t* dst, int K, LDSP lds) {
    LASF tl = (LASF)lds; const int tid = ltid();
    float4 v[4];
#pragma unroll
    for (int pass = 0; pass < 4; ++pass) v[pass] = *(const float4*)map(n0, tid & 15, k0 + pass * 32 + (tid >> 4));
#pragma unroll
    for (int pass = 0; pass < 4; ++pass) { const int k = pass * 32 + (tid >> 4), cb = tid & 15;
        tl[k * 65 + cb * 4 + 0] = v[pass].x; tl[k * 65 + cb * 4 + 1] = v[pass].y; tl[k * 65 + cb * 4 + 2] = v[pass].z; tl[k * 65 + cb * 4 + 3] = v[pass].w; }
    __syncthreads();
    { const int n = tid >> 3, kq = (tid & 7) * 16; float f[8], g[8];
#pragma unroll
      for (int i = 0; i < 8; ++i) { f[i] = tl[(kq + i) * 65 + n]; g[i] = tl[(kq + 8 + i) * 65 + n]; }
      bf16_t* d = dst + (size_t)(n0 + n) * K + k0 + kq;
      *(u32x4*)d = pack8(f); *(u32x4*)(d + 8) = pack8(g); }
    __syncthreads();
}
template <class MAP> __device__ __forceinline__ void xpose_mat(const MAP& map, int N, int K, bf16_t* dst, LDSP lds, int bid, int nb) {
    const int ntn = N / 64, ntk = K / 128;
    for (int ti = bid; ti < ntn * ntk; ti += nb) { const int nt = ti / ntk, kt = ti - nt * ntk; xpose_tile(map, nt * 64, kt * 128, dst, K, lds); }
}
__device__ __forceinline__ void phase_conv_small(const Params& p, int layer, LDSP lds, int bid, int nb) {
    { MapWin m{p.w_in + (size_t)layer * 1024 * 13328}; xpose_mat(m, 13312, 1024, p.Wt_in, lds, bid, nb); }
    { MapPlain m{p.w_br_m + (size_t)layer * 1048576, 1024}; xpose_mat(m, 1024, 1024, p.Wt_br + (size_t)layer * 3 * 1048576, lds, bid, nb); }
    { MapPlain m{p.w_br_a + (size_t)layer * 1048576, 1024}; xpose_mat(m, 1024, 1024, p.Wt_br + (size_t)layer * 3 * 1048576 + 1048576, lds, bid, nb); }
    { MapPlain m{p.w_br_h + (size_t)layer * 1048576, 1024}; xpose_mat(m, 1024, 1024, p.Wt_br + (size_t)layer * 3 * 1048576 + 2 * 1048576, lds, bid, nb); }
    { MapPlain m{p.w_out + (size_t)layer * 1048576, 1024}; xpose_mat(m, 1024, 1024, p.Wt_out + (size_t)layer * 1048576, lds, bid, nb); }
}
__device__ __forceinline__ void phase_conv_experts(const Params& p, int layer, bf16_t* Wt13, bf16_t* Wt2, LDSP lds, int bid, int nb) {
    for (int ti = bid; ti < 32 * 128; ti += nb) { const int e = ti >> 7, r = ti & 127, nt = r >> 3, kt = r & 7;
        MapE13 m{p.e_w1 + ((size_t)layer * 32 + e) * 524288, (long)(p.e_w3 - p.e_w1)};
        xpose_tile(m, nt * 64, kt * 128, Wt13 + (size_t)e * 1048576, 1024, lds); }
    for (int ti = bid; ti < 32 * 64; ti += nb) { const int e = ti >> 6, r = ti & 63, nt = r >> 2, kt = r & 3;
        MapPlain m{p.e_w2 + ((size_t)layer * 32 + e) * 524288, 1024};
        xpose_tile(m, nt * 64, kt * 128, Wt2 + (size_t)e * 524288, 512, lds); }
}

__device__ __forceinline__ void phase_modvec(const Params& p, LDSP lds, int bid, int nb) {
    LASF red = (LASF)lds; const int tid = ltid();
    for (int u = bid; u < 192; u += nb) {
        const int l = u / 96, cg = u - l * 96, col = tid & 63, ks = tid >> 6;
        const float* W = p.mod_w + (size_t)l * 1024 * 6144 + cg * 64 + col;
        float a0 = 0.f, a1 = 0.f, a2 = 0.f;
        for (int k0 = ks * 128; k0 < ks * 128 + 128; k0 += 16) { float w[16], c0[16], c1[16], c2[16];
#pragma unroll
            for (int j = 0; j < 16; ++j) { w[j] = W[(size_t)(k0 + j) * 6144]; c0[j] = p.c[k0 + j]; c1[j] = p.c[1024 + k0 + j]; c2[j] = p.c_ctx[k0 + j]; }
#pragma unroll
            for (int j = 0; j < 16; ++j) { a0 += siluf_(c0[j]) * w[j]; a1 += siluf_(c1[j]) * w[j]; a2 += siluf_(c2[j]) * w[j]; } }
        red[(ks * 3 + 0) * 64 + col] = a0; red[(ks * 3 + 1) * 64 + col] = a1; red[(ks * 3 + 2) * 64 + col] = a2;
        __syncthreads();
        if (tid < 192) { const int v = tid >> 6, cc = tid & 63; float s = p.mod_b[l * 6144 + cg * 64 + cc];
#pragma unroll
            for (int q = 0; q < 8; ++q) s += red[(q * 3 + v) * 64 + cc];
            p.modv[(size_t)(l * 3 + v) * 6144 + cg * 64 + cc] = s; }
        __syncthreads();
    }
}

__device__ __forceinline__ void phase_hdn(const Params& p, LDSP lds, int bid, int nb) {
    LASF w1s = (LASF)lds, b1s = w1s + 33 * 64, w2s = b1s + 64, b2s = w2s + 64 * 64, frs = b2s + 64, hbuf = frs + 64;
    const int tid = ltid();
    for (int u = bid; u < 132; u += nb) {
        const int l = u / 66, pu = u - l * 66;
        for (int i = tid; i < 33 * 64; i += NTH) w1s[i] = p.h_ffn_w1[l * 33 * 64 + i];
        for (int i = tid; i < 64 * 64; i += NTH) w2s[i] = p.h_ffn_w2[l * 4096 + i];
        if (tid < 64) { b1s[tid] = p.h_ffn_b1[l * 64 + tid]; b2s[tid] = p.h_ffn_b2[l * 64 + tid]; frs[tid] = p.h_freq[l * 64 + tid]; }
        __syncthreads();
        const int pos = tid >> 2, qd = tid & 3, q = pu * 128 + pos;
        const int Lf = q < 8192 ? 8192 : 256, t = q < 8192 ? q : q - 8192;
        float z[33];
        z[0] = (float)t / (float)(Lf - 1);
        const float wrev = (float)t / (float)Lf;
#pragma unroll
        for (int j = 0; j < 16; ++j) { const float f = 1e-4f + (float)j * ((15.0f - 1e-4f) / 15.0f); float ph = f * wrev; ph -= floorf(ph); z[1 + j] = cos2pi(ph); z[17 + j] = -sin2pi(ph); }
#pragma unroll
        for (int jj = 0; jj < 16; ++jj) { const int j = qd * 16 + jj; float a = b1s[j];
#pragma unroll
            for (int i = 0; i < 33; ++i) a += z[i] * w1s[i * 64 + j];
            hbuf[pos * 65 + j] = sinf(frs[j] * a); }
        __syncthreads();
        float acc[16];
#pragma unroll
        for (int jj = 0; jj < 16; ++jj) acc[jj] = b2s[qd * 16 + jj];
        for (int i = 0; i < 64; ++i) { const float hv = hbuf[pos * 65 + i];
#pragma unroll
            for (int jj = 0; jj < 16; ++jj) acc[jj] += hv * w2s[i * 64 + qd * 16 + jj]; }
#pragma unroll
        for (int jj = 0; jj < 16; ++jj) p.hdn2[((size_t)l * 8448 + q) * 64 + qd * 16 + jj] = sinf(frs[qd * 16 + jj] * acc[jj]);
        __syncthreads();
    }
}
__device__ __forceinline__ void phase_taps(const Params& p, int layer, bf16_t* tapsT, LDSP lds, int bid, int nb) {
    LASF wsum = (LASF)lds;
    const int nunits = 512 + (layer == 0 ? 64 : 0);
    const float* w3 = UP((const float*)p.h_ffn_w3 + (size_t)layer * 64 * 2048); const float* hd = UP((const float*)p.hdn2 + (size_t)layer * 8448 * 64);
    const float* decp = UP((const float*)p.h_decay + layer * 2048);
    for (int u = bid; u < nunits; u += nb) {
        const int tid = ltid(), lane = tid & 63, r32 = lane & 31, hi = lane >> 5; const int wid = __builtin_amdgcn_readfirstlane(tid >> 6);
        const bool isc = u >= 512; const int cgp = isc ? u - 512 : (u >> 3), tch = isc ? 0 : (u & 7);
        const int Lf = isc ? 256 : 8192; const float rL = 1.0f / (float)(Lf - 1);
        bf16x8 afh[4], afl[4];
#pragma unroll
        for (int kk = 0; kk < 4; ++kk) { float a[8], lo[8]; u32x4 wh, wl;
#pragma unroll
            for (int j = 0; j < 8; ++j) a[j] = w3[(size_t)(16 * kk + 8 * hi + j) * 2048 + 32 * cgp + r32];
            wh = pack8(a);
            { float ah[8]; unpack8(wh, ah);
#pragma unroll
              for (int j = 0; j < 8; ++j) lo[j] = a[j] - ah[j]; }
            wl = pack8(lo); afh[kk] = __builtin_bit_cast(bf16x8, wh); afl[kk] = __builtin_bit_cast(bf16x8, wl); }
        float dcy[16], ss[16];
#pragma unroll
        for (int r = 0; r < 16; ++r) { dcy[r] = fabsf(decp[32 * cgp + crow(r, hi)]); ss[r] = 0.f; }
        const int ntb = isc ? 1 : 4;
        for (int tb = 0; tb < ntb; ++tb) {
            const int t0 = isc ? 32 * wid : tch * 1024 + (4 * wid + tb) * 32, t = t0 + r32;
            const float* hr = hd + (size_t)(isc ? 8192 + t : t) * 64;
            f32x4 hv[8];
#pragma unroll
            for (int i = 0; i < 4; ++i) { hv[2 * i] = *(const f32x4*)(hr + 16 * i + 8 * hi); hv[2 * i + 1] = *(const f32x4*)(hr + 16 * i + 8 * hi + 4); }
            f32x16 acc;
#pragma unroll
            for (int r = 0; r < 16; ++r) acc[r] = 0.f;
#pragma unroll
            for (int kk = 0; kk < 4; ++kk) { float b[8], lo[8];
                const f32x4 q0 = hv[2 * kk], q1 = hv[2 * kk + 1];
                b[0] = q0.x; b[1] = q0.y; b[2] = q0.z; b[3] = q0.w; b[4] = q1.x; b[5] = q1.y; b[6] = q1.z; b[7] = q1.w;
                const u32x4 wh = pack8(b); float bh[8]; unpack8(wh, bh);
#pragma unroll
                for (int j = 0; j < 8; ++j) lo[j] = b[j] - bh[j];
                const u32x4 wl = pack8(lo); const bf16x8 bfh = __builtin_bit_cast(bf16x8, wh), bfl = __builtin_bit_cast(bf16x8, wl);
                acc = __builtin_amdgcn_mfma_f32_32x32x16_bf16(afh[kk], bfh, acc, 0, 0, 0);
                acc = __builtin_amdgcn_mfma_f32_32x32x16_bf16(afh[kk], bfl, acc, 0, 0, 0);
                acc = __builtin_amdgcn_mfma_f32_32x32x16_bf16(afl[kk], bfh, acc, 0, 0, 0); }
            const float tl = (float)t * rL;
#pragma unroll
            for (int r = 0; r < 16; ++r) { const float a = acc[r] * __expf(-tl * dcy[r]); ss[r] += a * a;
                const int col = 32 * cgp + crow(r, hi);
                if (isc) { if (col < 1024) p.hfC[col * 256 + t] = a; else p.hbC[(col - 1024) * 256 + t] = a; }
                else if (col < 1024) tapsT[(size_t)col * 16384 + t] = f2bf(a);
                else { if (t > 0) tapsT[(size_t)(col - 1024) * 16384 + 16384 - t] = f2bf(a); else tapsT[(size_t)(col - 1024) * 16384 + 8192] = 0; } }
        }
#pragma unroll
        for (int r = 0; r < 16; ++r) { float v = ss[r];
#pragma unroll
            for (int o = 16; o >= 1; o >>= 1) v += __shfl_xor(v, o);
            if (r32 == 0) wsum[wid * 32 + crow(r, hi)] = v; }
        __syncthreads();
        if (tid < 32) { float tot = 0.f;
#pragma unroll
            for (int w = 0; w < 8; ++w) tot += wsum[w * 32 + tid];
            if (isc) p.sumsqC[2048 + 32 * cgp + tid] = tot; else p.sumsq[((size_t)(layer * 64 + cgp) * 8 + tch) * 32 + tid] = tot; }
        __syncthreads();
    }
}

__device__ __forceinline__ void phase_norm1(const Params& p, int layer, LDSP lds, int bid, int nb) {
    LASF wg = (LASF)lds;
    const int tid = ltid(), lane = tid & 63, wid = tid >> 6;
    { float4 wv[8];
#pragma unroll
      for (int j = 0; j < 8; ++j) { const int i = tid + NTH * j; wv[j] = *(const float4*)(p.w_in + (size_t)layer * 1024 * 13328 + (size_t)(i >> 2) * 13328 + 4096 + (i & 3) * 4); }
#pragma unroll
      for (int j = 0; j < 8; ++j) { const int i = tid + NTH * j, n = i >> 2, j4 = (i & 3) * 4; wg[n * 20 + j4] = wv[j].x; wg[n * 20 + j4 + 1] = wv[j].y; wg[n * 20 + j4 + 2] = wv[j].z; wg[n * 20 + j4 + 3] = wv[j].w; } }
    __syncthreads();
    const float* gn = p.norm1_g + layer * 1024;
    for (int s = bid * 8 + wid; s < TT; s += nb * 8) {
        const float* xr = resid_row_in(p, layer, s); const float* mv = modvec(p, layer, s);
        float xv[16], gv[16], scv[16], shv[16]; float ssq = 0.f;
#pragma unroll
        for (int i = 0; i < 16; ++i) { const int n = lane + 64 * i; xv[i] = xr[n]; gv[i] = gn[n]; scv[i] = mv[1024 + n]; shv[i] = mv[n]; }
#pragma unroll
        for (int i = 0; i < 16; ++i) ssq += xv[i] * xv[i];
        ssq = wave_sum(ssq); const float rstd = rsqrtf(ssq * (1.0f / 1024.0f) + EPS_);
        float acc[16];
#pragma unroll
        for (int j = 0; j < 16; ++j) acc[j] = 0.f;
#pragma unroll
        for (int i = 0; i < 16; ++i) { const int n = lane + 64 * i; const float hv = xv[i] * rstd * gv[i] * (1.0f + scv[i]) + shv[i];
            p.hn[(size_t)s * 1024 + n] = f2bf(hv);
#pragma unroll
            for (int j4 = 0; j4 < 4; ++j4) { const f32x4 w = *(const PG8_LAS f32x4*)(wg + n * 20 + 4 * j4); acc[4 * j4] += hv * w.x; acc[4 * j4 + 1] += hv * w.y; acc[4 * j4 + 2] += hv * w.z; acc[4 * j4 + 3] += hv * w.w; }
            if (i & 1) __builtin_amdgcn_sched_barrier(0); }
        wave_sum16(acc);
        if ((lane & 15) == 0) { f32x4 g4; g4[0] = acc[0]; g4[1] = acc[1]; g4[2] = acc[2]; g4[3] = acc[3]; *(f32x4*)(p.G + (size_t)s * 16 + (lane >> 4) * 4) = g4; }
    }
    __syncthreads();
}

__device__ __forceinline__ void phase_attn_prep(const Params& p, int layer, bf16_t* aq, bf16_t* ak, int bid, int nb) {
    const int tid = ltid(), lane = tid & 63, wid = tid >> 6;
    const int grp = lane >> 2, i4 = lane & 3;
    const float* qg = p.a_qnorm_g + layer * 64; const float* kg = p.a_knorm_g + layer * 64;
    float gq[16], gk[16];
#pragma unroll
    for (int c = 0; c < 4; ++c)
#pragma unroll
        for (int e = 0; e < 4; ++e) { gq[c * 4 + e] = qg[16 * c + 4 * i4 + e]; gk[c * 4 + e] = kg[16 * c + 4 * i4 + e]; }
    float inv[4];
#pragma unroll
    for (int e = 0; e < 4; ++e) inv[e] = exp2f(-(float)(4 * i4 + e) * (13.287712379549449f / 16.0f));
    const float qscale = 0.125f * 1.4426950408889634f;
    for (int s = bid * 8 + wid; s < TT; s += nb * 8) {
        const int b = s / SEQB, pos = s - b * SEQB; const bool lat = pos >= LC; const int t = pos - LC;
        float cs[8], sn[8];
        if (lat) { const float rowf = (float)(t >> 6), colf = (float)(t & 63);
#pragma unroll
            for (int e = 0; e < 4; ++e) { float ar = rowf * inv[e] * INV2PI, ac = colf * inv[e] * INV2PI; ar -= floorf(ar); ac -= floorf(ac);
                cs[e] = cos2pi(ar); sn[e] = sin2pi(ar); cs[4 + e] = cos2pi(ac); sn[4 + e] = sin2pi(ac); } }
        u32x2 wqk[2][4];
#pragma unroll
        for (int which = 0; which < 2; ++which)
#pragma unroll
            for (int c = 0; c < 4; ++c) wqk[which][c] = *(const u32x2*)((which ? ak : aq) + (size_t)s * 1024 + grp * 64 + 4 * i4 + 16 * c);
#pragma unroll
        for (int which = 0; which < 2; ++which) {
            bf16_t* base = (which ? ak : aq) + (size_t)s * 1024 + grp * 64 + 4 * i4;
            float v[16]; float ssq = 0.f;
#pragma unroll
            for (int c = 0; c < 4; ++c) { const u32x2 w = wqk[which][c]; v[4 * c] = lo16(w.x); v[4 * c + 1] = hi16(w.x); v[4 * c + 2] = lo16(w.y); v[4 * c + 3] = hi16(w.y); }
#pragma unroll
            for (int i = 0; i < 16; ++i) ssq += v[i] * v[i];
            ssq += __shfl_xor(ssq, 1); ssq += __shfl_xor(ssq, 2);
            const float rstd = rsqrtf(ssq * (1.0f / 64.0f) + EPS_) * (which ? 1.0f : qscale);
#pragma unroll
            for (int i = 0; i < 16; ++i) v[i] = v[i] * rstd * (which ? gk[i] : gq[i]);
            if (lat) {
#pragma unroll
                for (int hf = 0; hf < 2; ++hf)
#pragma unroll
                    for (int e = 0; e < 4; ++e) { const float x1 = v[8 * hf + e], x2 = v[8 * hf + 4 + e], cc = cs[4 * hf + e], sv = sn[4 * hf + e];
                        v[8 * hf + e] = x1 * cc - x2 * sv; v[8 * hf + 4 + e] = x2 * cc + x1 * sv; }
            }
#pragma unroll
            for (int c = 0; c < 4; ++c) { u32x2 w; w.x = pk2(v[4 * c], v[4 * c + 1]); w.y = pk2(v[4 * c + 2], v[4 * c + 3]); *(u32x2*)(base + 16 * c) = w; }
        }
    }
}

__device__ __forceinline__ s16x4 vtr16(const PG8_LAS unsigned char* ptr) {
    typedef short v4i16_t __attribute__((ext_vector_type(4)));
    return __builtin_bit_cast(s16x4, __builtin_amdgcn_ds_read_tr16_b64_v4i16((PG8_LAS v4i16_t*)ptr)); }

__device__ __forceinline__ void glds16(const void* gsrc, unsigned lds_dst) { unsigned keep;
    asm volatile("s_mov_b32 %0, m0\n\ts_mov_b32 m0, %2\n\ts_nop 0\n\tglobal_load_lds_dwordx4 %1, off\n\ts_mov_b32 m0, %0" : "=&s"(keep) : "v"(gsrc), "s"(lds_dst) : "memory"); }
__device__ __forceinline__ float max3f_(float a, float b, float c) { float r; asm("v_max3_f32 %0, %1, %2, %3" : "=v"(r) : "v"(a), "v"(b), "v"(c)); return r; }
#define ATT_WAIT_BAR(N) asm volatile("s_waitcnt vmcnt(" #N ") lgkmcnt(0)\n\ts_barrier" ::: "memory")
__device__ __forceinline__ void attn_unit(const Params& p, int layer, const bf16_t* Q, const bf16_t* K, const bf16_t* V, bf16_t* O, int b, int h, int q0pos, int nkeys, float lam, float lam_init, LDSP lds) {
    const int tid = ltid(), lane = tid & 63, r32 = lane & 31, hi = lane >> 5; const int wid = __builtin_amdgcn_readfirstlane(tid >> 6), comp = wid >> 2, qblk = wid & 3;
    const size_t rowb = (size_t)b * SEQB;
    const bf16_t* qrow = Q + (rowb + q0pos + 32 * qblk + r32) * 1024 + h * 128 + comp * 64 + hi * 8;
    bf16x8 qf[4];
#pragma unroll
    for (int d0 = 0; d0 < 4; ++d0) qf[d0] = *(const bf16x8*)(qrow + d0 * 16);
    f32x16 o[4];
#pragma unroll
    for (int d0 = 0; d0 < 4; ++d0)
#pragma unroll
        for (int r = 0; r < 16; ++r) o[d0][r] = 0.f;
    float l = 0.f;
    const f32x16 zero16 = {0.f, 0.f, 0.f, 0.f, 0.f, 0.f, 0.f, 0.f, 0.f, 0.f, 0.f, 0.f, 0.f, 0.f, 0.f, 0.f};
    const int ntiles = nkeys >> 6;
    const unsigned lds0 = (unsigned)(uintptr_t)(unsigned char*)lds;
    const int krow0 = 8 * wid + (lane >> 4), krow1 = krow0 + 4, kpos = lane & 15;
    const unsigned kvo0 = (unsigned)(krow0 * 1024 + ((kpos ^ (krow0 & 15)) * 8)) * 2u, kvo1 = (unsigned)(krow1 * 1024 + ((kpos ^ (krow1 & 15)) * 8)) * 2u - 1024u;
    const unsigned vvo0 = (unsigned)((16 * ((2 * wid) & 3) + (lane >> 2)) * 1024 + ((2 * wid) >> 2) * 32 + (lane & 3) * 8) * 2u;
    const unsigned vvo1 = (unsigned)((16 * ((2 * wid + 1) & 3) + (lane >> 2)) * 1024 + ((2 * wid + 1) >> 2) * 32 + (lane & 3) * 8) * 2u - 1024u;
    const bf16_t* kub = K + rowb * 1024 + h * 128; const bf16_t* vub = V + rowb * 1024 + h * 128;
    const unsigned kd0 = lds0 + (2 * wid) * 1024, vd0 = lds0 + 16384 + (2 * wid) * 1024;
#define ATT_DMA2(sb, va, vb_, m0v) asm volatile("s_mov_b32 m0, %3\n\ts_nop 0\n\tglobal_load_lds_dwordx4 %0, %2\n\tglobal_load_lds_dwordx4 %1, %2 offset:1024" :: "v"(va), "v"(vb_), "s"(sb), "s"(m0v) : "memory", "m0")
#define ATT_DMA(t, slot) do { const size_t to_ = (size_t)(t) * 64 * 1024; const unsigned so_ = (unsigned)(slot) * 32768u; \
        ATT_DMA2(kub + to_, kvo0, kvo1, (unsigned)__builtin_amdgcn_readfirstlane(kd0 + so_)); ATT_DMA2(vub + to_, vvo0, vvo1, (unsigned)__builtin_amdgcn_readfirstlane(vd0 + so_)); } while (0)
    asm volatile("" : "+v"(qf[0]), "+v"(qf[1]), "+v"(qf[2]), "+v"(qf[3]));
    ATT_DMA(0, 0); ATT_DMA(1, 1); ATT_DMA(2, 2);
    ATT_WAIT_BAR(4);
    const PG8_LAS unsigned char* kbase = lds + r32 * 256; const int kx0 = ((comp * 8 + hi) ^ (r32 & 15)) << 4;
    const PG8_LAS unsigned char* vbase = lds + 16384 + ((lane >> 4) & 1) * 32 + (lane & 3) * 8 + (4 * hi + ((lane & 15) >> 2)) * 64;
    bf16x8 vbA[4], vbB[4], kb[4], pfA, pfB; f32x16 S0, S1; float la = 0.f, lb = 0.f;
#define ATT_SB __builtin_amdgcn_sched_barrier(0)
#define ATT_VLD(vb, Vp, ks) do { _Pragma("unroll") for (int d0 = 0; d0 < 4; ++d0) { const s16x4 lo = vtr16((Vp) + d0 * 4096 + (ks) * 1024), hh = vtr16((Vp) + d0 * 4096 + (ks) * 1024 + 512); \
        vb[d0] = (bf16x8){lo[0], lo[1], lo[2], lo[3], hh[0], hh[1], hh[2], hh[3]}; } } while (0)
#define ATT_KLD(Kp, half) do { _Pragma("unroll") for (int d0 = 0; d0 < 4; ++d0) kb[d0] = *(const PG8_LAS bf16x8*)((Kp) + (kx0 ^ (d0 << 5)) + (half) * 8192); } while (0)
#define ATT_STAGE(vbU, pfU, DOQK, QS, DOEXP, ES, off, pfN) do { unsigned w_[4]; \
        _Pragma("unroll") for (int g = 0; g < 4; ++g) { \
            o[g] = __builtin_amdgcn_mfma_f32_32x32x16_bf16(vbU[g], pfU, o[g], 0, 0, 0); \
            if (DOQK) QS = __builtin_amdgcn_mfma_f32_32x32x16_bf16(kb[g], qf[g], g ? QS : zero16, 0, 0, 0); \
            if (DOEXP) { const float ea_ = __builtin_amdgcn_exp2f(ES[(off) + 2 * g]), eb_ = __builtin_amdgcn_exp2f(ES[(off) + 2 * g + 1]); la += ea_; lb += eb_; w_[g] = pk2(ea_, eb_); } \
              \
            asm volatile("" : "+v"(o[g]), "+v"(pfU)); \
            if (DOQK) asm volatile("" : "+v"(QS)); \
            if (DOEXP) asm volatile("" : "+v"(w_[g]), "+v"(ES), "+v"(la), "+v"(lb)); \
            ATT_SB; } \
        if (DOEXP) { u32x4 wv_; wv_.x = w_[0]; wv_.y = w_[1]; wv_.z = w_[2]; wv_.w = w_[3]; pfN = __builtin_bit_cast(bf16x8, wv_); } } while (0)
    { ATT_KLD(kbase, 0);
#pragma unroll
      for (int d0 = 0; d0 < 4; ++d0) S0 = __builtin_amdgcn_mfma_f32_32x32x16_bf16(kb[d0], qf[d0], d0 ? S0 : zero16, 0, 0, 0);
      ATT_KLD(kbase, 1);
#pragma unroll
      for (int d0 = 0; d0 < 4; ++d0) S1 = __builtin_amdgcn_mfma_f32_32x32x16_bf16(kb[d0], qf[d0], d0 ? S1 : zero16, 0, 0, 0);
      ATT_VLD(vbA, vbase, 0);
      u32x4 w_;
#pragma unroll
      for (int g = 0; g < 4; ++g) { const float ea_ = __builtin_amdgcn_exp2f(S0[2 * g]), eb_ = __builtin_amdgcn_exp2f(S0[2 * g + 1]); la += ea_; lb += eb_; w_[g] = pk2(ea_, eb_); }
      pfA = __builtin_bit_cast(bf16x8, w_); ATT_SB; }
#define ATT_TILE(NX) do { const PG8_LAS unsigned char* Vs_ = vbase + (t & 3) * 32768; const PG8_LAS unsigned char* Vn_ = vbase + ((t + 1) & 3) * 32768; const PG8_LAS unsigned char* Kn_ = kbase + ((t + 1) & 3) * 32768; \
        ATT_VLD(vbB, Vs_, 1); if (NX) ATT_KLD(Kn_, 0); \
        { const int td = t + 3 < ntiles ? t + 3 : ntiles - 1; ATT_DMA(td, (t + 3) & 3); } ATT_SB; \
        ATT_STAGE(vbA, pfA, 0, S0, 1, S0, 8, pfB); \
        ATT_VLD(vbA, Vs_, 2); ATT_SB; \
        ATT_STAGE(vbB, pfB, NX, S0, 1, S1, 0, pfA); \
        ATT_VLD(vbB, Vs_, 3); if (NX) ATT_KLD(Kn_, 1); ATT_SB; \
        ATT_STAGE(vbA, pfA, 0, S1, 1, S1, 8, pfB); \
        if (NX) ATT_VLD(vbA, Vn_, 0); ATT_SB; \
        ATT_STAGE(vbB, pfB, NX, S1, NX, S0, 0, pfA); \
        ATT_WAIT_BAR(4); } while (0)
    int t = 0;
    for (; t < ntiles - 1; ++t) ATT_TILE(1);
    ATT_TILE(0);
    ATT_WAIT_BAR(0);
    l = la + lb;
#undef ATT_SB
#undef ATT_VLD
#undef ATT_KLD
#undef ATT_STAGE
#undef ATT_TILE
#undef ATT_DMA
#undef ATT_DMA2
    l += __shfl_xor(l, 32);
    const float rl = 1.0f / l;
    LASF xch = (LASF)(lds) + qblk * 4096;
    if (comp == 1) {
#pragma unroll
        for (int d0 = 0; d0 < 4; ++d0)
#pragma unroll
            for (int r = 0; r < 16; ++r) xch[(32 * d0 + crow(r, hi)) * 32 + r32] = o[d0][r] * rl;
    }
    __syncthreads();
    if (comp == 0) {
        float ssq = 0.f;
#pragma unroll
        for (int d0 = 0; d0 < 4; ++d0)
#pragma unroll
            for (int r = 0; r < 16; ++r) { const float y = o[d0][r] * rl - lam * xch[(32 * d0 + crow(r, hi)) * 32 + r32]; o[d0][r] = y; ssq += y * y; }
        ssq += __shfl_xor(ssq, 32);
        const float sc = rsqrtf(ssq * (1.0f / 128.0f) + EPS_) * (1.0f - lam_init);
        const float* sg = p.a_subln_g + layer * 128;
        bf16_t* orow = O + (rowb + q0pos + 32 * qblk + r32) * 1024 + h * 128;
#pragma unroll
        for (int d0 = 0; d0 < 4; ++d0)
#pragma unroll
            for (int r4 = 0; r4 < 4; ++r4) { const int d = 32 * d0 + 8 * r4 + 4 * hi; u32x2 w;
                w.x = pk2(o[d0][4 * r4] * sc * sg[d], o[d0][4 * r4 + 1] * sc * sg[d + 1]); w.y = pk2(o[d0][4 * r4 + 2] * sc * sg[d + 2], o[d0][4 * r4 + 3] * sc * sg[d + 3]);
                *(u32x2*)(orow + d) = w; }
    }
    __syncthreads();
}
__device__ __forceinline__ void phase_attn(const Params& p, int layer, const bf16_t* Q, const bf16_t* K, const bf16_t* V, bf16_t* O, LDSP lds, int bid, int nb) {
    const float lam_init = 0.8f - 0.6f * expf(-0.3f * (float)layer);
    const float* lp = p.a_lambda + layer * 256; float d1 = 0.f, d2 = 0.f;
    for (int i = 0; i < 64; ++i) { d1 += lp[i] * lp[64 + i]; d2 += lp[128 + i] * lp[192 + i]; }
    const float lam = expf(d1) - expf(d2) + lam_init;
    const int nunits = 1024 + (layer == 0 ? 32 : 0);
    for (int u = bid; u < nunits; u += nb) {
        if (u < 1024) { int bh = u >> 6, qb = u & 63;
            if (nb == 256) { const int x = bid & 7; bh = (x >> 1) + 4 * (u >> 8); qb = (x & 1) * 32 + (bid >> 3); }
            attn_unit(p, layer, Q, K, V, O, bh >> 3, bh & 7, LC + qb * 128, SEQB, lam, lam_init, lds); }
        else { const int v = u - 1024, bh = v >> 1, qb = v & 1; attn_unit(p, layer, Q, K, V, O, bh >> 3, bh & 7, qb * 128, LC, lam, lam_init, lds); }
    }
}

__device__ __forceinline__ int scan_idx(int dir, int c) { return dir == 0 ? c : (c < 2 ? 1 - c : 67 - c); }

__device__ __forceinline__ void load_gates(const Params& p, int layer, size_t row0, int h, LASF tb) {
    const int tid = ltid();
    if (tid < 128) { const float* g = p.G + (row0 + tid) * 16; const float* gb = p.m_gate_b + layer * 16;
        tb[tid] = g[h] + gb[h]; tb[128 + tid] = logsigf_(g[4 + h] + gb[4 + h]); tb[256 + tid] = g[8 + h] + gb[8 + h]; tb[384 + tid] = logsigf_(g[12 + h] + gb[12 + h]); }
}

__device__ __forceinline__ float wave_scan_sum(float v, int lane) {
#pragma unroll
    for (int o = 1; o < 64; o <<= 1) { const float y = __shfl_up(v, o); if (lane >= o) v += y; }
    return v; }
__device__ __forceinline__ float wave_scan_max(float v, int lane) {
#pragma unroll
    for (int o = 1; o < 64; o <<= 1) { const float y = __shfl_up(v, o); if (lane >= o) v = fmaxf(v, y); }
    return v; }

__device__ __forceinline__ void mconv8(const u32x4 rp, const u32x4 rc, const u32x4 rn, const float* cw, const float* cb, int cc, float scale, float (&o)[8]) {
    float up[8], uc[8], un[8]; unpack8(rp, up); unpack8(rc, uc); unpack8(rn, un);
    const f32x4 b0 = *(const f32x4*)(cb + cc), b1 = *(const f32x4*)(cb + cc + 4), w00 = *(const f32x4*)(cw + cc), w01 = *(const f32x4*)(cw + cc + 4);
    const f32x4 w10 = *(const f32x4*)(cw + 2048 + cc), w11 = *(const f32x4*)(cw + 2048 + cc + 4), w20 = *(const f32x4*)(cw + 4096 + cc), w21 = *(const f32x4*)(cw + 4096 + cc + 4);
#pragma unroll
    for (int i = 0; i < 4; ++i) { o[i] = siluf_(b0[i] + up[i] * w00[i] + uc[i] * w10[i] + un[i] * w20[i]) * scale; o[4 + i] = siluf_(b1[i] + up[4 + i] * w01[i] + uc[4 + i] * w11[i] + un[4 + i] * w21[i]) * scale; }
}
__device__ __forceinline__ void phase_mA(const Params& p, int layer, const bf16_t* mk_, const bf16_t* mv_, bf16_t* vT_, bf16_t* ST_, LDSP lds, int bid, int nb) {
    const bf16_t* mk = UP(mk_); const bf16_t* mv = UP(mv_); bf16_t* vT = UP(vT_); bf16_t* ST = UP(ST_);
    constexpr int RS = 576;
    LDSP Kt = lds; LDSP Vt = lds + 128 * RS;
    LASF tb = (LASF)(lds + 256 * RS);
    LASF part = tb + 512;
    const float* gbias = UP((const float*)p.m_gate_b + layer * 16); const float* Gp = UP((const float*)p.G);
    const float* cw = UP((const float*)p.m_conv_w + (size_t)layer * 3 * 2048); const float* cb = UP((const float*)p.m_conv_b + layer * 2048);
    float* scalp = UP((float*)p.scal); float* dnp = UP((float*)p.dn);
    for (int u = bid; u < 8 * 66; u += nb) {
        const int tid = ltid(), lane = tid & 63, r32 = lane & 31, hi = lane >> 5; const int wid = __builtin_amdgcn_readfirstlane(tid >> 6);
        const int c = u % 66, bh = u / 66, b = bh >> 2, h = bh & 3;
        const size_t row0 = (size_t)b * SEQB + 128 * c;
        const int idxf = scan_idx(0, c), idxb = scan_idx(1, c);
        const int tq = tid & 127, dsel = (tid >> 7) & 1;
        float li = 0.f, lf = 0.f;
        if (tid < 256) { const float* g = Gp + (row0 + tq) * 16; li = g[8 * dsel + h] + gbias[8 * dsel + h]; lf = logsigf_(g[8 * dsel + 4 + h] + gbias[8 * dsel + 4 + h]); }
        float inc = wave_scan_sum(lf, lane);
        if (lane == 63 && wid < 4) tb[256 + wid] = inc;
        __syncthreads();
        const float tot = tb[256 + 2 * dsel] + tb[257 + 2 * dsel]; if (wid == 1 || wid == 3) inc += tb[256 + wid - 1];
        const float wsv = (dsel == 0 ? tot - inc : inc - lf) + li;
        const float mxw = wave_max(tid < 256 ? wsv : -1e30f);
        if (lane == 0 && wid < 4) tb[272 + wid] = mxw;
        __syncthreads();
        { const float mloc = fmaxf(tb[272 + 2 * dsel], tb[273 + 2 * dsel]);
          if (tid < 256) tb[128 * dsel + tq] = __expf(wsv - mloc);
          if (tq == 0 && tid < 256) { float* s0 = scalp + ((size_t)(bh * 2 + dsel) * 66 + (dsel ? idxb : idxf)) * 2; s0[0] = tot; s0[1] = mloc; } }
        __syncthreads();
        const int ch8 = (tid & 31) * 8; float dnf[8], dnb[8];
#pragma unroll
        for (int e = 0; e < 8; ++e) { dnf[e] = 0.f; dnb[e] = 0.f; }
#pragma unroll
        for (int jb = 0; jb < 4; ++jb) { u32x4 rk[2][3], rv[2];
#pragma unroll
            for (int jj = 0; jj < 2; ++jj) { const int t = (tid >> 5) + 16 * (2 * jb + jj), pos = 128 * c + t; const bf16_t* src = mk + (row0 + t) * 1024 + h * 256 + ch8;
                const bool hasp = (pos != 0) && (pos != LC), hasn = (pos != LC - 1) && (pos != SEQB - 1);
                rk[jj][1] = *(const u32x4*)src; rk[jj][0] = hasp ? *(const u32x4*)(src - 1024) : (u32x4){0u, 0u, 0u, 0u}; rk[jj][2] = hasn ? *(const u32x4*)(src + 1024) : (u32x4){0u, 0u, 0u, 0u};
                rv[jj] = *(const u32x4*)(mv + (row0 + t) * 1024 + h * 256 + ch8); }
#pragma unroll
            for (int jj = 0; jj < 2; ++jj) { const int t = (tid >> 5) + 16 * (2 * jb + jj); float o[8];
                mconv8(rk[jj][0], rk[jj][1], rk[jj][2], cw, cb, 1024 + h * 256 + ch8, 0.0625f, o);
                const u32x4 kk = pack8(o); unpack8(kk, o);
                const float wf = tb[t], wb = tb[128 + t];
#pragma unroll
                for (int e = 0; e < 8; ++e) { dnf[e] += wf * o[e]; dnb[e] += wb * o[e]; }
                *(PG8_LAS u32x4*)(Kt + t * RS + ch8 * 2) = kk; *(PG8_LAS u32x4*)(Vt + t * RS + ch8 * 2) = rv[jj]; } }
#pragma unroll
        for (int e = 0; e < 8; ++e) { dnf[e] += __shfl_xor(dnf[e], 32); dnb[e] += __shfl_xor(dnb[e], 32); }
        if (hi == 0) {
#pragma unroll
            for (int e = 0; e < 8; ++e) part[wid * 256 + ch8 + e] = dnf[e]; }
        __syncthreads();
        if (tid < 256) { float sm = 0.f;
#pragma unroll
            for (int w = 0; w < 8; ++w) sm += part[w * 256 + tid];
            dnp[((size_t)(bh * 2) * 66 + idxf) * 256 + tid] = sm; }
        __syncthreads();
        if (hi == 0) {
#pragma unroll
            for (int e = 0; e < 8; ++e) part[wid * 256 + ch8 + e] = dnb[e]; }
#pragma unroll
        for (int it = 0; it < 2; ++it) { const int item = tid + NTH * it, dp = item >> 3, tg = item & 7;
            const PG8_LAS unsigned* srcl = (const PG8_LAS unsigned*)(Vt + (16 * tg) * RS + 4 * dp);
            bf16_t* dst = vT + ((size_t)(bh * 256 + 2 * dp)) * SEQB + 128 * c + 16 * tg;
            unsigned w[16];
#pragma unroll
            for (int i = 0; i < 16; ++i) w[i] = srcl[i * (RS / 4)];
            u32x4 lo0, lo1, hi0, hi1;
            lo0.x = __builtin_amdgcn_perm(w[1], w[0], 0x05040100u); lo0.y = __builtin_amdgcn_perm(w[3], w[2], 0x05040100u); lo0.z = __builtin_amdgcn_perm(w[5], w[4], 0x05040100u); lo0.w = __builtin_amdgcn_perm(w[7], w[6], 0x05040100u);
            lo1.x = __builtin_amdgcn_perm(w[9], w[8], 0x05040100u); lo1.y = __builtin_amdgcn_perm(w[11], w[10], 0x05040100u); lo1.z = __builtin_amdgcn_perm(w[13], w[12], 0x05040100u); lo1.w = __builtin_amdgcn_perm(w[15], w[14], 0x05040100u);
            hi0.x = __builtin_amdgcn_perm(w[1], w[0], 0x07060302u); hi0.y = __builtin_amdgcn_perm(w[3], w[2], 0x07060302u); hi0.z = __builtin_amdgcn_perm(w[5], w[4], 0x07060302u); hi0.w = __builtin_amdgcn_perm(w[7], w[6], 0x07060302u);
            hi1.x = __builtin_amdgcn_perm(w[9], w[8], 0x07060302u); hi1.y = __builtin_amdgcn_perm(w[11], w[10], 0x07060302u); hi1.z = __builtin_amdgcn_perm(w[13], w[12], 0x07060302u); hi1.w = __builtin_amdgcn_perm(w[15], w[14], 0x07060302u);
            *(u32x4*)(dst) = lo0; *(u32x4*)(dst + 8) = lo1; *(u32x4*)(dst + SEQB) = hi0; *(u32x4*)(dst + SEQB + 8) = hi1; }
        const int troff = ((lane >> 4) & 1) * 32 + (lane & 3) * 8 + (4 * hi + ((lane & 15) >> 2)) * RS;
        bf16x8 Bf[8];
#pragma unroll
        for (int ks = 0; ks < 8; ++ks) { const s16x4 lo = vtr16(Vt + troff + ks * 16 * RS + wid * 64), hh = vtr16(Vt + troff + (ks * 16 + 8) * RS + wid * 64);
            Bf[ks] = (bf16x8){lo[0], lo[1], lo[2], lo[3], hh[0], hh[1], hh[2], hh[3]}; }
        __syncthreads();
        if (tid < 256) { float sm = 0.f;
#pragma unroll
            for (int w = 0; w < 8; ++w) sm += part[w * 256 + tid];
            dnp[((size_t)(bh * 2 + 1) * 66 + idxb) * 256 + tid] = sm; }
        LDSP stg = Vt + wid * 8704;
#pragma unroll 1
        for (int dir = 0; dir < 2; ++dir) {
            bf16x8 Bs[8];
#pragma unroll
            for (int ks = 0; ks < 8; ++ks) { float f[8]; unpack8(__builtin_bit_cast(u32x4, Bf[ks]), f);
#pragma unroll
                for (int j = 0; j < 8; ++j) f[j] *= tb[128 * dir + 16 * ks + 8 * (j >> 2) + 4 * hi + (j & 3)];
                Bs[ks] = __builtin_bit_cast(bf16x8, pack8(f)); }
            unsigned char* st = (unsigned char*)ST + ((size_t)(bh * 2 + dir) * 66 + (dir ? idxb : idxf)) * 65536 + (size_t)(32 * wid) * 256;
#pragma unroll 1
            for (int kh = 0; kh < 2; ++kh) {
                f32x16 acc[4];
#pragma unroll
                for (int kb = 0; kb < 4; ++kb)
#pragma unroll
                    for (int r = 0; r < 16; ++r) acc[kb][r] = 0.f;
#pragma unroll
                for (int ks = 0; ks < 8; ++ks) {
#pragma unroll
                    for (int kb = 0; kb < 4; ++kb) { const s16x4 lo = vtr16(Kt + troff + ks * 16 * RS + (4 * kh + kb) * 64), hh = vtr16(Kt + troff + (ks * 16 + 8) * RS + (4 * kh + kb) * 64);
                        const bf16x8 aa = (bf16x8){lo[0], lo[1], lo[2], lo[3], hh[0], hh[1], hh[2], hh[3]};
                        acc[kb] = __builtin_amdgcn_mfma_f32_32x32x16_bf16(aa, Bs[ks], acc[kb], 0, 0, 0); }
                    if (ks & 1) __builtin_amdgcn_sched_barrier(0); }
#pragma unroll
                for (int kb = 0; kb < 4; ++kb)
#pragma unroll
                    for (int r4 = 0; r4 < 4; ++r4)
                        *(PG8_LAS unsigned*)(stg + r32 * 144 + (32 * kb + 8 * r4 + 4 * hi)) = pk4_fp8(acc[kb][4 * r4] * ST_SC, acc[kb][4 * r4 + 1] * ST_SC, acc[kb][4 * r4 + 2] * ST_SC, acc[kb][4 * r4 + 3] * ST_SC);
                asm volatile("s_waitcnt lgkmcnt(0)" ::: "memory");
#pragma unroll
                for (int i = 0; i < 4; ++i) { const int row = 8 * i + (lane >> 3), ch = lane & 7;
                    *(u32x4*)(st + (size_t)row * 256 + 128 * kh + 16 * ch) = *(const PG8_LAS u32x4*)(stg + row * 144 + ch * 16); }
            }
        }
        __syncthreads();
    }
}

__device__ __forceinline__ void phase_mB(const Params& p, bf16_t* ST, int bid, int nb) {
    const int tid = ltid();
    { const int ipb = (16 * 256 + nb - 1) / nb, it = bid * ipb + tid;
      if (tid < ipb && it < 16 * 256) {
          const int bhd = it >> 8, kd = it & 255; const float* sc = p.scal + (size_t)bhd * 132; float n = 0.f, m = 0.f;
          if (kd == 0) p.ms[bhd * 67] = 0.f;
          for (int i0 = 0; i0 < 66; i0 += 11) { float dv[11], bqv[11], mlv[11];
#pragma unroll
              for (int j = 0; j < 11; ++j) { dv[j] = p.dn[((size_t)bhd * 66 + i0 + j) * 256 + kd]; bqv[j] = sc[2 * (i0 + j)]; mlv[j] = sc[2 * (i0 + j) + 1]; }
#pragma unroll
              for (int j = 0; j < 11; ++j) { const float mn = fmaxf(bqv[j] + m, mlv[j]), a = __expf(bqv[j] + m - mn), bb = __expf(mlv[j] - mn);
                  n = a * n + bb * dv[j]; p.nst[((size_t)bhd * 66 + i0 + j) * 256 + kd] = n; m = mn; if (kd == 0) p.ms[bhd * 67 + i0 + j + 1] = mn; } } } }
    for (int it = bid * NTH + tid; it < 16 * 8192; it += nb * NTH) {
        const int bhd = it >> 13; unsigned char* st = (unsigned char*)ST + (size_t)bhd * 66 * 65536 + (size_t)(it & 8191) * 8; const float* sc = p.scal + (size_t)bhd * 132;
        float C[8];
#pragma unroll
        for (int e = 0; e < 8; ++e) C[e] = 0.f;
        float m = 0.f;
        for (int i0 = 0; i0 < 66; i0 += 11) {
            u32x2 v[11];
#pragma unroll
            for (int j = 0; j < 11; ++j) v[j] = *(const u32x2*)(st + (size_t)(i0 + j) * 65536);
#pragma unroll
            for (int j = 0; j < 11; ++j) { const float bq = sc[2 * (i0 + j)], ml = sc[2 * (i0 + j) + 1]; const float mn = fmaxf(bq + m, ml), a = __expf(bq + m - mn), bb = __expf(ml - mn);
                float f[8]; unpk8_fp8(v[j], f);
#pragma unroll
                for (int e = 0; e < 8; ++e) C[e] = a * C[e] + bb * f[e];
                u32x2 wo; wo.x = pk4_fp8(C[0], C[1], C[2], C[3]); wo.y = pk4_fp8(C[4], C[5], C[6], C[7]);
                *(u32x2*)(st + (size_t)(i0 + j) * 65536) = wo; m = mn; }
        }
    }
}

__device__ __forceinline__ void phase_mC(const Params& p, int layer, const bf16_t* mq_, const bf16_t* mk_, const bf16_t* vT_, const bf16_t* mo_, const bf16_t* ST_, bf16_t* ym_, LDSP lds, int bid, int nb) {
    const bf16_t* mq = UP(mq_); const bf16_t* mk = UP(mk_); const bf16_t* vT = UP(vT_);
    const float* cw = UP((const float*)p.m_conv_w + (size_t)layer * 3 * 2048); const float* cb = UP((const float*)p.m_conv_b + layer * 2048); const bf16_t* mo = UP(mo_); const bf16_t* ST = UP(ST_); bf16_t* ym = UP(ym_);
    LDSP qs = lds; LDSP ksm = lds + 67584; LDSP Wf = ksm; LDSP Wb = ksm + 34816;
    LASF T = (LASF)(lds + 67584 + 69632);
    LASF red = T + 2048; LASF den2 = red + 1024; LASF qn2 = den2 + 512;
    const int skip = layer == 0 ? 0 : 2;
    const int nun = 8 * (66 - skip);
    const float* gbias = UP((const float*)p.m_gate_b + layer * 16); const float* mng = UP((const float*)p.m_norm_g + layer * 256);
    const float* Gp = UP((const float*)p.G); const float* msp = UP((const float*)p.ms); const float* nstp = UP((const float*)p.nst);
    for (int u = bid; u < nun; u += nb) {
        const int tid = ltid(), lane = tid & 63, r32 = lane & 31, hi = lane >> 5; const int wid = __builtin_amdgcn_readfirstlane(tid >> 6);
        const int c = skip + u % (66 - skip), bh = u / (66 - skip), b = bh >> 2, h = bh & 3;
        const size_t row0 = (size_t)b * SEQB + 128 * c;
        const int idxf = scan_idx(0, c), idxb = scan_idx(1, c);
        const bf16_t* vp = vT + ((size_t)(bh * 256 + 32 * wid + r32)) * SEQB + 128 * c + 8 * hi;
        const int tq = tid & 127, dsel = (tid >> 7) & 1, tok = dsel ? 127 - tq : tq;
        float li = 0.f, lf = 0.f;
        if (tid < 256) { const float* g = Gp + (row0 + tok) * 16; li = g[8 * dsel + h] + gbias[8 * dsel + h]; lf = logsigf_(g[8 * dsel + 4 + h] + gbias[8 * dsel + 4 + h]); }
        const float mpf = msp[(bh * 2 + 0) * 67 + idxf], mpb = msp[(bh * 2 + 1) * 67 + idxb];
        { const int ch8 = (tid & 31) * 8;
#pragma unroll
          for (int jb = 0; jb < 4; ++jb) { u32x4 rq[2][3], rk[2][3];
#pragma unroll
              for (int jj = 0; jj < 2; ++jj) { const int t = (tid >> 5) + 16 * (2 * jb + jj), pos = 128 * c + t; const size_t off = (row0 + t) * 1024 + h * 256 + ch8;
                  const bool hasp = (pos != 0) && (pos != LC), hasn = (pos != LC - 1) && (pos != SEQB - 1); const u32x4 zz = {0u, 0u, 0u, 0u};
                  rq[jj][1] = *(const u32x4*)(mq + off); rq[jj][0] = hasp ? *(const u32x4*)(mq + off - 1024) : zz; rq[jj][2] = hasn ? *(const u32x4*)(mq + off + 1024) : zz;
                  rk[jj][1] = *(const u32x4*)(mk + off); rk[jj][0] = hasp ? *(const u32x4*)(mk + off - 1024) : zz; rk[jj][2] = hasn ? *(const u32x4*)(mk + off + 1024) : zz; }
#pragma unroll
              for (int jj = 0; jj < 2; ++jj) { const int t = (tid >> 5) + 16 * (2 * jb + jj); float o[8];
                  mconv8(rq[jj][0], rq[jj][1], rq[jj][2], cw, cb, h * 256 + ch8, 1.0f, o); *(PG8_LAS u32x4*)(qs + t * 528 + ch8 * 2) = pack8(o);
                  mconv8(rk[jj][0], rk[jj][1], rk[jj][2], cw, cb, 1024 + h * 256 + ch8, 0.0625f, o); *(PG8_LAS u32x4*)(ksm + t * 528 + ch8 * 2) = pack8(o); } } }
        float inc = wave_scan_sum(lf, lane);
        if (lane == 63 && wid < 4) red[wid] = inc;
        __syncthreads();
        if (wid == 1 || wid == 3) inc += red[wid - 1];
        const float av = li - inc;
        float pmx = wave_scan_max(tid < 256 ? av : -1e30f, lane);
        if (lane == 63 && wid < 4) red[8 + wid] = pmx;
        __syncthreads();
        if (wid == 1 || wid == 3) pmx = fmaxf(pmx, red[8 + wid - 1]);
        if (tid < 256) { const float mp = dsel ? mpb : mpf, g = fmaxf(mp, pmx);
            T[512 + 128 * dsel + tok] = av; T[768 + 128 * dsel + tok] = g; T[1024 + 128 * dsel + tok] = __expf(mp - g); T[1280 + 128 * dsel + tok] = __expf(-(inc + g)); }
        { const int t = tid & 127, part = tid >> 7; float sf = 0.f, sb = 0.f;
          if (idxf > 0 || idxb > 0) {
              const float* nf = nstp + ((size_t)(bh * 2 + 0) * 66 + (idxf > 0 ? idxf - 1 : 0)) * 256 + part * 64; const float* nbk = nstp + ((size_t)(bh * 2 + 1) * 66 + (idxb > 0 ? idxb - 1 : 0)) * 256 + part * 64;
              for (int d8 = 0; d8 < 8; ++d8) { float f[8]; unpack8(*(const PG8_LAS u32x4*)(qs + t * 528 + (part * 64 + d8 * 8) * 2), f);
#pragma unroll
                  for (int e = 0; e < 8; ++e) { sf += f[e] * nf[d8 * 8 + e]; sb += f[e] * nbk[d8 * 8 + e]; } } }
          qn2[(part * 2 + 0) * 128 + t] = idxf > 0 ? sf : 0.f; qn2[(part * 2 + 1) * 128 + t] = idxb > 0 ? sb : 0.f; }
        const int tj = wid & 3, sg = wid >> 2;
        f32x16 sacc[2];
#pragma unroll
        for (int e = 0; e < 2; ++e)
#pragma unroll
            for (int r = 0; r < 16; ++r) sacc[e][r] = 0.f;
#pragma unroll 4
        for (int kk = 0; kk < 16; ++kk) { const bf16x8 bq = *(const PG8_LAS bf16x8*)(qs + (32 * tj + r32) * 528 + (16 * kk + 8 * hi) * 2);
#pragma unroll
            for (int e = 0; e < 2; ++e) { const bf16x8 ak = *(const PG8_LAS bf16x8*)(ksm + (32 * (2 * sg + e) + r32) * 528 + (16 * kk + 8 * hi) * 2);
                sacc[e] = __builtin_amdgcn_mfma_f32_32x32x16_bf16(ak, bq, sacc[e], 0, 0, 0); } }
        __syncthreads();
        { const int tz2 = ltid(), r32b = tz2 & 31, hib = (tz2 >> 5) & 1;
          const int t = 32 * tj + r32b; const float gf = T[768 + t], gb = T[896 + t]; float denf = 0.f, denb = 0.f;
          const LASF Taf = T + 512 + 64 * sg + 4 * hib; const LASF Tab = T + 640 + 64 * sg + 4 * hib;
          LDSP wfp = Wf + t * 272 + (64 * sg + 4 * hib) * 2; LDSP wbp = Wb + t * 272 + (64 * sg + 4 * hib) * 2;
#pragma unroll
          for (int e = 0; e < 2; ++e)
#pragma unroll
              for (int r4 = 0; r4 < 4; ++r4) { const int s0 = 32 * (2 * sg + e) + 8 * r4 + 4 * hib; float wf[4], wb[4];
#pragma unroll
                  for (int i = 0; i < 4; ++i) { const int s = s0 + i; const float sv = sacc[e][4 * r4 + i];
                      wf[i] = (s <= t) ? sv * __expf(Taf[32 * e + 8 * r4 + i] - gf) : 0.f; wb[i] = (s >= t) ? sv * __expf(Tab[32 * e + 8 * r4 + i] - gb) : 0.f; denf += wf[i]; denb += wb[i]; }
                  u32x2 w; w.x = pk2(wf[0], wf[1]); w.y = pk2(wf[2], wf[3]); *(PG8_LAS u32x2*)(wfp + (32 * e + 8 * r4) * 2) = w;
                  w.x = pk2(wb[0], wb[1]); w.y = pk2(wb[2], wb[3]); *(PG8_LAS u32x2*)(wbp + (32 * e + 8 * r4) * 2) = w; }
          denf += __shfl_xor(denf, 32); denb += __shfl_xor(denb, 32);
          if (hib == 0) { den2[(sg * 2 + 0) * 128 + t] = denf; den2[(sg * 2 + 1) * 128 + t] = denb; } }
        __syncthreads();
        f32x16 hs[4]; unsigned hp[4][8];
#pragma unroll
        for (int dir = 0; dir < 2; ++dir) {
            const int idx = dir ? idxb : idxf;
            f32x16 acc[4];
#pragma unroll
            for (int j = 0; j < 4; ++j)
#pragma unroll
                for (int r = 0; r < 16; ++r) acc[j][r] = 0.f;
            if (idx > 0) {
                const unsigned char* Cp = (const unsigned char*)ST + ((size_t)(bh * 2 + dir) * 66 + idx - 1) * 65536 + (32 * wid + r32) * 256 + 8 * hi;
#pragma unroll
                for (int hb = 0; hb < 2; ++hb) {
                    bf16x8 Cf[8];
#pragma unroll
                    for (int k8 = 0; k8 < 8; ++k8) { const u32x2 cr = *(const u32x2*)(Cp + 16 * (8 * hb + k8)); float cf[8]; unpk8_fp8(cr, cf); Cf[k8] = __builtin_bit_cast(bf16x8, pack8(cf)); }
#pragma unroll
                    for (int k8 = 0; k8 < 8; ++k8) {
#pragma unroll
                        for (int j = 0; j < 4; ++j) { const bf16x8 bq = *(const PG8_LAS bf16x8*)(qs + (32 * j + r32) * 528 + (16 * (8 * hb + k8) + 8 * hi) * 2);
                            acc[j] = __builtin_amdgcn_mfma_f32_32x32x16_bf16(Cf[k8], bq, acc[j], 0, 0, 0); }
                        if (k8 & 1) __builtin_amdgcn_sched_barrier(0); } }
                const LASF Tw = T + 1024 + 128 * dir + (ltid() & 31);
#pragma unroll
                for (int j = 0; j < 4; ++j) { const float wi = Tw[32 * j] * ST_ISC;
#pragma unroll
                    for (int r = 0; r < 16; ++r) acc[j][r] *= wi; }
            }
            { bf16x8 Vf[8];
#pragma unroll
              for (int ks = 0; ks < 8; ++ks) Vf[ks] = *(const bf16x8*)(vp + 16 * ks);
              const LDSP W = dir ? Wb : Wf;
#pragma unroll
              for (int ks = 0; ks < 8; ++ks) {
#pragma unroll
                  for (int j = 0; j < 4; ++j) { const bf16x8 bw = *(const PG8_LAS bf16x8*)(W + (32 * j + r32) * 272 + (16 * ks + 8 * hi) * 2);
                      acc[j] = __builtin_amdgcn_mfma_f32_32x32x16_bf16(Vf[ks], bw, acc[j], 0, 0, 0); }
                  if (ks & 1) __builtin_amdgcn_sched_barrier(0); } }
            const int r32c = ltid() & 31;
            const LASF qnp = qn2 + dir * 128 + r32c; const LASF dnp = den2 + dir * 128 + r32c; const LASF Tp = T + 1024 + 128 * dir + r32c;
#pragma unroll
            for (int j = 0; j < 4; ++j) {
                const float qn = qnp[32 * j] + qnp[256 + 32 * j] + qnp[512 + 32 * j] + qnp[768 + 32 * j];
                const float den = dnp[32 * j] + dnp[256 + 32 * j] + Tp[32 * j] * qn;
                const float inv = 1.0f / fmaxf(fabsf(den), Tp[256 + 32 * j]);
                if (dir == 0) {
#pragma unroll
                    for (int r = 0; r < 16; r += 2) hp[j][r >> 1] = pk2(acc[j][r] * inv, acc[j][r + 1] * inv); }
                else {
#pragma unroll
                    for (int r = 0; r < 16; r += 2) { hs[j][r] = lo16(hp[j][r >> 1]) + acc[j][r] * inv; hs[j][r + 1] = hi16(hp[j][r >> 1]) + acc[j][r + 1] * inv; } } }
        }
        u32x2 gg[4][4];
        { const int tz = ltid(), r32o = tz & 31, hio = (tz >> 5) & 1, wido = tz >> 6; const size_t obase = (row0 + r32o) * 1024 + h * 256 + 32 * wido + 4 * hio;
#pragma unroll
          for (int j = 0; j < 4; ++j)
#pragma unroll
              for (int r4 = 0; r4 < 4; ++r4) gg[j][r4] = *(const u32x2*)(mo + obase + (size_t)j * 32 * 1024 + 8 * r4); }
#pragma unroll
        for (int j = 0; j < 4; ++j) { float ssq = 0.f;
#pragma unroll
            for (int r = 0; r < 16; ++r) ssq += hs[j][r] * hs[j][r];
            ssq += __shfl_xor(ssq, 32); const int tzr = ltid(); if (((tzr >> 5) & 1) == 0) red[(tzr >> 6) * 128 + 32 * j + (tzr & 31)] = ssq; }
        __syncthreads();
        {
          const int tz = ltid(), r32o = tz & 31, hio = (tz >> 5) & 1, wido = tz >> 6;
          const size_t obase = (row0 + r32o) * 1024 + h * 256 + 32 * wido + 4 * hio;
#pragma unroll
          for (int j = 0; j < 4; ++j) { const int t = 32 * j + r32o; float tot = 0.f;
#pragma unroll
              for (int w = 0; w < 8; ++w) tot += red[w * 128 + t];
              const float rstd = rsqrtf(tot * (1.0f / 256.0f) + EPS_);
#pragma unroll
              for (int r4 = 0; r4 < 4; ++r4) { const int v0 = 32 * wido + 8 * r4 + 4 * hio; const size_t off = obase + (size_t)j * 32 * 1024 + 8 * r4;
                  const u32x2 g = gg[j][r4]; u32x2 w;
                  w.x = pk2(hs[j][4 * r4] * rstd * mng[v0] * sigmoidf_(lo16(g.x)), hs[j][4 * r4 + 1] * rstd * mng[v0 + 1] * sigmoidf_(hi16(g.x)));
                  w.y = pk2(hs[j][4 * r4 + 2] * rstd * mng[v0 + 2] * sigmoidf_(lo16(g.y)), hs[j][4 * r4 + 3] * rstd * mng[v0 + 3] * sigmoidf_(hi16(g.y)));
                  *(u32x2*)(ym + off) = w; } } }
        __syncthreads();
    }
}

__device__ __forceinline__ void hconv8(const bf16_t* src, bool hasp, bool hasn, const float* cw, const float* cb, int cch, float (&o)[8]) {
    float up[8], uc[8], un[8];
    unpack8(*(const u32x4*)src, uc);
    if (hasp) unpack8(*(const u32x4*)(src - 1024), up); else {
#pragma unroll
        for (int i = 0; i < 8; ++i) up[i] = 0.f; }
    if (hasn) unpack8(*(const u32x4*)(src + 1024), un); else {
#pragma unroll
        for (int i = 0; i < 8; ++i) un[i] = 0.f; }
#pragma unroll
    for (int i = 0; i < 8; ++i) o[i] = cb[cch + i] + up[i] * cw[cch + i] + uc[i] * cw[3072 + cch + i] + un[i] * cw[6144 + cch + i];
}
struct H3 { u32x4 p, c, n; };
__device__ __forceinline__ H3 hload3(const bf16_t* src, bool hasp, bool hasn) { H3 r; const u32x4 z4 = {0u, 0u, 0u, 0u};
    r.c = *(const u32x4*)src; r.p = hasp ? *(const u32x4*)(src - 1024) : z4; r.n = hasn ? *(const u32x4*)(src + 1024) : z4; return r; }
__device__ __forceinline__ void hcomp8(const H3& r, const float* cw, const float* cb, int cch, float (&o)[8]) {
    float up[8], uc[8], un[8]; unpack8(r.p, up); unpack8(r.c, uc); unpack8(r.n, un);
#pragma unroll
    for (int i = 0; i < 8; ++i) o[i] = cb[cch + i] + up[i] * cw[cch + i] + uc[i] * cw[3072 + cch + i] + un[i] * cw[6144 + cch + i];
}
__device__ __forceinline__ void phase_hprep(const Params& p, int layer, const bf16_t* hx1, const bf16_t* hv, bf16_t* zT, LDSP lds, int bid, int nb) {
    const int tid = ltid(); LASF zt = (LASF)lds;
    const float* cw = p.h_conv_w + (size_t)layer * 3 * 3072; const float* cb = p.h_conv_b + layer * 3072;
    constexpr int NU = 2 * 128 * 4;
    u32x4 ra[4], rb[4];
#define HP_LOAD(u_) do { const int cg_ = (u_) & 3, tb_ = ((u_) >> 2) & 127, b_ = (u_) >> 9; const int tl_ = tb_ * 64 + (tid >> 3); const size_t row_ = (size_t)b_ * SEQB + LC + tl_; const bool hp_ = tl_ != 0, hn_ = tl_ != LL - 1; \
        _Pragma("unroll") for (int v8 = 0; v8 < 4; ++v8) { const int c_ = cg_ * 256 + v8 * 64 + (tid & 7) * 8; ra[v8] = *(const u32x4*)(hx1 + row_ * 1024 + c_); rb[v8] = *(const u32x4*)(hv + row_ * 1024 + c_); } } while (0)
    int u = bid;
    if (u < NU) HP_LOAD(u);
    for (; u < NU; u += nb) {
        const int cg = u & 3, tb = (u >> 2) & 127, b = u >> 9;
        const int t = tid >> 3, tl = tb * 64 + t; const size_t row = (size_t)b * SEQB + LC + tl; const bool hasp = tl != 0, hasn = tl != LL - 1; const u32x4 z4 = {0u, 0u, 0u, 0u};
#pragma unroll
        for (int v8 = 0; v8 < 4; ++v8) { const int cl = v8 * 64 + (tid & 7) * 8, c = cg * 256 + cl; float x1[8], vv[8];
            H3 ha, hb; ha.c = ra[v8]; hb.c = rb[v8];
            ha.p = hasp ? *(const u32x4*)(hx1 + (row - 1) * 1024 + c) : z4; ha.n = hasn ? *(const u32x4*)(hx1 + (row + 1) * 1024 + c) : z4;
            hb.p = hasp ? *(const u32x4*)(hv + (row - 1) * 1024 + c) : z4; hb.n = hasn ? *(const u32x4*)(hv + (row + 1) * 1024 + c) : z4;
            hcomp8(ha, cw, cb, 1024 + c, x1); hcomp8(hb, cw, cb, 2048 + c, vv);
#pragma unroll
            for (int i = 0; i < 8; ++i) zt[t * 257 + cl + i] = vv[i] * x1[i]; }
        __syncthreads();
        if (u + nb < NU) HP_LOAD(u + nb);
        __builtin_amdgcn_sched_barrier(0);
        { const int cl = tid >> 1, th = tid & 1; bf16_t* dst = zT + ((size_t)(b * 1024 + cg * 256 + cl)) * LL + tb * 64 + 32 * th;
#pragma unroll
          for (int q = 0; q < 4; ++q) { float f[8];
#pragma unroll
              for (int e = 0; e < 8; ++e) f[e] = zt[(32 * th + 8 * q + e) * 257 + cl];
              *(u32x4*)(dst + 8 * q) = pack8(f); } }
        __syncthreads();
    }
#undef HP_LOAD
}

__device__ __forceinline__ f32x2v cmul_(f32x2v a, f32x2v b) { return mk2_(a.x * b.x - a.y * b.y, a.x * b.y + a.y * b.x); }
__device__ __forceinline__ f32x2v cmulc_(f32x2v a, f32x2v b) { return mk2_(a.x * b.x + a.y * b.y, a.y * b.x - a.x * b.y); }
__device__ __forceinline__ f32x2v cadd_(f32x2v a, f32x2v b) { return mk2_(a.x + b.x, a.y + b.y); }
__device__ __forceinline__ f32x2v csub_(f32x2v a, f32x2v b) { return mk2_(a.x - b.x, a.y - b.y); }
__device__ __forceinline__ int fphys(int i) { return i + (i >> 5); }
template <bool INV> __device__ __forceinline__ void bfly16(f32x2v (&v)[16], const f32x2v w1) {
    const f32x2v w2 = cmul_(w1, w1), w4 = cmul_(w2, w2), w8 = cmul_(w4, w4);
    const float C1 = 0.92387953251128674f, S1 = 0.38268343236508977f, R2 = 0.70710678118654752f;
    const f32x2v c16[8] = {mk2_(1.f, 0.f), mk2_(C1, -S1), mk2_(R2, -R2), mk2_(S1, -C1), mk2_(0.f, -1.f), mk2_(-S1, -C1), mk2_(-R2, -R2), mk2_(-C1, -S1)};
    if (!INV) {
#pragma unroll
        for (int m = 0; m < 8; ++m) { const f32x2v W = cmul_(w1, c16[m]); const f32x2v a = v[m], b = v[m + 8]; v[m] = cadd_(a, b); v[m + 8] = cmul_(csub_(a, b), W); }
#pragma unroll
        for (int g = 0; g < 16; g += 8)
#pragma unroll
            for (int m = 0; m < 4; ++m) { const f32x2v W = cmul_(w2, c16[2 * m]); const f32x2v a = v[g + m], b = v[g + m + 4]; v[g + m] = cadd_(a, b); v[g + m + 4] = cmul_(csub_(a, b), W); }
#pragma unroll
        for (int g = 0; g < 16; g += 4)
#pragma unroll
            for (int m = 0; m < 2; ++m) { const f32x2v W = cmul_(w4, c16[4 * m]); const f32x2v a = v[g + m], b = v[g + m + 2]; v[g + m] = cadd_(a, b); v[g + m + 2] = cmul_(csub_(a, b), W); }
#pragma unroll
        for (int g = 0; g < 16; g += 2) { const f32x2v a = v[g], b = v[g + 1]; v[g] = cadd_(a, b); v[g + 1] = cmul_(csub_(a, b), w8); }
    } else {
#pragma unroll
        for (int g = 0; g < 16; g += 2) { const f32x2v a = v[g], b = cmulc_(v[g + 1], w8); v[g] = cadd_(a, b); v[g + 1] = csub_(a, b); }
#pragma unroll
        for (int g = 0; g < 16; g += 4)
#pragma unroll
            for (int m = 0; m < 2; ++m) { const f32x2v W = cmul_(w4, c16[4 * m]); const f32x2v a = v[g + m], b = cmulc_(v[g + m + 2], W); v[g + m] = cadd_(a, b); v[g + m + 2] = csub_(a, b); }
#pragma unroll
        for (int g = 0; g < 16; g += 8)
#pragma unroll
            for (int m = 0; m < 4; ++m) { const f32x2v W = cmul_(w2, c16[2 * m]); const f32x2v a = v[g + m], b = cmulc_(v[g + m + 4], W); v[g + m] = cadd_(a, b); v[g + m + 4] = csub_(a, b); }
#pragma unroll
        for (int m = 0; m < 8; ++m) { const f32x2v W = cmul_(w1, c16[m]); const f32x2v a = v[m], b = cmulc_(v[m + 8], W); v[m] = cadd_(a, b); v[m + 8] = csub_(a, b); }
    }
}
template <bool INV, int S, bool SYNC = true> __device__ __forceinline__ void fft_pass16(PG8_LAS f32x2v* cb) {
    constexpr int STR = S / 16;
    int tz = ltid();
#pragma unroll 2
    for (int k = 0; k < 2; ++k) { const int q = tz + NTH * k; const int j = q & (STR - 1), base = (q / STR) * S + j;
        f32x2v v[16];
#pragma unroll
        for (int m = 0; m < 16; ++m) v[m] = cb[fphys(base + STR * m)];
        const float rev = (float)j * (1.0f / (float)S); const f32x2v w1 = mk2_(cos2pi(rev), -sin2pi(rev));
        bfly16<INV>(v, w1);
#pragma unroll
        for (int m = 0; m < 16; ++m) cb[fphys(base + STR * m)] = v[m]; }
    if (SYNC) __syncthreads();
}
template <int NM> __device__ __forceinline__ void fft_pass_first(PG8_LAS f32x2v* cb, const bf16_t* s0, const bf16_t* s1) {
    const int tz = ltid();
    bf16_t r0[2][NM], r1[2][NM];
#pragma unroll
    for (int k = 0; k < 2; ++k)
#pragma unroll
        for (int m = 0; m < NM; ++m) { r0[k][m] = s0[tz + NTH * k + 1024 * m]; r1[k][m] = s1 ? s1[tz + NTH * k + 1024 * m] : (bf16_t)0; }
#pragma unroll
    for (int k = 0; k < 2; ++k) { const int j = tz + NTH * k;
        f32x2v v[16];
#pragma unroll
        for (int m = 0; m < 16; ++m) v[m] = m < NM ? mk2_(bf2f(r0[k][m]), bf2f(r1[k][m])) : mk2_(0.f, 0.f);
        const float rev = (float)j * (1.0f / 16384.0f); const f32x2v w1 = mk2_(cos2pi(rev), -sin2pi(rev));
        bfly16<false>(v, w1);
#pragma unroll
        for (int m = 0; m < 16; ++m) cb[fphys(j + 1024 * m)] = v[m]; }
    __syncthreads();
}
__device__ __forceinline__ void fft_pass_last(PG8_LAS f32x2v* cb, bf16_t* d0, bf16_t* d1) {
    const int tz = ltid();
#pragma unroll 1
    for (int k = 0; k < 2; ++k) { const int j = tz + NTH * k;
        f32x2v v[16];
#pragma unroll
        for (int m = 0; m < 16; ++m) v[m] = cb[fphys(j + 1024 * m)];
        const float rev = (float)j * (1.0f / 16384.0f); const f32x2v w1 = mk2_(cos2pi(rev), -sin2pi(rev));
        bfly16<true>(v, w1);
#pragma unroll
        for (int m = 0; m < 8; ++m) { d0[j + 1024 * m] = f2bf(v[m].x); d1[j + 1024 * m] = f2bf(v[m].y); } }
    __syncthreads();
}
__device__ __forceinline__ void r4_dif(f32x2v (&a)[4]) {
    const f32x2v b0 = cadd_(a[0], a[2]), b2 = csub_(a[0], a[2]), b1 = cadd_(a[1], a[3]); const f32x2v d = csub_(a[1], a[3]); const f32x2v b3 = mk2_(d.y, -d.x);
    a[0] = cadd_(b0, b1); a[1] = csub_(b0, b1); a[2] = cadd_(b2, b3); a[3] = csub_(b2, b3); }
__device__ __forceinline__ void r4_dit(f32x2v (&c)[4]) {
    const f32x2v b0 = cadd_(c[0], c[1]), b1 = csub_(c[0], c[1]), b2 = cadd_(c[2], c[3]), b3 = csub_(c[2], c[3]); const f32x2v ib3 = mk2_(-b3.y, b3.x);
    c[0] = cadd_(b0, b2); c[2] = csub_(b0, b2); c[1] = cadd_(b1, ib3); c[3] = csub_(b1, ib3); }

__device__ __forceinline__ void phase_fft(const Params& p, int layer, const bf16_t* tapsT, bf16_t* zT, float* Hscr, LDSP lds, int bid, int nb) {
    PG8_LAS f32x2v* cb = (PG8_LAS f32x2v*)lds; const int tid = ltid();
    for (int c = bid; c < 1024; c += nb) {
        fft_pass_first<16>(cb, tapsT + (size_t)c * 16384, nullptr); fft_pass16<false, 1024, false>(cb); fft_pass16<false, 64, false>(cb);
        float ssq_c = 0.f;
#pragma unroll
        for (int q = 0; q < 8; ++q) ssq_c += p.sumsq[((size_t)(layer * 64 + (c >> 5)) * 8 + q) * 32 + (c & 31)];
#pragma unroll
        for (int q = 0; q < 8; ++q) ssq_c += p.sumsq[((size_t)(layer * 64 + 32 + (c >> 5)) * 8 + q) * 32 + (c & 31)];
        const float scale = rsqrtf(ssq_c + EPS_) * (1.0f / 16384.0f);
        f32x2v H[8][4];
        { const int tz = ltid();
#pragma unroll
          for (int k = 0; k < 8; ++k) { const int q = 256 * (tz >> 6) + 2048 * (k >> 2) + 64 * (k & 3) + (tz & 63); f32x2v a[4];
#pragma unroll
              for (int m = 0; m < 4; ++m) a[m] = cb[fphys(4 * q + m)];
              r4_dif(a);
#pragma unroll
              for (int m = 0; m < 4; ++m) H[k][m] = mk2_(a[m].x * scale, a[m].y * scale); } }
        __syncthreads();
        fft_pass_first<8>(cb, zT + (size_t)c * LL, zT + (size_t)(1024 + c) * LL); fft_pass16<false, 1024, false>(cb); fft_pass16<false, 64, false>(cb);
        { const int tz = ltid();
#pragma unroll
          for (int k = 0; k < 8; ++k) { const int q = 256 * (tz >> 6) + 2048 * (k >> 2) + 64 * (k & 3) + (tz & 63); f32x2v a[4];
#pragma unroll
              for (int m = 0; m < 4; ++m) a[m] = cb[fphys(4 * q + m)];
              r4_dif(a);
#pragma unroll
              for (int m = 0; m < 4; ++m) a[m] = cmul_(a[m], H[k][m]);
              r4_dit(a);
#pragma unroll
              for (int m = 0; m < 4; ++m) cb[fphys(4 * q + m)] = a[m]; } }
        fft_pass16<true, 64, false>(cb); fft_pass16<true, 1024>(cb);
        fft_pass_last(cb, zT + (size_t)c * LL, zT + (size_t)(1024 + c) * LL);
    }
}
__device__ __forceinline__ void phase_hfin(const Params& p, int layer, const bf16_t* __restrict__ hx0, const bf16_t* __restrict__ hx1, const bf16_t* __restrict__ hv, const bf16_t* __restrict__ yT, bf16_t* __restrict__ yh, LDSP lds, int bid, int nb) {
    const int tid = ltid(); LASF yt = (LASF)lds;
    const float* cw = p.h_conv_w + (size_t)layer * 3 * 3072; const float* cb = p.h_conv_b + layer * 3072; const float* hb = p.h_bias + layer * 1024;
    for (int u = bid; u < 2 * 128 * 4; u += nb) {
        const int cg = u & 3, tb = (u >> 2) & 127, b = u >> 9;
        u32x4 rc0[4], rc1[4], rc2[4];
        { const size_t ro = ((size_t)b * SEQB + LC + tb * 64 + (tid >> 3)) * 1024 + cg * 256 + (tid & 7) * 8;
#pragma unroll
          for (int v8 = 0; v8 < 4; ++v8) { rc0[v8] = *(const u32x4*)(hx0 + ro + v8 * 64); rc1[v8] = *(const u32x4*)(hx1 + ro + v8 * 64); rc2[v8] = *(const u32x4*)(hv + ro + v8 * 64); } }
        { const int cl = tid >> 1, th = tid & 1; const bf16_t* src = yT + ((size_t)(b * 1024 + cg * 256 + cl)) * LL + tb * 64 + 32 * th;
          u32x4 yv[4];
#pragma unroll
          for (int q = 0; q < 4; ++q) yv[q] = *(const u32x4*)(src + 8 * q);
#pragma unroll
          for (int q = 0; q < 4; ++q) { float f[8]; unpack8(yv[q], f);
#pragma unroll
              for (int e = 0; e < 8; ++e) yt[cl * 65 + 32 * th + 8 * q + e] = f[e]; } }
        __syncthreads();
        const int t = tid >> 3, tl = tb * 64 + t; const size_t row = (size_t)b * SEQB + LC + tl; const bool hasp = tl != 0, hasn = tl != LL - 1;
#pragma unroll
        for (int v8 = 0; v8 < 4; ++v8) { const int cl = v8 * 64 + (tid & 7) * 8, c = cg * 256 + cl; float x0[8], x1[8], vv[8], o[8]; const u32x4 z4 = {0u, 0u, 0u, 0u};
            H3 h0, h1, h2; h0.c = rc0[v8]; h1.c = rc1[v8]; h2.c = rc2[v8];
            h0.p = hasp ? *(const u32x4*)(hx0 + (row - 1) * 1024 + c) : z4; h0.n = hasn ? *(const u32x4*)(hx0 + (row + 1) * 1024 + c) : z4;
            h1.p = hasp ? *(const u32x4*)(hx1 + (row - 1) * 1024 + c) : z4; h1.n = hasn ? *(const u32x4*)(hx1 + (row + 1) * 1024 + c) : z4;
            h2.p = hasp ? *(const u32x4*)(hv + (row - 1) * 1024 + c) : z4; h2.n = hasn ? *(const u32x4*)(hv + (row + 1) * 1024 + c) : z4;
            hcomp8(h0, cw, cb, c, x0); hcomp8(h1, cw, cb, 1024 + c, x1); hcomp8(h2, cw, cb, 2048 + c, vv);
#pragma unroll
            for (int i = 0; i < 8; ++i) o[i] = x0[i] * (yt[(cl + i) * 65 + t] + hb[c + i] * vv[i] * x1[i]);
            *(u32x4*)(yh + row * 1024 + c) = pack8(o); }
        __syncthreads();
    }
}
__device__ __forceinline__ void phase_hctx(const Params& p, int layer, const bf16_t* hx0, const bf16_t* hx1, const bf16_t* hv, bf16_t* yh, LDSP lds, int bid, int nb) {
    const int tid = ltid(); LASF zc = (LASF)lds, x0c = zc + 2048, hf = x0c + 2048, hbk = hf + 2048;
    const float* cw = p.h_conv_w + (size_t)layer * 3 * 3072; const float* cb = p.h_conv_b + layer * 3072; const float* hbias = p.h_bias + layer * 1024;
    for (int u = bid; u < 256; u += nb) {
        const int b = u >> 7, c0 = (u & 127) * 8;
        if (tid < 256) { const int t = tid; const size_t row = (size_t)b * SEQB + t; const bool hasp = t != 0, hasn = t != LC - 1; float x0[8], x1[8], vv[8];
            hconv8(hx0 + row * 1024 + c0, hasp, hasn, cw, cb, c0, x0); hconv8(hx1 + row * 1024 + c0, hasp, hasn, cw, cb, 1024 + c0, x1); hconv8(hv + row * 1024 + c0, hasp, hasn, cw, cb, 2048 + c0, vv);
#pragma unroll
            for (int i = 0; i < 8; ++i) { zc[t * 8 + i] = vv[i] * x1[i]; x0c[t * 8 + i] = x0[i]; } }
        for (int i = tid; i < 256 * 8; i += NTH) { const int j = i & 255, cl = i >> 8; const float rs = rsqrtf(p.sumsqC[2048 + c0 + cl] + p.sumsqC[2048 + 1024 + c0 + cl] + EPS_);
            hf[j * 8 + cl] = p.hfC[(size_t)(c0 + cl) * 256 + j] * rs; hbk[j * 8 + cl] = p.hbC[(size_t)(c0 + cl) * 256 + j] * rs; }
        __syncthreads();
        { const int cl = tid & 7, tg = tid >> 3;
#pragma unroll 1
          for (int ti = 0; ti < 4; ++ti) { const int t = tg + 64 * ti; float y = 0.f;
#pragma unroll 4
              for (int j = 0; j <= t; ++j) y += hf[j * 8 + cl] * zc[(t - j) * 8 + cl];
#pragma unroll 4
              for (int j = 1; j <= 255 - t; ++j) y += hbk[j * 8 + cl] * zc[(t + j) * 8 + cl];
              const float o = x0c[t * 8 + cl] * (y + hbias[c0 + cl] * zc[t * 8 + cl]);
              yh[((size_t)b * SEQB + t) * 1024 + c0 + cl] = f2bf(o); } }
        __syncthreads();
    }
}

__device__ __forceinline__ bool xcd_tile(int i, int c, int G, int T, int& tile) {
    if (G & 7) { tile = i * G + c; return tile < T; }
    const int per = G >> 3, x = c & 7, j = c >> 3, q = i * per + j, base = T >> 3, rem = T & 7;
    const int start = x * base + (x < rem ? x : rem), size = base + (x < rem ? 1 : 0);
    tile = start + q; return q < size; }
struct MergeOrder { int ntile, G, c, lat_only;
    __device__ __forceinline__ bool next(int i, pg8::Unit& u) const { const int tile = (i / 3) * G + c, j = i - (i / 3) * 3; if (tile >= ntile) return false;
        int pi = tile >> 2; const int n = tile & 3; if (lat_only) pi = (pi >> 5) * 33 + 1 + (pi & 31);
        u.pm = j * NPAN + pi; u.pn = j * 4 + n; return true; }
    __device__ __forceinline__ void a_ready(const pg8::Unit&) const {}
    __device__ __forceinline__ void done(const pg8::Unit&) const {} };
struct MergeEpi { static constexpr bool PERM = true, AFTER_DRAIN = false;
    const bf16_t* gates; const float* mb; bf16_t* ysum;
    __device__ __forceinline__ void operator()(const f32x4 (&acc)[2][2][4][2], const pg8::Unit& u, int wr, int wc, int fr, int fq) const {
        const int j = u.pn >> 2, pi = u.pm - j * NPAN, nt = u.pn & 3;
        const int row0 = pi * 256 + wr * 64 + fr, col0 = nt * 256 + wc * 32 + 8 * fq;
        const bf16_t* gj = gates + (size_t)j * TT * 1024;
#pragma unroll
        for (int bj = 0; bj < 2; ++bj) { const int col = col0 + bj * 128; float mbv[8];
#pragma unroll
            for (int i = 0; i < 8; ++i) mbv[i] = mb[j * 1024 + col + i];
#pragma unroll
            for (int ai = 0; ai < 2; ++ai) {
                u32x4 gv[4], ov[4];
#pragma unroll
                for (int m = 0; m < 4; ++m) { const size_t off = (size_t)(row0 + ai * 128 + m * 16) * 1024 + col; gv[m] = *(const u32x4*)(gj + off); if (j > 0) ov[m] = *(const u32x4*)(ysum + off); }
                __builtin_amdgcn_sched_barrier(0);
#pragma unroll
                for (int m = 0; m < 4; ++m) { const size_t off = (size_t)(row0 + ai * 128 + m * 16) * 1024 + col;
                    float g[8], o[8]; unpack8(gv[m], g);
#pragma unroll
                    for (int i = 0; i < 8; ++i) o[i] = sigmoidf_(g[i] + mbv[i]) * acc[ai][bj][m][i >> 2][i & 3];
                    if (j > 0) { float old[8]; unpack8(ov[m], old);
#pragma unroll
                        for (int i = 0; i < 8; ++i) o[i] += old[i]; }
                    *(u32x4*)(ysum + off) = pack8(o); }
                __builtin_amdgcn_sched_barrier(0); } }
    } };
struct OutOrder { int ntile, G, c, lat_only;
    __device__ __forceinline__ bool next(int i, pg8::Unit& u) const { const int tile = i * G + c; if (tile >= ntile) return false;
        int pi = tile >> 2; if (lat_only) pi = (pi >> 5) * 33 + 1 + (pi & 31); u.pm = pi; u.pn = tile & 3; return true; }
    __device__ __forceinline__ void a_ready(const pg8::Unit&) const {}
    __device__ __forceinline__ void done(const pg8::Unit&) const {} };
struct OutEpi { static constexpr bool PERM = false, AFTER_DRAIN = false;
    const Params* p; int layer;
    __device__ __forceinline__ void operator()(const f32x4 (&acc)[2][2][4][2], const pg8::Unit& u, int wr, int wc, int fr, int fq) const {
        const int row0 = u.pm * 256 + wr * 64 + fr, col0 = u.pn * 256 + wc * 32 + 4 * fq;
        const float* g1 = modvec(*p, layer, u.pm * 256) + 2048;
        f32x4 gq[4];
#pragma unroll
        for (int q = 0; q < 4; ++q) gq[q] = *(const f32x4*)(g1 + col0 + (q >> 1) * 128 + (q & 1) * 16);
#pragma unroll
        for (int ai = 0; ai < 2; ++ai) { f32x4 xv[16];
#pragma unroll
            for (int m = 0; m < 4; ++m) { const float* rin = resid_row_in(*p, layer, row0 + ai * 128 + m * 16);
#pragma unroll
                for (int q = 0; q < 4; ++q) xv[m * 4 + q] = *(const f32x4*)(rin + col0 + (q >> 1) * 128 + (q & 1) * 16); }
            __builtin_amdgcn_sched_barrier(0);
#pragma unroll
            for (int m = 0; m < 4; ++m) { float* ro = resid_row(*p, row0 + ai * 128 + m * 16);
#pragma unroll
                for (int q = 0; q < 4; ++q) *(f32x4*)(ro + col0 + (q >> 1) * 128 + (q & 1) * 16) = xv[m * 4 + q] + gq[q] * acc[ai][q >> 1][m][q & 1]; }
            __builtin_amdgcn_sched_barrier(0); }
    } };
struct MoeOrder { const PG8_LAS int* te; int ntl, G, c;
    __device__ __forceinline__ bool next(int i, pg8::Unit& u) const { int L; if (!xcd_tile(i, c, G, ntl * 4, L)) return false; const int tile = L >> 2; u.pm = tile; u.pn = te[tile] * 4 + (L & 3); return true; }
    __device__ __forceinline__ void a_ready(const pg8::Unit&) const {}
    __device__ __forceinline__ void done(const pg8::Unit&) const {} };
struct E1Epi { static constexpr bool PERM = true, AFTER_DRAIN = false;
    bf16_t* H;
    __device__ __forceinline__ void operator()(const f32x4 (&acc)[2][2][4][2], const pg8::Unit& u, int wr, int wc, int fr, int fq) const {
        const int row0 = u.pm * 256 + wr * 64 + fr, hid0 = ((u.pn & 3) * 256 + wc * 32 + 8 * fq) >> 1;
#pragma unroll
        for (int ai = 0; ai < 2; ++ai)
#pragma unroll
            for (int m = 0; m < 4; ++m)
#pragma unroll
                for (int bj = 0; bj < 2; ++bj) { const f32x4 a = acc[ai][bj][m][0], b = acc[ai][bj][m][1]; u32x2 w;
                    w.x = pk2(siluf_(a[0]) * b[0], siluf_(a[1]) * b[1]); w.y = pk2(siluf_(a[2]) * b[2], siluf_(a[3]) * b[3]);
                    *(u32x2*)(H + (size_t)(row0 + ai * 128 + m * 16) * 512 + hid0 + bj * 64) = w; }
    } };

struct EpiReg { static constexpr bool PERM = true, AFTER_DRAIN = false;
    bf16_t* O; size_t stride; bf16_t* O6; int col6;
    __device__ __forceinline__ void operator()(const f32x4 (&acc)[2][2][4][2], const pg8::Unit& u, int wr, int wc, int fr, int fq) const {
        const int row0 = u.pm * 256 + wr * 64 + fr; const int colt = u.pn * 256, reg = colt >> 10;
        bf16_t* base = reg < 6 ? O + (size_t)reg * stride : O6; const int col0 = (reg < 6 ? colt - (reg << 10) : col6 + colt - 6144) + wc * 32 + 8 * fq;
#pragma unroll
        for (int ai = 0; ai < 2; ++ai)
#pragma unroll
            for (int m = 0; m < 4; ++m) { bf16_t* rowp = base + (size_t)(row0 + ai * 128 + m * 16) * 1024 + col0;
#pragma unroll
                for (int bj = 0; bj < 2; ++bj) { const f32x4 v0 = acc[ai][bj][m][0], v1 = acc[ai][bj][m][1]; u32x4 w;
                    w.x = pk2(v0[0], v0[1]); w.y = pk2(v0[2], v0[3]); w.z = pk2(v1[0], v1[1]); w.w = pk2(v1[2], v1[3]);
                    *(u32x4*)(rowp + bj * 128) = w; } }
    } };

__device__ __forceinline__ void phase_norm2_router(const Params& p, int layer, LDSP lds, int bid, int nb, bool count = true) {
    LASF rw = (LASF)lds;
    const int tid = ltid(), lane = tid & 63, wid = tid >> 6;
    for (int i = bid * NTH + tid; i < TPAD; i += nb * NTH) p.rowidx[i] = 0;
    PG8_LAS int* hist = (PG8_LAS int*)(lds + 148 * 1024);
    if (tid < 32) hist[tid] = 0;
    { float4 wv[16];
#pragma unroll
      for (int j = 0; j < 16; ++j) { const int i = tid + NTH * j; wv[j] = *(const float4*)(p.router_w + (i >> 3) * 32 + (i & 7) * 4); }
#pragma unroll
      for (int j = 0; j < 16; ++j) { const int i = tid + NTH * j, n = i >> 3, e4 = (i & 7) * 4; rw[n * 36 + e4] = wv[j].x; rw[n * 36 + e4 + 1] = wv[j].y; rw[n * 36 + e4 + 2] = wv[j].z; rw[n * 36 + e4 + 3] = wv[j].w; } }
    __syncthreads();
    const float* gn = p.norm2_g + layer * 1024;
    float rb[8];
    { const f32x4 r0 = *(const f32x4*)(p.router_b + 8 * (lane >> 4)), r1 = *(const f32x4*)(p.router_b + 8 * (lane >> 4) + 4);
      rb[0] = r0[0]; rb[1] = r0[1]; rb[2] = r0[2]; rb[3] = r0[3]; rb[4] = r1[0]; rb[5] = r1[1]; rb[6] = r1[2]; rb[7] = r1[3]; }
    for (int s = bid * 8 + wid; s < TT; s += nb * 8) {
        const int pos = s % SEQB; if (layer == 1 && pos < LC) continue;
        const float* xr = resid_row(p, s); const float* mv = modvec(p, layer, s);
        float xv[16], gv[16], scv[16], shv[16]; float ssq = 0.f;
#pragma unroll
        for (int i = 0; i < 16; ++i) { const int n = lane + 64 * i; xv[i] = xr[n]; gv[i] = gn[n]; scv[i] = mv[4096 + n]; shv[i] = mv[3072 + n]; }
#pragma unroll
        for (int i = 0; i < 16; ++i) ssq += xv[i] * xv[i];
        ssq = wave_sum(ssq); const float rstd = rsqrtf(ssq * (1.0f / 1024.0f) + EPS_);
        float acc[32];
#pragma unroll
        for (int e = 0; e < 32; ++e) acc[e] = 0.f;
#pragma unroll
        for (int i = 0; i < 16; ++i) { const int n = lane + 64 * i; const float hv = xv[i] * rstd * gv[i] * (1.0f + scv[i]) + shv[i];
            p.hn[(size_t)s * 1024 + n] = f2bf(hv);
#pragma unroll
            for (int e4 = 0; e4 < 8; ++e4) { const f32x4 w = *(const PG8_LAS f32x4*)(rw + n * 36 + 4 * e4); acc[4 * e4] += hv * w.x; acc[4 * e4 + 1] += hv * w.y; acc[4 * e4 + 2] += hv * w.z; acc[4 * e4 + 3] += hv * w.w; }
            __builtin_amdgcn_sched_barrier(0); }
        wave_sum32(acc);
        float v1 = -1e30f, v2 = -1e30f, s1 = 0.f, s2 = 0.f; int i1 = 0, i2 = 0;
#pragma unroll
        for (int q = 0; q < 8; ++q) { const float sve = sigmoidf_(acc[q]), v = sve + rb[q];
            if (v > v1) { v2 = v1; i2 = i1; s2 = s1; v1 = v; i1 = q; s1 = sve; } else if (v > v2) { v2 = v; i2 = q; s2 = sve; } }
        const float gsc = v1 + v2; float best = readlane_f(gsc, 0); int bg = 0;
        { const float g1 = readlane_f(gsc, 16), g2 = readlane_f(gsc, 32), g3 = readlane_f(gsc, 48);
          if (g1 > best) { best = g1; bg = 1; } if (g2 > best) { best = g2; bg = 2; } if (g3 > best) { best = g3; bg = 3; } }
        if (lane == 16 * bg) { const float inv = 1.0f / (s1 + s2); const int be1 = 8 * bg + i1, be2 = 8 * bg + i2;
            p.sel_e[s * 2] = be1; p.sel_e[s * 2 + 1] = be2; p.sel_w[s * 2] = s1 * inv; p.sel_w[s * 2 + 1] = s2 * inv;
            atomicAdd((int*)(hist + be1), 1); atomicAdd((int*)(hist + be2), 1); }
    }
    __syncthreads();
    if (count && tid < 32 && hist[tid] != 0) atomicAdd(p.cnt + layer * 32 + tid, hist[tid]);
    __syncthreads();
}
__device__ __forceinline__ int moe_plan(const Params& p, int layer, PG8_LAS int* pstart, PG8_LAS int* te) {
    if (ltid() == 0) { int tl = 0; for (int e = 0; e < 32; ++e) { const int cn = p.cnt[layer * 32 + e]; pstart[e] = tl * 256; const int nt = (cn + 255) >> 8; for (int q = 0; q < nt; ++q) te[tl + q] = e; tl += nt; } pstart[32] = tl; }
    __syncthreads();
    return pstart[32];
}
__device__ __forceinline__ void phase_moe_assign(const Params& p, int layer, LDSP lds, int bid, int nb) {
    PG8_LAS int* pstart = (PG8_LAS int*)lds; PG8_LAS int* te = pstart + 64; PG8_LAS int* hist = pstart + 512; PG8_LAS int* base = hist + 32;
    const int tid = ltid();
    if (tid < 32) hist[tid] = 0;
    moe_plan(p, layer, pstart, te);
    const int per = (TT + nb - 1) / nb, s = bid * per + tid; const bool act = tid < per && s < TT && !(layer == 1 && (s % SEQB) < LC);
    int e0 = 0, e1 = 0, r0 = 0, r1 = 0;
    if (act) { e0 = p.sel_e[s * 2]; e1 = p.sel_e[s * 2 + 1]; r0 = atomicAdd((int*)(hist + e0), 1); r1 = atomicAdd((int*)(hist + e1), 1); }
    __syncthreads();
    if (tid < 32) base[tid] = hist[tid] ? atomicAdd(p.cur + layer * 32 + tid, hist[tid]) : 0;
    __syncthreads();
    if (act) { const int p0 = pstart[e0] + base[e0] + r0, p1 = pstart[e1] + base[e1] + r1;
        p.posbuf[s * 2] = p0; p.posbuf[s * 2 + 1] = p1; p.rowidx[p0] = s; p.rowidx[p1] = s; }
    __syncthreads();
}
template <bool NEXT_NORM> __device__ __forceinline__ void phase_moe_combine(const Params& p, int layer, const bf16_t* Yb_, LDSP lds, int bid, int nb) {
    const bf16_t* Yb = UP(Yb_);
    LASF wg = (LASF)lds;
    const int tid = ltid(), lane = tid & 63, wid = tid >> 6;
    if (NEXT_NORM) {
        float4 wv[8];
#pragma unroll
        for (int j = 0; j < 8; ++j) { const int i = tid + NTH * j; wv[j] = *(const float4*)(p.w_in + (size_t)(layer + 1) * 1024 * 13328 + (size_t)(i >> 2) * 13328 + 4096 + (i & 3) * 4); }
#pragma unroll
        for (int j = 0; j < 8; ++j) { const int i = tid + NTH * j, n = i >> 2, j4 = (i & 3) * 4; wg[n * 20 + j4] = wv[j].x; wg[n * 20 + j4 + 1] = wv[j].y; wg[n * 20 + j4 + 2] = wv[j].z; wg[n * 20 + j4 + 3] = wv[j].w; }
        __syncthreads();
    }
    const float* gn = p.norm1_g + (layer + 1) * 1024;
    for (int s = bid * 8 + wid; s < TT; s += nb * 8) {
        const int pos = s % SEQB; if (layer == 1 && pos < LC) continue;
        const int p0 = p.posbuf[s * 2], p1 = p.posbuf[s * 2 + 1]; const float w0 = p.sel_w[s * 2], w1 = p.sel_w[s * 2 + 1];
        float* xr = resid_row(p, s); const float* g2 = modvec(p, layer, s) + 5120;
        f32x4 xn[4]; float ssq = 0.f;
#pragma unroll
        for (int i = 0; i < 4; ++i) { const int col = 4 * lane + 256 * i; const u32x2 a = *(const u32x2*)(Yb + (size_t)p0 * 1024 + col), b = *(const u32x2*)(Yb + (size_t)p1 * 1024 + col);
            f32x4 x = *(const f32x4*)(xr + col); const f32x4 g = *(const f32x4*)(g2 + col);
            x[0] += g[0] * (w0 * lo16(a.x) + w1 * lo16(b.x)); x[1] += g[1] * (w0 * hi16(a.x) + w1 * hi16(b.x)); x[2] += g[2] * (w0 * lo16(a.y) + w1 * lo16(b.y)); x[3] += g[3] * (w0 * hi16(a.y) + w1 * hi16(b.y));
            *(f32x4*)(xr + col) = x; xn[i] = x; ssq += x[0] * x[0] + x[1] * x[1] + x[2] * x[2] + x[3] * x[3]; }
        if (NEXT_NORM) {
            const float* mv = modvec(p, layer + 1, s);
            ssq = wave_sum(ssq); const float rstd = rsqrtf(ssq * (1.0f / 1024.0f) + EPS_);
            float acc[16];
#pragma unroll
            for (int j = 0; j < 16; ++j) acc[j] = 0.f;
#pragma unroll
            for (int i = 0; i < 4; ++i) { const int col = 4 * lane + 256 * i; const f32x4 gv = *(const f32x4*)(gn + col), sc = *(const f32x4*)(mv + 1024 + col), sh = *(const f32x4*)(mv + col); float hv[4];
#pragma unroll
                for (int e = 0; e < 4; ++e) hv[e] = xn[i][e] * rstd * gv[e] * (1.0f + sc[e]) + sh[e];
                u32x2 w; w.x = pk2(hv[0], hv[1]); w.y = pk2(hv[2], hv[3]); *(u32x2*)(p.hn + (size_t)s * 1024 + col) = w;
#pragma unroll
                for (int e = 0; e < 4; ++e)
#pragma unroll
                    for (int j4 = 0; j4 < 4; ++j4) { const f32x4 wq = *(const PG8_LAS f32x4*)(wg + (col + e) * 20 + 4 * j4); acc[4 * j4] += hv[e] * wq.x; acc[4 * j4 + 1] += hv[e] * wq.y; acc[4 * j4 + 2] += hv[e] * wq.z; acc[4 * j4 + 3] += hv[e] * wq.w; }
                __builtin_amdgcn_sched_barrier(0); }
            wave_sum16(acc);
            if ((lane & 15) == 0) { f32x4 g4; g4[0] = acc[0]; g4[1] = acc[1]; g4[2] = acc[2]; g4[3] = acc[3]; *(f32x4*)(p.G + (size_t)s * 16 + (lane >> 4) * 4) = g4; }
        }
    }
    if (NEXT_NORM) __syncthreads();
}

constexpr size_t R_BYTES = 12 * UU;
constexpr size_t OFF_WT13 = 0, OFF_WT2 = OFF_WT13 + (size_t)32 * 1024 * 1024 * 2, OFF_XG = OFF_WT2 + (size_t)32 * 1024 * 512 * 2, OFF_H = OFF_XG + (size_t)TPAD * 1024 * 2, OFF_YB = OFF_H + (size_t)TPAD * 512 * 2;
static_assert(OFF_YB + (size_t)TPAD * 1024 * 2 <= R_BYTES, "MoE buffers must fit the big region");

#ifndef REPEAT_MASK
#define REPEAT_MASK 0
#endif
#define REP(bit) for (int rep_ = 0; rep_ < (((REPEAT_MASK) >> (bit)) & 1) + 1; ++rep_)
#define GRID_BAR() do { xcd_barrier(bar); if ((REPEAT_MASK >> 15) & 1) xcd_barrier(bar); asm volatile("" : "+s"(bid), "+s"(nb)); } while (0)

constexpr int PW = (int)(sizeof(Params) / 8);
static_assert(sizeof(Params) % 8 == 0 && sizeof(Params) <= 1024, "Params is a block of 8-byte words");
struct ParamsRaw { unsigned long long w[PW]; };
template <int layer> __device__ __forceinline__ void layer_body(const Params& p, const XcdBarrier& bar, LDSP lds, int& bid, int& nb);
__global__ void __launch_bounds__(512, 2) fwd_kernel(ParamsRaw raw, unsigned long long* gp, unsigned* barw) {
    extern __shared__ __attribute__((aligned(16))) unsigned char shm[];
    LDSP lds = (LDSP)shm;
    int bid = blockIdx.x, nb = gridDim.x; const int tid = threadIdx.x;
    unsigned long long* mygp = gp + (size_t)bid * 128;
    if (tid == 0) {
#pragma unroll
        for (int k = 0; k < PW; ++k) mygp[k] = raw.w[k];
        *(PG8_LAS u32x4*)(lds + LDS_BYTES - 16) = (u32x4){0u, 0u, 0u, 0u};
        asm volatile("s_waitcnt vmcnt(0)" ::: "memory"); }
    __syncthreads();
    const Params& p = *(const Params*)mygp;
    XcdBarrier bar = xcd_barrier_post(barw, (volatile LAS unsigned*)(lds + LDS_BYTES - 16));

#define RB ((unsigned char*)p.R)
#define aq ((bf16_t*)(RB))
#define ak ((bf16_t*)(RB + UU))
#define av ((bf16_t*)(RB + 2 * UU))
#define hx0 ((bf16_t*)(RB + 3 * UU))
#define hx1 ((bf16_t*)(RB + 4 * UU))
#define hv ((bf16_t*)(RB + 5 * UU))
#define zT ((bf16_t*)(RB + 6 * UU))
#define tapsT ((bf16_t*)(RB + 11 * UU))
#define ST ((bf16_t*)(RB))
#define mq ((bf16_t*)(RB + 4 * UU))
#define mk ((bf16_t*)(RB + 5 * UU))
#define mv ((bf16_t*)(RB + 6 * UU))
#define mo ((bf16_t*)(RB + 7 * UU))
#define gates ((bf16_t*)(RB + 8 * UU))
#define qc ((bf16_t*)(RB + 8 * UU))
#define kc ((bf16_t*)(RB + 9 * UU))
#define kT ((bf16_t*)(RB + 10 * UU))
#define vT ((bf16_t*)(RB + 11 * UU))
#define Wt13 ((bf16_t*)(RB + OFF_WT13))
#define Wt2 ((bf16_t*)(RB + OFF_WT2))
#define Xg ((bf16_t*)(RB + OFF_XG))
#define Hb ((bf16_t*)(RB + OFF_H))
#define Yb ((bf16_t*)(RB + OFF_YB))
#define ym ((bf16_t*)p.Y3)
#define ya ((bf16_t*)p.Y3 + (size_t)TT * 1024)
#define yh ((bf16_t*)p.Y3 + (size_t)2 * TT * 1024)

    REP(12) phase_conv_small(p, 0, lds, bid, nb);
    REP(7) { phase_modvec(p, lds, bid, nb);
    phase_hdn(p, lds, bid, nb); }
    GRID_BAR();
    layer_body<0>(p, bar, lds, bid, nb);
#if defined(PROBE_LEVEL) && (PROBE_LEVEL == 1 || PROBE_LEVEL == 2)
    return;
#endif
    layer_body<1>(p, bar, lds, bid, nb);
    if (bid == 0 && tid == 0 && xb_ld(&barw[XB_TMO]) != 0u) p.out[0] = __builtin_nanf("");
}
template <int layer> __device__ __forceinline__ void layer_body(const Params& p, const XcdBarrier& bar, LDSP lds, int& bid, int& nb) {
        if (layer == 0) {
            REP(10) phase_norm1(p, layer, lds, bid, nb);
            REP(13) phase_taps(p, layer, tapsT, lds, bid, nb);
            GRID_BAR(); }
        REP(0) { pg8::Gemm g{UP((const bf16_t*)p.hn), UP((const bf16_t*)p.Wt_in), TT, 6656, 1024}; pg8::StaticOrder S; S.init(TT, 6656, nb, bid);
          EpiReg E{UP(aq), (size_t)TT * 1024, UP(gates + (size_t)2 * TT * 1024), 0};
          pg8::gemm_phase<EpiReg, pg8::StaticOrder, false>(lds, g, S, E, nullptr);
        GRID_BAR(); }
        phase_attn_prep(p, layer, aq, ak, bid, nb);
        phase_hprep(p, layer, hx1, hv, zT, lds, bid, nb);
        if (layer == 0) REP(6) phase_hctx(p, layer, hx0, hx1, hv, yh, lds, bid, nb);
        GRID_BAR();
        phase_fft(p, layer, tapsT, zT, (float*)(RB + 10 * UU), lds, bid, nb);
        REP(1) phase_attn(p, layer, aq, ak, av, ya, lds, bid, nb);
        GRID_BAR();
        if ((REPEAT_MASK >> 3) & 1) { phase_hprep(p, layer, hx1, hv, zT, lds, bid, nb); GRID_BAR(); phase_fft(p, layer, tapsT, zT, (float*)(RB + 10 * UU), lds, bid, nb); GRID_BAR(); }
        REP(11) phase_hfin(p, layer, hx0, hx1, hv, zT, yh, lds, bid, nb);
        GRID_BAR();
        REP(0) { pg8::Gemm g{UP((const bf16_t*)p.hn), UP((const bf16_t*)p.Wt_in + (size_t)6656 * 1024), TT, 6656, 1024}; pg8::StaticOrder S; S.init(TT, 6656, nb, bid);
          EpiReg E{UP(mq), (size_t)TT * 1024, UP(gates + (size_t)2 * TT * 1024), 512};
          pg8::gemm_phase<EpiReg, pg8::StaticOrder, false>(lds, g, S, E, nullptr);
        GRID_BAR(); }
        REP(2) { phase_mA(p, layer, mk, mv, vT, ST, lds, bid, nb);
        GRID_BAR(); }
        phase_mB(p, ST, bid, nb);
        GRID_BAR();
        REP(14) { phase_mC(p, layer, mq, mk, vT, mo, ST, ym, lds, bid, nb);
        GRID_BAR(); }
        REP(4) { pg8::Gemm g{UP((const bf16_t*)p.Y3), UP((const bf16_t*)p.Wt_br + (size_t)layer * 3 * 1048576), 3 * TT, 3072, 1024}; MergeOrder S{layer == 0 ? 264 : 256, nb, bid, layer == 0 ? 0 : 1};
          MergeEpi E{UP((const bf16_t*)gates), UP((const float*)p.merge_b + layer * 3072), UP((bf16_t*)p.hn)};
          pg8::gemm_phase<MergeEpi, MergeOrder, false>(lds, g, S, E, nullptr);
          if (layer == 0 && rep_ == 0) {
              int me = bid, nl = nb; bool runf = true;
              if ((nb & 7) == 0) { const int per = nb >> 3, hx = 33 - per; if (hx > 0 && hx < per) { const int j = bid >> 3; runf = j >= hx; me = (j - hx) * 8 + (bid & 7); nl = nb - 8 * hx; } }
              if (runf) { __syncthreads();
                  phase_conv_experts(p, 0, Wt13, Wt2, lds, me, nl);
                  phase_taps(p, 1, tapsT, lds, me, nl);
                  phase_conv_small(p, 1, lds, me, nl); } }
        GRID_BAR(); }
        { pg8::Gemm g{UP((const bf16_t*)p.hn), UP((const bf16_t*)p.Wt_out + (size_t)layer * 1048576), TT, 1024, 1024}; OutOrder S{layer == 0 ? 264 : 256, nb, bid, layer == 0 ? 0 : 1};
          OutEpi E{&p, layer};
          pg8::gemm_phase<OutEpi, OutOrder, false>(lds, g, S, E, nullptr); }
        __syncthreads();
#if defined(PROBE_LEVEL) && PROBE_LEVEL == 1
        if (layer == 0) return;
#endif
#if defined(PROBE_LEVEL) && PROBE_LEVEL == 3
        if (layer == 1) return;
#endif
        if (layer == 1) REP(9) phase_conv_experts(p, layer, Wt13, Wt2, lds, bid, nb);
        GRID_BAR();
        REP(5) phase_norm2_router(p, layer, lds, bid, nb, rep_ == 0);
        GRID_BAR();
        phase_moe_assign(p, layer, lds, bid, nb);
        GRID_BAR();
        { PG8_LAS int* pstart = (PG8_LAS int*)(lds + 132 * 1024); PG8_LAS int* te = pstart + 64;
          const int ntl = moe_plan(p, layer, pstart, te);
          REP(16) { pg8::Gemm g{UP((const bf16_t*)p.hn), UP((const bf16_t*)Wt13), TT, 32 * 1024, 1024}; MoeOrder S{te, ntl, nb, bid}; E1Epi E{UP(Hb)};
            PG8_LAS int* rtab = (PG8_LAS int*)(lds + 133 * 1024);
            { pg8::Unit uu; const int tz = ltid();
#pragma unroll
              for (int i = 0; i < 4; ++i) { if (S.next(i, uu) && tz < 256) rtab[i * 256 + tz] = p.rowidx[uu.pm * 256 + tz]; } }
            __syncthreads();
            pg8::gemm_phase_g<E1Epi, MoeOrder, false>(lds, g, S, E, rtab);
          GRID_BAR(); }
          REP(17) { pg8::Gemm g{UP((const bf16_t*)Hb), UP((const bf16_t*)Wt2), TPAD, 32 * 1024, 512}; MoeOrder S{te, ntl, nb, bid}; pg8::EpiBf16<0> E{UP(Yb), 1024, nullptr, 1024, (size_t)0};
            pg8::gemm_phase<pg8::EpiBf16<0>, MoeOrder, false>(lds, g, S, E, nullptr);
          GRID_BAR(); } }
        if (layer == 0) phase_moe_combine<true>(p, layer, Yb, lds, bid, nb);
        else phase_moe_combine<false>(p, layer, Yb, lds, bid, nb);
        GRID_BAR();
}

extern "C" void kernel_launch(void* const* d_in, const int* in_sizes, int n_in, void* d_out, int out_size, void* d_ws, size_t ws_size, hipStream_t stream) {
    (void)in_sizes; (void)n_in; (void)out_size;
    Params p; memset(&p, 0, sizeof(p));
    const float* const* in = (const float* const*)d_in;
    p.x = in[0]; p.c = in[1]; p.ctx = in[2]; p.c_ctx = in[3]; p.mod_w = in[4]; p.mod_b = in[5]; p.norm1_g = in[6]; p.norm2_g = in[7]; p.w_in = in[8]; p.merge_b = in[9];
    p.m_conv_w = in[10]; p.m_conv_b = in[11]; p.m_gate_b = in[12]; p.m_norm_g = in[13]; p.a_qnorm_g = in[14]; p.a_knorm_g = in[15]; p.a_lambda = in[16]; p.a_subln_g = in[17];
    p.h_conv_w = in[18]; p.h_conv_b = in[19]; p.h_ffn_w1 = in[20]; p.h_ffn_b1 = in[21]; p.h_ffn_w2 = in[22]; p.h_ffn_b2 = in[23]; p.h_ffn_w3 = in[24]; p.h_freq = in[25]; p.h_decay = in[26]; p.h_bias = in[27];
    p.w_br_m = in[28]; p.w_br_a = in[29]; p.w_br_h = in[30]; p.w_out = in[31]; p.router_w = in[32]; p.router_b = in[33]; p.e_w1 = in[34]; p.e_w3 = in[35]; p.e_w2 = in[36];
    p.out = (float*)d_out;
    unsigned char* w = (unsigned char*)d_ws; size_t off = 0;
    auto take = [&](size_t bytes) { unsigned char* r = w + off; off += (bytes + 255) & ~(size_t)255; return r; };
    constexpr size_t ZERO_BYTES = 32768;
    unsigned char* z = take(ZERO_BYTES);
    p.bar = (unsigned*)z; p.cnt = (int*)(z + 16384); p.cur = (int*)(z + 16384 + 256); p.sumsq = (float*)take((size_t)2 * 64 * 8 * 32 * 4); p.sumsqC = (float*)take((size_t)4096 * 4);
    p.modv = (float*)take((size_t)6 * 6144 * 4); p.hdn2 = (float*)take((size_t)2 * 8448 * 64 * 4); p.G = (float*)take((size_t)TT * 16 * 4); p.xc = (float*)take((size_t)512 * 1024 * 4);
    p.sel_e = (int*)take((size_t)TT * 2 * 4); p.sel_w = (float*)take((size_t)TT * 2 * 4); p.posbuf = (int*)take((size_t)TT * 2 * 4); p.rowidx = (int*)take((size_t)TPAD * 4);
    p.scal = (float*)take((size_t)16 * 66 * 2 * 4); p.ms = (float*)take((size_t)16 * 67 * 4); p.dn = (float*)take((size_t)16 * 66 * 256 * 4); p.nst = (float*)take((size_t)16 * 66 * 256 * 4);
    p.hfC = (float*)take((size_t)1024 * 256 * 4); p.hbC = (float*)take((size_t)1024 * 256 * 4);
    p.Wt_in = (bf16_t*)take((size_t)13312 * 1024 * 2); p.Wt_br = (bf16_t*)take((size_t)2 * 3072 * 1024 * 2); p.Wt_out = (bf16_t*)take((size_t)2 * 1024 * 1024 * 2);
    unsigned long long* gpbuf = (unsigned long long*)take((size_t)1024 * 1024);
    p.hn = (bf16_t*)take(UU); p.Y3 = (bf16_t*)take(3 * UU); p.R = take(R_BYTES);
    if (off > ws_size) { fprintf(stderr, "kernel_launch: workspace too small: need %zu, have %zu\n", off, ws_size); return; }
    static int grid = 0;
    if (!grid) {
        int dev = 0, cus = 0; (void)hipGetDevice(&dev); (void)hipDeviceGetAttribute(&cus, hipDeviceAttributeMultiprocessorCount, dev);
        if (hipFuncSetAttribute((const void*)fwd_kernel, hipFuncAttributeMaxDynamicSharedMemorySize, LDS_BYTES) != hipSuccess) { fprintf(stderr, "kernel_launch: hipFuncSetAttribute failed\n"); return; }
        int per_cu = 0; (void)hipOccupancyMaxActiveBlocksPerMultiprocessor(&per_cu, (const void*)fwd_kernel, NTH, LDS_BYTES);
        if (per_cu < 1) fprintf(stderr, "kernel_launch: occupancy query reports %d blocks per CU\n", per_cu);
        grid = cus > 0 ? (cus > 1024 ? 1024 : cus) : 256;
    }
    (void)hipMemsetAsync(z, 0, ZERO_BYTES, stream);
    ParamsRaw raw; memcpy(&raw, &p, sizeof(raw));
    hipLaunchKernelGGL(fwd_kernel, dim3(grid), dim3(NTH), LDS_BYTES, stream, raw, gpbuf, (unsigned*)z);
}
```

```cpp
#include <hip/hip_runtime.h>
#include <cstdio>
#include <cstdint>
#include <cstring>
#define REPEAT_MASK 0
#define XB_TMO      128
#define XB_XCNT(j)  (256  + 64 * (j))
#define XB_XSUB(j)  (1280 + 64 * (j))
#define XB_XGEN(j)  (2304 + 64 * (j))
#define XB_TOP      3328
#define XB_TOPGEN   3392
#define XCD_BAR_WORDS 3456
#define XB_SPIN_CAP (1u << 24)
#define LAS __attribute__((address_space(3)))

__device__ __forceinline__ unsigned xb_ld(unsigned* p)              { return __hip_atomic_load(p, __ATOMIC_RELAXED, __HIP_MEMORY_SCOPE_AGENT); }
__device__ __forceinline__ unsigned xb_add(unsigned* p, unsigned v) { return __hip_atomic_fetch_add(p, v, __ATOMIC_RELAXED, __HIP_MEMORY_SCOPE_AGENT); }
__device__ __forceinline__ unsigned xb_xcc_id() { return (unsigned)__builtin_amdgcn_s_getreg((3 << 11) | 20) & 0xFu; }
#define XB_SPIN(cond, bar) do { unsigned _sp = 0; while (cond) { __builtin_amdgcn_s_sleep(1); \
    if ((++_sp & 255u) == 0u) { if (xb_ld(&(bar)[XB_TMO])) break; if (_sp > XB_SPIN_CAP) { atomicAdd(&(bar)[XB_TMO], 1u); break; } } } } while (0)

struct XcdBarrier {
    unsigned* bar; unsigned x;
    volatile LAS unsigned* st;
};

__device__ __forceinline__ XcdBarrier xcd_barrier_post(unsigned* bar, volatile LAS unsigned* st) {
    XcdBarrier b; b.bar = bar; b.x = xb_xcc_id(); b.st = st;
    if (threadIdx.x == 0) (void)xb_add(&bar[XB_XCNT(b.x)], 1u);
    return b;
}
__device__ __forceinline__ void xcd_barrier_complete(unsigned* bar, unsigned x, unsigned& nloc, unsigned& nx) {
    const unsigned G = gridDim.x * gridDim.y * gridDim.z;
    unsigned sum, cnt, mine, sp = 0u;
    for (;;) {
        sum = 0u; cnt = 0u; mine = 0u;
#pragma unroll
        for (unsigned j = 0; j < 16; ++j) { const unsigned c = xb_ld(&bar[XB_XCNT(j)]); sum += c; cnt += (c > 0u) ? 1u : 0u; mine = (j == x) ? c : mine; }
        if (sum == G) break;
        __builtin_amdgcn_s_sleep(1);
        if ((++sp & 255u) == 0u) { if (xb_ld(&bar[XB_TMO])) break; if (sp > XB_SPIN_CAP) { atomicAdd(&bar[XB_TMO], 1u); break; } }
    }
    nloc = mine > 0u ? mine : 1u; nx = cnt > 0u ? cnt : 1u;
}

__device__ __forceinline__ void xcd_barrier(const XcdBarrier& b) {
    asm volatile("s_waitcnt vmcnt(0)" ::: "memory");
    __syncthreads();
    if (threadIdx.x == 0) {
        unsigned* bar = b.bar;
        __builtin_amdgcn_s_waitcnt(0);
        unsigned nloc = b.st[0], nx = b.st[1];
        if (nloc == 0u) { xcd_barrier_complete(bar, b.x, nloc, nx); b.st[0] = nloc; b.st[1] = nx; }
        const unsigned old = xb_add(&bar[XB_XSUB(b.x)], 1u);
        const unsigned gen = old / nloc;
        if (old + 1u == (gen + 1u) * nloc) {
            __builtin_amdgcn_fence(__ATOMIC_RELEASE, "agent");
            asm volatile("s_waitcnt vmcnt(0)" ::: "memory");
            const unsigned og = xb_add(&bar[XB_TOP], 1u);
            const unsigned tg = og / nx;
            if (og + 1u == (tg + 1u) * nx) xb_add(&bar[XB_TOPGEN], 1u);
            else XB_SPIN(xb_ld(&bar[XB_TOPGEN]) == tg, bar);
            __builtin_amdgcn_fence(__ATOMIC_ACQUIRE, "agent");
            xb_add(&bar[XB_XGEN(b.x)], 1u);
            asm volatile("s_waitcnt vmcnt(0)" ::: "memory");
        } else {
            XB_SPIN(xb_ld(&bar[XB_XGEN(b.x)]) == gen, bar);
            __builtin_amdgcn_fence(__ATOMIC_ACQUIRE, "agent");
            asm volatile("s_waitcnt vmcnt(0)" ::: "memory");
        }
    }
    __syncthreads();
}
namespace pg8 {
#define PG8_LAS __attribute__((address_space(3)))
typedef unsigned short bf16_t;
typedef short bf16x8 __attribute__((ext_vector_type(8)));
typedef float f32x4 __attribute__((ext_vector_type(4)));
typedef unsigned u32x4 __attribute__((ext_vector_type(4)));
constexpr int BM = 256, BK = 64, HALF = 128, HTB = HALF * BK * 2  , STAGE_BYTES = 8 * HTB, NXCD = 8, WGM = 8;

__host__ __device__ __forceinline__ int lds_byte(int r, int c) { const int st = (r >> 4) * 2 + (c >> 5), rr = r & 15, cc = c & 31, ob = rr * 64 + cc * 2; return st * 1024 + (ob ^ (((ob >> 9) & 1) << 5)); }
__host__ __device__ __forceinline__ void stage_rc(int b, int& R, int& C) { const int st = b / 1024, sb = b % 1024, swz = sb ^ (((sb >> 9) & 1) << 5); R = (st >> 1) * 16 + swz / 64; C = (st & 1) * 32 + (swz % 64) / 2; }
__host__ __device__ __forceinline__ int perm32(int rho) { const int n = rho >> 4, i = rho & 15; return 8 * (i >> 2) + 4 * n + (i & 3); }

struct Unit { int pm, pn; };
struct Gemm { const bf16_t* A; const bf16_t* Bt; int M, N, K; };

struct StaticOrder {
    int nM, nN, nwg, G, c;
    __host__ __device__ void init(int M, int N, int G_, int c_) { nM = M / BM; nN = N / BM; nwg = nM * nN; G = G_; c = c_; }
    __host__ __device__ bool next(int i, Unit& u) const {
        const long L = (long)i * G + c; if (L >= nwg) return false;
        int wgid = (int)L; { const int q = nwg / NXCD, r = nwg % NXCD, xcd = wgid % NXCD, off = wgid / NXCD; wgid = (xcd < r ? xcd * (q + 1) : r * (q + 1) + (xcd - r) * q) + off; }
        const int nig = WGM * nN, gid = wgid / nig, fm = gid * WGM, gsz = (nM - fm) < WGM ? (nM - fm) : WGM;
        u.pm = fm + ((wgid % nig) % gsz); u.pn = (wgid % nig) / gsz; return true;
    }
    __device__ __forceinline__ void a_ready(const Unit&) const {}
    __device__ __forceinline__ void done(const Unit&) const {}
};
struct CountedOrder : StaticOrder {
    const unsigned* ready; unsigned need; unsigned* tmo;
    __device__ __forceinline__ void a_ready(const Unit& u) const {
        if (threadIdx.x < 64) {
            const unsigned long long t0 = __builtin_amdgcn_s_memrealtime(); unsigned polls = 0;
            while ((unsigned)__builtin_amdgcn_readfirstlane(__hip_atomic_load(ready + 64 * u.pm, __ATOMIC_RELAXED, __HIP_MEMORY_SCOPE_AGENT)) < need) {
                if ((++polls & 255u) == 0u && __builtin_amdgcn_readfirstlane(__hip_atomic_load(tmo, __ATOMIC_RELAXED, __HIP_MEMORY_SCOPE_AGENT)) != 0u) break;
                if (__builtin_amdgcn_s_memrealtime() - t0 > 2000000ull) {
                    if (threadIdx.x == 0) { unsigned expect = 0u; __hip_atomic_compare_exchange_strong(tmo + 1, &expect, 0x600u | (unsigned)(u.pm & 0xff), __ATOMIC_RELAXED, __ATOMIC_RELAXED, __HIP_MEMORY_SCOPE_AGENT); __hip_atomic_store(tmo, 1u, __ATOMIC_RELAXED, __HIP_MEMORY_SCOPE_AGENT); }
                    break; }
                __builtin_amdgcn_s_sleep(2); }
            __builtin_amdgcn_fence(__ATOMIC_ACQUIRE, "agent");
            asm volatile("s_waitcnt vmcnt(0)" ::: "memory");
        }
#if !defined(BROKEN_HOOK_NO_BARRIER)
        asm volatile("" ::: "memory"); __builtin_amdgcn_s_barrier(); asm volatile("" ::: "memory");
#endif
    }
};

__device__ __forceinline__ unsigned cvt_pk_bf16(float lo, float hi) { unsigned r; asm volatile("v_cvt_pk_bf16_f32 %0, %1, %2" : "=v"(r) : "v"(lo), "v"(hi)); return r; }
typedef float f32x2 __attribute__((ext_vector_type(2)));
__device__ __forceinline__ f32x2 gelu_pk(f32x2 v) {
    const f32x2 av = __builtin_elementwise_abs(v), d = av * 0.2316418882f + 1.0f;
    f32x2 t; t.x = __builtin_amdgcn_rcpf(d.x); t.y = __builtin_amdgcn_rcpf(d.y);
    f32x2 q = t * 0.5307027145f + (-0.7265760135f); q = q * t + 0.7107068705f; q = q * t + (-0.142248368f); q = q * t + 0.127414796f; q = q * t;
    const f32x2 s = (v * v) * (-0.72134752044f);
    f32x2 e; e.x = __builtin_amdgcn_exp2f(s.x); e.y = __builtin_amdgcn_exp2f(s.y);
    const f32x2 m = v * (q * e), r = v - m;
    f32x2 o; o.x = v.x < 0.f ? m.x : r.x; o.y = v.y < 0.f ? m.y : r.y; return o;
}

struct EpiF32 {
    static constexpr bool PERM = false, AFTER_DRAIN = false;
    float* C; int ldc; const float* bias;
    __device__ __forceinline__ void operator()(const f32x4 (&acc)[2][2][4][2], const Unit& u, int wr, int wc, int fr, int fq) const {
        const int row0 = u.pm * BM + wr * 64 + fr, col0 = u.pn * BM + wc * 32 + 4 * fq;
        f32x4 bv[2][2];
#pragma unroll
        for (int bj = 0; bj < 2; ++bj)
#pragma unroll
            for (int n = 0; n < 2; ++n) bv[bj][n] = bias ? *(const f32x4*)(bias + col0 + bj * HALF + n * 16) : (f32x4){0.f, 0.f, 0.f, 0.f};
#pragma unroll
        for (int ai = 0; ai < 2; ++ai)
#pragma unroll
            for (int m = 0; m < 4; ++m) { float* rowp = C + (size_t)(row0 + ai * HALF + m * 16) * ldc + col0;
#pragma unroll
                for (int bj = 0; bj < 2; ++bj)
#pragma unroll
                    for (int n = 0; n < 2; ++n) *(f32x4*)(rowp + bj * HALF + n * 16) = acc[ai][bj][m][n] + bv[bj][n]; }
    }
};
template <int ACT  > struct EpiBf16 {
    static constexpr bool PERM = true, AFTER_DRAIN = false;
    bf16_t* O; int ldc; const float* bias; int split_cols; size_t split_stride;
    __device__ __forceinline__ void operator()(const f32x4 (&acc)[2][2][4][2], const Unit& u, int wr, int wc, int fr, int fq) const {
        const int row0 = u.pm * BM + wr * 64 + fr; int colt = u.pn * BM; bf16_t* base = O;
        if (split_cols) { const int t = colt / split_cols; base += (size_t)t * split_stride; colt -= t * split_cols; }
        const int col0 = colt + wc * 32 + 8 * fq, bcol0 = u.pn * BM + wc * 32 + 8 * fq;
        f32x4 bv[2][2];
#pragma unroll
        for (int bj = 0; bj < 2; ++bj)
#pragma unroll
            for (int n = 0; n < 2; ++n) bv[bj][n] = bias ? *(const f32x4*)(bias + bcol0 + bj * HALF + 4 * n) : (f32x4){0.f, 0.f, 0.f, 0.f};
#pragma unroll
        for (int ai = 0; ai < 2; ++ai)
#pragma unroll
            for (int m = 0; m < 4; ++m) { bf16_t* rowp = base + (size_t)(row0 + ai * HALF + m * 16) * ldc + col0;
#pragma unroll
                for (int bj = 0; bj < 2; ++bj) { f32x4 v0 = acc[ai][bj][m][0] + bv[bj][0], v1 = acc[ai][bj][m][1] + bv[bj][1];
                    if (ACT == 1) { f32x2 a = gelu_pk((f32x2){v0[0], v0[1]}), b = gelu_pk((f32x2){v0[2], v0[3]}), c = gelu_pk((f32x2){v1[0], v1[1]}), d = gelu_pk((f32x2){v1[2], v1[3]});
                        v0 = (f32x4){a.x, a.y, b.x, b.y}; v1 = (f32x4){c.x, c.y, d.x, d.y}; }
                    if (ACT == 2) {
#pragma unroll
                        for (int j = 0; j < 4; ++j) { v0[j] = 0.5f * v0[j] * (1.0f + erff(v0[j] * 0.70710678f)); v1[j] = 0.5f * v1[j] * (1.0f + erff(v1[j] * 0.70710678f)); } }
                    u32x4 w; w.x = cvt_pk_bf16(v0[0], v0[1]); w.y = cvt_pk_bf16(v0[2], v0[3]); w.z = cvt_pk_bf16(v1[0], v1[1]); w.w = cvt_pk_bf16(v1[2], v1[3]);
                    *(u32x4*)(rowp + bj * HALF) = w; } }
    }
};

struct PanelStats {
    unsigned* xbuf;
    unsigned* cnt;
    unsigned* tmo;
    int ntn; float eps;
    unsigned code;
    __device__ __forceinline__ bool run(const f32x4 (&v)[2][2][4][2], const Unit& u, int wr, int wc, int fr, int fq, PG8_LAS unsigned char* lds, int wid, int lane) const {
        typedef float f32x2v __attribute__((ext_vector_type(2)));
        PG8_LAS f32x2v* P = (PG8_LAS f32x2v*)lds;
        PG8_LAS f32x2v* S = (PG8_LAS f32x2v*)(lds + 8192);
        PG8_LAS unsigned* flag = (PG8_LAS unsigned*)(lds + 8192 + 2048);
#pragma unroll
        for (int ai = 0; ai < 2; ++ai)
#pragma unroll
            for (int m = 0; m < 4; ++m) {
                float s = 0.f;
#pragma unroll
                for (int bj = 0; bj < 2; ++bj)
#pragma unroll
                    for (int n = 0; n < 2; ++n) { const f32x4 x = v[ai][bj][m][n]; s += (x[0] + x[1]) + (x[2] + x[3]); }
                s += __shfl_xor(s, 16); s += __shfl_xor(s, 32);
                const float mw = s * (1.0f / 64.0f); float q = 0.f;
#pragma unroll
                for (int bj = 0; bj < 2; ++bj)
#pragma unroll
                    for (int n = 0; n < 2; ++n) { const f32x4 d = v[ai][bj][m][n] - mw; q += (d[0] * d[0] + d[1] * d[1]) + (d[2] * d[2] + d[3] * d[3]); }
                q += __shfl_xor(q, 16); q += __shfl_xor(q, 32);
                if (fq == 0) P[(ai * HALF + wr * 64 + m * 16 + fr) * 4 + wc] = (f32x2v){mw, q};
            }
        asm volatile("s_waitcnt lgkmcnt(0)" ::: "memory"); __builtin_amdgcn_s_barrier(); asm volatile("" ::: "memory");
#if defined(BROKEN_NO_WAIT)
        if (blockIdx.x >= 64) { const long long t0 = clock64(); while (clock64() - t0 < 60000) __builtin_amdgcn_s_sleep(8); }
#endif
        const int row = wid * 32 + (lane & 31);
        if (lane < 32) {
            const f32x2v a = P[row * 4 + 0], b = P[row * 4 + 1], c = P[row * 4 + 2], d = P[row * 4 + 3];
            const float mt = (a.x + b.x + c.x + d.x) * 0.25f;
            const float da = a.x - mt, db = b.x - mt, dc = c.x - mt, dd = d.x - mt;
            const float m2 = (a.y + b.y) + (c.y + d.y) + 64.0f * ((da * da + db * db) + (dc * dc + dd * dd));
            unsigned long long* slot = (unsigned long long*)xbuf + ((size_t)(u.pm * BM + row) * 4 + u.pn);
            __hip_atomic_store(slot, ((unsigned long long)__float_as_uint(m2) << 32) | __float_as_uint(mt), __ATOMIC_RELAXED, __HIP_MEMORY_SCOPE_AGENT);
        }
        asm volatile("s_waitcnt vmcnt(0)" ::: "memory");
        if (lane == 0) __hip_atomic_fetch_add(cnt + 64 * u.pm, 1u, __ATOMIC_RELAXED, __HIP_MEMORY_SCOPE_AGENT);
        if (wid == 0) {
            bool dead = false; const unsigned long long t0 = __builtin_amdgcn_s_memrealtime(); const unsigned want = 8u * (unsigned)ntn;
            for (;;) {
#if defined(BROKEN_NO_WAIT)
                break;
#endif
                if ((unsigned)__builtin_amdgcn_readfirstlane(__hip_atomic_load(cnt + 64 * u.pm, __ATOMIC_RELAXED, __HIP_MEMORY_SCOPE_AGENT)) >= want) break;
                if (__builtin_amdgcn_s_memrealtime() - t0 > 2000000ull) {
                    if (lane == 0) { unsigned expect = 0u; __hip_atomic_compare_exchange_strong(tmo + 1, &expect, code | (unsigned)(u.pm & 0xff), __ATOMIC_RELAXED, __ATOMIC_RELAXED, __HIP_MEMORY_SCOPE_AGENT);
                                     __hip_atomic_store(tmo, 1u, __ATOMIC_RELAXED, __HIP_MEMORY_SCOPE_AGENT); }
                    dead = true; break; }
                __builtin_amdgcn_s_sleep(2);
            }
            __builtin_amdgcn_fence(__ATOMIC_ACQUIRE, "agent");
            if (lane == 0) flag[0] = dead ? 1u : 0u;
        }
        asm volatile("s_waitcnt vmcnt(0) lgkmcnt(0)" ::: "memory"); __builtin_amdgcn_s_barrier(); asm volatile("" ::: "memory");
        const bool bad = flag[0] != 0u;
        if (lane < 32) {
            const unsigned long long* slot = (const unsigned long long*)xbuf + (size_t)(u.pm * BM + row) * 4; float mt[4], m2[4]; float ms = 0.f;
#pragma unroll
            for (int t = 0; t < 4; ++t) { if (t < ntn) { const unsigned long long w = __hip_atomic_load(slot + t, __ATOMIC_RELAXED, __HIP_MEMORY_SCOPE_AGENT); mt[t] = __uint_as_float((unsigned)w); m2[t] = __uint_as_float((unsigned)(w >> 32)); } else { mt[t] = 0.f; m2[t] = 0.f; } ms += mt[t]; }
            const float mean = ms / (float)ntn; float q = 0.f;
#pragma unroll
            for (int t = 0; t < 4; ++t) if (t < ntn) { const float dm = mt[t] - mean; q += m2[t] + 256.0f * dm * dm; }
            S[row] = (f32x2v){mean, 1.0f / sqrtf(q / (256.0f * (float)ntn) + eps)};
        }
        asm volatile("s_waitcnt lgkmcnt(0)" ::: "memory"); __builtin_amdgcn_s_barrier(); asm volatile("" ::: "memory");
        return bad;
    }
};
struct EpiLnRes {
    static constexpr bool PERM = false, AFTER_DRAIN = true;
    const float* base; float* out; int ldc; const float* bias; PanelStats st; unsigned poison;
    __device__ __forceinline__ void refuse(size_t i0, size_t stride, int M, int N) const { const float q = __builtin_nanf(""); for (size_t i = i0; i < (size_t)M * N; i += stride) out[(i / N) * ldc + i % N] = q;
        if (i0 == 0) { unsigned expect = 0u; __hip_atomic_compare_exchange_strong(st.tmo + 1, &expect, 0x7f0u, __ATOMIC_RELAXED, __ATOMIC_RELAXED, __HIP_MEMORY_SCOPE_AGENT); __hip_atomic_store(st.tmo, 1u, __ATOMIC_RELAXED, __HIP_MEMORY_SCOPE_AGENT); } }
    __device__ __forceinline__ void fused(f32x4 (&acc)[2][2][4][2], const Unit& u, int wr, int wc, int fr, int fq, PG8_LAS unsigned char* lds, int wid, int lane) const {
        typedef float f32x2v __attribute__((ext_vector_type(2)));
        const PG8_LAS f32x2v* S = (const PG8_LAS f32x2v*)(lds + 8192);
        const int col0 = u.pn * BM + wc * 32 + 4 * fq;
#pragma unroll
        for (int bj = 0; bj < 2; ++bj)
#pragma unroll
            for (int n = 0; n < 2; ++n) { const f32x4 bv = bias ? *(const f32x4*)(bias + col0 + bj * HALF + n * 16) : (f32x4){0.f, 0.f, 0.f, 0.f};
#pragma unroll
                for (int ai = 0; ai < 2; ++ai)
#pragma unroll
                    for (int m = 0; m < 4; ++m) acc[ai][bj][m][n] += bv; }
        const bool bad = st.run(acc, u, wr, wc, fr, fq, lds, wid, lane) || poison != 0u;
        const float qnan = __builtin_nanf("");
#pragma unroll
        for (int ai = 0; ai < 2; ++ai)
#pragma unroll
            for (int m = 0; m < 4; ++m) { const int r = ai * HALF + wr * 64 + m * 16 + fr; const f32x2v sr = S[r]; const size_t off = (size_t)(u.pm * BM + r) * ldc + col0;
#pragma unroll
                for (int bj = 0; bj < 2; ++bj)
#pragma unroll
                    for (int n = 0; n < 2; ++n) { const f32x4 bs = *(const f32x4*)(base + off + bj * HALF + n * 16); f32x4 o = bs + (acc[ai][bj][m][n] - sr.x) * sr.y;
                        if (bad) o = (f32x4){qnan, qnan, qnan, qnan}; *(f32x4*)(out + off + bj * HALF + n * 16) = o; }
                asm volatile("" ::: "memory"); }
    }
};
struct EpiLnResLn {
    static constexpr bool PERM = false, AFTER_DRAIN = true;
    const float* base; float* out; bf16_t* xn; int ldc; const float* bias; PanelStats st1, st2; unsigned poison;
    __device__ __forceinline__ void refuse(size_t i0, size_t stride, int M, int N) const { const float q = __builtin_nanf(""); for (size_t i = i0; i < (size_t)M * N; i += stride) { const size_t o = (i / N) * ldc + i % N; out[o] = q; xn[o] = (bf16_t)0x7fc0u; }
        if (i0 == 0) { unsigned expect = 0u; __hip_atomic_compare_exchange_strong(st1.tmo + 1, &expect, 0x7f0u, __ATOMIC_RELAXED, __ATOMIC_RELAXED, __HIP_MEMORY_SCOPE_AGENT); __hip_atomic_store(st1.tmo, 1u, __ATOMIC_RELAXED, __HIP_MEMORY_SCOPE_AGENT); } }
    __device__ __forceinline__ void fused(f32x4 (&acc)[2][2][4][2], const Unit& u, int wr, int wc, int fr, int fq, PG8_LAS unsigned char* lds, int wid, int lane) const {
        typedef float f32x2v __attribute__((ext_vector_type(2))); typedef unsigned u32x2v __attribute__((ext_vector_type(2)));
        const PG8_LAS f32x2v* S = (const PG8_LAS f32x2v*)(lds + 8192);
        const int col0 = u.pn * BM + wc * 32 + 4 * fq;
#pragma unroll
        for (int bj = 0; bj < 2; ++bj)
#pragma unroll
            for (int n = 0; n < 2; ++n) { const f32x4 bv = bias ? *(const f32x4*)(bias + col0 + bj * HALF + n * 16) : (f32x4){0.f, 0.f, 0.f, 0.f};
#pragma unroll
                for (int ai = 0; ai < 2; ++ai)
#pragma unroll
                    for (int m = 0; m < 4; ++m) acc[ai][bj][m][n] += bv; }
        bool bad = st1.run(acc, u, wr, wc, fr, fq, lds, wid, lane) || poison != 0u;
        const float qnan = __builtin_nanf("");
#pragma unroll
        for (int ai = 0; ai < 2; ++ai)
#pragma unroll
            for (int m = 0; m < 4; ++m) { const int r = ai * HALF + wr * 64 + m * 16 + fr; const f32x2v sr = S[r]; const size_t off = (size_t)(u.pm * BM + r) * ldc + col0;
#pragma unroll
                for (int bj = 0; bj < 2; ++bj)
#pragma unroll
                    for (int n = 0; n < 2; ++n) { const f32x4 bs = *(const f32x4*)(base + off + bj * HALF + n * 16); acc[ai][bj][m][n] = bs + (acc[ai][bj][m][n] - sr.x) * sr.y; }
                asm volatile("" : "+v"(acc[ai][0][m][0]), "+v"(acc[ai][0][m][1]), "+v"(acc[ai][1][m][0]), "+v"(acc[ai][1][m][1]));
                if (m & 1) asm volatile("" ::: "memory"); }
        const bool bad1 = bad;
        bad = st2.run(acc, u, wr, wc, fr, fq, lds, wid, lane) || bad;
#pragma unroll
        for (int ai = 0; ai < 2; ++ai)
#pragma unroll
            for (int m = 0; m < 4; ++m) { const int r = ai * HALF + wr * 64 + m * 16 + fr; const f32x2v sr = S[r]; const size_t off = (size_t)(u.pm * BM + r) * ldc + col0;
#pragma unroll
                for (int bj = 0; bj < 2; ++bj)
#pragma unroll
                    for (int n = 0; n < 2; ++n) { const f32x4 x1 = acc[ai][bj][m][n]; *(f32x4*)(out + off + bj * HALF + n * 16) = bad1 ? (f32x4){qnan, qnan, qnan, qnan} : x1;
                        const f32x4 o = (x1 - sr.x) * sr.y; u32x2v w; w.x = cvt_pk_bf16(o[0], o[1]); w.y = cvt_pk_bf16(o[2], o[3]);
                        if (bad) { w.x = 0x7fc07fc0u; w.y = 0x7fc07fc0u; } *(u32x2v*)(xn + off + bj * HALF + n * 16) = w; }
                asm volatile("" ::: "memory"); }
    }
};

template <class Epi, class Sched, bool STAMP = false>
__device__ __forceinline__ void gemm_phase(PG8_LAS unsigned char* lds, const Gemm g, const Sched& S, const Epi& E, unsigned long long* stamps) {
    int tid_l_ = (int)threadIdx.x; asm volatile("" : "+v"(tid_l_)); const int tid = tid_l_, wid = __builtin_amdgcn_readfirstlane(tid >> 6), lane = tid & 63, wr = wid >> 2, wc = wid & 3, fr = lane & 15, fq = lane >> 4;
    const int K = g.K, nt = K / BK;
    int ts_lo = 0, ts_hi = 0, nts = 0; const unsigned long long rt_entry = STAMP ? (unsigned long long)wall_clock64() : 0ull;
#define PG8_STAMP() do { if (STAMP && wid == 0 && nts < 64) { const unsigned long long _c = (unsigned long long)clock64(); \
        ts_lo = (lane == nts) ? (int)(unsigned)_c : ts_lo; ts_hi = (lane == nts) ? (int)(unsigned)(_c >> 32) : ts_hi; ++nts; } } while (0)
    PG8_STAMP();
    unsigned voffA[2], voffB[2];
#pragma unroll
    for (int i = 0; i < 2; ++i) { int R, C; stage_rc(tid * 16 + i * 8192, R, C); const int Rb = Epi::PERM ? ((R & ~31) + perm32(R & 31)) : R;
        voffA[i] = (unsigned)(R * K + C) * 2u; voffB[i] = (unsigned)(Rb * K + C) * 2u; }
    const size_t kstep = (size_t)(BK * 2);
    const size_t hstep = (size_t)HALF * K * 2;
    const size_t tstep = 2 * hstep;
    const unsigned ldsw = (unsigned)wid * 1024u;
    const int aoff = lds_byte(wr * 64 + fr, fq * 8), boff = lds_byte(wc * 32 + fr, fq * 8);
#define PG8_SA(b, h) (((b) * 2 + (h)) * HTB)
#define PG8_SB(b, h) ((4 + (b) * 2 + (h)) * HTB)
#define PG8_STAGE(bufoff, gbase, voff) do { _Pragma("unroll") for (int _i = 0; _i < 2; ++_i) \
        __builtin_amdgcn_global_load_lds((const unsigned*)((const char*)(gbase) + (voff)[_i]), (PG8_LAS unsigned*)(lds + (bufoff) + ldsw + _i * 8192), 16, 0, 0); } while (0)
#define PG8_LDA(dst, b, h) do { _Pragma("unroll") for (int m = 0; m < 4; ++m) _Pragma("unroll") for (int k = 0; k < 2; ++k) dst[m][k] = *(const PG8_LAS bf16x8*)(lds + PG8_SA(b, h) + aoff + m * 2048 + k * 1024); } while (0)
#define PG8_LDB(dst, b, h) do { _Pragma("unroll") for (int n = 0; n < 2; ++n) _Pragma("unroll") for (int k = 0; k < 2; ++k) dst[n][k] = *(const PG8_LAS bf16x8*)(lds + PG8_SB(b, h) + boff + n * 2048 + k * 1024); } while (0)
#define PG8_MMA(ai, bj, At, Bt) do { __builtin_amdgcn_s_setprio(1); _Pragma("unroll") for (int m = 0; m < 4; ++m) _Pragma("unroll") for (int n = 0; n < 2; ++n) _Pragma("unroll") for (int k = 0; k < 2; ++k) \
        acc[ai][bj][m][n] = __builtin_amdgcn_mfma_f32_16x16x32_bf16(Bt[n][k], At[m][k], acc[ai][bj][m][n], 0, 0, 0); __builtin_amdgcn_s_setprio(0); } while (0)
#define PG8_WAIT_V(n) asm volatile("s_waitcnt vmcnt(" #n ")" ::: "memory")
#define PG8_WAIT_L(n) asm volatile("s_waitcnt lgkmcnt(" #n ")" ::: "memory")
#define PG8_BAR __builtin_amdgcn_s_barrier()
#define PG8_SCHED __builtin_amdgcn_sched_barrier(0)
    Unit cur, nxt; int ui = 0;
    if (!S.next(0, cur)) return;
    f32x4 acc[2][2][4][2];
#pragma unroll
    for (int a = 0; a < 2; ++a)
#pragma unroll
        for (int b = 0; b < 2; ++b)
#pragma unroll
            for (int m = 0; m < 4; ++m)
#pragma unroll
                for (int n = 0; n < 2; ++n) acc[a][b][m][n] = (f32x4){0.f, 0.f, 0.f, 0.f};
    bf16x8 At[4][2], B0[2][2], B1[2][2];
    const char* cA = (const char*)g.A + (size_t)cur.pm * tstep; const char* cB = (const char*)g.Bt + (size_t)cur.pn * tstep;
    S.a_ready(cur);
    PG8_STAGE(PG8_SB(0, 0), cB, voffB); PG8_STAGE(PG8_SA(0, 0), cA, voffA); PG8_STAGE(PG8_SB(0, 1), cB + hstep, voffB); PG8_STAGE(PG8_SA(0, 1), cA + hstep, voffA);
    if (wr == 1) PG8_BAR;
    PG8_WAIT_V(4); PG8_BAR;
    PG8_STAGE(PG8_SB(1, 0), cB + kstep, voffB); PG8_STAGE(PG8_SA(1, 0), cA + kstep, voffA); PG8_STAGE(PG8_SB(1, 1), cB + hstep + kstep, voffB);
    PG8_WAIT_V(6); PG8_BAR;
    PG8_STAMP();
    for (;;) {
        const bool has_next = S.next(ui + 1, nxt);
        const char* nA = has_next ? (const char*)g.A + (size_t)nxt.pm * tstep : cA; const char* nB = has_next ? (const char*)g.Bt + (size_t)nxt.pn * tstep : cB;
        for (int t = 0; t < nt; t += 2) {
            const bool last = (t == nt - 2);
            const char* a1 = cA + (size_t)(t + 1) * kstep;
            const char* a2 = last ? nA : cA + (size_t)(t + 2) * kstep; const char* b2 = last ? nB : cB + (size_t)(t + 2) * kstep;
            const char* a3 = a2 + kstep; const char* b3 = b2 + kstep;
            if (last && has_next) S.a_ready(nxt);
            PG8_LDB(B0, 0, 0); PG8_SCHED; PG8_LDA(At, 0, 0); PG8_STAGE(PG8_SA(1, 1), a1 + hstep, voffA);
            PG8_WAIT_L(8); PG8_BAR; PG8_WAIT_L(0); PG8_MMA(0, 0, At, B0); PG8_BAR; PG8_SCHED;
            PG8_LDB(B1, 0, 1); PG8_STAGE(PG8_SB(0, 0), b2, voffB);
            PG8_BAR; PG8_WAIT_L(0); PG8_MMA(0, 1, At, B1); PG8_BAR;
            PG8_LDA(At, 0, 1); PG8_STAGE(PG8_SA(0, 0), a2, voffA);
            PG8_BAR; PG8_WAIT_L(0); PG8_MMA(1, 0, At, B0); PG8_BAR; PG8_SCHED;
            PG8_STAGE(PG8_SB(0, 1), b2 + hstep, voffB);
            PG8_WAIT_V(6); PG8_BAR; PG8_MMA(1, 1, At, B1); PG8_BAR;
            PG8_LDB(B0, 1, 0); PG8_SCHED; PG8_LDA(At, 1, 0); PG8_STAGE(PG8_SA(0, 1), a2 + hstep, voffA);
            PG8_WAIT_L(8); PG8_BAR; PG8_WAIT_L(0); PG8_MMA(0, 0, At, B0); PG8_BAR; PG8_SCHED;
            PG8_LDB(B1, 1, 1); PG8_STAGE(PG8_SB(1, 0), b3, voffB);
            PG8_BAR; PG8_WAIT_L(0); PG8_MMA(0, 1, At, B1); PG8_BAR;
            PG8_LDA(At, 1, 1); PG8_STAGE(PG8_SA(1, 0), a3, voffA);
            PG8_BAR; PG8_WAIT_L(0); PG8_MMA(1, 0, At, B0); PG8_BAR; PG8_SCHED;
            PG8_STAGE(PG8_SB(1, 1), b3 + hstep, voffB);
            PG8_WAIT_V(6); PG8_BAR; PG8_MMA(1, 1, At, B1); PG8_BAR;
        }
        PG8_STAMP();
        if constexpr (!Epi::AFTER_DRAIN) { E(acc, cur, wr, wc, fr, fq); S.done(cur); }
        PG8_STAMP();
        if (!has_next) break;
#pragma unroll
        for (int a = 0; a < 2; ++a)
#pragma unroll
            for (int b = 0; b < 2; ++b)
#pragma unroll
                for (int m = 0; m < 4; ++m)
#pragma unroll
                    for (int n = 0; n < 2; ++n) acc[a][b][m][n] = (f32x4){0.f, 0.f, 0.f, 0.f};
        cur = nxt; cA = nA; cB = nB; ++ui;
    }
    PG8_WAIT_V(0);
    if (wr == 0) PG8_BAR;
    PG8_BAR;
    if constexpr (Epi::AFTER_DRAIN) { E.fused(acc, cur, wr, wc, fr, fq, lds, wid, lane); S.done(cur); }
    PG8_STAMP();
    if (STAMP && wid == 0) { stamps[lane] = lane < nts ? (((unsigned long long)(unsigned)ts_hi << 32) | (unsigned)ts_lo) : 0ull;
        if (lane == 62) stamps[62] = rt_entry; if (lane == 63) stamps[63] = (unsigned long long)wall_clock64(); }
#undef PG8_STAMP
#undef PG8_SA
#undef PG8_SB
#undef PG8_STAGE
#undef PG8_LDA
#undef PG8_LDB
#undef PG8_MMA
#undef PG8_WAIT_V
#undef PG8_WAIT_L
#undef PG8_BAR
#undef PG8_SCHED
}
template <class Epi, class Sched, bool STAMP = false>
__device__ __forceinline__ void gemm_phase_g(PG8_LAS unsigned char* lds, const Gemm g, const Sched& S, const Epi& E, const PG8_LAS int* ridx) {
    unsigned long long* stamps = nullptr;
    int tid_l_ = (int)threadIdx.x; asm volatile("" : "+v"(tid_l_)); const int tid = tid_l_, wid = __builtin_amdgcn_readfirstlane(tid >> 6), lane = tid & 63, wr = wid >> 2, wc = wid & 3, fr = lane & 15, fq = lane >> 4;
    const int K = g.K, nt = K / BK;
    int ts_lo = 0, ts_hi = 0, nts = 0; const unsigned long long rt_entry = STAMP ? (unsigned long long)wall_clock64() : 0ull;
#define PG8_STAMP() do { if (STAMP && wid == 0 && nts < 64) { const unsigned long long _c = (unsigned long long)clock64(); \
        ts_lo = (lane == nts) ? (int)(unsigned)_c : ts_lo; ts_hi = (lane == nts) ? (int)(unsigned)(_c >> 32) : ts_hi; ++nts; } } while (0)
    PG8_STAMP();
    unsigned voffB[2]; int rA[2]; unsigned cA2[2];
#pragma unroll
    for (int i = 0; i < 2; ++i) { int R, C; stage_rc(tid * 16 + i * 8192, R, C); const int Rb = Epi::PERM ? ((R & ~31) + perm32(R & 31)) : R;
        rA[i] = R; cA2[i] = (unsigned)C * 2u; voffB[i] = (unsigned)(Rb * K + C) * 2u; }
    unsigned vc[2][2], vn[2][2];
#define PG8_GIDX(dst, ui_) do { _Pragma("unroll") for (int h_ = 0; h_ < 2; ++h_) _Pragma("unroll") for (int i_ = 0; i_ < 2; ++i_) dst[h_][i_] = (unsigned)ridx[(ui_) * 256 + h_ * 128 + rA[i_]] * (unsigned)(K * 2) + cA2[i_]; \
        asm volatile("s_waitcnt lgkmcnt(0)" ::: "memory"); } while (0)
    const size_t kstep = (size_t)(BK * 2);
    const size_t hstep = (size_t)HALF * K * 2;
    const size_t tstep = 2 * hstep;
    const unsigned ldsw = (unsigned)wid * 1024u;
    const int aoff = lds_byte(wr * 64 + fr, fq * 8), boff = lds_byte(wc * 32 + fr, fq * 8);
#define PG8_SA(b, h) (((b) * 2 + (h)) * HTB)
#define PG8_SB(b, h) ((4 + (b) * 2 + (h)) * HTB)
#define PG8_STAGE(bufoff, gbase, voff) do { _Pragma("unroll") for (int _i = 0; _i < 2; ++_i) \
        __builtin_amdgcn_global_load_lds((const unsigned*)((const char*)(gbase) + (voff)[_i]), (PG8_LAS unsigned*)(lds + (bufoff) + ldsw + _i * 8192), 16, 0, 0); } while (0)
#define PG8_LDA(dst, b, h) do { _Pragma("unroll") for (int m = 0; m < 4; ++m) _Pragma("unroll") for (int k = 0; k < 2; ++k) dst[m][k] = *(const PG8_LAS bf16x8*)(lds + PG8_SA(b, h) + aoff + m * 2048 + k * 1024); } while (0)
#define PG8_LDB(dst, b, h) do { _Pragma("unroll") for (int n = 0; n < 2; ++n) _Pragma("unroll") for (int k = 0; k < 2; ++k) dst[n][k] = *(const PG8_LAS bf16x8*)(lds + PG8_SB(b, h) + boff + n * 2048 + k * 1024); } while (0)
#define PG8_MMA(ai, bj, At, Bt) do { __builtin_amdgcn_s_setprio(1); _Pragma("unroll") for (int m = 0; m < 4; ++m) _Pragma("unroll") for (int n = 0; n < 2; ++n) _Pragma("unroll") for (int k = 0; k < 2; ++k) \
        acc[ai][bj][m][n] = __builtin_amdgcn_mfma_f32_16x16x32_bf16(Bt[n][k], At[m][k], acc[ai][bj][m][n], 0, 0, 0); __builtin_amdgcn_s_setprio(0); } while (0)
#define PG8_WAIT_V(n) asm volatile("s_waitcnt vmcnt(" #n ")" ::: "memory")
#define PG8_WAIT_L(n) asm volatile("s_waitcnt lgkmcnt(" #n ")" ::: "memory")
#define PG8_BAR __builtin_amdgcn_s_barrier()
#define PG8_SCHED __builtin_amdgcn_sched_barrier(0)
    Unit cur, nxt; int ui = 0;
    if (!S.next(0, cur)) return;
    f32x4 acc[2][2][4][2];
#pragma unroll
    for (int a = 0; a < 2; ++a)
#pragma unroll
        for (int b = 0; b < 2; ++b)
#pragma unroll
            for (int m = 0; m < 4; ++m)
#pragma unroll
                for (int n = 0; n < 2; ++n) acc[a][b][m][n] = (f32x4){0.f, 0.f, 0.f, 0.f};
    bf16x8 At[4][2], B0[2][2], B1[2][2];
    const char* cA = (const char*)g.A; const char* cB = (const char*)g.Bt + (size_t)cur.pn * tstep;
    PG8_GIDX(vc, 0);
    S.a_ready(cur);
    PG8_STAGE(PG8_SB(0, 0), cB, voffB); PG8_STAGE(PG8_SA(0, 0), cA, vc[0]); PG8_STAGE(PG8_SB(0, 1), cB + hstep, voffB); PG8_STAGE(PG8_SA(0, 1), cA, vc[1]);
    if (wr == 1) PG8_BAR;
    PG8_WAIT_V(4); PG8_BAR;
    PG8_STAGE(PG8_SB(1, 0), cB + kstep, voffB); PG8_STAGE(PG8_SA(1, 0), cA + kstep, vc[0]); PG8_STAGE(PG8_SB(1, 1), cB + hstep + kstep, voffB);
    PG8_WAIT_V(6); PG8_BAR;
    PG8_STAMP();
    for (;;) {
        const bool has_next = S.next(ui + 1, nxt);
        const char* nB = has_next ? (const char*)g.Bt + (size_t)nxt.pn * tstep : cB;
        if (has_next) PG8_GIDX(vn, ui + 1); else {
#pragma unroll
            for (int h_ = 0; h_ < 2; ++h_)
#pragma unroll
                for (int i_ = 0; i_ < 2; ++i_) vn[h_][i_] = vc[h_][i_]; }
        for (int t = 0; t < nt; t += 2) {
            const bool last = (t == nt - 2);
            const char* a1 = cA + (size_t)(t + 1) * kstep;
            const char* a2 = last ? cA : cA + (size_t)(t + 2) * kstep; const char* b2 = last ? nB : cB + (size_t)(t + 2) * kstep;
            const char* a3 = a2 + kstep; const char* b3 = b2 + kstep;
            unsigned v2[2][2];
#pragma unroll
            for (int h_ = 0; h_ < 2; ++h_)
#pragma unroll
                for (int i_ = 0; i_ < 2; ++i_) v2[h_][i_] = last ? vn[h_][i_] : vc[h_][i_];
            if (last && has_next) S.a_ready(nxt);
            PG8_LDB(B0, 0, 0); PG8_SCHED; PG8_LDA(At, 0, 0); PG8_STAGE(PG8_SA(1, 1), a1, vc[1]);
            PG8_WAIT_L(8); PG8_BAR; PG8_WAIT_L(0); PG8_MMA(0, 0, At, B0); PG8_BAR; PG8_SCHED;
            PG8_LDB(B1, 0, 1); PG8_STAGE(PG8_SB(0, 0), b2, voffB);
            PG8_BAR; PG8_WAIT_L(0); PG8_MMA(0, 1, At, B1); PG8_BAR;
            PG8_LDA(At, 0, 1); PG8_STAGE(PG8_SA(0, 0), a2, v2[0]);
            PG8_BAR; PG8_WAIT_L(0); PG8_MMA(1, 0, At, B0); PG8_BAR; PG8_SCHED;
            PG8_STAGE(PG8_SB(0, 1), b2 + hstep, voffB);
            PG8_WAIT_V(6); PG8_BAR; PG8_MMA(1, 1, At, B1); PG8_BAR;
            PG8_LDB(B0, 1, 0); PG8_SCHED; PG8_LDA(At, 1, 0); PG8_STAGE(PG8_SA(0, 1), a2, v2[1]);
            PG8_WAIT_L(8); PG8_BAR; PG8_WAIT_L(0); PG8_MMA(0, 0, At, B0); PG8_BAR; PG8_SCHED;
            PG8_LDB(B1, 1, 1); PG8_STAGE(PG8_SB(1, 0), b3, voffB);
            PG8_BAR; PG8_WAIT_L(0); PG8_MMA(0, 1, At, B1); PG8_BAR;
            PG8_LDA(At, 1, 1); PG8_STAGE(PG8_SA(1, 0), a3, v2[0]);
            PG8_BAR; PG8_WAIT_L(0); PG8_MMA(1, 0, At, B0); PG8_BAR; PG8_SCHED;
            PG8_STAGE(PG8_SB(1, 1), b3 + hstep, voffB);
            PG8_WAIT_V(6); PG8_BAR; PG8_MMA(1, 1, At, B1); PG8_BAR;
        }
        PG8_STAMP();
        if constexpr (!Epi::AFTER_DRAIN) { E(acc, cur, wr, wc, fr, fq); S.done(cur); }
        PG8_STAMP();
        if (!has_next) break;
#pragma unroll
        for (int a = 0; a < 2; ++a)
#pragma unroll
            for (int b = 0; b < 2; ++b)
#pragma unroll
                for (int m = 0; m < 4; ++m)
#pragma unroll
                    for (int n = 0; n < 2; ++n) acc[a][b][m][n] = (f32x4){0.f, 0.f, 0.f, 0.f};
        cur = nxt; cB = nB; ++ui;
#pragma unroll
        for (int h_ = 0; h_ < 2; ++h_)
#pragma unroll
            for (int i_ = 0; i_ < 2; ++i_) vc[h_][i_] = vn[h_][i_];
    }
    PG8_WAIT_V(0);
    if (wr == 0) PG8_BAR;
    PG8_BAR;
    if constexpr (Epi::AFTER_DRAIN) { E.fused(acc, cur, wr, wc, fr, fq, lds, wid, lane); S.done(cur); }
    PG8_STAMP();
    if (STAMP && wid == 0) { stamps[lane] = lane < nts ? (((unsigned long long)(unsigned)ts_hi << 32) | (unsigned)ts_lo) : 0ull;
        if (lane == 62) stamps[62] = rt_entry; if (lane == 63) stamps[63] = (unsigned long long)wall_clock64(); }
#undef PG8_STAMP
#undef PG8_GIDX
#undef PG8_SA
#undef PG8_SB
#undef PG8_STAGE
#undef PG8_LDA
#undef PG8_LDB
#undef PG8_MMA
#undef PG8_WAIT_V
#undef PG8_WAIT_L
#undef PG8_BAR
#undef PG8_SCHED
}
}

using pg8::bf16_t; using pg8::bf16x8; using pg8::f32x4;
typedef float f32x16 __attribute__((ext_vector_type(16)));
typedef float f32x2v __attribute__((ext_vector_type(2)));
typedef __bf16 bf16x2v __attribute__((ext_vector_type(2)));
typedef short s16x4 __attribute__((ext_vector_type(4)));
typedef unsigned u32x4 __attribute__((ext_vector_type(4)));
typedef unsigned u32x2 __attribute__((ext_vector_type(2)));
typedef PG8_LAS unsigned char* LDSP;
typedef PG8_LAS float* LASF;

constexpr int NTH = 512;
constexpr int LDS_BYTES = 156 * 1024;
constexpr int DM = 1024, LL = 8192, LC = 256, SEQB = 8448, TT = 16896, NPAN = 66, TPAD = 41984;
constexpr size_t UU = (size_t)TT * 1024 * 2;
constexpr float EPS_ = 1e-6f;
constexpr float INV2PI = 0.15915494309189535f;

template <class T> __device__ __forceinline__ T* UP(T* q) { const unsigned long long v = (unsigned long long)q;
    const unsigned lo = (unsigned)__builtin_amdgcn_readfirstlane((int)(unsigned)v), hi = (unsigned)__builtin_amdgcn_readfirstlane((int)(unsigned)(v >> 32));
    return (T*)(__attribute__((address_space(1))) T*)(((unsigned long long)hi << 32) | lo); }
__device__ __forceinline__ int ltid() { int t = (int)threadIdx.x; asm volatile("" : "+v"(t)); return t; }
__device__ __forceinline__ f32x2v mk2_(float x, float y) { f32x2v r; r.x = x; r.y = y; return r; }
__device__ __forceinline__ float bf2f(bf16_t v) { return __uint_as_float(((unsigned)v) << 16); }
__device__ __forceinline__ unsigned pk2(float lo, float hi) { f32x2v v = {lo, hi}; bf16x2v b = __builtin_convertvector(v, bf16x2v); return __builtin_bit_cast(unsigned, b); }
__device__ __forceinline__ bf16_t f2bf(float f) { return (bf16_t)(pk2(f, 0.f) & 0xffffu); }
__device__ __forceinline__ float lo16(unsigned w) { return __uint_as_float(w << 16); }
__device__ __forceinline__ float hi16(unsigned w) { return __uint_as_float(w & 0xffff0000u); }
__device__ __forceinline__ float sigmoidf_(float x) { return __builtin_amdgcn_rcpf(1.0f + __expf(-x)); }
__device__ __forceinline__ float siluf_(float x) { return x * __builtin_amdgcn_rcpf(1.0f + __expf(-x)); }
__device__ __forceinline__ float logsigf_(float x) { return fminf(x, 0.f) - log1pf(__expf(-fabsf(x))); }
__device__ __forceinline__ float sin2pi(float rev) { return __builtin_amdgcn_sinf(rev); }
__device__ __forceinline__ float cos2pi(float rev) { return __builtin_amdgcn_cosf(rev); }
__device__ __forceinline__ int crow(int r, int hi) { return (r & 3) + 8 * (r >> 2) + 4 * hi; }
template <int CTRL> __device__ __forceinline__ float dpp_mov(float x) { return __int_as_float(__builtin_amdgcn_update_dpp(0, __float_as_int(x), CTRL, 0xf, 0xf, false)); }
__device__ __forceinline__ float row_sum(float x) { x += dpp_mov<0x128>(x); x += dpp_mov<0x124>(x); x += dpp_mov<0x122>(x); x += dpp_mov<0x121>(x); return x; }
__device__ __forceinline__ float row_max(float x) { x = fmaxf(x, dpp_mov<0x128>(x)); x = fmaxf(x, dpp_mov<0x124>(x)); x = fmaxf(x, dpp_mov<0x122>(x)); x = fmaxf(x, dpp_mov<0x121>(x)); return x; }
__device__ __forceinline__ void swap32_(float& a, float& b) { auto r = __builtin_amdgcn_permlane32_swap(__float_as_uint(a), __float_as_uint(b), false, false); a = __uint_as_float(r[0]); b = __uint_as_float(r[1]); }
__device__ __forceinline__ void swap16_(float& a, float& b) { auto r = __builtin_amdgcn_permlane16_swap(__float_as_uint(a), __float_as_uint(b), false, false); a = __uint_as_float(r[0]); b = __uint_as_float(r[1]); }
__device__ __forceinline__ float wave_sum(float v) { v = row_sum(v); float w = v; swap16_(v, w); v += w; w = v; swap32_(v, w); return v + w; }
__device__ __forceinline__ float wave_max(float v) { v = row_max(v); float w = v; swap16_(v, w); v = fmaxf(v, w); w = v; swap32_(v, w); return fmaxf(v, w); }
__device__ __forceinline__ void wave_sum32(float (&v)[32]) {
#pragma unroll
    for (int i = 0; i < 16; ++i) { swap32_(v[i], v[16 + i]); v[i] += v[16 + i]; }
#pragma unroll
    for (int i = 0; i < 8; ++i) { swap16_(v[i], v[8 + i]); v[i] += v[8 + i]; }
#pragma unroll
    for (int i = 0; i < 8; ++i) v[i] = row_sum(v[i]); }
__device__ __forceinline__ void wave_sum16(float (&v)[16]) {
#pragma unroll
    for (int i = 0; i < 8; ++i) { swap32_(v[i], v[8 + i]); v[i] += v[8 + i]; }
#pragma unroll
    for (int i = 0; i < 4; ++i) { swap16_(v[i], v[4 + i]); v[i] += v[4 + i]; }
#pragma unroll
    for (int i = 0; i < 4; ++i) v[i] = row_sum(v[i]); }
__device__ __forceinline__ float readlane_f(float x, int l) { return __int_as_float(__builtin_amdgcn_readlane(__float_as_int(x), l)); }
__device__ __forceinline__ void unpack8(const u32x4 w, float (&f)[8]) {
    f[0] = lo16(w.x); f[1] = hi16(w.x); f[2] = lo16(w.y); f[3] = hi16(w.y); f[4] = lo16(w.z); f[5] = hi16(w.z); f[6] = lo16(w.w); f[7] = hi16(w.w); }
constexpr float ST_SC = 4.0f, ST_ISC = 0.25f;
__device__ __forceinline__ unsigned pk4_fp8(float a, float b, float c, float d) {
    a = fminf(fmaxf(a, -440.f), 440.f); b = fminf(fmaxf(b, -440.f), 440.f); c = fminf(fmaxf(c, -440.f), 440.f); d = fminf(fmaxf(d, -440.f), 440.f);
    unsigned w = 0u; w = (unsigned)__builtin_amdgcn_cvt_pk_fp8_f32(a, b, (int)w, false); w = (unsigned)__builtin_amdgcn_cvt_pk_fp8_f32(c, d, (int)w, true); return w; }
__device__ __forceinline__ void unpk8_fp8(const u32x2 w, float (&f)[8]) {
    const f32x2v a = __builtin_amdgcn_cvt_pk_f32_fp8((int)w.x, false), b = __builtin_amdgcn_cvt_pk_f32_fp8((int)w.x, true), c = __builtin_amdgcn_cvt_pk_f32_fp8((int)w.y, false), d = __builtin_amdgcn_cvt_pk_f32_fp8((int)w.y, true);
    f[0] = a.x; f[1] = a.y; f[2] = b.x; f[3] = b.y; f[4] = c.x; f[5] = c.y; f[6] = d.x; f[7] = d.y; }
__device__ __forceinline__ u32x4 pack8(const float (&f)[8]) { u32x4 w; w.x = pk2(f[0], f[1]); w.y = pk2(f[2], f[3]); w.z = pk2(f[4], f[5]); w.w = pk2(f[6], f[7]); return w; }

template <class T> struct GP { __attribute__((address_space(1))) T* p;
    __host__ __device__ __forceinline__ GP& operator=(T* q) { p = (__attribute__((address_space(1))) T*)q; return *this; }
    __device__ __forceinline__ operator T*() const { return (T*)p; } };
struct Params {
    GP<const float> x, c, ctx, c_ctx, mod_w, mod_b, norm1_g, norm2_g, w_in, merge_b, m_conv_w, m_conv_b, m_gate_b, m_norm_g;
    GP<const float> a_qnorm_g, a_knorm_g, a_lambda, a_subln_g, h_conv_w, h_conv_b, h_ffn_w1, h_ffn_b1, h_ffn_w2, h_ffn_b2, h_ffn_w3;
    GP<const float> h_freq, h_decay, h_bias, w_br_m, w_br_a, w_br_h, w_out, router_w, router_b, e_w1, e_w3, e_w2;
    GP<float> out;
    GP<unsigned> bar; GP<int> cnt; GP<int> cur; GP<float> sumsq; GP<float> sumsqC;
    GP<float> modv; GP<float> hdn2; GP<float> G; GP<float> xc; GP<int> sel_e; GP<float> sel_w; GP<int> posbuf; GP<int> rowidx;
    GP<float> scal; GP<float> ms; GP<float> dn; GP<float> nst; GP<float> hfC; GP<float> hbC;
    GP<bf16_t> Wt_in, Wt_br, Wt_out, hn, Y3;
    GP<unsigned char> R;
};

__device__ __forceinline__ const float* resid_row_in(const Params& p, int layer, int s) {
    const int b = s / SEQB, pos = s - b * SEQB;
    if (pos < LC) return (layer == 0 ? p.ctx : p.xc) + (size_t)(b * LC + pos) * DM;
    return (layer == 0 ? p.x : p.out) + (size_t)(b * LL + pos - LC) * DM; }
__device__ __forceinline__ float* resid_row(const Params& p, int s) {
    const int b = s / SEQB, pos = s - b * SEQB;
    if (pos < LC) return p.xc + (size_t)(b * LC + pos) * DM;
    return p.out + (size_t)(b * LL + pos - LC) * DM; }
__device__ __forceinline__ const float* modvec(const Params& p, int layer, int s) { const int b = s / SEQB, pos = s - b * SEQB; return p.modv + (size_t)(layer * 3 + (pos < LC ? 2 : b)) * 6144; }

struct MapWin { const float* w;
    __device__ __forceinline__ const float* operator()(int n0, int cb, int k) const { int col;
        if (n0 < 6144) col = 4112 + n0;
        else if (n0 < 6656) col = 12304 + (n0 - 6144);
        else if (n0 < 12800) { const int m = n0 - 6656, d = m >> 10; col = (d < 4 ? 1024 * d : (d == 4 ? 10256 : 11280)) + (m & 1023); }
        else col = 12304 + 512 + (n0 - 12800);
        return w + (size_t)k * 13328 + col + cb * 4; } };
struct MapPlain { const float* w; int ld;
    __device__ __forceinline__ const float* operator()(int n0, int cb, int k) const { return w + (size_t)k * ld + n0 + cb * 4; } };
struct MapE13 { const float* w1; long d31;
    __device__ __forceinline__ const float* operator()(int n0, int cb, int k) const { return w1 + ((cb & 1) ? d31 : 0l) + (size_t)k * 512 + (n0 >> 1) + 4 * (cb >> 1); } };
template <class MAP> __device__ __forceinline__ void xpose_tile(const MAP& map, int n0, int k0, bf16_t* dst, int K, LDSP lds) {
    LASF tl = (LASF)lds; const int tid = ltid();
    float4 v[4];
#pragma unroll
    for (int pass = 0; pass < 4; ++pass) v[pass] = *(const float4*)map(n0, tid & 15, k0 + pass * 32 + (tid >> 4));
#pragma unroll
    for (int pass = 0; pass < 4; ++pass) { const int k = pass * 32 + (tid >> 4), cb = tid & 15;
        tl[k * 65 + cb * 4 + 0] = v[pass].x; tl[k * 65 + cb * 4 + 1] = v[pass].y; tl[k * 65 + cb * 4 + 2] = v[pass].z; tl[k * 65 + cb * 4 + 3] = v[pass].w; }
    __syncthreads();
    { const int n = tid >> 3, kq = (tid & 7) * 16; float f[8], g[8];
#pragma unroll
      for (int i = 0; i < 8; ++i) { f[i] = tl[(kq + i) * 65 + n]; g[i] = tl[(kq + 8 + i) * 65 + n]; }
      bf16_t* d = dst + (size_t)(n0 + n) * K + k0 + kq;
      *(u32x4*)d = pack8(f); *(u32x4*)(d + 8) = pack8(g); }
    __syncthreads();
}
template <class MAP> __device__ __forceinline__ void xpose_mat(const MAP& map, int N, int K, bf16_t* dst, LDSP lds, int bid, int nb) {
    const int ntn = N / 64, ntk = K / 128;
    for (int ti = bid; ti < ntn * ntk; ti += nb) { const int nt = ti / ntk, kt = ti - nt * ntk; xpose_tile(map, nt * 64, kt * 128, dst, K, lds); }
}
__device__ __forceinline__ void phase_conv_small(const Params& p, int layer, LDSP lds, int bid, int nb) {
    { MapWin m{p.w_in + (size_t)layer * 1024 * 13328}; xpose_mat(m, 13312, 1024, p.Wt_in, lds, bid, nb); }
    { MapPlain m{p.w_br_m + (size_t)layer * 1048576, 1024}; xpose_mat(m, 1024, 1024, p.Wt_br + (size_t)layer * 3 * 1048576, lds, bid, nb); }
    { MapPlain m{p.w_br_a + (size_t)layer * 1048576, 1024}; xpose_mat(m, 1024, 1024, p.Wt_br + (size_t)layer * 3 * 1048576 + 1048576, lds, bid, nb); }
    { MapPlain m{p.w_br_h + (size_t)layer * 1048576, 1024}; xpose_mat(m, 1024, 1024, p.Wt_br + (size_t)layer * 3 * 1048576 + 2 * 1048576, lds, bid, nb); }
    { MapPlain m{p.w_out + (size_t)layer * 1048576, 1024}; xpose_mat(m, 1024, 1024, p.Wt_out + (size_t)layer * 1048576, lds, bid, nb); }
}
__device__ __forceinline__ void phase_conv_experts(const Params& p, int layer, bf16_t* Wt13, bf16_t* Wt2, LDSP lds, int bid, int nb) {
    for (int ti = bid; ti < 32 * 128; ti += nb) { const int e = ti >> 7, r = ti & 127, nt = r >> 3, kt = r & 7;
        MapE13 m{p.e_w1 + ((size_t)layer * 32 + e) * 524288, (long)(p.e_w3 - p.e_w1)};
        xpose_tile(m, nt * 64, kt * 128, Wt13 + (size_t)e * 1048576, 1024, lds); }
    for (int ti = bid; ti < 32 * 64; ti += nb) { const int e = ti >> 6, r = ti & 63, nt = r >> 2, kt = r & 3;
        MapPlain m{p.e_w2 + ((size_t)layer * 32 + e) * 524288, 1024};
        xpose_tile(m, nt * 64, kt * 128, Wt2 + (size_t)e * 524288, 512, lds); }
}

__device__ __forceinline__ void phase_modvec(const Params& p, LDSP lds, int bid, int nb) {
    LASF red = (LASF)lds; const int tid = ltid();
    for (int u = bid; u < 192; u += nb) {
        const int l = u / 96, cg = u - l * 96, col = tid & 63, ks = tid >> 6;
        const float* W = p.mod_w + (size_t)l * 1024 * 6144 + cg * 64 + col;
        float a0 = 0.f, a1 = 0.f, a2 = 0.f;
        for (int k0 = ks * 128; k0 < ks * 128 + 128; k0 += 16) { float w[16], c0[16], c1[16], c2[16];
#pragma unroll
            for (int j = 0; j < 16; ++j) { w[j] = W[(size_t)(k0 + j) * 6144]; c0[j] = p.c[k0 + j]; c1[j] = p.c[1024 + k0 + j]; c2[j] = p.c_ctx[k0 + j]; }
#pragma unroll
            for (int j = 0; j < 16; ++j) { a0 += siluf_(c0[j]) * w[j]; a1 += siluf_(c1[j]) * w[j]; a2 += siluf_(c2[j]) * w[j]; } }
        red[(ks * 3 + 0) * 64 + col] = a0; red[(ks * 3 + 1) * 64 + col] = a1; red[(ks * 3 + 2) * 64 + col] = a2;
        __syncthreads();
        if (tid < 192) { const int v = tid >> 6, cc = tid & 63; float s = p.mod_b[l * 6144 + cg * 64 + cc];
#pragma unroll
            for (int q = 0; q < 8; ++q) s += red[(q * 3 + v) * 64 + cc];
            p.modv[(size_t)(l * 3 + v) * 6144 + cg * 64 + cc] = s; }
        __syncthreads();
    }
}

__device__ __forceinline__ void phase_hdn(const Params& p, LDSP lds, int bid, int nb) {
    LASF w1s = (LASF)lds, b1s = w1s + 33 * 64, w2s = b1s + 64, b2s = w2s + 64 * 64, frs = b2s + 64, hbuf = frs + 64;
    const int tid = ltid();
    for (int u = bid; u < 132; u += nb) {
        const int l = u / 66, pu = u - l * 66;
        for (int i = tid; i < 33 * 64; i += NTH) w1s[i] = p.h_ffn_w1[l * 33 * 64 + i];
        for (int i = tid; i < 64 * 64; i += NTH) w2s[i] = p.h_ffn_w2[l * 4096 + i];
        if (tid < 64) { b1s[tid] = p.h_ffn_b1[l * 64 + tid]; b2s[tid] = p.h_ffn_b2[l * 64 + tid]; frs[tid] = p.h_freq[l * 64 + tid]; }
        __syncthreads();
        const int pos = tid >> 2, qd = tid & 3, q = pu * 128 + pos;
        const int Lf = q < 8192 ? 8192 : 256, t = q < 8192 ? q : q - 8192;
        float z[33];
        z[0] = (float)t / (float)(Lf - 1);
        const float wrev = (float)t / (float)Lf;
#pragma unroll
        for (int j = 0; j < 16; ++j) { const float f = 1e-4f + (float)j * ((15.0f - 1e-4f) / 15.0f); float ph = f * wrev; ph -= floorf(ph); z[1 + j] = cos2pi(ph); z[17 + j] = -sin2pi(ph); }
#pragma unroll
        for (int jj = 0; jj < 16; ++jj) { const int j = qd * 16 + jj; float a = b1s[j];
#pragma unroll
            for (int i = 0; i < 33; ++i) a += z[i] * w1s[i * 64 + j];
            hbuf[pos * 65 + j] = sinf(frs[j] * a); }
        __syncthreads();
        float acc[16];
#pragma unroll
        for (int jj = 0; jj < 16; ++jj) acc[jj] = b2s[qd * 16 + jj];
        for (int i = 0; i < 64; ++i) { const float hv = hbuf[pos * 65 + i];
#pragma unroll
            for (int jj = 0; jj < 16; ++jj) acc[jj] += hv * w2s[i * 64 + qd * 16 + jj]; }
#pragma unroll
        for (int jj = 0; jj < 16; ++jj) p.hdn2[((size_t)l * 8448 + q) * 64 + qd * 16 + jj] = sinf(frs[qd * 16 + jj] * acc[jj]);
        __syncthreads();
    }
}
__device__ __forceinline__ void phase_taps(const Params& p, int layer, bf16_t* tapsT, LDSP lds, int bid, int nb) {
    LASF wsum = (LASF)lds;
    const int nunits = 512 + (layer == 0 ? 64 : 0);
    const float* w3 = UP((const float*)p.h_ffn_w3 + (size_t)layer * 64 * 2048); const float* hd = UP((const float*)p.hdn2 + (size_t)layer * 8448 * 64);
    const float* decp = UP((const float*)p.h_decay + layer * 2048);
    for (int u = bid; u < nunits; u += nb) {
        const int tid = ltid(), lane = tid & 63, r32 = lane & 31, hi = lane >> 5; const int wid = __builtin_amdgcn_readfirstlane(tid >> 6);
        const bool isc = u >= 512; const int cgp = isc ? u - 512 : (u >> 3), tch = isc ? 0 : (u & 7);
        const int Lf = isc ? 256 : 8192; const float rL = 1.0f / (float)(Lf - 1);
        bf16x8 afh[4], afl[4];
#pragma unroll
        for (int kk = 0; kk < 4; ++kk) { float a[8], lo[8]; u32x4 wh, wl;
#pragma unroll
            for (int j = 0; j < 8; ++j) a[j] = w3[(size_t)(16 * kk + 8 * hi + j) * 2048 + 32 * cgp + r32];
            wh = pack8(a);
            { float ah[8]; unpack8(wh, ah);
#pragma unroll
              for (int j = 0; j < 8; ++j) lo[j] = a[j] - ah[j]; }
            wl = pack8(lo); afh[kk] = __builtin_bit_cast(bf16x8, wh); afl[kk] = __builtin_bit_cast(bf16x8, wl); }
        float dcy[16], ss[16];
#pragma unroll
        for (int r = 0; r < 16; ++r) { dcy[r] = fabsf(decp[32 * cgp + crow(r, hi)]); ss[r] = 0.f; }
        const int ntb = isc ? 1 : 4;
        for (int tb = 0; tb < ntb; ++tb) {
            const int t0 = isc ? 32 * wid : tch * 1024 + (4 * wid + tb) * 32, t = t0 + r32;
            const float* hr = hd + (size_t)(isc ? 8192 + t : t) * 64;
            f32x4 hv[8];
#pragma unroll
            for (int i = 0; i < 4; ++i) { hv[2 * i] = *(const f32x4*)(hr + 16 * i + 8 * hi); hv[2 * i + 1] = *(const f32x4*)(hr + 16 * i + 8 * hi + 4); }
            f32x16 acc;
#pragma unroll
            for (int r = 0; r < 16; ++r) acc[r] = 0.f;
#pragma unroll
            for (int kk = 0; kk < 4; ++kk) { float b[8], lo[8];
                const f32x4 q0 = hv[2 * kk], q1 = hv[2 * kk + 1];
                b[0] = q0.x; b[1] = q0.y; b[2] = q0.z; b[3] = q0.w; b[4] = q1.x; b[5] = q1.y; b[6] = q1.z; b[7] = q1.w;
                const u32x4 wh = pack8(b); float bh[8]; unpack8(wh, bh);
#pragma unroll
                for (int j = 0; j < 8; ++j) lo[j] = b[j] - bh[j];
                const u32x4 wl = pack8(lo); const bf16x8 bfh = __builtin_bit_cast(bf16x8, wh), bfl = __builtin_bit_cast(bf16x8, wl);
                acc = __builtin_amdgcn_mfma_f32_32x32x16_bf16(afh[kk], bfh, acc, 0, 0, 0);
                acc = __builtin_amdgcn_mfma_f32_32x32x16_bf16(afh[kk], bfl, acc, 0, 0, 0);
                acc = __builtin_amdgcn_mfma_f32_32x32x16_bf16(afl[kk], bfh, acc, 0, 0, 0); }
            const float tl = (float)t * rL;
#pragma unroll
            for (int r = 0; r < 16; ++r) { const float a = acc[r] * __expf(-tl * dcy[r]); ss[r] += a * a;
                const int col = 32 * cgp + crow(r, hi);
                if (isc) { if (col < 1024) p.hfC[col * 256 + t] = a; else p.hbC[(col - 1024) * 256 + t] = a; }
                else if (col < 1024) tapsT[(size_t)col * 16384 + t] = f2bf(a);
                else { if (t > 0) tapsT[(size_t)(col - 1024) * 16384 + 16384 - t] = f2bf(a); else tapsT[(size_t)(col - 1024) * 16384 + 8192] = 0; } }
        }
#pragma unroll
        for (int r = 0; r < 16; ++r) { float v = ss[r];
#pragma unroll
            for (int o = 16; o >= 1; o >>= 1) v += __shfl_xor(v, o);
            if (r32 == 0) wsum[wid * 32 + crow(r, hi)] = v; }
        __syncthreads();
        if (tid < 32) { float tot = 0.f;
#pragma unroll
            for (int w = 0; w < 8; ++w) tot += wsum[w * 32 + tid];
            if (isc) p.sumsqC[2048 + 32 * cgp + tid] = tot; else p.sumsq[((size_t)(layer * 64 + cgp) * 8 + tch) * 32 + tid] = tot; }
        __syncthreads();
    }
}

__device__ __forceinline__ void phase_norm1(const Params& p, int layer, LDSP lds, int bid, int nb) {
    LASF wg = (LASF)lds;
    const int tid = ltid(), lane = tid & 63, wid = tid >> 6;
    { float4 wv[8];
#pragma unroll
      for (int j = 0; j < 8; ++j) { const int i = tid + NTH * j; wv[j] = *(const float4*)(p.w_in + (size_t)layer * 1024 * 13328 + (size_t)(i >> 2) * 13328 + 4096 + (i & 3) * 4); }
#pragma unroll
      for (int j = 0; j < 8; ++j) { const int i = tid + NTH * j, n = i >> 2, j4 = (i & 3) * 4; wg[n * 20 + j4] = wv[j].x; wg[n * 20 + j4 + 1] = wv[j].y; wg[n * 20 + j4 + 2] = wv[j].z; wg[n * 20 + j4 + 3] = wv[j].w; } }
    __syncthreads();
    const float* gn = p.norm1_g + layer * 1024;
    for (int s = bid * 8 + wid; s < TT; s += nb * 8) {
        const float* xr = resid_row_in(p, layer, s); const float* mv = modvec(p, layer, s);
        float xv[16], gv[16], scv[16], shv[16]; float ssq = 0.f;
#pragma unroll
        for (int i = 0; i < 16; ++i) { const int n = lane + 64 * i; xv[i] = xr[n]; gv[i] = gn[n]; scv[i] = mv[1024 + n]; shv[i] = mv[n]; }
#pragma unroll
        for (int i = 0; i < 16; ++i) ssq += xv[i] * xv[i];
        ssq = wave_sum(ssq); const float rstd = rsqrtf(ssq * (1.0f / 1024.0f) + EPS_);
        float acc[16];
#pragma unroll
        for (int j = 0; j < 16; ++j) acc[j] = 0.f;
#pragma unroll
        for (int i = 0; i < 16; ++i) { const int n = lane + 64 * i; const float hv = xv[i] * rstd * gv[i] * (1.0f + scv[i]) + shv[i];
            p.hn[(size_t)s * 1024 + n] = f2bf(hv);
#pragma unroll
            for (int j4 = 0; j4 < 4; ++j4) { const f32x4 w = *(const PG8_LAS f32x4*)(wg + n * 20 + 4 * j4); acc[4 * j4] += hv * w.x; acc[4 * j4 + 1] += hv * w.y; acc[4 * j4 + 2] += hv * w.z; acc[4 * j4 + 3] += hv * w.w; }
            if (i & 1) __builtin_amdgcn_sched_barrier(0); }
        wave_sum16(acc);
        if ((lane & 15) == 0) { f32x4 g4; g4[0] = acc[0]; g4[1] = acc[1]; g4[2] = acc[2]; g4[3] = acc[3]; *(f32x4*)(p.G + (size_t)s * 16 + (lane >> 4) * 4) = g4; }
    }
    __syncthreads();
}

__device__ __forceinline__ void phase_attn_prep(const Params& p, int layer, bf16_t* aq, bf16_t* ak, int bid, int nb) {
    const int tid = ltid(), lane = tid & 63, wid = tid >> 6;
    const int grp = lane >> 2, i4 = lane & 3;
    const float* qg = p.a_qnorm_g + layer * 64; const float* kg = p.a_knorm_g + layer * 64;
    float gq[16], gk[16];
#pragma unroll
    for (int c = 0; c < 4; ++c)
#pragma unroll
        for (int e = 0; e < 4; ++e) { gq[c * 4 + e] = qg[16 * c + 4 * i4 + e]; gk[c * 4 + e] = kg[16 * c + 4 * i4 + e]; }
    float inv[4];
#pragma unroll
    for (int e = 0; e < 4; ++e) inv[e] = exp2f(-(float)(4 * i4 + e) * (13.287712379549449f / 16.0f));
    const float qscale = 0.125f * 1.4426950408889634f;
    for (int s = bid * 8 + wid; s < TT; s += nb * 8) {
        const int b = s / SEQB, pos = s - b * SEQB; const bool lat = pos >= LC; const int t = pos - LC;
        float cs[8], sn[8];
        if (lat) { const float rowf = (float)(t >> 6), colf = (float)(t & 63);
#pragma unroll
            for (int e = 0; e < 4; ++e) { float ar = rowf * inv[e] * INV2PI, ac = colf * inv[e] * INV2PI; ar -= floorf(ar); ac -= floorf(ac);
                cs[e] = cos2pi(ar); sn[e] = sin2pi(ar); cs[4 + e] = cos2pi(ac); sn[4 + e] = sin2pi(ac); } }
        u32x2 wqk[2][4];
#pragma unroll
        for (int which = 0; which < 2; ++which)
#pragma unroll
            for (int c = 0; c < 4; ++c) wqk[which][c] = *(const u32x2*)((which ? ak : aq) + (size_t)s * 1024 + grp * 64 + 4 * i4 + 16 * c);
#pragma unroll
        for (int which = 0; which < 2; ++which) {
            bf16_t* base = (which ? ak : aq) + (size_t)s * 1024 + grp * 64 + 4 * i4;
            float v[16]; float ssq = 0.f;
#pragma unroll
            for (int c = 0; c < 4; ++c) { const u32x2 w = wqk[which][c]; v[4 * c] = lo16(w.x); v[4 * c + 1] = hi16(w.x); v[4 * c + 2] = lo16(w.y); v[4 * c + 3] = hi16(w.y); }
#pragma unroll
            for (int i = 0; i < 16; ++i) ssq += v[i] * v[i];
            ssq += __shfl_xor(ssq, 1); ssq += __shfl_xor(ssq, 2);
            const float rstd = rsqrtf(ssq * (1.0f / 64.0f) + EPS_) * (which ? 1.0f : qscale);
#pragma unroll
            for (int i = 0; i < 16; ++i) v[i] = v[i] * rstd * (which ? gk[i] : gq[i]);
            if (lat) {
#pragma unroll
                for (int hf = 0; hf < 2; ++hf)
#pragma unroll
                    for (int e = 0; e < 4; ++e) { const float x1 = v[8 * hf + e], x2 = v[8 * hf + 4 + e], cc = cs[4 * hf + e], sv = sn[4 * hf + e];
                        v[8 * hf + e] = x1 * cc - x2 * sv; v[8 * hf + 4 + e] = x2 * cc + x1 * sv; }
            }
#pragma unroll
            for (int c = 0; c < 4; ++c) { u32x2 w; w.x = pk2(v[4 * c], v[4 * c + 1]); w.y = pk2(v[4 * c + 2], v[4 * c + 3]); *(u32x2*)(base + 16 * c) = w; }
        }
    }
}

__device__ __forceinline__ s16x4 vtr16(const PG8_LAS unsigned char* ptr) {
    typedef short v4i16_t __attribute__((ext_vector_type(4)));
    return __builtin_bit_cast(s16x4, __builtin_amdgcn_ds_read_tr16_b64_v4i16((PG8_LAS v4i16_t*)ptr)); }

__device__ __forceinline__ void glds16(const void* gsrc, unsigned lds_dst) { unsigned keep;
    asm volatile("s_mov_b32 %0, m0\n\ts_mov_b32 m0, %2\n\ts_nop 0\n\tglobal_load_lds_dwordx4 %1, off\n\ts_mov_b32 m0, %0" : "=&s"(keep) : "v"(gsrc), "s"(lds_dst) : "memory"); }
__device__ __forceinline__ float max3f_(float a, float b, float c) { float r; asm("v_max3_f32 %0, %1, %2, %3" : "=v"(r) : "v"(a), "v"(b), "v"(c)); return r; }
#define ATT_WAIT_BAR(N) asm volatile("s_waitcnt vmcnt(" #N ") lgkmcnt(0)\n\ts_barrier" ::: "memory")
__device__ __forceinline__ void attn_unit(const Params& p, int layer, const bf16_t* Q, const bf16_t* K, const bf16_t* V, bf16_t* O, int b, int h, int q0pos, int nkeys, float lam, float lam_init, LDSP lds) {
    const int tid = ltid(), lane = tid & 63, r32 = lane & 31, hi = lane >> 5; const int wid = __builtin_amdgcn_readfirstlane(tid >> 6), comp = wid >> 2, qblk = wid & 3;
    const size_t rowb = (size_t)b * SEQB;
    const bf16_t* qrow = Q + (rowb + q0pos + 32 * qblk + r32) * 1024 + h * 128 + comp * 64 + hi * 8;
    bf16x8 qf[4];
#pragma unroll
    for (int d0 = 0; d0 < 4; ++d0) qf[d0] = *(const bf16x8*)(qrow + d0 * 16);
    f32x16 o[4];
#pragma unroll
    for (int d0 = 0; d0 < 4; ++d0)
#pragma unroll
        for (int r = 0; r < 16; ++r) o[d0][r] = 0.f;
    float l = 0.f;
    const f32x16 zero16 = {0.f, 0.f, 0.f, 0.f, 0.f, 0.f, 0.f, 0.f, 0.f, 0.f, 0.f, 0.f, 0.f, 0.f, 0.f, 0.f};
    const int ntiles = nkeys >> 6;
    const unsigned lds0 = (unsigned)(uintptr_t)(unsigned char*)lds;
    const int krow0 = 8 * wid + (lane >> 4), krow1 = krow0 + 4, kpos = lane & 15;
    const unsigned kvo0 = (unsigned)(krow0 * 1024 + ((kpos ^ (krow0 & 15)) * 8)) * 2u, kvo1 = (unsigned)(krow1 * 1024 + ((kpos ^ (krow1 & 15)) * 8)) * 2u - 1024u;
    const unsigned vvo0 = (unsigned)((16 * ((2 * wid) & 3) + (lane >> 2)) * 1024 + ((2 * wid) >> 2) * 32 + (lane & 3) * 8) * 2u;
    const unsigned vvo1 = (unsigned)((16 * ((2 * wid + 1) & 3) + (lane >> 2)) * 1024 + ((2 * wid + 1) >> 2) * 32 + (lane & 3) * 8) * 2u - 1024u;
    const bf16_t* kub = K + rowb * 1024 + h * 128; const bf16_t* vub = V + rowb * 1024 + h * 128;
    const unsigned kd0 = lds0 + (2 * wid) * 1024, vd0 = lds0 + 16384 + (2 * wid) * 1024;
#define ATT_DMA2(sb, va, vb_, m0v) asm volatile("s_mov_b32 m0, %3\n\ts_nop 0\n\tglobal_load_lds_dwordx4 %0, %2\n\tglobal_load_lds_dwordx4 %1, %2 offset:1024" :: "v"(va), "v"(vb_), "s"(sb), "s"(m0v) : "memory", "m0")
#define ATT_DMA(t, slot) do { const size_t to_ = (size_t)(t) * 64 * 1024; const unsigned so_ = (unsigned)(slot) * 32768u; \
        ATT_DMA2(kub + to_, kvo0, kvo1, (unsigned)__builtin_amdgcn_readfirstlane(kd0 + so_)); ATT_DMA2(vub + to_, vvo0, vvo1, (unsigned)__builtin_amdgcn_readfirstlane(vd0 + so_)); } while (0)
    asm volatile("" : "+v"(qf[0]), "+v"(qf[1]), "+v"(qf[2]), "+v"(qf[3]));
    ATT_DMA(0, 0); ATT_DMA(1, 1); ATT_DMA(2, 2);
    ATT_WAIT_BAR(4);
    const PG8_LAS unsigned char* kbase = lds + r32 * 256; const int kx0 = ((comp * 8 + hi) ^ (r32 & 15)) << 4;
    const PG8_LAS unsigned char* vbase = lds + 16384 + ((lane >> 4) & 1) * 32 + (lane & 3) * 8 + (4 * hi + ((lane & 15) >> 2)) * 64;
    bf16x8 vbA[4], vbB[4], kb[4], pfA, pfB; f32x16 S0, S1; float la = 0.f, lb = 0.f;
#define ATT_SB __builtin_amdgcn_sched_barrier(0)
#define ATT_VLD(vb, Vp, ks) do { _Pragma("unroll") for (int d0 = 0; d0 < 4; ++d0) { const s16x4 lo = vtr16((Vp) + d0 * 4096 + (ks) * 1024), hh = vtr16((Vp) + d0 * 4096 + (ks) * 1024 + 512); \
        vb[d0] = (bf16x8){lo[0], lo[1], lo[2], lo[3], hh[0], hh[1], hh[2], hh[3]}; } } while (0)
#define ATT_KLD(Kp, half) do { _Pragma("unroll") for (int d0 = 0; d0 < 4; ++d0) kb[d0] = *(const PG8_LAS bf16x8*)((Kp) + (kx0 ^ (d0 << 5)) + (half) * 8192); } while (0)
#define ATT_STAGE(vbU, pfU, DOQK, QS, DOEXP, ES, off, pfN) do { unsigned w_[4]; \
        _Pragma("unroll") for (int g = 0; g < 4; ++g) { \
            o[g] = __builtin_amdgcn_mfma_f32_32x32x16_bf16(vbU[g], pfU, o[g], 0, 0, 0); \
            if (DOQK) QS = __builtin_amdgcn_mfma_f32_32x32x16_bf16(kb[g], qf[g], g ? QS : zero16, 0, 0, 0); \
            if (DOEXP) { const float ea_ = __builtin_amdgcn_exp2f(ES[(off) + 2 * g]), eb_ = __builtin_amdgcn_exp2f(ES[(off) + 2 * g + 1]); la += ea_; lb += eb_; w_[g] = pk2(ea_, eb_); } \
              \
            asm volatile("" : "+v"(o[g]), "+v"(pfU)); \
            if (DOQK) asm volatile("" : "+v"(QS)); \
            if (DOEXP) asm volatile("" : "+v"(w_[g]), "+v"(ES), "+v"(la), "+v"(lb)); \
            ATT_SB; } \
        if (DOEXP) { u32x4 wv_; wv_.x = w_[0]; wv_.y = w_[1]; wv_.z = w_[2]; wv_.w = w_[3]; pfN = __builtin_bit_cast(bf16x8, wv_); } } while (0)
    { ATT_KLD(kbase, 0);
#pragma unroll
      for (int d0 = 0; d0 < 4; ++d0) S0 = __builtin_amdgcn_mfma_f32_32x32x16_bf16(kb[d0], qf[d0], d0 ? S0 : zero16, 0, 0, 0);
      ATT_KLD(kbase, 1);
#pragma unroll
      for (int d0 = 0; d0 < 4; ++d0) S1 = __builtin_amdgcn_mfma_f32_32x32x16_bf16(kb[d0], qf[d0], d0 ? S1 : zero16, 0, 0, 0);
      ATT_VLD(vbA, vbase, 0);
      u32x4 w_;
#pragma unroll
      for (int g = 0; g < 4; ++g) { const float ea_ = __builtin_amdgcn_exp2f(S0[2 * g]), eb_ = __builtin_amdgcn_exp2f(S0[2 * g + 1]); la += ea_; lb += eb_; w_[g] = pk2(ea_, eb_); }
      pfA = __builtin_bit_cast(bf16x8, w_); ATT_SB; }
#define ATT_TILE(NX) do { const PG8_LAS unsigned char* Vs_ = vbase + (t & 3) * 32768; const PG8_LAS unsigned char* Vn_ = vbase + ((t + 1) & 3) * 32768; const PG8_LAS unsigned char* Kn_ = kbase + ((t + 1) & 3) * 32768; \
        ATT_VLD(vbB, Vs_, 1); if (NX) ATT_KLD(Kn_, 0); \
        { const int td = t + 3 < ntiles ? t + 3 : ntiles - 1; ATT_DMA(td, (t + 3) & 3); } ATT_SB; \
        ATT_STAGE(vbA, pfA, 0, S0, 1, S0, 8, pfB); \
        ATT_VLD(vbA, Vs_, 2); ATT_SB; \
        ATT_STAGE(vbB, pfB, NX, S0, 1, S1, 0, pfA); \
        ATT_VLD(vbB, Vs_, 3); if (NX) ATT_KLD(Kn_, 1); ATT_SB; \
        ATT_STAGE(vbA, pfA, 0, S1, 1, S1, 8, pfB); \
        if (NX) ATT_VLD(vbA, Vn_, 0); ATT_SB; \
        ATT_STAGE(vbB, pfB, NX, S1, NX, S0, 0, pfA); \
        ATT_WAIT_BAR(4); } while (0)
    int t = 0;
    for (; t < ntiles - 1; ++t) ATT_TILE(1);
    ATT_TILE(0);
    ATT_WAIT_BAR(0);
    l = la + lb;
#undef ATT_SB
#undef ATT_VLD
#undef ATT_KLD
#undef ATT_STAGE
#undef ATT_TILE
#undef ATT_DMA
#undef ATT_DMA2
    l += __shfl_xor(l, 32);
    const float rl = 1.0f / l;
    LASF xch = (LASF)(lds) + qblk * 4096;
    if (comp == 1) {
#pragma unroll
        for (int d0 = 0; d0 < 4; ++d0)
#pragma unroll
            for (int r = 0; r < 16; ++r) xch[(32 * d0 + crow(r, hi)) * 32 + r32] = o[d0][r] * rl;
    }
    __syncthreads();
    if (comp == 0) {
        float ssq = 0.f;
#pragma unroll
        for (int d0 = 0; d0 < 4; ++d0)
#pragma unroll
            for (int r = 0; r < 16; ++r) { const float y = o[d0][r] * rl - lam * xch[(32 * d0 + crow(r, hi)) * 32 + r32]; o[d0][r] = y; ssq += y * y; }
        ssq += __shfl_xor(ssq, 32);
        const float sc = rsqrtf(ssq * (1.0f / 128.0f) + EPS_) * (1.0f - lam_init);
        const float* sg = p.a_subln_g + layer * 128;
        bf16_t* orow = O + (rowb + q0pos + 32 * qblk + r32) * 1024 + h * 128;
#pragma unroll
        for (int d0 = 0; d0 < 4; ++d0)
#pragma unroll
            for (int r4 = 0; r4 < 4; ++r4) { const int d = 32 * d0 + 8 * r4 + 4 * hi; u32x2 w;
                w.x = pk2(o[d0][4 * r4] * sc * sg[d], o[d0][4 * r4 + 1] * sc * sg[d + 1]); w.y = pk2(o[d0][4 * r4 + 2] * sc * sg[d + 2], o[d0][4 * r4 + 3] * sc * sg[d + 3]);
                *(u32x2*)(orow + d) = w; }
    }
    __syncthreads();
}
__device__ __forceinline__ void phase_attn(const Params& p, int layer, const bf16_t* Q, const bf16_t* K, const bf16_t* V, bf16_t* O, LDSP lds, int bid, int nb) {
    const float lam_init = 0.8f - 0.6f * expf(-0.3f * (float)layer);
    const float* lp = p.a_lambda + layer * 256; float d1 = 0.f, d2 = 0.f;
    for (int i = 0; i < 64; ++i) { d1 += lp[i] * lp[64 + i]; d2 += lp[128 + i] * lp[192 + i]; }
    const float lam = expf(d1) - expf(d2) + lam_init;
    const int nunits = 1024 + (layer == 0 ? 32 : 0);
    for (int u = bid; u < nunits; u += nb) {
        if (u < 1024) { int bh = u >> 6, qb = u & 63;
            if (nb == 256) { const int x = bid & 7; bh = (x >> 1) + 4 * (u >> 8); qb = (x & 1) * 32 + (bid >> 3); }
            attn_unit(p, layer, Q, K, V, O, bh >> 3, bh & 7, LC + qb * 128, SEQB, lam, lam_init, lds); }
        else { const int v = u - 1024, bh = v >> 1, qb = v & 1; attn_unit(p, layer, Q, K, V, O, bh >> 3, bh & 7, qb * 128, LC, lam, lam_init, lds); }
    }
}

__device__ __forceinline__ int scan_idx(int dir, int c) { return dir == 0 ? c : (c < 2 ? 1 - c : 67 - c); }

__device__ __forceinline__ void load_gates(const Params& p, int layer, size_t row0, int h, LASF tb) {
    const int tid = ltid();
    if (tid < 128) { const float* g = p.G + (row0 + tid) * 16; const float* gb = p.m_gate_b + layer * 16;
        tb[tid] = g[h] + gb[h]; tb[128 + tid] = logsigf_(g[4 + h] + gb[4 + h]); tb[256 + tid] = g[8 + h] + gb[8 + h]; tb[384 + tid] = logsigf_(g[12 + h] + gb[12 + h]); }
}

__device__ __forceinline__ float wave_scan_sum(float v, int lane) {
#pragma unroll
    for (int o = 1; o < 64; o <<= 1) { const float y = __shfl_up(v, o); if (lane >= o) v += y; }
    return v; }
__device__ __forceinline__ float wave_scan_max(float v, int lane) {
#pragma unroll
    for (int o = 1; o < 64; o <<= 1) { const float y = __shfl_up(v, o); if (lane >= o) v = fmaxf(v, y); }
    return v; }

__device__ __forceinline__ void mconv8(const u32x4 rp, const u32x4 rc, const u32x4 rn, const float* cw, const float* cb, int cc, float scale, float (&o)[8]) {
    float up[8], uc[8], un[8]; unpack8(rp, up); unpack8(rc, uc); unpack8(rn, un);
    const f32x4 b0 = *(const f32x4*)(cb + cc), b1 = *(const f32x4*)(cb + cc + 4), w00 = *(const f32x4*)(cw + cc), w01 = *(const f32x4*)(cw + cc + 4);
    const f32x4 w10 = *(const f32x4*)(cw + 2048 + cc), w11 = *(const f32x4*)(cw + 2048 + cc + 4), w20 = *(const f32x4*)(cw + 4096 + cc), w21 = *(const f32x4*)(cw + 4096 + cc + 4);
#pragma unroll
    for (int i = 0; i < 4; ++i) { o[i] = siluf_(b0[i] + up[i] * w00[i] + uc[i] * w10[i] + un[i] * w20[i]) * scale; o[4 + i] = siluf_(b1[i] + up[4 + i] * w01[i] + uc[4 + i] * w11[i] + un[4 + i] * w21[i]) * scale; }
}
__device__ __forceinline__ void phase_mA(const Params& p, int layer, const bf16_t* mk_, const bf16_t* mv_, bf16_t* vT_, bf16_t* ST_, LDSP lds, int bid, int nb) {
    const bf16_t* mk = UP(mk_); const bf16_t* mv = UP(mv_); bf16_t* vT = UP(vT_); bf16_t* ST = UP(ST_);
    constexpr int RS = 576;
    LDSP Kt = lds; LDSP Vt = lds + 128 * RS;
    LASF tb = (LASF)(lds + 256 * RS);
    LASF part = tb + 512;
    const float* gbias = UP((const float*)p.m_gate_b + layer * 16); const float* Gp = UP((const float*)p.G);
    const float* cw = UP((const float*)p.m_conv_w + (size_t)layer * 3 * 2048); const float* cb = UP((const float*)p.m_conv_b + layer * 2048);
    float* scalp = UP((float*)p.scal); float* dnp = UP((float*)p.dn);
    for (int u = bid; u < 8 * 66; u += nb) {
        const int tid = ltid(), lane = tid & 63, r32 = lane & 31, hi = lane >> 5; const int wid = __builtin_amdgcn_readfirstlane(tid >> 6);
        const int c = u % 66, bh = u / 66, b = bh >> 2, h = bh & 3;
        const size_t row0 = (size_t)b * SEQB + 128 * c;
        const int idxf = scan_idx(0, c), idxb = scan_idx(1, c);
        const int tq = tid & 127, dsel = (tid >> 7) & 1;
        float li = 0.f, lf = 0.f;
        if (tid < 256) { const float* g = Gp + (row0 + tq) * 16; li = g[8 * dsel + h] + gbias[8 * dsel + h]; lf = logsigf_(g[8 * dsel + 4 + h] + gbias[8 * dsel + 4 + h]); }
        float inc = wave_scan_sum(lf, lane);
        if (lane == 63 && wid < 4) tb[256 + wid] = inc;
        __syncthreads();
        const float tot = tb[256 + 2 * dsel] + tb[257 + 2 * dsel]; if (wid == 1 || wid == 3) inc += tb[256 + wid - 1];
        const float wsv = (dsel == 0 ? tot - inc : inc - lf) + li;
        const float mxw = wave_max(tid < 256 ? wsv : -1e30f);
        if (lane == 0 && wid < 4) tb[272 + wid] = mxw;
        __syncthreads();
        { const float mloc = fmaxf(tb[272 + 2 * dsel], tb[273 + 2 * dsel]);
          if (tid < 256) tb[128 * dsel + tq] = __expf(wsv - mloc);
          if (tq == 0 && tid < 256) { float* s0 = scalp + ((size_t)(bh * 2 + dsel) * 66 + (dsel ? idxb : idxf)) * 2; s0[0] = tot; s0[1] = mloc; } }
        __syncthreads();
        const int ch8 = (tid & 31) * 8; float dnf[8], dnb[8];
#pragma unroll
        for (int e = 0; e < 8; ++e) { dnf[e] = 0.f; dnb[e] = 0.f; }
#pragma unroll
        for (int jb = 0; jb < 4; ++jb) { u32x4 rk[2][3], rv[2];
#pragma unroll
            for (int jj = 0; jj < 2; ++jj) { const int t = (tid >> 5) + 16 * (2 * jb + jj), pos = 128 * c + t; const bf16_t* src = mk + (row0 + t) * 1024 + h * 256 + ch8;
                const bool hasp = (pos != 0) && (pos != LC), hasn = (pos != LC - 1) && (pos != SEQB - 1);
                rk[jj][1] = *(const u32x4*)src; rk[jj][0] = hasp ? *(const u32x4*)(src - 1024) : (u32x4){0u, 0u, 0u, 0u}; rk[jj][2] = hasn ? *(const u32x4*)(src + 1024) : (u32x4){0u, 0u, 0u, 0u};
                rv[jj] = *(const u32x4*)(mv + (row0 + t) * 1024 + h * 256 + ch8); }
#pragma unroll
            for (int jj = 0; jj < 2; ++jj) { const int t = (tid >> 5) + 16 * (2 * jb + jj); float o[8];
                mconv8(rk[jj][0], rk[jj][1], rk[jj][2], cw, cb, 1024 + h * 256 + ch8, 0.0625f, o);
                const u32x4 kk = pack8(o); unpack8(kk, o);
                const float wf = tb[t], wb = tb[128 + t];
#pragma unroll
                for (int e = 0; e < 8; ++e) { dnf[e] += wf * o[e]; dnb[e] += wb * o[e]; }
                *(PG8_LAS u32x4*)(Kt + t * RS + ch8 * 2) = kk; *(PG8_LAS u32x4*)(Vt + t * RS + ch8 * 2) = rv[jj]; } }
#pragma unroll
        for (int e = 0; e < 8; ++e) { dnf[e] += __shfl_xor(dnf[e], 32); dnb[e] += __shfl_xor(dnb[e], 32); }
        if (hi == 0) {
#pragma unroll
            for (int e = 0; e < 8; ++e) part[wid * 256 + ch8 + e] = dnf[e]; }
        __syncthreads();
        if (tid < 256) { float sm = 0.f;
#pragma unroll
            for (int w = 0; w < 8; ++w) sm += part[w * 256 + tid];
            dnp[((size_t)(bh * 2) * 66 + idxf) * 256 + tid] = sm; }
        __syncthreads();
        if (hi == 0) {
#pragma unroll
            for (int e = 0; e < 8; ++e) part[wid * 256 + ch8 + e] = dnb[e]; }
#pragma unroll
        for (int it = 0; it < 2; ++it) { const int item = tid + NTH * it, dp = item >> 3, tg = item & 7;
            const PG8_LAS unsigned* srcl = (const PG8_LAS unsigned*)(Vt + (16 * tg) * RS + 4 * dp);
            bf16_t* dst = vT + ((size_t)(bh * 256 + 2 * dp)) * SEQB + 128 * c + 16 * tg;
            unsigned w[16];
#pragma unroll
            for (int i = 0; i < 16; ++i) w[i] = srcl[i * (RS / 4)];
            u32x4 lo0, lo1, hi0, hi1;
            lo0.x = __builtin_amdgcn_perm(w[1], w[0], 0x05040100u); lo0.y = __builtin_amdgcn_perm(w[3], w[2], 0x05040100u); lo0.z = __builtin_amdgcn_perm(w[5], w[4], 0x05040100u); lo0.w = __builtin_amdgcn_perm(w[7], w[6], 0x05040100u);
            lo1.x = __builtin_amdgcn_perm(w[9], w[8], 0x05040100u); lo1.y = __builtin_amdgcn_perm(w[11], w[10], 0x05040100u); lo1.z = __builtin_amdgcn_perm(w[13], w[12], 0x05040100u); lo1.w = __builtin_amdgcn_perm(w[15], w[14], 0x05040100u);
            hi0.x = __builtin_amdgcn_perm(w[1], w[0], 0x07060302u); hi0.y = __builtin_amdgcn_perm(w[3], w[2], 0x07060302u); hi0.z = __builtin_amdgcn_perm(w[5], w[4], 0x07060302u); hi0.w = __builtin_amdgcn_perm(w[7], w[6], 0x07060302u);
            hi1.x = __builtin_amdgcn_perm(w[9], w[8], 0x07060302u); hi1.y = __builtin_amdgcn_perm(w[11], w[10], 0x07060302u); hi1.z = __builtin_amdgcn_perm(w[13], w[12], 0x07060302u); hi1.w = __builtin_amdgcn_perm(w[15], w[14], 0x07060302u);
            *(u32x4*)(dst) = lo0; *(u32x4*)(dst + 8) = lo1; *(u32x4*)(dst + SEQB) = hi0; *(u32x4*)(dst + SEQB + 8) = hi1; }
        const int troff = ((lane >> 4) & 1) * 32 + (lane & 3) * 8 + (4 * hi + ((lane & 15) >> 2)) * RS;
        bf16x8 Bf[8];
#pragma unroll
        for (int ks = 0; ks < 8; ++ks) { const s16x4 lo = vtr16(Vt + troff + ks * 16 * RS + wid * 64), hh = vtr16(Vt + troff + (ks * 16 + 8) * RS + wid * 64);
            Bf[ks] = (bf16x8){lo[0], lo[1], lo[2], lo[3], hh[0], hh[1], hh[2], hh[3]}; }
        __syncthreads();
        if (tid < 256) { float sm = 0.f;
#pragma unroll
            for (int w = 0; w < 8; ++w) sm += part[w * 256 + tid];
            dnp[((size_t)(bh * 2 + 1) * 66 + idxb) * 256 + tid] = sm; }
        LDSP stg = Vt + wid * 8704;
#pragma unroll 1
        for (int dir = 0; dir < 2; ++dir) {
            bf16x8 Bs[8];
#pragma unroll
            for (int ks = 0; ks < 8; ++ks) { float f[8]; unpack8(__builtin_bit_cast(u32x4, Bf[ks]), f);
#pragma unroll
                for (int j = 0; j < 8; ++j) f[j] *= tb[128 * dir + 16 * ks + 8 * (j >> 2) + 4 * hi + (j & 3)];
                Bs[ks] = __builtin_bit_cast(bf16x8, pack8(f)); }
            unsigned char* st = (unsigned char*)ST + ((size_t)(bh * 2 + dir) * 66 + (dir ? idxb : idxf)) * 65536 + (size_t)(32 * wid) * 256;
#pragma unroll 1
            for (int kh = 0; kh < 2; ++kh) {
                f32x16 acc[4];
#pragma unroll
                for (int kb = 0; kb < 4; ++kb)
#pragma unroll
                    for (int r = 0; r < 16; ++r) acc[kb][r] = 0.f;
#pragma unroll
                for (int ks = 0; ks < 8; ++ks) {
#pragma unroll
                    for (int kb = 0; kb < 4; ++kb) { const s16x4 lo = vtr16(Kt + troff + ks * 16 * RS + (4 * kh + kb) * 64), hh = vtr16(Kt + troff + (ks * 16 + 8) * RS + (4 * kh + kb) * 64);
                        const bf16x8 aa = (bf16x8){lo[0], lo[1], lo[2], lo[3], hh[0], hh[1], hh[2], hh[3]};
                        acc[kb] = __builtin_amdgcn_mfma_f32_32x32x16_bf16(aa, Bs[ks], acc[kb], 0, 0, 0); }
                    if (ks & 1) __builtin_amdgcn_sched_barrier(0); }
#pragma unroll
                for (int kb = 0; kb < 4; ++kb)
#pragma unroll
                    for (int r4 = 0; r4 < 4; ++r4)
                        *(PG8_LAS unsigned*)(stg + r32 * 144 + (32 * kb + 8 * r4 + 4 * hi)) = pk4_fp8(acc[kb][4 * r4] * ST_SC, acc[kb][4 * r4 + 1] * ST_SC, acc[kb][4 * r4 + 2] * ST_SC, acc[kb][4 * r4 + 3] * ST_SC);
                asm volatile("s_waitcnt lgkmcnt(0)" ::: "memory");
#pragma unroll
                for (int i = 0; i < 4; ++i) { const int row = 8 * i + (lane >> 3), ch = lane & 7;
                    *(u32x4*)(st + (size_t)row * 256 + 128 * kh + 16 * ch) = *(const PG8_LAS u32x4*)(stg + row * 144 + ch * 16); }
            }
        }
        __syncthreads();
    }
}

__device__ __forceinline__ void phase_mB(const Params& p, bf16_t* ST, int bid, int nb) {
    const int tid = ltid();
    { const int ipb = (16 * 256 + nb - 1) / nb, it = bid * ipb + tid;
      if (tid < ipb && it < 16 * 256) {
          const int bhd = it >> 8, kd = it & 255; const float* sc = p.scal + (size_t)bhd * 132; float n = 0.f, m = 0.f;
          if (kd == 0) p.ms[bhd * 67] = 0.f;
          for (int i0 = 0; i0 < 66; i0 += 11) { float dv[11], bqv[11], mlv[11];
#pragma unroll
              for (int j = 0; j < 11; ++j) { dv[j] = p.dn[((size_t)bhd * 66 + i0 + j) * 256 + kd]; bqv[j] = sc[2 * (i0 + j)]; mlv[j] = sc[2 * (i0 + j) + 1]; }
#pragma unroll
              for (int j = 0; j < 11; ++j) { const float mn = fmaxf(bqv[j] + m, mlv[j]), a = __expf(bqv[j] + m - mn), bb = __expf(mlv[j] - mn);
                  n = a * n + bb * dv[j]; p.nst[((size_t)bhd * 66 + i0 + j) * 256 + kd] = n; m = mn; if (kd == 0) p.ms[bhd * 67 + i0 + j + 1] = mn; } } } }
    for (int it = bid * NTH + tid; it < 16 * 8192; it += nb * NTH) {
        const int bhd = it >> 13; unsigned char* st = (unsigned char*)ST + (size_t)bhd * 66 * 65536 + (size_t)(it & 8191) * 8; const float* sc = p.scal + (size_t)bhd * 132;
        float C[8];
#pragma unroll
        for (int e = 0; e < 8; ++e) C[e] = 0.f;
        float m = 0.f;
        for (int i0 = 0; i0 < 66; i0 += 11) {
            u32x2 v[11];
#pragma unroll
            for (int j = 0; j < 11; ++j) v[j] = *(const u32x2*)(st + (size_t)(i0 + j) * 65536);
#pragma unroll
            for (int j = 0; j < 11; ++j) { const float bq = sc[2 * (i0 + j)], ml = sc[2 * (i0 + j) + 1]; const float mn = fmaxf(bq + m, ml), a = __expf(bq + m - mn), bb = __expf(ml - mn);
                float f[8]; unpk8_fp8(v[j], f);
#pragma unroll
                for (int e = 0; e < 8; ++e) C[e] = a * C[e] + bb * f[e];
                u32x2 wo; wo.x = pk4_fp8(C[0], C[1], C[2], C[3]); wo.y = pk4_fp8(C[4], C[5], C[6], C[7]);
                *(u32x2*)(st + (size_t)(i0 + j) * 65536) = wo; m = mn; }
        }
    }
}

__device__ __forceinline__ void phase_mC(const Params& p, int layer, const bf16_t* mq_, const bf16_t* mk_, const bf16_t* vT_, const bf16_t* mo_, const bf16_t* ST_, bf16_t* ym_, LDSP lds, int bid, int nb) {
    const bf16_t* mq = UP(mq_); const bf16_t* mk = UP(mk_); const bf16_t* vT = UP(vT_);
    const float* cw = UP((const float*)p.m_conv_w + (size_t)layer * 3 * 2048); const float* cb = UP((const float*)p.m_conv_b + layer * 2048); const bf16_t* mo = UP(mo_); const bf16_t* ST = UP(ST_); bf16_t* ym = UP(ym_);
    LDSP qs = lds; LDSP ksm = lds + 67584; LDSP Wf = ksm; LDSP Wb = ksm + 34816;
    LASF T = (LASF)(lds + 67584 + 69632);
    LASF red = T + 2048; LASF den2 = red + 1024; LASF qn2 = den2 + 512;
    const int skip = layer == 0 ? 0 : 2;
    const int nun = 8 * (66 - skip);
    const float* gbias = UP((const float*)p.m_gate_b + layer * 16); const float* mng = UP((const float*)p.m_norm_g + layer * 256);
    const float* Gp = UP((const float*)p.G); const float* msp = UP((const float*)p.ms); const float* nstp = UP((const float*)p.nst);
    for (int u = bid; u < nun; u += nb) {
        const int tid = ltid(), lane = tid & 63, r32 = lane & 31, hi = lane >> 5; const int wid = __builtin_amdgcn_readfirstlane(tid >> 6);
        const int c = skip + u % (66 - skip), bh = u / (66 - skip), b = bh >> 2, h = bh & 3;
        const size_t row0 = (size_t)b * SEQB + 128 * c;
        const int idxf = scan_idx(0, c), idxb = scan_idx(1, c);
        const bf16_t* vp = vT + ((size_t)(bh * 256 + 32 * wid + r32)) * SEQB + 128 * c + 8 * hi;
        const int tq = tid & 127, dsel = (tid >> 7) & 1, tok = dsel ? 127 - tq : tq;
        float li = 0.f, lf = 0.f;
        if (tid < 256) { const float* g = Gp + (row0 + tok) * 16; li = g[8 * dsel + h] + gbias[8 * dsel + h]; lf = logsigf_(g[8 * dsel + 4 + h] + gbias[8 * dsel + 4 + h]); }
        const float mpf = msp[(bh * 2 + 0) * 67 + idxf], mpb = msp[(bh * 2 + 1) * 67 + idxb];
        { const int ch8 = (tid & 31) * 8;
#pragma unroll
          for (int jb = 0; jb < 4; ++jb) { u32x4 rq[2][3], rk[2][3];
#pragma unroll
              for (int jj = 0; jj < 2; ++jj) { const int t = (tid >> 5) + 16 * (2 * jb + jj), pos = 128 * c + t; const size_t off = (row0 + t) * 1024 + h * 256 + ch8;
                  const bool hasp = (pos != 0) && (pos != LC), hasn = (pos != LC - 1) && (pos != SEQB - 1); const u32x4 zz = {0u, 0u, 0u, 0u};
                  rq[jj][1] = *(const u32x4*)(mq + off); rq[jj][0] = hasp ? *(const u32x4*)(mq + off - 1024) : zz; rq[jj][2] = hasn ? *(const u32x4*)(mq + off + 1024) : zz;
                  rk[jj][1] = *(const u32x4*)(mk + off); rk[jj][0] = hasp ? *(const u32x4*)(mk + off - 1024) : zz; rk[jj][2] = hasn ? *(const u32x4*)(mk + off + 1024) : zz; }
#pragma unroll
              for (int jj = 0; jj < 2; ++jj) { const int t = (tid >> 5) + 16 * (2 * jb + jj); float o[8];
                  mconv8(rq[jj][0], rq[jj][1], rq[jj][2], cw, cb, h * 256 + ch8, 1.0f, o); *(PG8_LAS u32x4*)(qs + t * 528 + ch8 * 2) = pack8(o);
                  mconv8(rk[jj][0], rk[jj][1], rk[jj][2], cw, cb, 1024 + h * 256 + ch8, 0.0625f, o); *(PG8_LAS u32x4*)(ksm + t * 528 + ch8 * 2) = pack8(o); } } }
        float inc = wave_scan_sum(lf, lane);
        if (lane == 63 && wid < 4) red[wid] = inc;
        __syncthreads();
        if (wid == 1 || wid == 3) inc += red[wid - 1];
        const float av = li - inc;
        float pmx = wave_scan_max(tid < 256 ? av : -1e30f, lane);
        if (lane == 63 && wid < 4) red[8 + wid] = pmx;
        __syncthreads();
        if (wid == 1 || wid == 3) pmx = fmaxf(pmx, red[8 + wid - 1]);
        if (tid < 256) { const float mp = dsel ? mpb : mpf, g = fmaxf(mp, pmx);
            T[512 + 128 * dsel + tok] = av; T[768 + 128 * dsel + tok] = g; T[1024 + 128 * dsel + tok] = __expf(mp - g); T[1280 + 128 * dsel + tok] = __expf(-(inc + g)); }
        { const int t = tid & 127, part = tid >> 7; float sf = 0.f, sb = 0.f;
          if (idxf > 0 || idxb > 0) {
              const float* nf = nstp + ((size_t)(bh * 2 + 0) * 66 + (idxf > 0 ? idxf - 1 : 0)) * 256 + part * 64; const float* nbk = nstp + ((size_t)(bh * 2 + 1) * 66 + (idxb > 0 ? idxb - 1 : 0)) * 256 + part * 64;
              for (int d8 = 0; d8 < 8; ++d8) { float f[8]; unpack8(*(const PG8_LAS u32x4*)(qs + t * 528 + (part * 64 + d8 * 8) * 2), f);
#pragma unroll
                  for (int e = 0; e < 8; ++e) { sf += f[e] * nf[d8 * 8 + e]; sb += f[e] * nbk[d8 * 8 + e]; } } }
          qn2[(part * 2 + 0) * 128 + t] = idxf > 0 ? sf : 0.f; qn2[(part * 2 + 1) * 128 + t] = idxb > 0 ? sb : 0.f; }
        const int tj = wid & 3, sg = wid >> 2;
        f32x16 sacc[2];
#pragma unroll
        for (int e = 0; e < 2; ++e)
#pragma unroll
            for (int r = 0; r < 16; ++r) sacc[e][r] = 0.f;
#pragma unroll 4
        for (int kk = 0; kk < 16; ++kk) { const bf16x8 bq = *(const PG8_LAS bf16x8*)(qs + (32 * tj + r32) * 528 + (16 * kk + 8 * hi) * 2);
#pragma unroll
            for (int e = 0; e < 2; ++e) { const bf16x8 ak = *(const PG8_LAS bf16x8*)(ksm + (32 * (2 * sg + e) + r32) * 528 + (16 * kk + 8 * hi) * 2);
                sacc[e] = __builtin_amdgcn_mfma_f32_32x32x16_bf16(ak, bq, sacc[e], 0, 0, 0); } }
        __syncthreads();
        { const int tz2 = ltid(), r32b = tz2 & 31, hib = (tz2 >> 5) & 1;
          const int t = 32 * tj + r32b; const float gf = T[768 + t], gb = T[896 + t]; float denf = 0.f, denb = 0.f;
          const LASF Taf = T + 512 + 64 * sg + 4 * hib; const LASF Tab = T + 640 + 64 * sg + 4 * hib;
          LDSP wfp = Wf + t * 272 + (64 * sg + 4 * hib) * 2; LDSP wbp = Wb + t * 272 + (64 * sg + 4 * hib) * 2;
#pragma unroll
          for (int e = 0; e < 2; ++e)
#pragma unroll
              for (int r4 = 0; r4 < 4; ++r4) { const int s0 = 32 * (2 * sg + e) + 8 * r4 + 4 * hib; float wf[4], wb[4];
#pragma unroll
                  for (int i = 0; i < 4; ++i) { const int s = s0 + i; const float sv = sacc[e][4 * r4 + i];
                      wf[i] = (s <= t) ? sv * __expf(Taf[32 * e + 8 * r4 + i] - gf) : 0.f; wb[i] = (s >= t) ? sv * __expf(Tab[32 * e + 8 * r4 + i] - gb) : 0.f; denf += wf[i]; denb += wb[i]; }
                  u32x2 w; w.x = pk2(wf[0], wf[1]); w.y = pk2(wf[2], wf[3]); *(PG8_LAS u32x2*)(wfp + (32 * e + 8 * r4) * 2) = w;
                  w.x = pk2(wb[0], wb[1]); w.y = pk2(wb[2], wb[3]); *(PG8_LAS u32x2*)(wbp + (32 * e + 8 * r4) * 2) = w; }
          denf += __shfl_xor(denf, 32); denb += __shfl_xor(denb, 32);
          if (hib == 0) { den2[(sg * 2 + 0) * 128 + t] = denf; den2[(sg * 2 + 1) * 128 + t] = denb; } }
        __syncthreads();
        f32x16 hs[4]; unsigned hp[4][8];
#pragma unroll
        for (int dir = 0; dir < 2; ++dir) {
            const int idx = dir ? idxb : idxf;
            f32x16 acc[4];
#pragma unroll
            for (int j = 0; j < 4; ++j)
#pragma unroll
                for (int r = 0; r < 16; ++r) acc[j][r] = 0.f;
            if (idx > 0) {
                const unsigned char* Cp = (const unsigned char*)ST + ((size_t)(bh * 2 + dir) * 66 + idx - 1) * 65536 + (32 * wid + r32) * 256 + 8 * hi;
#pragma unroll
                for (int hb = 0; hb < 2; ++hb) {
                    bf16x8 Cf[8];
#pragma unroll
                    for (int k8 = 0; k8 < 8; ++k8) { const u32x2 cr = *(const u32x2*)(Cp + 16 * (8 * hb + k8)); float cf[8]; unpk8_fp8(cr, cf); Cf[k8] = __builtin_bit_cast(bf16x8, pack8(cf)); }
#pragma unroll
                    for (int k8 = 0; k8 < 8; ++k8) {
#pragma unroll
                        for (int j = 0; j < 4; ++j) { const bf16x8 bq = *(const PG8_LAS bf16x8*)(qs + (32 * j + r32) * 528 + (16 * (8 * hb + k8) + 8 * hi) * 2);
                            acc[j] = __builtin_amdgcn_mfma_f32_32x32x16_bf16(Cf[k8], bq, acc[j], 0, 0, 0); }
                        if (k8 & 1) __builtin_amdgcn_sched_barrier(0); } }
                const LASF Tw = T + 1024 + 128 * dir + (ltid() & 31);
#pragma unroll
                for (int j = 0; j < 4; ++j) { const float wi = Tw[32 * j] * ST_ISC;
#pragma unroll
                    for (int r = 0; r < 16; ++r) acc[j][r] *= wi; }
            }
            { bf16x8 Vf[8];
#pragma unroll
              for (int ks = 0; ks < 8; ++ks) Vf[ks] = *(const bf16x8*)(vp + 16 * ks);
              const LDSP W = dir ? Wb : Wf;
#pragma unroll
              for (int ks = 0; ks < 8; ++ks) {
#pragma unroll
                  for (int j = 0; j < 4; ++j) { const bf16x8 bw = *(const PG8_LAS bf16x8*)(W + (32 * j + r32) * 272 + (16 * ks + 8 * hi) * 2);
                      acc[j] = __builtin_amdgcn_mfma_f32_32x32x16_bf16(Vf[ks], bw, acc[j], 0, 0, 0); }
                  if (ks & 1) __builtin_amdgcn_sched_barrier(0); } }
            const int r32c = ltid() & 31;
            const LASF qnp = qn2 + dir * 128 + r32c; const LASF dnp = den2 + dir * 128 + r32c; const LASF Tp = T + 1024 + 128 * dir + r32c;
#pragma unroll
            for (int j = 0; j < 4; ++j) {
                const float qn = qnp[32 * j] + qnp[256 + 32 * j] + qnp[512 + 32 * j] + qnp[768 + 32 * j];
                const float den = dnp[32 * j] + dnp[256 + 32 * j] + Tp[32 * j] * qn;
                const float inv = 1.0f / fmaxf(fabsf(den), Tp[256 + 32 * j]);
                if (dir == 0) {
#pragma unroll
                    for (int r = 0; r < 16; r += 2) hp[j][r >> 1] = pk2(acc[j][r] * inv, acc[j][r + 1] * inv); }
                else {
#pragma unroll
                    for (int r = 0; r < 16; r += 2) { hs[j][r] = lo16(hp[j][r >> 1]) + acc[j][r] * inv; hs[j][r + 1] = hi16(hp[j][r >> 1]) + acc[j][r + 1] * inv; } } }
        }
        u32x2 gg[4][4];
        { const int tz = ltid(), r32o = tz & 31, hio = (tz >> 5) & 1, wido = tz >> 6; const size_t obase = (row0 + r32o) * 1024 + h * 256 + 32 * wido + 4 * hio;
#pragma unroll
          for (int j = 0; j < 4; ++j)
#pragma unroll
              for (int r4 = 0; r4 < 4; ++r4) gg[j][r4] = *(const u32x2*)(mo + obase + (size_t)j * 32 * 1024 + 8 * r4); }
#pragma unroll
        for (int j = 0; j < 4; ++j) { float ssq = 0.f;
#pragma unroll
            for (int r = 0; r < 16; ++r) ssq += hs[j][r] * hs[j][r];
            ssq += __shfl_xor(ssq, 32); const int tzr = ltid(); if (((tzr >> 5) & 1) == 0) red[(tzr >> 6) * 128 + 32 * j + (tzr & 31)] = ssq; }
        __syncthreads();
        {
          const int tz = ltid(), r32o = tz & 31, hio = (tz >> 5) & 1, wido = tz >> 6;
          const size_t obase = (row0 + r32o) * 1024 + h * 256 + 32 * wido + 4 * hio;
#pragma unroll
          for (int j = 0; j < 4; ++j) { const int t = 32 * j + r32o; float tot = 0.f;
#pragma unroll
              for (int w = 0; w < 8; ++w) tot += red[w * 128 + t];
              const float rstd = rsqrtf(tot * (1.0f / 256.0f) + EPS_);
#pragma unroll
              for (int r4 = 0; r4 < 4; ++r4) { const int v0 = 32 * wido + 8 * r4 + 4 * hio; const size_t off = obase + (size_t)j * 32 * 1024 + 8 * r4;
                  const u32x2 g = gg[j][r4]; u32x2 w;
                  w.x = pk2(hs[j][4 * r4] * rstd * mng[v0] * sigmoidf_(lo16(g.x)), hs[j][4 * r4 + 1] * rstd * mng[v0 + 1] * sigmoidf_(hi16(g.x)));
                  w.y = pk2(hs[j][4 * r4 + 2] * rstd * mng[v0 + 2] * sigmoidf_(lo16(g.y)), hs[j][4 * r4 + 3] * rstd * mng[v0 + 3] * sigmoidf_(hi16(g.y)));
                  *(u32x2*)(ym + off) = w; } } }
        __syncthreads();
    }
}

__device__ __forceinline__ void hconv8(const bf16_t* src, bool hasp, bool hasn, const float* cw, const float* cb, int cch, float (&o)[8]) {
    float up[8], uc[8], un[8];
    unpack8(*(const u32x4*)src, uc);
    if (hasp) unpack8(*(const u32x4*)(src - 1024), up); else {
#pragma unroll
        for (int i = 0; i < 8; ++i) up[i] = 0.f; }
    if (hasn) unpack8(*(const u32x4*)(src + 1024), un); else {
#pragma unroll
        for (int i = 0; i < 8; ++i) un[i] = 0.f; }
#pragma unroll
    for (int i = 0; i < 8; ++i) o[i] = cb[cch + i] + up[i] * cw[cch + i] + uc[i] * cw[3072 + cch + i] + un[i] * cw[6144 + cch + i];
}
struct H3 { u32x4 p, c, n; };
__device__ __forceinline__ H3 hload3(const bf16_t* src, bool hasp, bool hasn) { H3 r; const u32x4 z4 = {0u, 0u, 0u, 0u};
    r.c = *(const u32x4*)src; r.p = hasp ? *(const u32x4*)(src - 1024) : z4; r.n = hasn ? *(const u32x4*)(src + 1024) : z4; return r; }
__device__ __forceinline__ void hcomp8(const H3& r, const float* cw, const float* cb, int cch, float (&o)[8]) {
    float up[8], uc[8], un[8]; unpack8(r.p, up); unpack8(r.c, uc); unpack8(r.n, un);
#pragma unroll
    for (int i = 0; i < 8; ++i) o[i] = cb[cch + i] + up[i] * cw[cch + i] + uc[i] * cw[3072 + cch + i] + un[i] * cw[6144 + cch + i];
}
__device__ __forceinline__ void hw_stage(LASF wl, const float* cw, const float* cb, int conv0, int nconv, int cg) {
    for (int i = ltid(); i < nconv * 1024; i += NTH) { const int cv = i >> 10, r = (i >> 8) & 3, ch = i & 255; const int cch = (conv0 + cv) * 1024 + cg * 256 + ch;
        wl[i] = r == 0 ? cb[cch] : cw[(r - 1) * 3072 + cch]; } }
__device__ __forceinline__ void hcomp8l(const H3& r, const LASF w, float (&o)[8]) {
    float up[8], uc[8], un[8]; unpack8(r.p, up); unpack8(r.c, uc); unpack8(r.n, un);
    const f32x4 b0 = *(const PG8_LAS f32x4*)(w), b1 = *(const PG8_LAS f32x4*)(w + 4), p0 = *(const PG8_LAS f32x4*)(w + 256), p1 = *(const PG8_LAS f32x4*)(w + 260);
    const f32x4 c0 = *(const PG8_LAS f32x4*)(w + 512), c1 = *(const PG8_LAS f32x4*)(w + 516), n0 = *(const PG8_LAS f32x4*)(w + 768), n1 = *(const PG8_LAS f32x4*)(w + 772);
#pragma unroll
    for (int i = 0; i < 4; ++i) { o[i] = b0[i] + up[i] * p0[i] + uc[i] * c0[i] + un[i] * n0[i]; o[4 + i] = b1[i] + up[4 + i] * p1[i] + uc[4 + i] * c1[i] + un[4 + i] * n1[i]; }
}
__device__ __forceinline__ void phase_hprep(const Params& p, int layer, const bf16_t* hx1, const bf16_t* hv, bf16_t* zT, LDSP lds, int bid, int nb) {
    const int tid = ltid(); LASF zt = (LASF)lds;
    const float* cw = p.h_conv_w + (size_t)layer * 3 * 3072; const float* cb = p.h_conv_b + layer * 3072;
    constexpr int NU = 2 * 128 * 4;
    u32x4 ra[4], rb[4];
#define HP_LOAD(u_) do { const int cg_ = (u_) & 3, tb_ = ((u_) >> 2) & 127, b_ = (u_) >> 9; const int tl_ = tb_ * 64 + (tid >> 3); const size_t row_ = (size_t)b_ * SEQB + LC + tl_; const bool hp_ = tl_ != 0, hn_ = tl_ != LL - 1; \
        _Pragma("unroll") for (int v8 = 0; v8 < 4; ++v8) { const int c_ = cg_ * 256 + v8 * 64 + (tid & 7) * 8; ra[v8] = *(const u32x4*)(hx1 + row_ * 1024 + c_); rb[v8] = *(const u32x4*)(hv + row_ * 1024 + c_); } } while (0)
    int u = bid; int cgl = -1; LASF wl = zt + 16512;
    if (u < NU) HP_LOAD(u);
    for (; u < NU; u += nb) {
        const int cg = u & 3, tb = (u >> 2) & 127, b = u >> 9;
        if (cg != cgl) { hw_stage(wl, cw, cb, 1, 2, cg); cgl = cg; __syncthreads(); }
        const int t = tid >> 3, tl = tb * 64 + t; const size_t row = (size_t)b * SEQB + LC + tl; const bool hasp = tl != 0, hasn = tl != LL - 1; const u32x4 z4 = {0u, 0u, 0u, 0u};
#pragma unroll
        for (int v8 = 0; v8 < 4; ++v8) { const int cl = v8 * 64 + (tid & 7) * 8, c = cg * 256 + cl; float x1[8], vv[8];
            H3 ha, hb; ha.c = ra[v8]; hb.c = rb[v8];
            ha.p = hasp ? *(const u32x4*)(hx1 + (row - 1) * 1024 + c) : z4; ha.n = hasn ? *(const u32x4*)(hx1 + (row + 1) * 1024 + c) : z4;
            hb.p = hasp ? *(const u32x4*)(hv + (row - 1) * 1024 + c) : z4; hb.n = hasn ? *(const u32x4*)(hv + (row + 1) * 1024 + c) : z4;
            hcomp8l(ha, wl + cl, x1); hcomp8l(hb, wl + 1024 + cl, vv);
#pragma unroll
            for (int i = 0; i < 8; ++i) zt[t * 257 + cl + i] = vv[i] * x1[i]; }
        __syncthreads();
        if (u + nb < NU) HP_LOAD(u + nb);
        __builtin_amdgcn_sched_barrier(0);
        { const int cl = tid >> 1, th = tid & 1; bf16_t* dst = zT + ((size_t)(b * 1024 + cg * 256 + cl)) * LL + tb * 64 + 32 * th;
#pragma unroll
          for (int q = 0; q < 4; ++q) { float f[8];
#pragma unroll
              for (int e = 0; e < 8; ++e) f[e] = zt[(32 * th + 8 * q + e) * 257 + cl];
              *(u32x4*)(dst + 8 * q) = pack8(f); } }
        __syncthreads();
    }
#undef HP_LOAD
}

__device__ __forceinline__ f32x2v cmul_(f32x2v a, f32x2v b) { return mk2_(a.x * b.x - a.y * b.y, a.x * b.y + a.y * b.x); }
__device__ __forceinline__ f32x2v cmulc_(f32x2v a, f32x2v b) { return mk2_(a.x * b.x + a.y * b.y, a.y * b.x - a.x * b.y); }
__device__ __forceinline__ f32x2v cadd_(f32x2v a, f32x2v b) { return mk2_(a.x + b.x, a.y + b.y); }
__device__ __forceinline__ f32x2v csub_(f32x2v a, f32x2v b) { return mk2_(a.x - b.x, a.y - b.y); }
__device__ __forceinline__ int fphys(int i) { return i + (i >> 5); }
template <bool INV> __device__ __forceinline__ void bfly16(f32x2v (&v)[16], const f32x2v w1) {
    const f32x2v w2 = cmul_(w1, w1), w4 = cmul_(w2, w2), w8 = cmul_(w4, w4);
    const float C1 = 0.92387953251128674f, S1 = 0.38268343236508977f, R2 = 0.70710678118654752f;
    const f32x2v c16[8] = {mk2_(1.f, 0.f), mk2_(C1, -S1), mk2_(R2, -R2), mk2_(S1, -C1), mk2_(0.f, -1.f), mk2_(-S1, -C1), mk2_(-R2, -R2), mk2_(-C1, -S1)};
    if (!INV) {
#pragma unroll
        for (int m = 0; m < 8; ++m) { const f32x2v W = cmul_(w1, c16[m]); const f32x2v a = v[m], b = v[m + 8]; v[m] = cadd_(a, b); v[m + 8] = cmul_(csub_(a, b), W); }
#pragma unroll
        for (int g = 0; g < 16; g += 8)
#pragma unroll
            for (int m = 0; m < 4; ++m) { const f32x2v W = cmul_(w2, c16[2 * m]); const f32x2v a = v[g + m], b = v[g + m + 4]; v[g + m] = cadd_(a, b); v[g + m + 4] = cmul_(csub_(a, b), W); }
#pragma unroll
        for (int g = 0; g < 16; g += 4)
#pragma unroll
            for (int m = 0; m < 2; ++m) { const f32x2v W = cmul_(w4, c16[4 * m]); const f32x2v a = v[g + m], b = v[g + m + 2]; v[g + m] = cadd_(a, b); v[g + m + 2] = cmul_(csub_(a, b), W); }
#pragma unroll
        for (int g = 0; g < 16; g += 2) { const f32x2v a = v[g], b = v[g + 1]; v[g] = cadd_(a, b); v[g + 1] = cmul_(csub_(a, b), w8); }
    } else {
#pragma unroll
        for (int g = 0; g < 16; g += 2) { const f32x2v a = v[g], b = cmulc_(v[g + 1], w8); v[g] = cadd_(a, b); v[g + 1] = csub_(a, b); }
#pragma unroll
        for (int g = 0; g < 16; g += 4)
#pragma unroll
            for (int m = 0; m < 2; ++m) { const f32x2v W = cmul_(w4, c16[4 * m]); const f32x2v a = v[g + m], b = cmulc_(v[g + m + 2], W); v[g + m] = cadd_(a, b); v[g + m + 2] = csub_(a, b); }
#pragma unroll
        for (int g = 0; g < 16; g += 8)
#pragma unroll
            for (int m = 0; m < 4; ++m) { const f32x2v W = cmul_(w2, c16[2 * m]); const f32x2v a = v[g + m], b = cmulc_(v[g + m + 4], W); v[g + m] = cadd_(a, b); v[g + m + 4] = csub_(a, b); }
#pragma unroll
        for (int m = 0; m < 8; ++m) { const f32x2v W = cmul_(w1, c16[m]); const f32x2v a = v[m], b = cmulc_(v[m + 8], W); v[m] = cadd_(a, b); v[m + 8] = csub_(a, b); }
    }
}
template <bool INV, int S, bool SYNC = true> __device__ __forceinline__ void fft_pass16(PG8_LAS f32x2v* cb) {
    constexpr int STR = S / 16;
    int tz = ltid();
#pragma unroll 2
    for (int k = 0; k < 2; ++k) { const int q = tz + NTH * k; const int j = q & (STR - 1), base = (q / STR) * S + j;
        f32x2v v[16];
#pragma unroll
        for (int m = 0; m < 16; ++m) v[m] = cb[fphys(base + STR * m)];
        const float rev = (float)j * (1.0f / (float)S); const f32x2v w1 = mk2_(cos2pi(rev), -sin2pi(rev));
        bfly16<INV>(v, w1);
#pragma unroll
        for (int m = 0; m < 16; ++m) cb[fphys(base + STR * m)] = v[m]; }
    if (SYNC) __syncthreads();
}
template <int NM> __device__ __forceinline__ void fft_pass_first(PG8_LAS f32x2v* cb, const bf16_t* s0, const bf16_t* s1) {
    const int tz = ltid();
    bf16_t r0[2][NM], r1[2][NM];
#pragma unroll
    for (int k = 0; k < 2; ++k)
#pragma unroll
        for (int m = 0; m < NM; ++m) { r0[k][m] = s0[tz + NTH * k + 1024 * m]; r1[k][m] = s1 ? s1[tz + NTH * k + 1024 * m] : (bf16_t)0; }
#pragma unroll
    for (int k = 0; k < 2; ++k) { const int j = tz + NTH * k;
        f32x2v v[16];
#pragma unroll
        for (int m = 0; m < 16; ++m) v[m] = m < NM ? mk2_(bf2f(r0[k][m]), bf2f(r1[k][m])) : mk2_(0.f, 0.f);
        const float rev = (float)j * (1.0f / 16384.0f); const f32x2v w1 = mk2_(cos2pi(rev), -sin2pi(rev));
        bfly16<false>(v, w1);
#pragma unroll
        for (int m = 0; m < 16; ++m) cb[fphys(j + 1024 * m)] = v[m]; }
    __syncthreads();
}
__device__ __forceinline__ void fft_pass_last(PG8_LAS f32x2v* cb, bf16_t* d0, bf16_t* d1) {
    const int tz = ltid();
#pragma unroll 1
    for (int k = 0; k < 2; ++k) { const int j = tz + NTH * k;
        f32x2v v[16];
#pragma unroll
        for (int m = 0; m < 16; ++m) v[m] = cb[fphys(j + 1024 * m)];
        const float rev = (float)j * (1.0f / 16384.0f); const f32x2v w1 = mk2_(cos2pi(rev), -sin2pi(rev));
        bfly16<true>(v, w1);
#pragma unroll
        for (int m = 0; m < 8; ++m) { d0[j + 1024 * m] = f2bf(v[m].x); d1[j + 1024 * m] = f2bf(v[m].y); } }
    __syncthreads();
}
__device__ __forceinline__ void r4_dif(f32x2v (&a)[4]) {
    const f32x2v b0 = cadd_(a[0], a[2]), b2 = csub_(a[0], a[2]), b1 = cadd_(a[1], a[3]); const f32x2v d = csub_(a[1], a[3]); const f32x2v b3 = mk2_(d.y, -d.x);
    a[0] = cadd_(b0, b1); a[1] = csub_(b0, b1); a[2] = cadd_(b2, b3); a[3] = csub_(b2, b3); }
__device__ __forceinline__ void r4_dit(f32x2v (&c)[4]) {
    const f32x2v b0 = cadd_(c[0], c[1]), b1 = csub_(c[0], c[1]), b2 = cadd_(c[2], c[3]), b3 = csub_(c[2], c[3]); const f32x2v ib3 = mk2_(-b3.y, b3.x);
    c[0] = cadd_(b0, b2); c[2] = csub_(b0, b2); c[1] = cadd_(b1, ib3); c[3] = csub_(b1, ib3); }

__device__ __forceinline__ void phase_fft(const Params& p, int layer, const bf16_t* tapsT, bf16_t* zT, float* Hscr, LDSP lds, int bid, int nb) {
    PG8_LAS f32x2v* cb = (PG8_LAS f32x2v*)lds; const int tid = ltid();
    for (int c = bid; c < 1024; c += nb) {
        fft_pass_first<16>(cb, tapsT + (size_t)c * 16384, nullptr); fft_pass16<false, 1024, false>(cb); fft_pass16<false, 64, false>(cb);
        float ssq_c = 0.f;
#pragma unroll
        for (int q = 0; q < 8; ++q) ssq_c += p.sumsq[((size_t)(layer * 64 + (c >> 5)) * 8 + q) * 32 + (c & 31)];
#pragma unroll
        for (int q = 0; q < 8; ++q) ssq_c += p.sumsq[((size_t)(layer * 64 + 32 + (c >> 5)) * 8 + q) * 32 + (c & 31)];
        const float scale = rsqrtf(ssq_c + EPS_) * (1.0f / 16384.0f);
        f32x2v H[8][4];
        { const int tz = ltid();
#pragma unroll
          for (int k = 0; k < 8; ++k) { const int q = 256 * (tz >> 6) + 2048 * (k >> 2) + 64 * (k & 3) + (tz & 63); f32x2v a[4];
#pragma unroll
              for (int m = 0; m < 4; ++m) a[m] = cb[fphys(4 * q + m)];
              r4_dif(a);
#pragma unroll
              for (int m = 0; m < 4; ++m) H[k][m] = mk2_(a[m].x * scale, a[m].y * scale); } }
        __syncthreads();
        fft_pass_first<8>(cb, zT + (size_t)c * LL, zT + (size_t)(1024 + c) * LL); fft_pass16<false, 1024, false>(cb); fft_pass16<false, 64, false>(cb);
        { const int tz = ltid();
#pragma unroll
          for (int k = 0; k < 8; ++k) { const int q = 256 * (tz >> 6) + 2048 * (k >> 2) + 64 * (k & 3) + (tz & 63); f32x2v a[4];
#pragma unroll
              for (int m = 0; m < 4; ++m) a[m] = cb[fphys(4 * q + m)];
              r4_dif(a);
#pragma unroll
              for (int m = 0; m < 4; ++m) a[m] = cmul_(a[m], H[k][m]);
              r4_dit(a);
#pragma unroll
              for (int m = 0; m < 4; ++m) cb[fphys(4 * q + m)] = a[m]; } }
        fft_pass16<true, 64, false>(cb); fft_pass16<true, 1024>(cb);
        fft_pass_last(cb, zT + (size_t)c * LL, zT + (size_t)(1024 + c) * LL);
    }
}
__device__ __forceinline__ void phase_hfin(const Params& p, int layer, const bf16_t* __restrict__ hx0, const bf16_t* __restrict__ hx1, const bf16_t* __restrict__ hv, const bf16_t* __restrict__ yT, bf16_t* __restrict__ yh, LDSP lds, int bid, int nb) {
    const int tid = ltid(); LASF yt = (LASF)lds;
    const float* cw = p.h_conv_w + (size_t)layer * 3 * 3072; const float* cb = p.h_conv_b + layer * 3072; const float* hb = p.h_bias + layer * 1024;
    int cgl = -1; LASF wl = yt + 16640; LASF hbl = wl + 3072;
    for (int u = bid; u < 2 * 128 * 4; u += nb) {
        const int cg = u & 3, tb = (u >> 2) & 127, b = u >> 9;
        if (cg != cgl) { hw_stage(wl, cw, cb, 0, 3, cg); if (tid < 256) hbl[tid] = hb[cg * 256 + tid]; cgl = cg; }
        u32x4 rc0[4], rc1[4], rc2[4];
        { const size_t ro = ((size_t)b * SEQB + LC + tb * 64 + (tid >> 3)) * 1024 + cg * 256 + (tid & 7) * 8;
#pragma unroll
          for (int v8 = 0; v8 < 4; ++v8) { rc0[v8] = *(const u32x4*)(hx0 + ro + v8 * 64); rc1[v8] = *(const u32x4*)(hx1 + ro + v8 * 64); rc2[v8] = *(const u32x4*)(hv + ro + v8 * 64); } }
        { const int cl = tid >> 1, th = tid & 1; const bf16_t* src = yT + ((size_t)(b * 1024 + cg * 256 + cl)) * LL + tb * 64 + 32 * th;
          u32x4 yv[4];
#pragma unroll
          for (int q = 0; q < 4; ++q) yv[q] = *(const u32x4*)(src + 8 * q);
#pragma unroll
          for (int q = 0; q < 4; ++q) { float f[8]; unpack8(yv[q], f);
#pragma unroll
              for (int e = 0; e < 8; ++e) yt[cl * 65 + 32 * th + 8 * q + e] = f[e]; } }
        __syncthreads();
        const int t = tid >> 3, tl = tb * 64 + t; const size_t row = (size_t)b * SEQB + LC + tl; const bool hasp = tl != 0, hasn = tl != LL - 1;
#pragma unroll
        for (int v8 = 0; v8 < 4; ++v8) { const int cl = v8 * 64 + (tid & 7) * 8, c = cg * 256 + cl; float x0[8], x1[8], vv[8], o[8]; const u32x4 z4 = {0u, 0u, 0u, 0u};
            H3 h0, h1, h2; h0.c = rc0[v8]; h1.c = rc1[v8]; h2.c = rc2[v8];
            h0.p = hasp ? *(const u32x4*)(hx0 + (row - 1) * 1024 + c) : z4; h0.n = hasn ? *(const u32x4*)(hx0 + (row + 1) * 1024 + c) : z4;
            h1.p = hasp ? *(const u32x4*)(hx1 + (row - 1) * 1024 + c) : z4; h1.n = hasn ? *(const u32x4*)(hx1 + (row + 1) * 1024 + c) : z4;
            h2.p = hasp ? *(const u32x4*)(hv + (row - 1) * 1024 + c) : z4; h2.n = hasn ? *(const u32x4*)(hv + (row + 1) * 1024 + c) : z4;
            hcomp8l(h0, wl + cl, x0); hcomp8l(h1, wl + 1024 + cl, x1); hcomp8l(h2, wl + 2048 + cl, vv);
            const f32x4 hb0 = *(const PG8_LAS f32x4*)(hbl + cl), hb1 = *(const PG8_LAS f32x4*)(hbl + cl + 4);
#pragma unroll
            for (int i = 0; i < 8; ++i) o[i] = x0[i] * (yt[(cl + i) * 65 + t] + (i < 4 ? hb0[i] : hb1[i - 4]) * vv[i] * x1[i]);
            *(u32x4*)(yh + row * 1024 + c) = pack8(o); }
        __syncthreads();
    }
}
__device__ __forceinline__ void phase_hctx(const Params& p, int layer, const bf16_t* hx0, const bf16_t* hx1, const bf16_t* hv, bf16_t* yh, LDSP lds, int bid, int nb) {
    const int tid = ltid(); LASF zc = (LASF)lds, x0c = zc + 2048, hf = x0c + 2048, hbk = hf + 2048;
    const float* cw = p.h_conv_w + (size_t)layer * 3 * 3072; const float* cb = p.h_conv_b + layer * 3072; const float* hbias = p.h_bias + layer * 1024;
    for (int u = bid; u < 256; u += nb) {
        const int b = u >> 7, c0 = (u & 127) * 8;
        if (tid < 256) { const int t = tid; const size_t row = (size_t)b * SEQB + t; const bool hasp = t != 0, hasn = t != LC - 1; float x0[8], x1[8], vv[8];
            hconv8(hx0 + row * 1024 + c0, hasp, hasn, cw, cb, c0, x0); hconv8(hx1 + row * 1024 + c0, hasp, hasn, cw, cb, 1024 + c0, x1); hconv8(hv + row * 1024 + c0, hasp, hasn, cw, cb, 2048 + c0, vv);
#pragma unroll
            for (int i = 0; i < 8; ++i) { zc[t * 8 + i] = vv[i] * x1[i]; x0c[t * 8 + i] = x0[i]; } }
        for (int i = tid; i < 256 * 8; i += NTH) { const int j = i & 255, cl = i >> 8; const float rs = rsqrtf(p.sumsqC[2048 + c0 + cl] + p.sumsqC[2048 + 1024 + c0 + cl] + EPS_);
            hf[j * 8 + cl] = p.hfC[(size_t)(c0 + cl) * 256 + j] * rs; hbk[j * 8 + cl] = p.hbC[(size_t)(c0 + cl) * 256 + j] * rs; }
        __syncthreads();
        { const int cl = tid & 7, tg = tid >> 3;
#pragma unroll 1
          for (int ti = 0; ti < 4; ++ti) { const int t = tg + 64 * ti; float y = 0.f;
#pragma unroll 4
              for (int j = 0; j <= t; ++j) y += hf[j * 8 + cl] * zc[(t - j) * 8 + cl];
#pragma unroll 4
              for (int j = 1; j <= 255 - t; ++j) y += hbk[j * 8 + cl] * zc[(t + j) * 8 + cl];
              const float o = x0c[t * 8 + cl] * (y + hbias[c0 + cl] * zc[t * 8 + cl]);
              yh[((size_t)b * SEQB + t) * 1024 + c0 + cl] = f2bf(o); } }
        __syncthreads();
    }
}

__device__ __forceinline__ bool xcd_tile(int i, int c, int G, int T, int& tile) {
    if (G & 7) { tile = i * G + c; return tile < T; }
    const int per = G >> 3, x = c & 7, j = c >> 3, q = i * per + j, base = T >> 3, rem = T & 7;
    const int start = x * base + (x < rem ? x : rem), size = base + (x < rem ? 1 : 0);
    tile = start + q; return q < size; }
struct MergeOrder { int ntile, G, c, lat_only;
    __device__ __forceinline__ bool next(int i, pg8::Unit& u) const { const int tile = (i / 3) * G + c, j = i - (i / 3) * 3; if (tile >= ntile) return false;
        int pi = tile >> 2; const int n = tile & 3; if (lat_only) pi = (pi >> 5) * 33 + 1 + (pi & 31);
        u.pm = j * NPAN + pi; u.pn = j * 4 + n; return true; }
    __device__ __forceinline__ void a_ready(const pg8::Unit&) const {}
    __device__ __forceinline__ void done(const pg8::Unit&) const {} };
struct MergeEpi { static constexpr bool PERM = true, AFTER_DRAIN = false;
    const bf16_t* gates; const float* mb; bf16_t* ysum;
    __device__ __forceinline__ void operator()(const f32x4 (&acc)[2][2][4][2], const pg8::Unit& u, int wr, int wc, int fr, int fq) const {
        const int j = u.pn >> 2, pi = u.pm - j * NPAN, nt = u.pn & 3;
        const int row0 = pi * 256 + wr * 64 + fr, col0 = nt * 256 + wc * 32 + 8 * fq;
        const bf16_t* gj = gates + (size_t)j * TT * 1024;
#pragma unroll
        for (int bj = 0; bj < 2; ++bj) { const int col = col0 + bj * 128; float mbv[8];
#pragma unroll
            for (int i = 0; i < 8; ++i) mbv[i] = mb[j * 1024 + col + i];
#pragma unroll
            for (int ai = 0; ai < 2; ++ai) {
                u32x4 gv[4], ov[4];
#pragma unroll
                for (int m = 0; m < 4; ++m) { const size_t off = (size_t)(row0 + ai * 128 + m * 16) * 1024 + col; gv[m] = *(const u32x4*)(gj + off); if (j > 0) ov[m] = *(const u32x4*)(ysum + off); }
                __builtin_amdgcn_sched_barrier(0);
#pragma unroll
                for (int m = 0; m < 4; ++m) { const size_t off = (size_t)(row0 + ai * 128 + m * 16) * 1024 + col;
                    float g[8], o[8]; unpack8(gv[m], g);
#pragma unroll
                    for (int i = 0; i < 8; ++i) o[i] = sigmoidf_(g[i] + mbv[i]) * acc[ai][bj][m][i >> 2][i & 3];
                    if (j > 0) { float old[8]; unpack8(ov[m], old);
#pragma unroll
                        for (int i = 0; i < 8; ++i) o[i] += old[i]; }
                    *(u32x4*)(ysum + off) = pack8(o); }
                __builtin_amdgcn_sched_barrier(0); } }
    } };
struct OutOrder { int ntile, G, c, lat_only;
    __device__ __forceinline__ bool next(int i, pg8::Unit& u) const { const int tile = i * G + c; if (tile >= ntile) return false;
        int pi = tile >> 2; if (lat_only) pi = (pi >> 5) * 33 + 1 + (pi & 31); u.pm = pi; u.pn = tile & 3; return true; }
    __device__ __forceinline__ void a_ready(const pg8::Unit&) const {}
    __device__ __forceinline__ void done(const pg8::Unit&) const {} };
struct OutEpi { static constexpr bool PERM = false, AFTER_DRAIN = false;
    const Params* p; int layer;
    __device__ __forceinline__ void operator()(const f32x4 (&acc)[2][2][4][2], const pg8::Unit& u, int wr, int wc, int fr, int fq) const {
        const int row0 = u.pm * 256 + wr * 64 + fr, col0 = u.pn * 256 + wc * 32 + 4 * fq;
        const float* g1 = modvec(*p, layer, u.pm * 256) + 2048;
        f32x4 gq[4];
#pragma unroll
        for (int q = 0; q < 4; ++q) gq[q] = *(const f32x4*)(g1 + col0 + (q >> 1) * 128 + (q & 1) * 16);
#pragma unroll
        for (int ai = 0; ai < 2; ++ai) { f32x4 xv[16];
#pragma unroll
            for (int m = 0; m < 4; ++m) { const float* rin = resid_row_in(*p, layer, row0 + ai * 128 + m * 16);
#pragma unroll
                for (int q = 0; q < 4; ++q) xv[m * 4 + q] = *(const f32x4*)(rin + col0 + (q >> 1) * 128 + (q & 1) * 16); }
            __builtin_amdgcn_sched_barrier(0);
#pragma unroll
            for (int m = 0; m < 4; ++m) { float* ro = resid_row(*p, row0 + ai * 128 + m * 16);
#pragma unroll
                for (int q = 0; q < 4; ++q) *(f32x4*)(ro + col0 + (q >> 1) * 128 + (q & 1) * 16) = xv[m * 4 + q] + gq[q] * acc[ai][q >> 1][m][q & 1]; }
            __builtin_amdgcn_sched_barrier(0); }
    } };
struct MoeOrder { const PG8_LAS int* te; int ntl, G, c;
    __device__ __forceinline__ bool next(int i, pg8::Unit& u) const { int L; if (!xcd_tile(i, c, G, ntl * 4, L)) return false; const int tile = L >> 2; u.pm = tile; u.pn = te[tile] * 4 + (L & 3); return true; }
    __device__ __forceinline__ void a_ready(const pg8::Unit&) const {}
    __device__ __forceinline__ void done(const pg8::Unit&) const {} };
struct E1Epi { static constexpr bool PERM = true, AFTER_DRAIN = false;
    bf16_t* H;
    __device__ __forceinline__ void operator()(const f32x4 (&acc)[2][2][4][2], const pg8::Unit& u, int wr, int wc, int fr, int fq) const {
        const int row0 = u.pm * 256 + wr * 64 + fr, hid0 = ((u.pn & 3) * 256 + wc * 32 + 8 * fq) >> 1;
#pragma unroll
        for (int ai = 0; ai < 2; ++ai)
#pragma unroll
            for (int m = 0; m < 4; ++m)
#pragma unroll
                for (int bj = 0; bj < 2; ++bj) { const f32x4 a = acc[ai][bj][m][0], b = acc[ai][bj][m][1]; u32x2 w;
                    w.x = pk2(siluf_(a[0]) * b[0], siluf_(a[1]) * b[1]); w.y = pk2(siluf_(a[2]) * b[2], siluf_(a[3]) * b[3]);
                    *(u32x2*)(H + (size_t)(row0 + ai * 128 + m * 16) * 512 + hid0 + bj * 64) = w; }
    } };

struct EpiReg { static constexpr bool PERM = true, AFTER_DRAIN = false;
    bf16_t* O; size_t stride; bf16_t* O6; int col6;
    __device__ __forceinline__ void operator()(const f32x4 (&acc)[2][2][4][2], const pg8::Unit& u, int wr, int wc, int fr, int fq) const {
        const int row0 = u.pm * 256 + wr * 64 + fr; const int colt = u.pn * 256, reg = colt >> 10;
        bf16_t* base = reg < 6 ? O + (size_t)reg * stride : O6; const int col0 = (reg < 6 ? colt - (reg << 10) : col6 + colt - 6144) + wc * 32 + 8 * fq;
#pragma unroll
        for (int ai = 0; ai < 2; ++ai)
#pragma unroll
            for (int m = 0; m < 4; ++m) { bf16_t* rowp = base + (size_t)(row0 + ai * 128 + m * 16) * 1024 + col0;
#pragma unroll
                for (int bj = 0; bj < 2; ++bj) { const f32x4 v0 = acc[ai][bj][m][0], v1 = acc[ai][bj][m][1]; u32x4 w;
                    w.x = pk2(v0[0], v0[1]); w.y = pk2(v0[2], v0[3]); w.z = pk2(v1[0], v1[1]); w.w = pk2(v1[2], v1[3]);
                    *(u32x4*)(rowp + bj * 128) = w; } }
    } };

__device__ __forceinline__ void phase_norm2_router(const Params& p, int layer, LDSP lds, int bid, int nb, bool count = true) {
    LASF rw = (LASF)lds;
    const int tid = ltid(), lane = tid & 63, wid = tid >> 6;
    for (int i = bid * NTH + tid; i < TPAD; i += nb * NTH) p.rowidx[i] = 0;
    PG8_LAS int* hist = (PG8_LAS int*)(lds + 148 * 1024);
    if (tid < 32) hist[tid] = 0;
    { float4 wv[16];
#pragma unroll
      for (int j = 0; j < 16; ++j) { const int i = tid + NTH * j; wv[j] = *(const float4*)(p.router_w + (i >> 3) * 32 + (i & 7) * 4); }
#pragma unroll
      for (int j = 0; j < 16; ++j) { const int i = tid + NTH * j, n = i >> 3, e4 = (i & 7) * 4; rw[n * 36 + e4] = wv[j].x; rw[n * 36 + e4 + 1] = wv[j].y; rw[n * 36 + e4 + 2] = wv[j].z; rw[n * 36 + e4 + 3] = wv[j].w; } }
    __syncthreads();
    const float* gn = p.norm2_g + layer * 1024;
    float rb[8];
    { const f32x4 r0 = *(const f32x4*)(p.router_b + 8 * (lane >> 4)), r1 = *(const f32x4*)(p.router_b + 8 * (lane >> 4) + 4);
      rb[0] = r0[0]; rb[1] = r0[1]; rb[2] = r0[2]; rb[3] = r0[3]; rb[4] = r1[0]; rb[5] = r1[1]; rb[6] = r1[2]; rb[7] = r1[3]; }
    for (int s = bid * 8 + wid; s < TT; s += nb * 8) {
        const int pos = s % SEQB; if (layer == 1 && pos < LC) continue;
        const float* xr = resid_row(p, s); const float* mv = modvec(p, layer, s);
        float xv[16], gv[16], scv[16], shv[16]; float ssq = 0.f;
#pragma unroll
        for (int i = 0; i < 16; ++i) { const int n = lane + 64 * i; xv[i] = xr[n]; gv[i] = gn[n]; scv[i] = mv[4096 + n]; shv[i] = mv[3072 + n]; }
#pragma unroll
        for (int i = 0; i < 16; ++i) ssq += xv[i] * xv[i];
        ssq = wave_sum(ssq); const float rstd = rsqrtf(ssq * (1.0f / 1024.0f) + EPS_);
        float acc[32];
#pragma unroll
        for (int e = 0; e < 32; ++e) acc[e] = 0.f;
#pragma unroll
        for (int i = 0; i < 16; ++i) { const int n = lane + 64 * i; const float hv = xv[i] * rstd * gv[i] * (1.0f + scv[i]) + shv[i];
            p.hn[(size_t)s * 1024 + n] = f2bf(hv);
#pragma unroll
            for (int e4 = 0; e4 < 8; ++e4) { const f32x4 w = *(const PG8_LAS f32x4*)(rw + n * 36 + 4 * e4); acc[4 * e4] += hv * w.x; acc[4 * e4 + 1] += hv * w.y; acc[4 * e4 + 2] += hv * w.z; acc[4 * e4 + 3] += hv * w.w; }
            __builtin_amdgcn_sched_barrier(0); }
        wave_sum32(acc);
        float v1 = -1e30f, v2 = -1e30f, s1 = 0.f, s2 = 0.f; int i1 = 0, i2 = 0;
#pragma unroll
        for (int q = 0; q < 8; ++q) { const float sve = sigmoidf_(acc[q]), v = sve + rb[q];
            if (v > v1) { v2 = v1; i2 = i1; s2 = s1; v1 = v; i1 = q; s1 = sve; } else if (v > v2) { v2 = v; i2 = q; s2 = sve; } }
        const float gsc = v1 + v2; float best = readlane_f(gsc, 0); int bg = 0;
        { const float g1 = readlane_f(gsc, 16), g2 = readlane_f(gsc, 32), g3 = readlane_f(gsc, 48);
          if (g1 > best) { best = g1; bg = 1; } if (g2 > best) { best = g2; bg = 2; } if (g3 > best) { best = g3; bg = 3; } }
        if (lane == 16 * bg) { const float inv = 1.0f / (s1 + s2); const int be1 = 8 * bg + i1, be2 = 8 * bg + i2;
            p.sel_e[s * 2] = be1; p.sel_e[s * 2 + 1] = be2; p.sel_w[s * 2] = s1 * inv; p.sel_w[s * 2 + 1] = s2 * inv;
            atomicAdd((int*)(hist + be1), 1); atomicAdd((int*)(hist + be2), 1); }
    }
    __syncthreads();
    if (count && tid < 32 && hist[tid] != 0) atomicAdd(p.cnt + layer * 32 + tid, hist[tid]);
    __syncthreads();
}
__device__ __forceinline__ int moe_plan(const Params& p, int layer, PG8_LAS int* pstart, PG8_LAS int* te) {
    if (ltid() == 0) { int tl = 0; for (int e = 0; e < 32; ++e) { const int cn = p.cnt[layer * 32 + e]; pstart[e] = tl * 256; const int nt = (cn + 255) >> 8; for (int q = 0; q < nt; ++q) te[tl + q] = e; tl += nt; } pstart[32] = tl; }
    __syncthreads();
    return pstart[32];
}
__device__ __forceinline__ void phase_moe_assign(const Params& p, int layer, LDSP lds, int bid, int nb) {
    PG8_LAS int* pstart = (PG8_LAS int*)lds; PG8_LAS int* te = pstart + 64; PG8_LAS int* hist = pstart + 512; PG8_LAS int* base = hist + 32;
    const int tid = ltid();
    if (tid < 32) hist[tid] = 0;
    moe_plan(p, layer, pstart, te);
    const int per = (TT + nb - 1) / nb, s = bid * per + tid; const bool act = tid < per && s < TT && !(layer == 1 && (s % SEQB) < LC);
    int e0 = 0, e1 = 0, r0 = 0, r1 = 0;
    if (act) { e0 = p.sel_e[s * 2]; e1 = p.sel_e[s * 2 + 1]; r0 = atomicAdd((int*)(hist + e0), 1); r1 = atomicAdd((int*)(hist + e1), 1); }
    __syncthreads();
    if (tid < 32) base[tid] = hist[tid] ? atomicAdd(p.cur + layer * 32 + tid, hist[tid]) : 0;
    __syncthreads();
    if (act) { const int p0 = pstart[e0] + base[e0] + r0, p1 = pstart[e1] + base[e1] + r1;
        p.posbuf[s * 2] = p0; p.posbuf[s * 2 + 1] = p1; p.rowidx[p0] = s; p.rowidx[p1] = s; }
    __syncthreads();
}
template <bool NEXT_NORM> __device__ __forceinline__ void phase_moe_combine(const Params& p, int layer, const bf16_t* Yb_, LDSP lds, int bid, int nb) {
    const bf16_t* Yb = UP(Yb_);
    LASF wg = (LASF)lds;
    const int tid = ltid(), lane = tid & 63, wid = tid >> 6;
    if (NEXT_NORM) {
        float4 wv[8];
#pragma unroll
        for (int j = 0; j < 8; ++j) { const int i = tid + NTH * j; wv[j] = *(const float4*)(p.w_in + (size_t)(layer + 1) * 1024 * 13328 + (size_t)(i >> 2) * 13328 + 4096 + (i & 3) * 4); }
#pragma unroll
        for (int j = 0; j < 8; ++j) { const int i = tid + NTH * j, n = i >> 2, j4 = (i & 3) * 4; wg[n * 20 + j4] = wv[j].x; wg[n * 20 + j4 + 1] = wv[j].y; wg[n * 20 + j4 + 2] = wv[j].z; wg[n * 20 + j4 + 3] = wv[j].w; }
        __syncthreads();
    }
    const float* gn = p.norm1_g + (layer + 1) * 1024;
    for (int s = bid * 8 + wid; s < TT; s += nb * 8) {
        const int pos = s % SEQB; if (layer == 1 && pos < LC) continue;
        const int p0 = p.posbuf[s * 2], p1 = p.posbuf[s * 2 + 1]; const float w0 = p.sel_w[s * 2], w1 = p.sel_w[s * 2 + 1];
        float* xr = resid_row(p, s); const float* g2 = modvec(p, layer, s) + 5120;
        f32x4 xn[4]; float ssq = 0.f;
#pragma unroll
        for (int i = 0; i < 4; ++i) { const int col = 4 * lane + 256 * i; const u32x2 a = *(const u32x2*)(Yb + (size_t)p0 * 1024 + col), b = *(const u32x2*)(Yb + (size_t)p1 * 1024 + col);
            f32x4 x = *(const f32x4*)(xr + col); const f32x4 g = *(const f32x4*)(g2 + col);
            x[0] += g[0] * (w0 * lo16(a.x) + w1 * lo16(b.x)); x[1] += g[1] * (w0 * hi16(a.x) + w1 * hi16(b.x)); x[2] += g[2] * (w0 * lo16(a.y) + w1 * lo16(b.y)); x[3] += g[3] * (w0 * hi16(a.y) + w1 * hi16(b.y));
            *(f32x4*)(xr + col) = x; xn[i] = x; ssq += x[0] * x[0] + x[1] * x[1] + x[2] * x[2] + x[3] * x[3]; }
        if (NEXT_NORM) {
            const float* mv = modvec(p, layer + 1, s);
            ssq = wave_sum(ssq); const float rstd = rsqrtf(ssq * (1.0f / 1024.0f) + EPS_);
            float acc[16];
#pragma unroll
            for (int j = 0; j < 16; ++j) acc[j] = 0.f;
#pragma unroll
            for (int i = 0; i < 4; ++i) { const int col = 4 * lane + 256 * i; const f32x4 gv = *(const f32x4*)(gn + col), sc = *(const f32x4*)(mv + 1024 + col), sh = *(const f32x4*)(mv + col); float hv[4];
#pragma unroll
                for (int e = 0; e < 4; ++e) hv[e] = xn[i][e] * rstd * gv[e] * (1.0f + sc[e]) + sh[e];
                u32x2 w; w.x = pk2(hv[0], hv[1]); w.y = pk2(hv[2], hv[3]); *(u32x2*)(p.hn + (size_t)s * 1024 + col) = w;
#pragma unroll
                for (int e = 0; e < 4; ++e)
#pragma unroll
                    for (int j4 = 0; j4 < 4; ++j4) { const f32x4 wq = *(const PG8_LAS f32x4*)(wg + (col + e) * 20 + 4 * j4); acc[4 * j4] += hv[e] * wq.x; acc[4 * j4 + 1] += hv[e] * wq.y; acc[4 * j4 + 2] += hv[e] * wq.z; acc[4 * j4 + 3] += hv[e] * wq.w; }
                __builtin_amdgcn_sched_barrier(0); }
            wave_sum16(acc);
            if ((lane & 15) == 0) { f32x4 g4; g4[0] = acc[0]; g4[1] = acc[1]; g4[2] = acc[2]; g4[3] = acc[3]; *(f32x4*)(p.G + (size_t)s * 16 + (lane >> 4) * 4) = g4; }
        }
    }
    if (NEXT_NORM) __syncthreads();
}

constexpr size_t R_BYTES = 12 * UU;
constexpr size_t OFF_WT13 = 0, OFF_WT2 = OFF_WT13 + (size_t)32 * 1024 * 1024 * 2, OFF_XG = OFF_WT2 + (size_t)32 * 1024 * 512 * 2, OFF_H = OFF_XG + (size_t)TPAD * 1024 * 2, OFF_YB = OFF_H + (size_t)TPAD * 512 * 2;
static_assert(OFF_YB + (size_t)TPAD * 1024 * 2 <= R_BYTES, "MoE buffers must fit the big region");

#ifndef REPEAT_MASK
#define REPEAT_MASK 0
#endif
#define REP(bit) for (int rep_ = 0; rep_ < (((REPEAT_MASK) >> (bit)) & 1) + 1; ++rep_)
#define GRID_BAR() do { xcd_barrier(bar); if ((REPEAT_MASK >> 15) & 1) xcd_barrier(bar); asm volatile("" : "+s"(bid), "+s"(nb)); } while (0)

constexpr int PW = (int)(sizeof(Params) / 8);
static_assert(sizeof(Params) % 8 == 0 && sizeof(Params) <= 1024, "Params is a block of 8-byte words");
struct ParamsRaw { unsigned long long w[PW]; };
template <int layer> __device__ __forceinline__ void layer_body(const Params& p, const XcdBarrier& bar, LDSP lds, int& bid, int& nb);
__global__ void __launch_bounds__(512, 2) fwd_kernel(ParamsRaw raw, unsigned long long* gp, unsigned* barw) {
    extern __shared__ __attribute__((aligned(16))) unsigned char shm[];
    LDSP lds = (LDSP)shm;
    int bid = blockIdx.x, nb = gridDim.x; const int tid = threadIdx.x;
    unsigned long long* mygp = gp + (size_t)bid * 128;
    if (tid == 0) {
#pragma unroll
        for (int k = 0; k < PW; ++k) mygp[k] = raw.w[k];
        *(PG8_LAS u32x4*)(lds + LDS_BYTES - 16) = (u32x4){0u, 0u, 0u, 0u};
        asm volatile("s_waitcnt vmcnt(0)" ::: "memory"); }
    __syncthreads();
    const Params& p = *(const Params*)mygp;
    XcdBarrier bar = xcd_barrier_post(barw, (volatile LAS unsigned*)(lds + LDS_BYTES - 16));

#define RB ((unsigned char*)p.R)
#define aq ((bf16_t*)(RB))
#define ak ((bf16_t*)(RB + UU))
#define av ((bf16_t*)(RB + 2 * UU))
#define hx0 ((bf16_t*)(RB + 3 * UU))
#define hx1 ((bf16_t*)(RB + 4 * UU))
#define hv ((bf16_t*)(RB + 5 * UU))
#define zT ((bf16_t*)(RB + 6 * UU))
#define tapsT ((bf16_t*)(RB + 11 * UU))
#define ST ((bf16_t*)(RB))
#define mq ((bf16_t*)(RB + 4 * UU))
#define mk ((bf16_t*)(RB + 5 * UU))
#define mv ((bf16_t*)(RB + 6 * UU))
#define mo ((bf16_t*)(RB + 7 * UU))
#define gates ((bf16_t*)(RB + 8 * UU))
#define qc ((bf16_t*)(RB + 8 * UU))
#define kc ((bf16_t*)(RB + 9 * UU))
#define kT ((bf16_t*)(RB + 10 * UU))
#define vT ((bf16_t*)(RB + 11 * UU))
#define Wt13 ((bf16_t*)(RB + OFF_WT13))
#define Wt2 ((bf16_t*)(RB + OFF_WT2))
#define Xg ((bf16_t*)(RB + OFF_XG))
#define Hb ((bf16_t*)(RB + OFF_H))
#define Yb ((bf16_t*)(RB + OFF_YB))
#define ym ((bf16_t*)p.Y3)
#define ya ((bf16_t*)p.Y3 + (size_t)TT * 1024)
#define yh ((bf16_t*)p.Y3 + (size_t)2 * TT * 1024)

    REP(12) phase_conv_small(p, 0, lds, bid, nb);
    REP(7) { phase_modvec(p, lds, bid, nb);
    phase_hdn(p, lds, bid, nb); }
    GRID_BAR();
    layer_body<0>(p, bar, lds, bid, nb);
#if defined(PROBE_LEVEL) && (PROBE_LEVEL == 1 || PROBE_LEVEL == 2)
    return;
#endif
    layer_body<1>(p, bar, lds, bid, nb);
    if (bid == 0 && tid == 0 && xb_ld(&barw[XB_TMO]) != 0u) p.out[0] = __builtin_nanf("");
}
template <int layer> __device__ __forceinline__ void layer_body(const Params& p, const XcdBarrier& bar, LDSP lds, int& bid, int& nb) {
        if (layer == 0) {
            REP(10) phase_norm1(p, layer, lds, bid, nb);
            REP(13) phase_taps(p, layer, tapsT, lds, bid, nb);
            GRID_BAR(); }
        REP(0) { pg8::Gemm g{UP((const bf16_t*)p.hn), UP((const bf16_t*)p.Wt_in), TT, 6656, 1024}; pg8::StaticOrder S; S.init(TT, 6656, nb, bid);
          EpiReg E{UP(aq), (size_t)TT * 1024, UP(gates + (size_t)2 * TT * 1024), 0};
          pg8::gemm_phase<EpiReg, pg8::StaticOrder, false>(lds, g, S, E, nullptr);
        GRID_BAR(); }
        phase_attn_prep(p, layer, aq, ak, bid, nb);
        phase_hprep(p, layer, hx1, hv, zT, lds, bid, nb);
        if (layer == 0) REP(6) phase_hctx(p, layer, hx0, hx1, hv, yh, lds, bid, nb);
        GRID_BAR();
        phase_fft(p, layer, tapsT, zT, (float*)(RB + 10 * UU), lds, bid, nb);
        REP(1) phase_attn(p, layer, aq, ak, av, ya, lds, bid, nb);
        GRID_BAR();
        if ((REPEAT_MASK >> 3) & 1) { phase_hprep(p, layer, hx1, hv, zT, lds, bid, nb); GRID_BAR(); phase_fft(p, layer, tapsT, zT, (float*)(RB + 10 * UU), lds, bid, nb); GRID_BAR(); }
        REP(11) phase_hfin(p, layer, hx0, hx1, hv, zT, yh, lds, bid, nb);
        GRID_BAR();
        REP(0) { pg8::Gemm g{UP((const bf16_t*)p.hn), UP((const bf16_t*)p.Wt_in + (size_t)6656 * 1024), TT, 6656, 1024}; pg8::StaticOrder S; S.init(TT, 6656, nb, bid);
          EpiReg E{UP(mq), (size_t)TT * 1024, UP(gates + (size_t)2 * TT * 1024), 512};
          pg8::gemm_phase<EpiReg, pg8::StaticOrder, false>(lds, g, S, E, nullptr);
        GRID_BAR(); }
        REP(2) { phase_mA(p, layer, mk, mv, vT, ST, lds, bid, nb);
        GRID_BAR(); }
        phase_mB(p, ST, bid, nb);
        GRID_BAR();
        REP(14) { phase_mC(p, layer, mq, mk, vT, mo, ST, ym, lds, bid, nb);
        GRID_BAR(); }
        REP(4) { pg8::Gemm g{UP((const bf16_t*)p.Y3), UP((const bf16_t*)p.Wt_br + (size_t)layer * 3 * 1048576), 3 * TT, 3072, 1024}; MergeOrder S{layer == 0 ? 264 : 256, nb, bid, layer == 0 ? 0 : 1};
          MergeEpi E{UP((const bf16_t*)gates), UP((const float*)p.merge_b + layer * 3072), UP((bf16_t*)p.hn)};
          pg8::gemm_phase<MergeEpi, MergeOrder, false>(lds, g, S, E, nullptr);
          if (layer == 0 && rep_ == 0) {
              int me = bid, nl = nb; bool runf = true;
              if ((nb & 7) == 0) { const int per = nb >> 3, hx = 33 - per; if (hx > 0 && hx < per) { const int j = bid >> 3; runf = j >= hx; me = (j - hx) * 8 + (bid & 7); nl = nb - 8 * hx; } }
              if (runf) { __syncthreads();
                  phase_conv_experts(p, 0, Wt13, Wt2, lds, me, nl);
                  phase_taps(p, 1, tapsT, lds, me, nl);
                  phase_conv_small(p, 1, lds, me, nl); } }
        GRID_BAR(); }
        { pg8::Gemm g{UP((const bf16_t*)p.hn), UP((const bf16_t*)p.Wt_out + (size_t)layer * 1048576), TT, 1024, 1024}; OutOrder S{layer == 0 ? 264 : 256, nb, bid, layer == 0 ? 0 : 1};
          OutEpi E{&p, layer};
          pg8::gemm_phase<OutEpi, OutOrder, false>(lds, g, S, E, nullptr); }
        __syncthreads();
#if defined(PROBE_LEVEL) && PROBE_LEVEL == 1
        if (layer == 0) return;
#endif
#if defined(PROBE_LEVEL) && PROBE_LEVEL == 3
        if (layer == 1) return;
#endif
        if (layer == 1) REP(9) phase_conv_experts(p, layer, Wt13, Wt2, lds, bid, nb);
        GRID_BAR();
        REP(5) phase_norm2_router(p, layer, lds, bid, nb, rep_ == 0);
        GRID_BAR();
        phase_moe_assign(p, layer, lds, bid, nb);
        GRID_BAR();
        { PG8_LAS int* pstart = (PG8_LAS int*)(lds + 132 * 1024); PG8_LAS int* te = pstart + 64;
          const int ntl = moe_plan(p, layer, pstart, te);
          REP(16) { pg8::Gemm g{UP((const bf16_t*)p.hn), UP((const bf16_t*)Wt13), TT, 32 * 1024, 1024}; MoeOrder S{te, ntl, nb, bid}; E1Epi E{UP(Hb)};
            PG8_LAS int* rtab = (PG8_LAS int*)(lds + 133 * 1024);
            { pg8::Unit uu; const int tz = ltid();
#pragma unroll
              for (int i = 0; i < 4; ++i) { if (S.next(i, uu) && tz < 256) rtab[i * 256 + tz] = p.rowidx[uu.pm * 256 + tz]; } }
            __syncthreads();
            pg8::gemm_phase_g<E1Epi, MoeOrder, false>(lds, g, S, E, rtab);
          GRID_BAR(); }
          REP(17) { pg8::Gemm g{UP((const bf16_t*)Hb), UP((const bf16_t*)Wt2), TPAD, 32 * 1024, 512}; MoeOrder S{te, ntl, nb, bid}; pg8::EpiBf16<0> E{UP(Yb), 1024, nullptr, 1024, (size_t)0};
            pg8::gemm_phase<pg8::EpiBf16<0>, MoeOrder, false>(lds, g, S, E, nullptr);
          GRID_BAR(); } }
        if (layer == 0) phase_moe_combine<true>(p, layer, Yb, lds, bid, nb);
        else phase_moe_combine<false>(p, layer, Yb, lds, bid, nb);
        GRID_BAR();
}

extern "C" void kernel_launch(void* const* d_in, const int* in_sizes, int n_in, void* d_out, int out_size, void* d_ws, size_t ws_size, hipStream_t stream) {
    (void)in_sizes; (void)n_in; (void)out_size;
    Params p; memset(&p, 0, sizeof(p));
    const float* const* in = (const float* const*)d_in;
    p.x = in[0]; p.c = in[1]; p.ctx = in[2]; p.c_ctx = in[3]; p.mod_w = in[4]; p.mod_b = in[5]; p.norm1_g = in[6]; p.norm2_g = in[7]; p.w_in = in[8]; p.merge_b = in[9];
    p.m_conv_w = in[10]; p.m_conv_b = in[11]; p.m_gate_b = in[12]; p.m_norm_g = in[13]; p.a_qnorm_g = in[14]; p.a_knorm_g = in[15]; p.a_lambda = in[16]; p.a_subln_g = in[17];
    p.h_conv_w = in[18]; p.h_conv_b = in[19]; p.h_ffn_w1 = in[20]; p.h_ffn_b1 = in[21]; p.h_ffn_w2 = in[22]; p.h_ffn_b2 = in[23]; p.h_ffn_w3 = in[24]; p.h_freq = in[25]; p.h_decay = in[26]; p.h_bias = in[27];
    p.w_br_m = in[28]; p.w_br_a = in[29]; p.w_br_h = in[30]; p.w_out = in[31]; p.router_w = in[32]; p.router_b = in[33]; p.e_w1 = in[34]; p.e_w3 = in[35]; p.e_w2 = in[36];
    p.out = (float*)d_out;
    unsigned char* w = (unsigned char*)d_ws; size_t off = 0;
    auto take = [&](size_t bytes) { unsigned char* r = w + off; off += (bytes + 255) & ~(size_t)255; return r; };
    constexpr size_t ZERO_BYTES = 32768;
    unsigned char* z = take(ZERO_BYTES);
    p.bar = (unsigned*)z; p.cnt = (int*)(z + 16384); p.cur = (int*)(z + 16384 + 256); p.sumsq = (float*)take((size_t)2 * 64 * 8 * 32 * 4); p.sumsqC = (float*)take((size_t)4096 * 4);
    p.modv = (float*)take((size_t)6 * 6144 * 4); p.hdn2 = (float*)take((size_t)2 * 8448 * 64 * 4); p.G = (float*)take((size_t)TT * 16 * 4); p.xc = (float*)take((size_t)512 * 1024 * 4);
    p.sel_e = (int*)take((size_t)TT * 2 * 4); p.sel_w = (float*)take((size_t)TT * 2 * 4); p.posbuf = (int*)take((size_t)TT * 2 * 4); p.rowidx = (int*)take((size_t)TPAD * 4);
    p.scal = (float*)take((size_t)16 * 66 * 2 * 4); p.ms = (float*)take((size_t)16 * 67 * 4); p.dn = (float*)take((size_t)16 * 66 * 256 * 4); p.nst = (float*)take((size_t)16 * 66 * 256 * 4);
    p.hfC = (float*)take((size_t)1024 * 256 * 4); p.hbC = (float*)take((size_t)1024 * 256 * 4);
    p.Wt_in = (bf16_t*)take((size_t)13312 * 1024 * 2); p.Wt_br = (bf16_t*)take((size_t)2 * 3072 * 1024 * 2); p.Wt_out = (bf16_t*)take((size_t)2 * 1024 * 1024 * 2);
    unsigned long long* gpbuf = (unsigned long long*)take((size_t)1024 * 1024);
    p.hn = (bf16_t*)take(UU); p.Y3 = (bf16_t*)take(3 * UU); p.R = take(R_BYTES);
    if (off > ws_size) { fprintf(stderr, "kernel_launch: workspace too small: need %zu, have %zu\n", off, ws_size); return; }
    static int grid = 0;
    if (!grid) {
        int dev = 0, cus = 0; (void)hipGetDevice(&dev); (void)hipDeviceGetAttribute(&cus, hipDeviceAttributeMultiprocessorCount, dev);
        if (hipFuncSetAttribute((const void*)fwd_kernel, hipFuncAttributeMaxDynamicSharedMemorySize, LDS_BYTES) != hipSuccess) { fprintf(stderr, "kernel_launch: hipFuncSetAttribute failed\n"); return; }
        int per_cu = 0; (void)hipOccupancyMaxActiveBlocksPerMultiprocessor(&per_cu, (const void*)fwd_kernel, NTH, LDS_BYTES);
        if (per_cu < 1) fprintf(stderr, "kernel_launch: occupancy query reports %d blocks per CU\n", per_cu);
        grid = cus > 0 ? (cus > 1024 ? 1024 : cus) : 256;
    }
    (void)hipMemsetAsync(z, 0, ZERO_BYTES, stream);
    ParamsRaw raw; memcpy(&raw, &p, sizeof(raw));
    hipLaunchKernelGGL(fwd_kernel, dim3(grid), dim3(NTH), LDS_BYTES, stream, raw, gpbuf, (unsigned*)z);
}
```

```cpp
#include <hip/hip_runtime.h>
#include <cstdio>
#include <cstdint>
#include <cstring>
#define REPEAT_MASK 0
#define XB_TMO      128
#define XB_XCNT(j)  (256  + 64 * (j))
#define XB_XSUB(j)  (1280 + 64 * (j))
#define XB_XGEN(j)  (2304 + 64 * (j))
#define XB_TOP      3328
#define XB_TOPGEN   3392
#define XCD_BAR_WORDS 3456
#define XB_SPIN_CAP (1u << 24)
#define LAS __attribute__((address_space(3)))

__device__ __forceinline__ unsigned xb_ld(unsigned* p)              { return __hip_atomic_load(p, __ATOMIC_RELAXED, __HIP_MEMORY_SCOPE_AGENT); }
__device__ __forceinline__ unsigned xb_add(unsigned* p, unsigned v) { return __hip_atomic_fetch_add(p, v, __ATOMIC_RELAXED, __HIP_MEMORY_SCOPE_AGENT); }
__device__ __forceinline__ unsigned xb_xcc_id() { return (unsigned)__builtin_amdgcn_s_getreg((3 << 11) | 20) & 0xFu; }
#define XB_SPIN(cond, bar) do { unsigned _sp = 0; while (cond) { __builtin_amdgcn_s_sleep(1); \
    if ((++_sp & 255u) == 0u) { if (xb_ld(&(bar)[XB_TMO])) break; if (_sp > XB_SPIN_CAP) { atomicAdd(&(bar)[XB_TMO], 1u); break; } } } } while (0)

struct XcdBarrier {
    unsigned* bar; unsigned x;
    volatile LAS unsigned* st;
};

__device__ __forceinline__ XcdBarrier xcd_barrier_post(unsigned* bar, volatile LAS unsigned* st) {
    XcdBarrier b; b.bar = bar; b.x = xb_xcc_id(); b.st = st;
    if (threadIdx.x == 0) (void)xb_add(&bar[XB_XCNT(b.x)], 1u);
    return b;
}
__device__ __forceinline__ void xcd_barrier_complete(unsigned* bar, unsigned x, unsigned& nloc, unsigned& nx) {
    const unsigned G = gridDim.x * gridDim.y * gridDim.z;
    unsigned sum, cnt, mine, sp = 0u;
    for (;;) {
        sum = 0u; cnt = 0u; mine = 0u;
#pragma unroll
        for (unsigned j = 0; j < 16; ++j) { const unsigned c = xb_ld(&bar[XB_XCNT(j)]); sum += c; cnt += (c > 0u) ? 1u : 0u; mine = (j == x) ? c : mine; }
        if (sum == G) break;
        __builtin_amdgcn_s_sleep(1);
        if ((++sp & 255u) == 0u) { if (xb_ld(&bar[XB_TMO])) break; if (sp > XB_SPIN_CAP) { atomicAdd(&bar[XB_TMO], 1u); break; } }
    }
    nloc = mine > 0u ? mine : 1u; nx = cnt > 0u ? cnt : 1u;
}

__device__ __forceinline__ void xcd_barrier(const XcdBarrier& b) {
    asm volatile("s_waitcnt vmcnt(0)" ::: "memory");
    __syncthreads();
    if (threadIdx.x == 0) {
        unsigned* bar = b.bar;
        __builtin_amdgcn_s_waitcnt(0);
        unsigned nloc = b.st[0], nx = b.st[1];
        if (nloc == 0u) { xcd_barrier_complete(bar, b.x, nloc, nx); b.st[0] = nloc; b.st[1] = nx; }
        const unsigned old = xb_add(&bar[XB_XSUB(b.x)], 1u);
        const unsigned gen = old / nloc;
        if (old + 1u == (gen + 1u) * nloc) {
            __builtin_amdgcn_fence(__ATOMIC_RELEASE, "agent");
            asm volatile("s_waitcnt vmcnt(0)" ::: "memory");
            const unsigned og = xb_add(&bar[XB_TOP], 1u);
            const unsigned tg = og / nx;
            if (og + 1u == (tg + 1u) * nx) xb_add(&bar[XB_TOPGEN], 1u);
            else XB_SPIN(xb_ld(&bar[XB_TOPGEN]) == tg, bar);
            __builtin_amdgcn_fence(__ATOMIC_ACQUIRE, "agent");
            xb_add(&bar[XB_XGEN(b.x)], 1u);
            asm volatile("s_waitcnt vmcnt(0)" ::: "memory");
        } else {
            XB_SPIN(xb_ld(&bar[XB_XGEN(b.x)]) == gen, bar);
            __builtin_amdgcn_fence(__ATOMIC_ACQUIRE, "agent");
            asm volatile("s_waitcnt vmcnt(0)" ::: "memory");
        }
    }
    __syncthreads();
}
namespace pg8 {
#define PG8_LAS __attribute__((address_space(3)))
typedef unsigned short bf16_t;
typedef short bf16x8 __attribute__((ext_vector_type(8)));
typedef float f32x4 __attribute__((ext_vector_type(4)));
typedef unsigned u32x4 __attribute__((ext_vector_type(4)));
constexpr int BM = 256, BK = 64, HALF = 128, HTB = HALF * BK * 2  , STAGE_BYTES = 8 * HTB, NXCD = 8, WGM = 8;

__host__ __device__ __forceinline__ int lds_byte(int r, int c) { const int st = (r >> 4) * 2 + (c >> 5), rr = r & 15, cc = c & 31, ob = rr * 64 + cc * 2; return st * 1024 + (ob ^ (((ob >> 9) & 1) << 5)); }
__host__ __device__ __forceinline__ void stage_rc(int b, int& R, int& C) { const int st = b / 1024, sb = b % 1024, swz = sb ^ (((sb >> 9) & 1) << 5); R = (st >> 1) * 16 + swz / 64; C = (st & 1) * 32 + (swz % 64) / 2; }
__host__ __device__ __forceinline__ int perm32(int rho) { const int n = rho >> 4, i = rho & 15; return 8 * (i >> 2) + 4 * n + (i & 3); }

struct Unit { int pm, pn; };
struct Gemm { const bf16_t* A; const bf16_t* Bt; int M, N, K; };

struct StaticOrder {
    int nM, nN, nwg, G, c;
    __host__ __device__ void init(int M, int N, int G_, int c_) { nM = M / BM; nN = N / BM; nwg = nM * nN; G = G_; c = c_; }
    __host__ __device__ bool next(int i, Unit& u) const {
        const long L = (long)i * G + c; if (L >= nwg) return false;
        int wgid = (int)L; { const int q = nwg / NXCD, r = nwg % NXCD, xcd = wgid % NXCD, off = wgid / NXCD; wgid = (xcd < r ? xcd * (q + 1) : r * (q + 1) + (xcd - r) * q) + off; }
        const int nig = WGM * nN, gid = wgid / nig, fm = gid * WGM, gsz = (nM - fm) < WGM ? (nM - fm) : WGM;
        u.pm = fm + ((wgid % nig) % gsz); u.pn = (wgid % nig) / gsz; return true;
    }
    __device__ __forceinline__ void a_ready(const Unit&) const {}
    __device__ __forceinline__ void done(const Unit&) const {}
};
struct CountedOrder : StaticOrder {
    const unsigned* ready; unsigned need; unsigned* tmo;
    __device__ __forceinline__ void a_ready(const Unit& u) const {
        if (threadIdx.x < 64) {
            const unsigned long long t0 = __builtin_amdgcn_s_memrealtime(); unsigned polls = 0;
            while ((unsigned)__builtin_amdgcn_readfirstlane(__hip_atomic_load(ready + 64 * u.pm, __ATOMIC_RELAXED, __HIP_MEMORY_SCOPE_AGENT)) < need) {
                if ((++polls & 255u) == 0u && __builtin_amdgcn_readfirstlane(__hip_atomic_load(tmo, __ATOMIC_RELAXED, __HIP_MEMORY_SCOPE_AGENT)) != 0u) break;
                if (__builtin_amdgcn_s_memrealtime() - t0 > 2000000ull) {
                    if (threadIdx.x == 0) { unsigned expect = 0u; __hip_atomic_compare_exchange_strong(tmo + 1, &expect, 0x600u | (unsigned)(u.pm & 0xff), __ATOMIC_RELAXED, __ATOMIC_RELAXED, __HIP_MEMORY_SCOPE_AGENT); __hip_atomic_store(tmo, 1u, __ATOMIC_RELAXED, __HIP_MEMORY_SCOPE_AGENT); }
                    break; }
                __builtin_amdgcn_s_sleep(2); }
            __builtin_amdgcn_fence(__ATOMIC_ACQUIRE, "agent");
            asm volatile("s_waitcnt vmcnt(0)" ::: "memory");
        }
#if !defined(BROKEN_HOOK_NO_BARRIER)
        asm volatile("" ::: "memory"); __builtin_amdgcn_s_barrier(); asm volatile("" ::: "memory");
#endif
    }
};

__device__ __forceinline__ unsigned cvt_pk_bf16(float lo, float hi) { unsigned r; asm volatile("v_cvt_pk_bf16_f32 %0, %1, %2" : "=v"(r) : "v"(lo), "v"(hi)); return r; }
typedef float f32x2 __attribute__((ext_vector_type(2)));
__device__ __forceinline__ f32x2 gelu_pk(f32x2 v) {
    const f32x2 av = __builtin_elementwise_abs(v), d = av * 0.2316418882f + 1.0f;
    f32x2 t; t.x = __builtin_amdgcn_rcpf(d.x); t.y = __builtin_amdgcn_rcpf(d.y);
    f32x2 q = t * 0.5307027145f + (-0.7265760135f); q = q * t + 0.7107068705f; q = q * t + (-0.142248368f); q = q * t + 0.127414796f; q = q * t;
    const f32x2 s = (v * v) * (-0.72134752044f);
    f32x2 e; e.x = __builtin_amdgcn_exp2f(s.x); e.y = __builtin_amdgcn_exp2f(s.y);
    const f32x2 m = v * (q * e), r = v - m;
    f32x2 o; o.x = v.x < 0.f ? m.x : r.x; o.y = v.y < 0.f ? m.y : r.y; return o;
}

struct EpiF32 {
    static constexpr bool PERM = false, AFTER_DRAIN = false;
    float* C; int ldc; const float* bias;
    __device__ __forceinline__ void operator()(const f32x4 (&acc)[2][2][4][2], const Unit& u, int wr, int wc, int fr, int fq) const {
        const int row0 = u.pm * BM + wr * 64 + fr, col0 = u.pn * BM + wc * 32 + 4 * fq;
        f32x4 bv[2][2];
#pragma unroll
        for (int bj = 0; bj < 2; ++bj)
#pragma unroll
            for (int n = 0; n < 2; ++n) bv[bj][n] = bias ? *(const f32x4*)(bias + col0 + bj * HALF + n * 16) : (f32x4){0.f, 0.f, 0.f, 0.f};
#pragma unroll
        for (int ai = 0; ai < 2; ++ai)
#pragma unroll
            for (int m = 0; m < 4; ++m) { float* rowp = C + (size_t)(row0 + ai * HALF + m * 16) * ldc + col0;
#pragma unroll
                for (int bj = 0; bj < 2; ++bj)
#pragma unroll
                    for (int n = 0; n < 2; ++n) *(f32x4*)(rowp + bj * HALF + n * 16) = acc[ai][bj][m][n] + bv[bj][n]; }
    }
};
template <int ACT  > struct EpiBf16 {
    static constexpr bool PERM = true, AFTER_DRAIN = false;
    bf16_t* O; int ldc; const float* bias; int split_cols; size_t split_stride;
    __device__ __forceinline__ void operator()(const f32x4 (&acc)[2][2][4][2], const Unit& u, int wr, int wc, int fr, int fq) const {
        const int row0 = u.pm * BM + wr * 64 + fr; int colt = u.pn * BM; bf16_t* base = O;
        if (split_cols) { const int t = colt / split_cols; base += (size_t)t * split_stride; colt -= t * split_cols; }
        const int col0 = colt + wc * 32 + 8 * fq, bcol0 = u.pn * BM + wc * 32 + 8 * fq;
        f32x4 bv[2][2];
#pragma unroll
        for (int bj = 0; bj < 2; ++bj)
#pragma unroll
            for (int n = 0; n < 2; ++n) bv[bj][n] = bias ? *(const f32x4*)(bias + bcol0 + bj * HALF + 4 * n) : (f32x4){0.f, 0.f, 0.f, 0.f};
#pragma unroll
        for (int ai = 0; ai < 2; ++ai)
#pragma unroll
            for (int m = 0; m < 4; ++m) { bf16_t* rowp = base + (size_t)(row0 + ai * HALF + m * 16) * ldc + col0;
#pragma unroll
                for (int bj = 0; bj < 2; ++bj) { f32x4 v0 = acc[ai][bj][m][0] + bv[bj][0], v1 = acc[ai][bj][m][1] + bv[bj][1];
                    if (ACT == 1) { f32x2 a = gelu_pk((f32x2){v0[0], v0[1]}), b = gelu_pk((f32x2){v0[2], v0[3]}), c = gelu_pk((f32x2){v1[0], v1[1]}), d = gelu_pk((f32x2){v1[2], v1[3]});
                        v0 = (f32x4){a.x, a.y, b.x, b.y}; v1 = (f32x4){c.x, c.y, d.x, d.y}; }
                    if (ACT == 2) {
#pragma unroll
                        for (int j = 0; j < 4; ++j) { v0[j] = 0.5f * v0[j] * (1.0f + erff(v0[j] * 0.70710678f)); v1[j] = 0.5f * v1[j] * (1.0f + erff(v1[j] * 0.70710678f)); } }
                    u32x4 w; w.x = cvt_pk_bf16(v0[0], v0[1]); w.y = cvt_pk_bf16(v0[2], v0[3]); w.z = cvt_pk_bf16(v1[0], v1[1]); w.w = cvt_pk_bf16(v1[2], v1[3]);
                    *(u32x4*)(rowp + bj * HALF) = w; } }
    }
};

struct PanelStats {
    unsigned* xbuf;
    unsigned* cnt;
    unsigned* tmo;
    int ntn; float eps;
    unsigned code;
    __device__ __forceinline__ bool run(const f32x4 (&v)[2][2][4][2], const Unit& u, int wr, int wc, int fr, int fq, PG8_LAS unsigned char* lds, int wid, int lane) const {
        typedef float f32x2v __attribute__((ext_vector_type(2)));
        PG8_LAS f32x2v* P = (PG8_LAS f32x2v*)lds;
        PG8_LAS f32x2v* S = (PG8_LAS f32x2v*)(lds + 8192);
        PG8_LAS unsigned* flag = (PG8_LAS unsigned*)(lds + 8192 + 2048);
#pragma unroll
        for (int ai = 0; ai < 2; ++ai)
#pragma unroll
            for (int m = 0; m < 4; ++m) {
                float s = 0.f;
#pragma unroll
                for (int bj = 0; bj < 2; ++bj)
#pragma unroll
                    for (int n = 0; n < 2; ++n) { const f32x4 x = v[ai][bj][m][n]; s += (x[0] + x[1]) + (x[2] + x[3]); }
                s += __shfl_xor(s, 16); s += __shfl_xor(s, 32);
                const float mw = s * (1.0f / 64.0f); float q = 0.f;
#pragma unroll
                for (int bj = 0; bj < 2; ++bj)
#pragma unroll
                    for (int n = 0; n < 2; ++n) { const f32x4 d = v[ai][bj][m][n] - mw; q += (d[0] * d[0] + d[1] * d[1]) + (d[2] * d[2] + d[3] * d[3]); }
                q += __shfl_xor(q, 16); q += __shfl_xor(q, 32);
                if (fq == 0) P[(ai * HALF + wr * 64 + m * 16 + fr) * 4 + wc] = (f32x2v){mw, q};
            }
        asm volatile("s_waitcnt lgkmcnt(0)" ::: "memory"); __builtin_amdgcn_s_barrier(); asm volatile("" ::: "memory");
#if defined(BROKEN_NO_WAIT)
        if (blockIdx.x >= 64) { const long long t0 = clock64(); while (clock64() - t0 < 60000) __builtin_amdgcn_s_sleep(8); }
#endif
        const int row = wid * 32 + (lane & 31);
        if (lane < 32) {
            const f32x2v a = P[row * 4 + 0], b = P[row * 4 + 1], c = P[row * 4 + 2], d = P[row * 4 + 3];
            const float mt = (a.x + b.x + c.x + d.x) * 0.25f;
            const float da = a.x - mt, db = b.x - mt, dc = c.x - mt, dd = d.x - mt;
            const float m2 = (a.y + b.y) + (c.y + d.y) + 64.0f * ((da * da + db * db) + (dc * dc + dd * dd));
            unsigned long long* slot = (unsigned long long*)xbuf + ((size_t)(u.pm * BM + row) * 4 + u.pn);
            __hip_atomic_store(slot, ((unsigned long long)__float_as_uint(m2) << 32) | __float_as_uint(mt), __ATOMIC_RELAXED, __HIP_MEMORY_SCOPE_AGENT);
        }
        asm volatile("s_waitcnt vmcnt(0)" ::: "memory");
        if (lane == 0) __hip_atomic_fetch_add(cnt + 64 * u.pm, 1u, __ATOMIC_RELAXED, __HIP_MEMORY_SCOPE_AGENT);
        if (wid == 0) {
            bool dead = false; const unsigned long long t0 = __builtin_amdgcn_s_memrealtime(); const unsigned want = 8u * (unsigned)ntn;
            for (;;) {
#if defined(BROKEN_NO_WAIT)
                break;
#endif
                if ((unsigned)__builtin_amdgcn_readfirstlane(__hip_atomic_load(cnt + 64 * u.pm, __ATOMIC_RELAXED, __HIP_MEMORY_SCOPE_AGENT)) >= want) break;
                if (__builtin_amdgcn_s_memrealtime() - t0 > 2000000ull) {
                    if (lane == 0) { unsigned expect = 0u; __hip_atomic_compare_exchange_strong(tmo + 1, &expect, code | (unsigned)(u.pm & 0xff), __ATOMIC_RELAXED, __ATOMIC_RELAXED, __HIP_MEMORY_SCOPE_AGENT);
                                     __hip_atomic_store(tmo, 1u, __ATOMIC_RELAXED, __HIP_MEMORY_SCOPE_AGENT); }
                    dead = true; break; }
                __builtin_amdgcn_s_sleep(2);
            }
            __builtin_amdgcn_fence(__ATOMIC_ACQUIRE, "agent");
            if (lane == 0) flag[0] = dead ? 1u : 0u;
        }
        asm volatile("s_waitcnt vmcnt(0) lgkmcnt(0)" ::: "memory"); __builtin_amdgcn_s_barrier(); asm volatile("" ::: "memory");
        const bool bad = flag[0] != 0u;
        if (lane < 32) {
            const unsigned long long* slot = (const unsigned long long*)xbuf + (size_t)(u.pm * BM + row) * 4; float mt[4], m2[4]; float ms = 0.f;
#pragma unroll
            for (int t = 0; t < 4; ++t) { if (t < ntn) { const unsigned long long w = __hip_atomic_load(slot + t, __ATOMIC_RELAXED, __HIP_MEMORY_SCOPE_AGENT); mt[t] = __uint_as_float((unsigned)w); m2[t] = __uint_as_float((unsigned)(w >> 32)); } else { mt[t] = 0.f; m2[t] = 0.f; } ms += mt[t]; }
            const float mean = ms / (float)ntn; float q = 0.f;
#pragma unroll
            for (int t = 0; t < 4; ++t) if (t < ntn) { const float dm = mt[t] - mean; q += m2[t] + 256.0f * dm * dm; }
            S[row] = (f32x2v){mean, 1.0f / sqrtf(q / (256.0f * (float)ntn) + eps)};
        }
        asm volatile("s_waitcnt lgkmcnt(0)" ::: "memory"); __builtin_amdgcn_s_barrier(); asm volatile("" ::: "memory");
        return bad;
    }
};
struct EpiLnRes {
    static constexpr bool PERM = false, AFTER_DRAIN = true;
    const float* base; float* out; int ldc; const float* bias; PanelStats st; unsigned poison;
    __device__ __forceinline__ void refuse(size_t i0, size_t stride, int M, int N) const { const float q = __builtin_nanf(""); for (size_t i = i0; i < (size_t)M * N; i += stride) out[(i / N) * ldc + i % N] = q;
        if (i0 == 0) { unsigned expect = 0u; __hip_atomic_compare_exchange_strong(st.tmo + 1, &expect, 0x7f0u, __ATOMIC_RELAXED, __ATOMIC_RELAXED, __HIP_MEMORY_SCOPE_AGENT); __hip_atomic_store(st.tmo, 1u, __ATOMIC_RELAXED, __HIP_MEMORY_SCOPE_AGENT); } }
    __device__ __forceinline__ void fused(f32x4 (&acc)[2][2][4][2], const Unit& u, int wr, int wc, int fr, int fq, PG8_LAS unsigned char* lds, int wid, int lane) const {
        typedef float f32x2v __attribute__((ext_vector_type(2)));
        const PG8_LAS f32x2v* S = (const PG8_LAS f32x2v*)(lds + 8192);
        const int col0 = u.pn * BM + wc * 32 + 4 * fq;
#pragma unroll
        for (int bj = 0; bj < 2; ++bj)
#pragma unroll
            for (int n = 0; n < 2; ++n) { const f32x4 bv = bias ? *(const f32x4*)(bias + col0 + bj * HALF + n * 16) : (f32x4){0.f, 0.f, 0.f, 0.f};
#pragma unroll
                for (int ai = 0; ai < 2; ++ai)
#pragma unroll
                    for (int m = 0; m < 4; ++m) acc[ai][bj][m][n] += bv; }
        const bool bad = st.run(acc, u, wr, wc, fr, fq, lds, wid, lane) || poison != 0u;
        const float qnan = __builtin_nanf("");
#pragma unroll
        for (int ai = 0; ai < 2; ++ai)
#pragma unroll
            for (int m = 0; m < 4; ++m) { const int r = ai * HALF + wr * 64 + m * 16 + fr; const f32x2v sr = S[r]; const size_t off = (size_t)(u.pm * BM + r) * ldc + col0;
#pragma unroll
                for (int bj = 0; bj < 2; ++bj)
#pragma unroll
                    for (int n = 0; n < 2; ++n) { const f32x4 bs = *(const f32x4*)(base + off + bj * HALF + n * 16); f32x4 o = bs + (acc[ai][bj][m][n] - sr.x) * sr.y;
                        if (bad) o = (f32x4){qnan, qnan, qnan, qnan}; *(f32x4*)(out + off + bj * HALF + n * 16) = o; }
                asm volatile("" ::: "memory"); }
    }
};
struct EpiLnResLn {
    static constexpr bool PERM = false, AFTER_DRAIN = true;
    const float* base; float* out; bf16_t* xn; int ldc; const float* bias; PanelStats st1, st2; unsigned poison;
    __device__ __forceinline__ void refuse(size_t i0, size_t stride, int M, int N) const { const float q = __builtin_nanf(""); for (size_t i = i0; i < (size_t)M * N; i += stride) { const size_t o = (i / N) * ldc + i % N; out[o] = q; xn[o] = (bf16_t)0x7fc0u; }
        if (i0 == 0) { unsigned expect = 0u; __hip_atomic_compare_exchange_strong(st1.tmo + 1, &expect, 0x7f0u, __ATOMIC_RELAXED, __ATOMIC_RELAXED, __HIP_MEMORY_SCOPE_AGENT); __hip_atomic_store(st1.tmo, 1u, __ATOMIC_RELAXED, __HIP_MEMORY_SCOPE_AGENT); } }
    __device__ __forceinline__ void fused(f32x4 (&acc)[2][2][4][2], const Unit& u, int wr, int wc, int fr, int fq, PG8_LAS unsigned char* lds, int wid, int lane) const {
        typedef float f32x2v __attribute__((ext_vector_type(2))); typedef unsigned u32x2v __attribute__((ext_vector_type(2)));
        const PG8_LAS f32x2v* S = (const PG8_LAS f32x2v*)(lds + 8192);
        const int col0 = u.pn * BM + wc * 32 + 4 * fq;
#pragma unroll
        for (int bj = 0; bj < 2; ++bj)
#pragma unroll
            for (int n = 0; n < 2; ++n) { const f32x4 bv = bias ? *(const f32x4*)(bias + col0 + bj * HALF + n * 16) : (f32x4){0.f, 0.f, 0.f, 0.f};
#pragma unroll
                for (int ai = 0; ai < 2; ++ai)
#pragma unroll
                    for (int m = 0; m < 4; ++m) acc[ai][bj][m][n] += bv; }
        bool bad = st1.run(acc, u, wr, wc, fr, fq, lds, wid, lane) || poison != 0u;
        const float qnan = __builtin_nanf("");
#pragma unroll
        for (int ai = 0; ai < 2; ++ai)
#pragma unroll
            for (int m = 0; m < 4; ++m) { const int r = ai * HALF + wr * 64 + m * 16 + fr; const f32x2v sr = S[r]; const size_t off = (size_t)(u.pm * BM + r) * ldc + col0;
#pragma unroll
                for (int bj = 0; bj < 2; ++bj)
#pragma unroll
                    for (int n = 0; n < 2; ++n) { const f32x4 bs = *(const f32x4*)(base + off + bj * HALF + n * 16); acc[ai][bj][m][n] = bs + (acc[ai][bj][m][n] - sr.x) * sr.y; }
                asm volatile("" : "+v"(acc[ai][0][m][0]), "+v"(acc[ai][0][m][1]), "+v"(acc[ai][1][m][0]), "+v"(acc[ai][1][m][1]));
                if (m & 1) asm volatile("" ::: "memory"); }
        const bool bad1 = bad;
        bad = st2.run(acc, u, wr, wc, fr, fq, lds, wid, lane) || bad;
#pragma unroll
        for (int ai = 0; ai < 2; ++ai)
#pragma unroll
            for (int m = 0; m < 4; ++m) { const int r = ai * HALF + wr * 64 + m * 16 + fr; const f32x2v sr = S[r]; const size_t off = (size_t)(u.pm * BM + r) * ldc + col0;
#pragma unroll
                for (int bj = 0; bj < 2; ++bj)
#pragma unroll
                    for (int n = 0; n < 2; ++n) { const f32x4 x1 = acc[ai][bj][m][n]; *(f32x4*)(out + off + bj * HALF + n * 16) = bad1 ? (f32x4){qnan, qnan, qnan, qnan} : x1;
                        const f32x4 o = (x1 - sr.x) * sr.y; u32x2v w; w.x = cvt_pk_bf16(o[0], o[1]); w.y = cvt_pk_bf16(o[2], o[3]);
                        if (bad) { w.x = 0x7fc07fc0u; w.y = 0x7fc07fc0u; } *(u32x2v*)(xn + off + bj * HALF + n * 16) = w; }
                asm volatile("" ::: "memory"); }
    }
};

template <class Epi, class Sched, bool STAMP = false>
__device__ __forceinline__ void gemm_phase(PG8_LAS unsigned char* lds, const Gemm g, const Sched& S, const Epi& E, unsigned long long* stamps) {
    int tid_l_ = (int)threadIdx.x; asm volatile("" : "+v"(tid_l_)); const int tid = tid_l_, wid = __builtin_amdgcn_readfirstlane(tid >> 6), lane = tid & 63, wr = wid >> 2, wc = wid & 3, fr = lane & 15, fq = lane >> 4;
    const int K = g.K, nt = K / BK;
    int ts_lo = 0, ts_hi = 0, nts = 0; const unsigned long long rt_entry = STAMP ? (unsigned long long)wall_clock64() : 0ull;
#define PG8_STAMP() do { if (STAMP && wid == 0 && nts < 64) { const unsigned long long _c = (unsigned long long)clock64(); \
        ts_lo = (lane == nts) ? (int)(unsigned)_c : ts_lo; ts_hi = (lane == nts) ? (int)(unsigned)(_c >> 32) : ts_hi; ++nts; } } while (0)
    PG8_STAMP();
    unsigned voffA[2], voffB[2];
#pragma unroll
    for (int i = 0; i < 2; ++i) { int R, C; stage_rc(tid * 16 + i * 8192, R, C); const int Rb = Epi::PERM ? ((R & ~31) + perm32(R & 31)) : R;
        voffA[i] = (unsigned)(R * K + C) * 2u; voffB[i] = (unsigned)(Rb * K + C) * 2u; }
    const size_t kstep = (size_t)(BK * 2);
    const size_t hstep = (size_t)HALF * K * 2;
    const size_t tstep = 2 * hstep;
    const unsigned ldsw = (unsigned)wid * 1024u;
    const int aoff = lds_byte(wr * 64 + fr, fq * 8), boff = lds_byte(wc * 32 + fr, fq * 8);
#define PG8_SA(b, h) (((b) * 2 + (h)) * HTB)
#define PG8_SB(b, h) ((4 + (b) * 2 + (h)) * HTB)
#define PG8_STAGE(bufoff, gbase, voff) do { _Pragma("unroll") for (int _i = 0; _i < 2; ++_i) \
        __builtin_amdgcn_global_load_lds((const unsigned*)((const char*)(gbase) + (voff)[_i]), (PG8_LAS unsigned*)(lds + (bufoff) + ldsw + _i * 8192), 16, 0, 0); } while (0)
#define PG8_LDA(dst, b, h) do { _Pragma("unroll") for (int m = 0; m < 4; ++m) _Pragma("unroll") for (int k = 0; k < 2; ++k) dst[m][k] = *(const PG8_LAS bf16x8*)(lds + PG8_SA(b, h) + aoff + m * 2048 + k * 1024); } while (0)
#define PG8_LDB(dst, b, h) do { _Pragma("unroll") for (int n = 0; n < 2; ++n) _Pragma("unroll") for (int k = 0; k < 2; ++k) dst[n][k] = *(const PG8_LAS bf16x8*)(lds + PG8_SB(b, h) + boff + n * 2048 + k * 1024); } while (0)
#define PG8_MMA(ai, bj, At, Bt) do { __builtin_amdgcn_s_setprio(1); _Pragma("unroll") for (int m = 0; m < 4; ++m) _Pragma("unroll") for (int n = 0; n < 2; ++n) _Pragma("unroll") for (int k = 0; k < 2; ++k) \
        acc[ai][bj][m][n] = __builtin_amdgcn_mfma_f32_16x16x32_bf16(Bt[n][k], At[m][k], acc[ai][bj][m][n], 0, 0, 0); __builtin_amdgcn_s_setprio(0); } while (0)
#define PG8_WAIT_V(n) asm volatile("s_waitcnt vmcnt(" #n ")" ::: "memory")
#define PG8_WAIT_L(n) asm volatile("s_waitcnt lgkmcnt(" #n ")" ::: "memory")
#define PG8_BAR __builtin_amdgcn_s_barrier()
#define PG8_SCHED __builtin_amdgcn_sched_barrier(0)
    Unit cur, nxt; int ui = 0;
    if (!S.next(0, cur)) return;
    f32x4 acc[2][2][4][2];
#pragma unroll
    for (int a = 0; a < 2; ++a)
#pragma unroll
        for (int b = 0; b < 2; ++b)
#pragma unroll
            for (int m = 0; m < 4; ++m)
#pragma unroll
                for (int n = 0; n < 2; ++n) acc[a][b][m][n] = (f32x4){0.f, 0.f, 0.f, 0.f};
    bf16x8 At[4][2], B0[2][2], B1[2][2];
    const char* cA = (const char*)g.A + (size_t)cur.pm * tstep; const char* cB = (const char*)g.Bt + (size_t)cur.pn * tstep;
    S.a_ready(cur);
    PG8_STAGE(PG8_SB(0, 0), cB, voffB); PG8_STAGE(PG8_SA(0, 0), cA, voffA); PG8_STAGE(PG8_SB(0, 1), cB + hstep, voffB); PG8_STAGE(PG8_SA(0, 1), cA + hstep, voffA);
    if (wr == 1) PG8_BAR;
    PG8_WAIT_V(4); PG8_BAR;
    PG8_STAGE(PG8_SB(1, 0), cB + kstep, voffB); PG8_STAGE(PG8_SA(1, 0), cA + kstep, voffA); PG8_STAGE(PG8_SB(1, 1), cB + hstep + kstep, voffB);
    PG8_WAIT_V(6); PG8_BAR;
    PG8_STAMP();
    for (;;) {
        const bool has_next = S.next(ui + 1, nxt);
        const char* nA = has_next ? (const char*)g.A + (size_t)nxt.pm * tstep : cA; const char* nB = has_next ? (const char*)g.Bt + (size_t)nxt.pn * tstep : cB;
        for (int t = 0; t < nt; t += 2) {
            const bool last = (t == nt - 2);
            const char* a1 = cA + (size_t)(t + 1) * kstep;
            const char* a2 = last ? nA : cA + (size_t)(t + 2) * kstep; const char* b2 = last ? nB : cB + (size_t)(t + 2) * kstep;
            const char* a3 = a2 + kstep; const char* b3 = b2 + kstep;
            if (last && has_next) S.a_ready(nxt);
            PG8_LDB(B0, 0, 0); PG8_SCHED; PG8_LDA(At, 0, 0); PG8_STAGE(PG8_SA(1, 1), a1 + hstep, voffA);
            PG8_WAIT_L(8); PG8_BAR; PG8_WAIT_L(0); PG8_MMA(0, 0, At, B0); PG8_BAR; PG8_SCHED;
            PG8_LDB(B1, 0, 1); PG8_STAGE(PG8_SB(0, 0), b2, voffB);
            PG8_BAR; PG8_WAIT_L(0); PG8_MMA(0, 1, At, B1); PG8_BAR;
            PG8_LDA(At, 0, 1); PG8_STAGE(PG8_SA(0, 0), a2, voffA);
            PG8_BAR; PG8_WAIT_L(0); PG8_MMA(1, 0, At, B0); PG8_BAR; PG8_SCHED;
            PG8_STAGE(PG8_SB(0, 1), b2 + hstep, voffB);
            PG8_WAIT_V(6); PG8_BAR; PG8_MMA(1, 1, At, B1); PG8_BAR;
            PG8_LDB(B0, 1, 0); PG8_SCHED; PG8_LDA(At, 1, 0); PG8_STAGE(PG8_SA(0, 1), a2 + hstep, voffA);
            PG8_WAIT_L(8); PG8_BAR; PG8_WAIT_L(0); PG8_MMA(0, 0, At, B0); PG8_BAR; PG8_SCHED;
            PG8_LDB(B1, 1, 1); PG8_STAGE(PG8_SB(1, 0), b3, voffB);
            PG8_BAR; PG8_WAIT_L(0); PG8_MMA(0, 1, At, B1); PG8_BAR;
            PG8_LDA(At, 1, 1); PG8_STAGE(PG8_SA(1, 0), a3, voffA);
            PG8_BAR; PG8_WAIT_L(0); PG8_MMA(1, 0, At, B0); PG8_BAR; PG8_SCHED;
            PG8_STAGE(PG8_SB(1, 1), b3 + hstep, voffB);
            PG8_WAIT_V(6); PG8_BAR; PG8_MMA(1, 1, At, B1); PG8_BAR;
        }
        PG8_STAMP();
        if constexpr (!Epi::AFTER_DRAIN) { E(acc, cur, wr, wc, fr, fq); S.done(cur); }
        PG8_STAMP();
        if (!has_next) break;
#pragma unroll
        for (int a = 0; a < 2; ++a)
#pragma unroll
            for (int b = 0; b < 2; ++b)
#pragma unroll
                for (int m = 0; m < 4; ++m)
#pragma unroll
                    for (int n = 0; n < 2; ++n) acc[a][b][m][n] = (f32x4){0.f, 0.f, 0.f, 0.f};
        cur = nxt; cA = nA; cB = nB; ++ui;
    }
    PG8_WAIT_V(0);
    if (wr == 0) PG8_BAR;
    PG8_BAR;
    if constexpr (Epi::AFTER_DRAIN) { E.fused(acc, cur, wr, wc, fr, fq, lds, wid, lane); S.done(cur); }
    PG8_STAMP();
    if (STAMP && wid == 0) { stamps[lane] = lane < nts ? (((unsigned long long)(unsigned)ts_hi << 32) | (unsigned)ts_lo) : 0ull;
        if (lane == 62) stamps[62] = rt_entry; if (lane == 63) stamps[63] = (unsigned long long)wall_clock64(); }
#undef PG8_STAMP
#undef PG8_SA
#undef PG8_SB
#undef PG8_STAGE
#undef PG8_LDA
#undef PG8_LDB
#undef PG8_MMA
#undef PG8_WAIT_V
#undef PG8_WAIT_L
#undef PG8_BAR
#undef PG8_SCHED
}
template <class Epi, class Sched, bool STAMP = false>
__device__ __forceinline__ void gemm_phase_g(PG8_LAS unsigned char* lds, const Gemm g, const Sched& S, const Epi& E, const PG8_LAS int* ridx) {
    unsigned long long* stamps = nullptr;
    int tid_l_ = (int)threadIdx.x; asm volatile("" : "+v"(tid_l_)); const int tid = tid_l_, wid = __builtin_amdgcn_readfirstlane(tid >> 6), lane = tid & 63, wr = wid >> 2, wc = wid & 3, fr = lane & 15, fq = lane >> 4;
    const int K = g.K, nt = K / BK;
    int ts_lo = 0, ts_hi = 0, nts = 0; const unsigned long long rt_entry = STAMP ? (unsigned long long)wall_clock64() : 0ull;
#define PG8_STAMP() do { if (STAMP && wid == 0 && nts < 64) { const unsigned long long _c = (unsigned long long)clock64(); \
        ts_lo = (lane == nts) ? (int)(unsigned)_c : ts_lo; ts_hi = (lane == nts) ? (int)(unsigned)(_c >> 32) : ts_hi; ++nts; } } while (0)
    PG8_STAMP();
    unsigned voffB[2]; int rA[2]; unsigned cA2[2];
#pragma unroll
    for (int i = 0; i < 2; ++i) { int R, C; stage_rc(tid * 16 + i * 8192, R, C); const int Rb = Epi::PERM ? ((R & ~31) + perm32(R & 31)) : R;
        rA[i] = R; cA2[i] = (unsigned)C * 2u; voffB[i] = (unsigned)(Rb * K + C) * 2u; }
    unsigned vc[2][2], vn[2][2];
#define PG8_GIDX(dst, ui_) do { _Pragma("unroll") for (int h_ = 0; h_ < 2; ++h_) _Pragma("unroll") for (int i_ = 0; i_ < 2; ++i_) dst[h_][i_] = (unsigned)ridx[(ui_) * 256 + h_ * 128 + rA[i_]] * (unsigned)(K * 2) + cA2[i_]; \
        asm volatile("s_waitcnt lgkmcnt(0)" ::: "memory"); } while (0)
    const size_t kstep = (size_t)(BK * 2);
    const size_t hstep = (size_t)HALF * K * 2;
    const size_t tstep = 2 * hstep;
    const unsigned ldsw = (unsigned)wid * 1024u;
    const int aoff = lds_byte(wr * 64 + fr, fq * 8), boff = lds_byte(wc * 32 + fr, fq * 8);
#define PG8_SA(b, h) (((b) * 2 + (h)) * HTB)
#define PG8_SB(b, h) ((4 + (b) * 2 + (h)) * HTB)
#define PG8_STAGE(bufoff, gbase, voff) do { _Pragma("unroll") for (int _i = 0; _i < 2; ++_i) \
        __builtin_amdgcn_global_load_lds((const unsigned*)((const char*)(gbase) + (voff)[_i]), (PG8_LAS unsigned*)(lds + (bufoff) + ldsw + _i * 8192), 16, 0, 0); } while (0)
#define PG8_LDA(dst, b, h) do { _Pragma("unroll") for (int m = 0; m < 4; ++m) _Pragma("unroll") for (int k = 0; k < 2; ++k) dst[m][k] = *(const PG8_LAS bf16x8*)(lds + PG8_SA(b, h) + aoff + m * 2048 + k * 1024); } while (0)
#define PG8_LDB(dst, b, h) do { _Pragma("unroll") for (int n = 0; n < 2; ++n) _Pragma("unroll") for (int k = 0; k < 2; ++k) dst[n][k] = *(const PG8_LAS bf16x8*)(lds + PG8_SB(b, h) + boff + n * 2048 + k * 1024); } while (0)
#define PG8_MMA(ai, bj, At, Bt) do { __builtin_amdgcn_s_setprio(1); _Pragma("unroll") for (int m = 0; m < 4; ++m) _Pragma("unroll") for (int n = 0; n < 2; ++n) _Pragma("unroll") for (int k = 0; k < 2; ++k) \
        acc[ai][bj][m][n] = __builtin_amdgcn_mfma_f32_16x16x32_bf16(Bt[n][k], At[m][k], acc[ai][bj][m][n], 0, 0, 0); __builtin_amdgcn_s_setprio(0); } while (0)
#define PG8_WAIT_V(n) asm volatile("s_waitcnt vmcnt(" #n ")" ::: "memory")
#define PG8_WAIT_L(n) asm volatile("s_waitcnt lgkmcnt(" #n ")" ::: "memory")
#define PG8_BAR __builtin_amdgcn_s_barrier()
#define PG8_SCHED __builtin_amdgcn_sched_barrier(0)
    Unit cur, nxt; int ui = 0;
    if (!S.next(0, cur)) return;
    f32x4 acc[2][2][4][2];
#pragma unroll
    for (int a = 0; a < 2; ++a)
#pragma unroll
        for (int b = 0; b < 2; ++b)
#pragma unroll
            for (int m = 0; m < 4; ++m)
#pragma unroll
                for (int n = 0; n < 2; ++n) acc[a][b][m][n] = (f32x4){0.f, 0.f, 0.f, 0.f};
    bf16x8 At[4][2], B0[2][2], B1[2][2];
    const char* cA = (const char*)g.A; const char* cB = (const char*)g.Bt + (size_t)cur.pn * tstep;
    PG8_GIDX(vc, 0);
    S.a_ready(cur);
    PG8_STAGE(PG8_SB(0, 0), cB, voffB); PG8_STAGE(PG8_SA(0, 0), cA, vc[0]); PG8_STAGE(PG8_SB(0, 1), cB + hstep, voffB); PG8_STAGE(PG8_SA(0, 1), cA, vc[1]);
    if (wr == 1) PG8_BAR;
    PG8_WAIT_V(4); PG8_BAR;
    PG8_STAGE(PG8_SB(1, 0), cB + kstep, voffB); PG8_STAGE(PG8_SA(1, 0), cA + kstep, vc[0]); PG8_STAGE(PG8_SB(1, 1), cB + hstep + kstep, voffB);
    PG8_WAIT_V(6); PG8_BAR;
    PG8_STAMP();
    for (;;) {
        const bool has_next = S.next(ui + 1, nxt);
        const char* nB = has_next ? (const char*)g.Bt + (size_t)nxt.pn * tstep : cB;
        if (has_next) PG8_GIDX(vn, ui + 1); else {
#pragma unroll
            for (int h_ = 0; h_ < 2; ++h_)
#pragma unroll
                for (int i_ = 0; i_ < 2; ++i_) vn[h_][i_] = vc[h_][i_]; }
        for (int t = 0; t < nt; t += 2) {
            const bool last = (t == nt - 2);
            const char* a1 = cA + (size_t)(t + 1) * kstep;
            const char* a2 = last ? cA : cA + (size_t)(t + 2) * kstep; const char* b2 = last ? nB : cB + (size_t)(t + 2) * kstep;
            const char* a3 = a2 + kstep; const char* b3 = b2 + kstep;
            unsigned v2[2][2];
#pragma unroll
            for (int h_ = 0; h_ < 2; ++h_)
#pragma unroll
                for (int i_ = 0; i_ < 2; ++i_) v2[h_][i_] = last ? vn[h_][i_] : vc[h_][i_];
            if (last && has_next) S.a_ready(nxt);
            PG8_LDB(B0, 0, 0); PG8_SCHED; PG8_LDA(At, 0, 0); PG8_STAGE(PG8_SA(1, 1), a1, vc[1]);
            PG8_WAIT_L(8); PG8_BAR; PG8_WAIT_L(0); PG8_MMA(0, 0, At, B0); PG8_BAR; PG8_SCHED;
            PG8_LDB(B1, 0, 1); PG8_STAGE(PG8_SB(0, 0), b2, voffB);
            PG8_BAR; PG8_WAIT_L(0); PG8_MMA(0, 1, At, B1); PG8_BAR;
            PG8_LDA(At, 0, 1); PG8_STAGE(PG8_SA(0, 0), a2, v2[0]);
            PG8_BAR; PG8_WAIT_L(0); PG8_MMA(1, 0, At, B0); PG8_BAR; PG8_SCHED;
            PG8_STAGE(PG8_SB(0, 1), b2 + hstep, voffB);
            PG8_WAIT_V(6); PG8_BAR; PG8_MMA(1, 1, At, B1); PG8_BAR;
            PG8_LDB(B0, 1, 0); PG8_SCHED; PG8_LDA(At, 1, 0); PG8_STAGE(PG8_SA(0, 1), a2, v2[1]);
            PG8_WAIT_L(8); PG8_BAR; PG8_WAIT_L(0); PG8_MMA(0, 0, At, B0); PG8_BAR; PG8_SCHED;
            PG8_LDB(B1, 1, 1); PG8_STAGE(PG8_SB(1, 0), b3, voffB);
            PG8_BAR; PG8_WAIT_L(0); PG8_MMA(0, 1, At, B1); PG8_BAR;
            PG8_LDA(At, 1, 1); PG8_STAGE(PG8_SA(1, 0), a3, v2[0]);
            PG8_BAR; PG8_WAIT_L(0); PG8_MMA(1, 0, At, B0); PG8_BAR; PG8_SCHED;
            PG8_STAGE(PG8_SB(1, 1), b3 + hstep, voffB);
            PG8_WAIT_V(6); PG8_BAR; PG8_MMA(1, 1, At, B1); PG8_BAR;
        }
        PG8_STAMP();
        if constexpr (!Epi::AFTER_DRAIN) { E(acc, cur, wr, wc, fr, fq); S.done(cur); }
        PG8_STAMP();
        if (!has_next) break;
#pragma unroll
        for (int a = 0; a < 2; ++a)
#pragma unroll
            for (int b = 0; b < 2; ++b)
#pragma unroll
                for (int m = 0; m < 4; ++m)
#pragma unroll
                    for (int n = 0; n < 2; ++n) acc[a][b][m][n] = (f32x4){0.f, 0.f, 0.f, 0.f};
        cur = nxt; cB = nB; ++ui;
#pragma unroll
        for (int h_ = 0; h_ < 2; ++h_)
#pragma unroll
            for (int i_ = 0; i_ < 2; ++i_) vc[h_][i_] = vn[h_][i_];
    }
    PG8_WAIT_V(0);
    if (wr == 0) PG8_BAR;
    PG8_BAR;
    if constexpr (Epi::AFTER_DRAIN) { E.fused(acc, cur, wr, wc, fr, fq, lds, wid, lane); S.done(cur); }
    PG8_STAMP();
    if (STAMP && wid == 0) { stamps[lane] = lane < nts ? (((unsigned long long)(unsigned)ts_hi << 32) | (unsigned)ts_lo) : 0ull;
        if (lane == 62) stamps[62] = rt_entry; if (lane == 63) stamps[63] = (unsigned long long)wall_clock64(); }
#undef PG8_STAMP
#undef PG8_GIDX
#undef PG8_SA
#undef PG8_SB
#undef PG8_STAGE
#undef PG8_LDA
#undef PG8_LDB
#undef PG8_MMA
#undef PG8_WAIT_V
#undef PG8_WAIT_L
#undef PG8_BAR
#undef PG8_SCHED
}
}

using pg8::bf16_t; using pg8::bf16x8; using pg8::f32x4;
typedef float f32x16 __attribute__((ext_vector_type(16)));
typedef float f32x2v __attribute__((ext_vector_type(2)));
typedef __bf16 bf16x2v __attribute__((ext_vector_type(2)));
typedef short s16x4 __attribute__((ext_vector_type(4)));
typedef unsigned u32x4 __attribute__((ext_vector_type(4)));
typedef unsigned u32x2 __attribute__((ext_vector_type(2)));
typedef PG8_LAS unsigned char* LDSP;
typedef PG8_LAS float* LASF;

constexpr int NTH = 512;
constexpr int LDS_BYTES = 156 * 1024;
constexpr int DM = 1024, LL = 8192, LC = 256, SEQB = 8448, TT = 16896, NPAN = 66, TPAD = 41984;
constexpr size_t UU = (size_t)TT * 1024 * 2;
constexpr float EPS_ = 1e-6f;
constexpr float INV2PI = 0.15915494309189535f;

template <class T> __device__ __forceinline__ T* UP(T* q) { const unsigned long long v = (unsigned long long)q;
    const unsigned lo = (unsigned)__builtin_amdgcn_readfirstlane((int)(unsigned)v), hi = (unsigned)__builtin_amdgcn_readfirstlane((int)(unsigned)(v >> 32));
    return (T*)(__attribute__((address_space(1))) T*)(((unsigned long long)hi << 32) | lo); }
__device__ __forceinline__ int ltid() { int t = (int)threadIdx.x; asm volatile("" : "+v"(t)); return t; }
__device__ __forceinline__ f32x2v mk2_(float x, float y) { f32x2v r; r.x = x; r.y = y; return r; }
__device__ __forceinline__ float bf2f(bf16_t v) { return __uint_as_float(((unsigned)v) << 16); }
__device__ __forceinline__ unsigned pk2(float lo, float hi) { f32x2v v = {lo, hi}; bf16x2v b = __builtin_convertvector(v, bf16x2v); return __builtin_bit_cast(unsigned, b); }
__device__ __forceinline__ bf16_t f2bf(float f) { return (bf16_t)(pk2(f, 0.f) & 0xffffu); }
__device__ __forceinline__ float lo16(unsigned w) { return __uint_as_float(w << 16); }
__device__ __forceinline__ float hi16(unsigned w) { return __uint_as_float(w & 0xffff0000u); }
__device__ __forceinline__ float sigmoidf_(float x) { return __builtin_amdgcn_rcpf(1.0f + __expf(-x)); }
__device__ __forceinline__ float siluf_(float x) { return x * __builtin_amdgcn_rcpf(1.0f + __expf(-x)); }
__device__ __forceinline__ float logsigf_(float x) { return fminf(x, 0.f) - log1pf(__expf(-fabsf(x))); }
__device__ __forceinline__ float sin2pi(float rev) { return __builtin_amdgcn_sinf(rev); }
__device__ __forceinline__ float cos2pi(float rev) { return __builtin_amdgcn_cosf(rev); }
__device__ __forceinline__ int crow(int r, int hi) { return (r & 3) + 8 * (r >> 2) + 4 * hi; }
template <int CTRL> __device__ __forceinline__ float dpp_mov(float x) { return __int_as_float(__builtin_amdgcn_update_dpp(0, __float_as_int(x), CTRL, 0xf, 0xf, false)); }
__device__ __forceinline__ float row_sum(float x) { x += dpp_mov<0x128>(x); x += dpp_mov<0x124>(x); x += dpp_mov<0x122>(x); x += dpp_mov<0x121>(x); return x; }
__device__ __forceinline__ float row_max(float x) { x = fmaxf(x, dpp_mov<0x128>(x)); x = fmaxf(x, dpp_mov<0x124>(x)); x = fmaxf(x, dpp_mov<0x122>(x)); x = fmaxf(x, dpp_mov<0x121>(x)); return x; }
__device__ __forceinline__ void swap32_(float& a, float& b) { auto r = __builtin_amdgcn_permlane32_swap(__float_as_uint(a), __float_as_uint(b), false, false); a = __uint_as_float(r[0]); b = __uint_as_float(r[1]); }
__device__ __forceinline__ void swap16_(float& a, float& b) { auto r = __builtin_amdgcn_permlane16_swap(__float_as_uint(a), __float_as_uint(b), false, false); a = __uint_as_float(r[0]); b = __uint_as_float(r[1]); }
__device__ __forceinline__ float wave_sum(float v) { v = row_sum(v); float w = v; swap16_(v, w); v += w; w = v; swap32_(v, w); return v + w; }
__device__ __forceinline__ float wave_max(float v) { v = row_max(v); float w = v; swap16_(v, w); v = fmaxf(v, w); w = v; swap32_(v, w); return fmaxf(v, w); }
__device__ __forceinline__ void wave_sum32(float (&v)[32]) {
#pragma unroll
    for (int i = 0; i < 16; ++i) { swap32_(v[i], v[16 + i]); v[i] += v[16 + i]; }
#pragma unroll
    for (int i = 0; i < 8; ++i) { swap16_(v[i], v[8 + i]); v[i] += v[8 + i]; }
#pragma unroll
    for (int i = 0; i < 8; ++i) v[i] = row_sum(v[i]); }
__device__ __forceinline__ void wave_sum16(float (&v)[16]) {
#pragma unroll
    for (int i = 0; i < 8; ++i) { swap32_(v[i], v[8 + i]); v[i] += v[8 + i]; }
#pragma unroll
    for (int i = 0; i < 4; ++i) { swap16_(v[i], v[4 + i]); v[i] += v[4 + i]; }
#pragma unroll
    for (int i = 0; i < 4; ++i) v[i] = row_sum(v[i]); }
__device__ __forceinline__ float readlane_f(float x, int l) { return __int_as_float(__builtin_amdgcn_readlane(__float_as_int(x), l)); }
__device__ __forceinline__ void unpack8(const u32x4 w, float (&f)[8]) {
    f[0] = lo16(w.x); f[1] = hi16(w.x); f[2] = lo16(w.y); f[3] = hi16(w.y); f[4] = lo16(w.z); f[5] = hi16(w.z); f[6] = lo16(w.w); f[7] = hi16(w.w); }
constexpr float ST_SC = 4.0f, ST_ISC = 0.25f;
__device__ __forceinline__ unsigned pk4_fp8(float a, float b, float c, float d) {
    a = fminf(fmaxf(a, -440.f), 440.f); b = fminf(fmaxf(b, -440.f), 440.f); c = fminf(fmaxf(c, -440.f), 440.f); d = fminf(fmaxf(d, -440.f), 440.f);
    unsigned w = 0u; w = (unsigned)__builtin_amdgcn_cvt_pk_fp8_f32(a, b, (int)w, false); w = (unsigned)__builtin_amdgcn_cvt_pk_fp8_f32(c, d, (int)w, true); return w; }
__device__ __forceinline__ void unpk8_fp8(const u32x2 w, float (&f)[8]) {
    const f32x2v a = __builtin_amdgcn_cvt_pk_f32_fp8((int)w.x, false), b = __builtin_amdgcn_cvt_pk_f32_fp8((int)w.x, true), c = __builtin_amdgcn_cvt_pk_f32_fp8((int)w.y, false), d = __builtin_amdgcn_cvt_pk_f32_fp8((int)w.y, true);
    f[0] = a.x; f[1] = a.y; f[2] = b.x; f[3] = b.y; f[4] = c.x; f[5] = c.y; f[6] = d.x; f[7] = d.y; }
__device__ __forceinline__ u32x4 pack8(const float (&f)[8]) { u32x4 w; w.x = pk2(f[0], f[1]); w.y = pk2(f[2], f[3]); w.z = pk2(f[4], f[5]); w.w = pk2(f[6], f[7]); return w; }

template <class T> struct GP { __attribute__((address_space(1))) T* p;
    __host__ __device__ __forceinline__ GP& operator=(T* q) { p = (__attribute__((address_space(1))) T*)q; return *this; }
    __device__ __forceinline__ operator T*() const { return (T*)p; } };
struct Params {
    GP<const float> x, c, ctx, c_ctx, mod_w, mod_b, norm1_g, norm2_g, w_in, merge_b, m_conv_w, m_conv_b, m_gate_b, m_norm_g;
    GP<const float> a_qnorm_g, a_knorm_g, a_lambda, a_subln_g, h_conv_w, h_conv_b, h_ffn_w1, h_ffn_b1, h_ffn_w2, h_ffn_b2, h_ffn_w3;
    GP<const float> h_freq, h_decay, h_bias, w_br_m, w_br_a, w_br_h, w_out, router_w, router_b, e_w1, e_w3, e_w2;
    GP<float> out;
    GP<unsigned> bar; GP<int> cnt; GP<int> cur; GP<float> sumsq; GP<float> sumsqC;
    GP<float> modv; GP<float> hdn2; GP<float> G; GP<float> xc; GP<int> sel_e; GP<float> sel_w; GP<int> posbuf; GP<int> rowidx;
    GP<float> scal; GP<float> ms; GP<float> dn; GP<float> nst; GP<float> hfC; GP<float> hbC;
    GP<bf16_t> Wt_in, Wt_br, Wt_out, hn, Y3;
    GP<unsigned char> R;
};

__device__ __forceinline__ const float* resid_row_in(const Params& p, int layer, int s) {
    const int b = s / SEQB, pos = s - b * SEQB;
    if (pos < LC) return (layer == 0 ? p.ctx : p.xc) + (size_t)(b * LC + pos) * DM;
    return (layer == 0 ? p.x : p.out) + (size_t)(b * LL + pos - LC) * DM; }
__device__ __forceinline__ float* resid_row(const Params& p, int s) {
    const int b = s / SEQB, pos = s - b * SEQB;
    if (pos < LC) return p.xc + (size_t)(b * LC + pos) * DM;
    return p.out + (size_t)(b * LL + pos - LC) * DM; }
__device__ __forceinline__ const float* modvec(const Params& p, int layer, int s) { const int b = s / SEQB, pos = s - b * SEQB; return p.modv + (size_t)(layer * 3 + (pos < LC ? 2 : b)) * 6144; }

struct MapWin { const float* w;
    __device__ __forceinline__ const float* operator()(int n0, int cb, int k) const { int col;
        if (n0 < 6144) col = 4112 + n0;
        else if (n0 < 6656) col = 12304 + (n0 - 6144);
        else if (n0 < 12800) { const int m = n0 - 6656, d = m >> 10; col = (d < 4 ? 1024 * d : (d == 4 ? 10256 : 11280)) + (m & 1023); }
        else col = 12304 + 512 + (n0 - 12800);
        return w + (size_t)k * 13328 + col + cb * 4; } };
struct MapPlain { const float* w; int ld;
    __device__ __forceinline__ const float* operator()(int n0, int cb, int k) const { return w + (size_t)k * ld + n0 + cb * 4; } };
struct MapE13 { const float* w1; long d31;
    __device__ __forceinline__ const float* operator()(int n0, int cb, int k) const { return w1 + ((cb & 1) ? d31 : 0l) + (size_t)k * 512 + (n0 >> 1) + 4 * (cb >> 1); } };
template <class MAP> __device__ __forceinline__ void xpose_tile(const MAP& map, int n0, int k0, bf16_t* dst, int K, LDSP lds) {
    LASF tl = (LASF)lds; const int tid = ltid();
    float4 v[4];
#pragma unroll
    for (int pass = 0; pass < 4; ++pass) v[pass] = *(const float4*)map(n0, tid & 15, k0 + pass * 32 + (tid >> 4));
#pragma unroll
    for (int pass = 0; pass < 4; ++pass) { const int k = pass * 32 + (tid >> 4), cb = tid & 15;
        tl[k * 65 + cb * 4 + 0] = v[pass].x; tl[k * 65 + cb * 4 + 1] = v[pass].y; tl[k * 65 + cb * 4 + 2] = v[pass].z; tl[k * 65 + cb * 4 + 3] = v[pass].w; }
    __syncthreads();
    { const int n = tid >> 3, kq = (tid & 7) * 16; float f[8], g[8];
#pragma unroll
      for (int i = 0; i < 8; ++i) { f[i] = tl[(kq + i) * 65 + n]; g[i] = tl[(kq + 8 + i) * 65 + n]; }
      bf16_t* d = dst + (size_t)(n0 + n) * K + k0 + kq;
      *(u32x4*)d = pack8(f); *(u32x4*)(d + 8) = pack8(g); }
    __syncthreads();
}
template <class MAP> __device__ __forceinline__ void xpose_mat(const MAP& map, int N, int K, bf16_t* dst, LDSP lds, int bid, int nb) {
    const int ntn = N / 64, ntk = K / 128;
    for (int ti = bid; ti < ntn * ntk; ti += nb) { const int nt = ti / ntk, kt = ti - nt * ntk; xpose_tile(map, nt * 64, kt * 128, dst, K, lds); }
}
__device__ __forceinline__ void phase_conv_small(const Params& p, int layer, LDSP lds, int bid, int nb) {
    { MapWin m{p.w_in + (size_t)layer * 1024 * 13328}; xpose_mat(m, 13312, 1024, p.Wt_in, lds, bid, nb); }
    { MapPlain m{p.w_br_m + (size_t)layer * 1048576, 1024}; xpose_mat(m, 1024, 1024, p.Wt_br + (size_t)layer * 3 * 1048576, lds, bid, nb); }
    { MapPlain m{p.w_br_a + (size_t)layer * 1048576, 1024}; xpose_mat(m, 1024, 1024, p.Wt_br + (size_t)layer * 3 * 1048576 + 1048576, lds, bid, nb); }
    { MapPlain m{p.w_br_h + (size_t)layer * 1048576, 1024}; xpose_mat(m, 1024, 1024, p.Wt_br + (size_t)layer * 3 * 1048576 + 2 * 1048576, lds, bid, nb); }
    { MapPlain m{p.w_out + (size_t)layer * 1048576, 1024}; xpose_mat(m, 1024, 1024, p.Wt_out + (size_t)layer * 1048576, lds, bid, nb); }
}
__device__ __forceinline__ void phase_conv_experts(const Params& p, int layer, bf16_t* Wt13, bf16_t* Wt2, LDSP lds, int bid, int nb) {
    for (int ti = bid; ti < 32 * 128; ti += nb) { const int e = ti >> 7, r = ti & 127, nt = r >> 3, kt = r & 7;
        MapE13 m{p.e_w1 + ((size_t)layer * 32 + e) * 524288, (long)(p.e_w3 - p.e_w1)};
        xpose_tile(m, nt * 64, kt * 128, Wt13 + (size_t)e * 1048576, 1024, lds); }
    for (int ti = bid; ti < 32 * 64; ti += nb) { const int e = ti >> 6, r = ti & 63, nt = r >> 2, kt = r & 3;
        MapPlain m{p.e_w2 + ((size_t)layer * 32 + e) * 524288, 1024};
        xpose_tile(m, nt * 64, kt * 128, Wt2 + (size_t)e * 524288, 512, lds); }
}

__device__ __forceinline__ void phase_modvec(const Params& p, LDSP lds, int bid, int nb) {
    LASF red = (LASF)lds; const int tid = ltid();
    for (int u = bid; u < 192; u += nb) {
        const int l = u / 96, cg = u - l * 96, col = tid & 63, ks = tid >> 6;
        const float* W = p.mod_w + (size_t)l * 1024 * 6144 + cg * 64 + col;
        float a0 = 0.f, a1 = 0.f, a2 = 0.f;
        for (int k0 = ks * 128; k0 < ks * 128 + 128; k0 += 16) { float w[16], c0[16], c1[16], c2[16];
#pragma unroll
            for (int j = 0; j < 16; ++j) { w[j] = W[(size_t)(k0 + j) * 6144]; c0[j] = p.c[k0 + j]; c1[j] = p.c[1024 + k0 + j]; c2[j] = p.c_ctx[k0 + j]; }
#pragma unroll
            for (int j = 0; j < 16; ++j) { a0 += siluf_(c0[j]) * w[j]; a1 += siluf_(c1[j]) * w[j]; a2 += siluf_(c2[j]) * w[j]; } }
        red[(ks * 3 + 0) * 64 + col] = a0; red[(ks * 3 + 1) * 64 + col] = a1; red[(ks * 3 + 2) * 64 + col] = a2;
        __syncthreads();
        if (tid < 192) { const int v = tid >> 6, cc = tid & 63; float s = p.mod_b[l * 6144 + cg * 64 + cc];
#pragma unroll
            for (int q = 0; q < 8; ++q) s += red[(q * 3 + v) * 64 + cc];
            p.modv[(size_t)(l * 3 + v) * 6144 + cg * 64 + cc] = s; }
        __syncthreads();
    }
}

__device__ __forceinline__ void phase_hdn(const Params& p, LDSP lds, int bid, int nb) {
    LASF w1s = (LASF)lds, b1s = w1s + 33 * 64, w2s = b1s + 64, b2s = w2s + 64 * 64, frs = b2s + 64, hbuf = frs + 64;
    const int tid = ltid();
    for (int u = bid; u < 132; u += nb) {
        const int l = u / 66, pu = u - l * 66;
        for (int i = tid; i < 33 * 64; i += NTH) w1s[i] = p.h_ffn_w1[l * 33 * 64 + i];
        for (int i = tid; i < 64 * 64; i += NTH) w2s[i] = p.h_ffn_w2[l * 4096 + i];
        if (tid < 64) { b1s[tid] = p.h_ffn_b1[l * 64 + tid]; b2s[tid] = p.h_ffn_b2[l * 64 + tid]; frs[tid] = p.h_freq[l * 64 + tid]; }
        __syncthreads();
        const int pos = tid >> 2, qd = tid & 3, q = pu * 128 + pos;
        const int Lf = q < 8192 ? 8192 : 256, t = q < 8192 ? q : q - 8192;
        float z[33];
        z[0] = (float)t / (float)(Lf - 1);
        const float wrev = (float)t / (float)Lf;
#pragma unroll
        for (int j = 0; j < 16; ++j) { const float f = 1e-4f + (float)j * ((15.0f - 1e-4f) / 15.0f); float ph = f * wrev; ph -= floorf(ph); z[1 + j] = cos2pi(ph); z[17 + j] = -sin2pi(ph); }
#pragma unroll
        for (int jj = 0; jj < 16; ++jj) { const int j = qd * 16 + jj; float a = b1s[j];
#pragma unroll
            for (int i = 0; i < 33; ++i) a += z[i] * w1s[i * 64 + j];
            hbuf[pos * 65 + j] = sinf(frs[j] * a); }
        __syncthreads();
        float acc[16];
#pragma unroll
        for (int jj = 0; jj < 16; ++jj) acc[jj] = b2s[qd * 16 + jj];
        for (int i = 0; i < 64; ++i) { const float hv = hbuf[pos * 65 + i];
#pragma unroll
            for (int jj = 0; jj < 16; ++jj) acc[jj] += hv * w2s[i * 64 + qd * 16 + jj]; }
#pragma unroll
        for (int jj = 0; jj < 16; ++jj) p.hdn2[((size_t)l * 8448 + q) * 64 + qd * 16 + jj] = sinf(frs[qd * 16 + jj] * acc[jj]);
        __syncthreads();
    }
}
__device__ __forceinline__ void phase_taps(const Params& p, int layer, bf16_t* tapsT, LDSP lds, int bid, int nb) {
    LASF wsum = (LASF)lds;
    const int nunits = 512 + (layer == 0 ? 64 : 0);
    const float* w3 = UP((const float*)p.h_ffn_w3 + (size_t)layer * 64 * 2048); const float* hd = UP((const float*)p.hdn2 + (size_t)layer * 8448 * 64);
    const float* decp = UP((const float*)p.h_decay + layer * 2048);
    for (int u = bid; u < nunits; u += nb) {
        const int tid = ltid(), lane = tid & 63, r32 = lane & 31, hi = lane >> 5; const int wid = __builtin_amdgcn_readfirstlane(tid >> 6);
        const bool isc = u >= 512; const int cgp = isc ? u - 512 : (u >> 3), tch = isc ? 0 : (u & 7);
        const int Lf = isc ? 256 : 8192; const float rL = 1.0f / (float)(Lf - 1);
        bf16x8 afh[4], afl[4];
#pragma unroll
        for (int kk = 0; kk < 4; ++kk) { float a[8], lo[8]; u32x4 wh, wl;
#pragma unroll
            for (int j = 0; j < 8; ++j) a[j] = w3[(size_t)(16 * kk + 8 * hi + j) * 2048 + 32 * cgp + r32];
            wh = pack8(a);
            { float ah[8]; unpack8(wh, ah);
#pragma unroll
              for (int j = 0; j < 8; ++j) lo[j] = a[j] - ah[j]; }
            wl = pack8(lo); afh[kk] = __builtin_bit_cast(bf16x8, wh); afl[kk] = __builtin_bit_cast(bf16x8, wl); }
        float dcy[16], ss[16];
#pragma unroll
        for (int r = 0; r < 16; ++r) { dcy[r] = fabsf(decp[32 * cgp + crow(r, hi)]); ss[r] = 0.f; }
        const int ntb = isc ? 1 : 4;
        for (int tb = 0; tb < ntb; ++tb) {
            const int t0 = isc ? 32 * wid : tch * 1024 + (4 * wid + tb) * 32, t = t0 + r32;
            const float* hr = hd + (size_t)(isc ? 8192 + t : t) * 64;
            f32x4 hv[8];
#pragma unroll
            for (int i = 0; i < 4; ++i) { hv[2 * i] = *(const f32x4*)(hr + 16 * i + 8 * hi); hv[2 * i + 1] = *(const f32x4*)(hr + 16 * i + 8 * hi + 4); }
            f32x16 acc;
#pragma unroll
            for (int r = 0; r < 16; ++r) acc[r] = 0.f;
#pragma unroll
            for (int kk = 0; kk < 4; ++kk) { float b[8], lo[8];
                const f32x4 q0 = hv[2 * kk], q1 = hv[2 * kk + 1];
                b[0] = q0.x; b[1] = q0.y; b[2] = q0.z; b[3] = q0.w; b[4] = q1.x; b[5] = q1.y; b[6] = q1.z; b[7] = q1.w;
                const u32x4 wh = pack8(b); float bh[8]; unpack8(wh, bh);
#pragma unroll
                for (int j = 0; j < 8; ++j) lo[j] = b[j] - bh[j];
                const u32x4 wl = pack8(lo); const bf16x8 bfh = __builtin_bit_cast(bf16x8, wh), bfl = __builtin_bit_cast(bf16x8, wl);
                acc = __builtin_amdgcn_mfma_f32_32x32x16_bf16(afh[kk], bfh, acc, 0, 0, 0);
                acc = __builtin_amdgcn_mfma_f32_32x32x16_bf16(afh[kk], bfl, acc, 0, 0, 0);
                acc = __builtin_amdgcn_mfma_f32_32x32x16_bf16(afl[kk], bfh, acc, 0, 0, 0); }
            const float tl = (float)t * rL;
#pragma unroll
            for (int r = 0; r < 16; ++r) { const float a = acc[r] * __expf(-tl * dcy[r]); ss[r] += a * a;
                const int col = 32 * cgp + crow(r, hi);
                if (isc) { if (col < 1024) p.hfC[col * 256 + t] = a; else p.hbC[(col - 1024) * 256 + t] = a; }
                else if (col < 1024) tapsT[(size_t)col * 16384 + t] = f2bf(a);
                else { if (t > 0) tapsT[(size_t)(col - 1024) * 16384 + 16384 - t] = f2bf(a); else tapsT[(size_t)(col - 1024) * 16384 + 8192] = 0; } }
        }
#pragma unroll
        for (int r = 0; r < 16; ++r) { float v = ss[r];
#pragma unroll
            for (int o = 16; o >= 1; o >>= 1) v += __shfl_xor(v, o);
            if (r32 == 0) wsum[wid * 32 + crow(r, hi)] = v; }
        __syncthreads();
        if (tid < 32) { float tot = 0.f;
#pragma unroll
            for (int w = 0; w < 8; ++w) tot += wsum[w * 32 + tid];
            if (isc) p.sumsqC[2048 + 32 * cgp + tid] = tot; else p.sumsq[((size_t)(layer * 64 + cgp) * 8 + tch) * 32 + tid] = tot; }
        __syncthreads();
    }
}

__device__ __forceinline__ void phase_norm1(const Params& p, int layer, LDSP lds, int bid, int nb) {
    LASF wg = (LASF)lds;
    const int tid = ltid(), lane = tid & 63, wid = tid >> 6;
    { float4 wv[8];
#pragma unroll
      for (int j = 0; j < 8; ++j) { const int i = tid + NTH * j; wv[j] = *(const float4*)(p.w_in + (size_t)layer * 1024 * 13328 + (size_t)(i >> 2) * 13328 + 4096 + (i & 3) * 4); }
#pragma unroll
      for (int j = 0; j < 8; ++j) { const int i = tid + NTH * j, n = i >> 2, j4 = (i & 3) * 4; wg[n * 20 + j4] = wv[j].x; wg[n * 20 + j4 + 1] = wv[j].y; wg[n * 20 + j4 + 2] = wv[j].z; wg[n * 20 + j4 + 3] = wv[j].w; } }
    __syncthreads();
    const float* gn = p.norm1_g + layer * 1024;
    float gv[16], scv[16], shv[16]; const float* mvc = nullptr;
#pragma unroll
    for (int i = 0; i < 16; ++i) gv[i] = gn[lane + 64 * i];
    for (int s = bid * 8 + wid; s < TT; s += nb * 8) {
        const float* xr = resid_row_in(p, layer, s); const float* mv = modvec(p, layer, s);
        float xv[16]; float ssq = 0.f;
#pragma unroll
        for (int i = 0; i < 16; ++i) xv[i] = xr[lane + 64 * i];
        if (mv != mvc) { mvc = mv;
#pragma unroll
            for (int i = 0; i < 16; ++i) { const int n = lane + 64 * i; scv[i] = mv[1024 + n]; shv[i] = mv[n]; } }
#pragma unroll
        for (int i = 0; i < 16; ++i) ssq += xv[i] * xv[i];
        ssq = wave_sum(ssq); const float rstd = rsqrtf(ssq * (1.0f / 1024.0f) + EPS_);
        float acc[16];
#pragma unroll
        for (int j = 0; j < 16; ++j) acc[j] = 0.f;
#pragma unroll
        for (int i = 0; i < 16; ++i) { const int n = lane + 64 * i; const float hv = xv[i] * rstd * gv[i] * (1.0f + scv[i]) + shv[i];
            p.hn[(size_t)s * 1024 + n] = f2bf(hv);
#pragma unroll
            for (int j4 = 0; j4 < 4; ++j4) { const f32x4 w = *(const PG8_LAS f32x4*)(wg + n * 20 + 4 * j4); acc[4 * j4] += hv * w.x; acc[4 * j4 + 1] += hv * w.y; acc[4 * j4 + 2] += hv * w.z; acc[4 * j4 + 3] += hv * w.w; }
            if (i & 1) __builtin_amdgcn_sched_barrier(0); }
        wave_sum16(acc);
        if ((lane & 15) == 0) { f32x4 g4; g4[0] = acc[0]; g4[1] = acc[1]; g4[2] = acc[2]; g4[3] = acc[3]; *(f32x4*)(p.G + (size_t)s * 16 + (lane >> 4) * 4) = g4; }
    }
    __syncthreads();
}

__device__ __forceinline__ void phase_attn_prep(const Params& p, int layer, bf16_t* aq, bf16_t* ak, int bid, int nb) {
    const int tid = ltid(), lane = tid & 63, wid = tid >> 6;
    const int grp = lane >> 2, i4 = lane & 3;
    const float* qg = p.a_qnorm_g + layer * 64; const float* kg = p.a_knorm_g + layer * 64;
    float gq[16], gk[16];
#pragma unroll
    for (int c = 0; c < 4; ++c)
#pragma unroll
        for (int e = 0; e < 4; ++e) { gq[c * 4 + e] = qg[16 * c + 4 * i4 + e]; gk[c * 4 + e] = kg[16 * c + 4 * i4 + e]; }
    float inv[4];
#pragma unroll
    for (int e = 0; e < 4; ++e) inv[e] = exp2f(-(float)(4 * i4 + e) * (13.287712379549449f / 16.0f));
    const float qscale = 0.125f * 1.4426950408889634f;
    for (int s = bid * 8 + wid; s < TT; s += nb * 8) {
        const int b = s / SEQB, pos = s - b * SEQB; const bool lat = pos >= LC; const int t = pos - LC;
        float cs[8], sn[8];
        if (lat) { const float rowf = (float)(t >> 6), colf = (float)(t & 63);
#pragma unroll
            for (int e = 0; e < 4; ++e) { float ar = rowf * inv[e] * INV2PI, ac = colf * inv[e] * INV2PI; ar -= floorf(ar); ac -= floorf(ac);
                cs[e] = cos2pi(ar); sn[e] = sin2pi(ar); cs[4 + e] = cos2pi(ac); sn[4 + e] = sin2pi(ac); } }
        u32x2 wqk[2][4];
#pragma unroll
        for (int which = 0; which < 2; ++which)
#pragma unroll
            for (int c = 0; c < 4; ++c) wqk[which][c] = *(const u32x2*)((which ? ak : aq) + (size_t)s * 1024 + grp * 64 + 4 * i4 + 16 * c);
#pragma unroll
        for (int which = 0; which < 2; ++which) {
            bf16_t* base = (which ? ak : aq) + (size_t)s * 1024 + grp * 64 + 4 * i4;
            float v[16]; float ssq = 0.f;
#pragma unroll
            for (int c = 0; c < 4; ++c) { const u32x2 w = wqk[which][c]; v[4 * c] = lo16(w.x); v[4 * c + 1] = hi16(w.x); v[4 * c + 2] = lo16(w.y); v[4 * c + 3] = hi16(w.y); }
#pragma unroll
            for (int i = 0; i < 16; ++i) ssq += v[i] * v[i];
            ssq += __shfl_xor(ssq, 1); ssq += __shfl_xor(ssq, 2);
            const float rstd = rsqrtf(ssq * (1.0f / 64.0f) + EPS_) * (which ? 1.0f : qscale);
#pragma unroll
            for (int i = 0; i < 16; ++i) v[i] = v[i] * rstd * (which ? gk[i] : gq[i]);
            if (lat) {
#pragma unroll
                for (int hf = 0; hf < 2; ++hf)
#pragma unroll
                    for (int e = 0; e < 4; ++e) { const float x1 = v[8 * hf + e], x2 = v[8 * hf + 4 + e], cc = cs[4 * hf + e], sv = sn[4 * hf + e];
                        v[8 * hf + e] = x1 * cc - x2 * sv; v[8 * hf + 4 + e] = x2 * cc + x1 * sv; }
            }
#pragma unroll
            for (int c = 0; c < 4; ++c) { u32x2 w; w.x = pk2(v[4 * c], v[4 * c + 1]); w.y = pk2(v[4 * c + 2], v[4 * c + 3]); *(u32x2*)(base + 16 * c) = w; }
        }
    }
}

__device__ __forceinline__ s16x4 vtr16(const PG8_LAS unsigned char* ptr) {
    typedef short v4i16_t __attribute__((ext_vector_type(4)));
    return __builtin_bit_cast(s16x4, __builtin_amdgcn_ds_read_tr16_b64_v4i16((PG8_LAS v4i16_t*)ptr)); }

__device__ __forceinline__ void glds16(const void* gsrc, unsigned lds_dst) { unsigned keep;
    asm volatile("s_mov_b32 %0, m0\n\ts_mov_b32 m0, %2\n\ts_nop 0\n\tglobal_load_lds_dwordx4 %1, off\n\ts_mov_b32 m0, %0" : "=&s"(keep) : "v"(gsrc), "s"(lds_dst) : "memory"); }
__device__ __forceinline__ float max3f_(float a, float b, float c) { float r; asm("v_max3_f32 %0, %1, %2, %3" : "=v"(r) : "v"(a), "v"(b), "v"(c)); return r; }
#define ATT_WAIT_BAR(N) asm volatile("s_waitcnt vmcnt(" #N ") lgkmcnt(0)\n\ts_barrier" ::: "memory")
__device__ __forceinline__ void attn_unit(const Params& p, int layer, const bf16_t* Q, const bf16_t* K, const bf16_t* V, bf16_t* O, int b, int h, int q0pos, int nkeys, float lam, float lam_init, LDSP lds) {
    const int tid = ltid(), lane = tid & 63, r32 = lane & 31, hi = lane >> 5; const int wid = __builtin_amdgcn_readfirstlane(tid >> 6), comp = wid >> 2, qblk = wid & 3;
    const size_t rowb = (size_t)b * SEQB;
    const bf16_t* qrow = Q + (rowb + q0pos + 32 * qblk + r32) * 1024 + h * 128 + comp * 64 + hi * 8;
    bf16x8 qf[4];
#pragma unroll
    for (int d0 = 0; d0 < 4; ++d0) qf[d0] = *(const bf16x8*)(qrow + d0 * 16);
    f32x16 o[4];
#pragma unroll
    for (int d0 = 0; d0 < 4; ++d0)
#pragma unroll
        for (int r = 0; r < 16; ++r) o[d0][r] = 0.f;
    float l = 0.f;
    const f32x16 zero16 = {0.f, 0.f, 0.f, 0.f, 0.f, 0.f, 0.f, 0.f, 0.f, 0.f, 0.f, 0.f, 0.f, 0.f, 0.f, 0.f};
    const int ntiles = nkeys >> 6;
    const unsigned lds0 = (unsigned)(uintptr_t)(unsigned char*)lds;
    const int krow0 = 8 * wid + (lane >> 4), krow1 = krow0 + 4, kpos = lane & 15;
    const unsigned kvo0 = (unsigned)(krow0 * 1024 + ((kpos ^ (krow0 & 15)) * 8)) * 2u, kvo1 = (unsigned)(krow1 * 1024 + ((kpos ^ (krow1 & 15)) * 8)) * 2u - 1024u;
    const unsigned vvo0 = (unsigned)((16 * ((2 * wid) & 3) + (lane >> 2)) * 1024 + ((2 * wid) >> 2) * 32 + (lane & 3) * 8) * 2u;
    const unsigned vvo1 = (unsigned)((16 * ((2 * wid + 1) & 3) + (lane >> 2)) * 1024 + ((2 * wid + 1) >> 2) * 32 + (lane & 3) * 8) * 2u - 1024u;
    const bf16_t* kub = K + rowb * 1024 + h * 128; const bf16_t* vub = V + rowb * 1024 + h * 128;
    const unsigned kd0 = lds0 + (2 * wid) * 1024, vd0 = lds0 + 16384 + (2 * wid) * 1024;
#define ATT_DMA2(sb, va, vb_, m0v) asm volatile("s_mov_b32 m0, %3\n\ts_nop 0\n\tglobal_load_lds_dwordx4 %0, %2\n\tglobal_load_lds_dwordx4 %1, %2 offset:1024" :: "v"(va), "v"(vb_), "s"(sb), "s"(m0v) : "memory", "m0")
#define ATT_DMA(t, slot) do { const size_t to_ = (size_t)(t) * 64 * 1024; const unsigned so_ = (unsigned)(slot) * 32768u; \
        ATT_DMA2(kub + to_, kvo0, kvo1, (unsigned)__builtin_amdgcn_readfirstlane(kd0 + so_)); ATT_DMA2(vub + to_, vvo0, vvo1, (unsigned)__builtin_amdgcn_readfirstlane(vd0 + so_)); } while (0)
    asm volatile("" : "+v"(qf[0]), "+v"(qf[1]), "+v"(qf[2]), "+v"(qf[3]));
    ATT_DMA(0, 0); ATT_DMA(1, 1); ATT_DMA(2, 2);
    ATT_WAIT_BAR(4);
    const PG8_LAS unsigned char* kbase = lds + r32 * 256; const int kx0 = ((comp * 8 + hi) ^ (r32 & 15)) << 4;
    const PG8_LAS unsigned char* vbase = lds + 16384 + ((lane >> 4) & 1) * 32 + (lane & 3) * 8 + (4 * hi + ((lane & 15) >> 2)) * 64;
    bf16x8 vbA[4], vbB[4], kb[4], pfA, pfB; f32x16 S0, S1; float la = 0.f, lb = 0.f;
#define ATT_SB __builtin_amdgcn_sched_barrier(0)
#define ATT_VLD(vb, Vp, ks) do { _Pragma("unroll") for (int d0 = 0; d0 < 4; ++d0) { const s16x4 lo = vtr16((Vp) + d0 * 4096 + (ks) * 1024), hh = vtr16((Vp) + d0 * 4096 + (ks) * 1024 + 512); \
        vb[d0] = (bf16x8){lo[0], lo[1], lo[2], lo[3], hh[0], hh[1], hh[2], hh[3]}; } } while (0)
#define ATT_KLD(Kp, half) do { _Pragma("unroll") for (int d0 = 0; d0 < 4; ++d0) kb[d0] = *(const PG8_LAS bf16x8*)((Kp) + (kx0 ^ (d0 << 5)) + (half) * 8192); } while (0)
#define ATT_STAGE(vbU, pfU, DOQK, QS, DOEXP, ES, off, pfN) do { unsigned w_[4]; \
        _Pragma("unroll") for (int g = 0; g < 4; ++g) { \
            o[g] = __builtin_amdgcn_mfma_f32_32x32x16_bf16(vbU[g], pfU, o[g], 0, 0, 0); \
            if (DOQK) QS = __builtin_amdgcn_mfma_f32_32x32x16_bf16(kb[g], qf[g], g ? QS : zero16, 0, 0, 0); \
            if (DOEXP) { const float ea_ = __builtin_amdgcn_exp2f(ES[(off) + 2 * g]), eb_ = __builtin_amdgcn_exp2f(ES[(off) + 2 * g + 1]); la += ea_; lb += eb_; w_[g] = pk2(ea_, eb_); } \
              \
            asm volatile("" : "+v"(o[g]), "+v"(pfU)); \
            if (DOQK) asm volatile("" : "+v"(QS)); \
            if (DOEXP) asm volatile("" : "+v"(w_[g]), "+v"(ES), "+v"(la), "+v"(lb)); \
            ATT_SB; } \
        if (DOEXP) { u32x4 wv_; wv_.x = w_[0]; wv_.y = w_[1]; wv_.z = w_[2]; wv_.w = w_[3]; pfN = __builtin_bit_cast(bf16x8, wv_); } } while (0)
    { ATT_KLD(kbase, 0);
#pragma unroll
      for (int d0 = 0; d0 < 4; ++d0) S0 = __builtin_amdgcn_mfma_f32_32x32x16_bf16(kb[d0], qf[d0], d0 ? S0 : zero16, 0, 0, 0);
      ATT_KLD(kbase, 1);
#pragma unroll
      for (int d0 = 0; d0 < 4; ++d0) S1 = __builtin_amdgcn_mfma_f32_32x32x16_bf16(kb[d0], qf[d0], d0 ? S1 : zero16, 0, 0, 0);
      ATT_VLD(vbA, vbase, 0);
      u32x4 w_;
#pragma unroll
      for (int g = 0; g < 4; ++g) { const float ea_ = __builtin_amdgcn_exp2f(S0[2 * g]), eb_ = __builtin_amdgcn_exp2f(S0[2 * g + 1]); la += ea_; lb += eb_; w_[g] = pk2(ea_, eb_); }
      pfA = __builtin_bit_cast(bf16x8, w_); ATT_SB; }
#define ATT_TILE(NX) do { const PG8_LAS unsigned char* Vs_ = vbase + (t & 3) * 32768; const PG8_LAS unsigned char* Vn_ = vbase + ((t + 1) & 3) * 32768; const PG8_LAS unsigned char* Kn_ = kbase + ((t + 1) & 3) * 32768; \
        ATT_VLD(vbB, Vs_, 1); if (NX) ATT_KLD(Kn_, 0); \
        { const int td = t + 3 < ntiles ? t + 3 : ntiles - 1; ATT_DMA(td, (t + 3) & 3); } ATT_SB; \
        ATT_STAGE(vbA, pfA, 0, S0, 1, S0, 8, pfB); \
        ATT_VLD(vbA, Vs_, 2); ATT_SB; \
        ATT_STAGE(vbB, pfB, NX, S0, 1, S1, 0, pfA); \
        ATT_VLD(vbB, Vs_, 3); if (NX) ATT_KLD(Kn_, 1); ATT_SB; \
        ATT_STAGE(vbA, pfA, 0, S1, 1, S1, 8, pfB); \
        if (NX) ATT_VLD(vbA, Vn_, 0); ATT_SB; \
        ATT_STAGE(vbB, pfB, NX, S1, NX, S0, 0, pfA); \
        ATT_WAIT_BAR(4); } while (0)
    int t = 0;
    for (; t < ntiles - 1; ++t) ATT_TILE(1);
    ATT_TILE(0);
    ATT_WAIT_BAR(0);
    l = la + lb;
#undef ATT_SB
#undef ATT_VLD
#undef ATT_KLD
#undef ATT_STAGE
#undef ATT_TILE
#undef ATT_DMA
#undef ATT_DMA2
    l += __shfl_xor(l, 32);
    const float rl = 1.0f / l;
    LASF xch = (LASF)(lds) + qblk * 4096;
    if (comp == 1) {
#pragma unroll
        for (int d0 = 0; d0 < 4; ++d0)
#pragma unroll
            for (int r = 0; r < 16; ++r) xch[(32 * d0 + crow(r, hi)) * 32 + r32] = o[d0][r] * rl;
    }
    __syncthreads();
    if (comp == 0) {
        float ssq = 0.f;
#pragma unroll
        for (int d0 = 0; d0 < 4; ++d0)
#pragma unroll
            for (int r = 0; r < 16; ++r) { const float y = o[d0][r] * rl - lam * xch[(32 * d0 + crow(r, hi)) * 32 + r32]; o[d0][r] = y; ssq += y * y; }
        ssq += __shfl_xor(ssq, 32);
        const float sc = rsqrtf(ssq * (1.0f / 128.0f) + EPS_) * (1.0f - lam_init);
        const float* sg = p.a_subln_g + layer * 128;
        bf16_t* orow = O + (rowb + q0pos + 32 * qblk + r32) * 1024 + h * 128;
#pragma unroll
        for (int d0 = 0; d0 < 4; ++d0)
#pragma unroll
            for (int r4 = 0; r4 < 4; ++r4) { const int d = 32 * d0 + 8 * r4 + 4 * hi; u32x2 w;
                w.x = pk2(o[d0][4 * r4] * sc * sg[d], o[d0][4 * r4 + 1] * sc * sg[d + 1]); w.y = pk2(o[d0][4 * r4 + 2] * sc * sg[d + 2], o[d0][4 * r4 + 3] * sc * sg[d + 3]);
                *(u32x2*)(orow + d) = w; }
    }
    __syncthreads();
}
__device__ __forceinline__ void phase_attn(const Params& p, int layer, const bf16_t* Q, const bf16_t* K, const bf16_t* V, bf16_t* O, LDSP lds, int bid, int nb) {
    const float lam_init = 0.8f - 0.6f * expf(-0.3f * (float)layer);
    const float* lp = p.a_lambda + layer * 256; float d1 = 0.f, d2 = 0.f;
    for (int i = 0; i < 64; ++i) { d1 += lp[i] * lp[64 + i]; d2 += lp[128 + i] * lp[192 + i]; }
    const float lam = expf(d1) - expf(d2) + lam_init;
    const int nunits = 1024 + (layer == 0 ? 32 : 0);
    for (int u = bid; u < nunits; u += nb) {
        if (u < 1024) { int bh = u >> 6, qb = u & 63;
            if (nb == 256) { const int x = bid & 7; bh = (x >> 1) + 4 * (u >> 8); qb = (x & 1) * 32 + (bid >> 3); }
            attn_unit(p, layer, Q, K, V, O, bh >> 3, bh & 7, LC + qb * 128, SEQB, lam, lam_init, lds); }
        else { const int v = u - 1024, bh = v >> 1, qb = v & 1; attn_unit(p, layer, Q, K, V, O, bh >> 3, bh & 7, qb * 128, LC, lam, lam_init, lds); }
    }
}

__device__ __forceinline__ int scan_idx(int dir, int c) { return dir == 0 ? c : (c < 2 ? 1 - c : 67 - c); }

__device__ __forceinline__ void load_gates(const Params& p, int layer, size_t row0, int h, LASF tb) {
    const int tid = ltid();
    if (tid < 128) { const float* g = p.G + (row0 + tid) * 16; const float* gb = p.m_gate_b + layer * 16;
        tb[tid] = g[h] + gb[h]; tb[128 + tid] = logsigf_(g[4 + h] + gb[4 + h]); tb[256 + tid] = g[8 + h] + gb[8 + h]; tb[384 + tid] = logsigf_(g[12 + h] + gb[12 + h]); }
}

__device__ __forceinline__ float wave_scan_sum(float v, int lane) {
#pragma unroll
    for (int o = 1; o < 64; o <<= 1) { const float y = __shfl_up(v, o); if (lane >= o) v += y; }
    return v; }
__device__ __forceinline__ float wave_scan_max(float v, int lane) {
#pragma unroll
    for (int o = 1; o < 64; o <<= 1) { const float y = __shfl_up(v, o); if (lane >= o) v = fmaxf(v, y); }
    return v; }

__device__ __forceinline__ void mconv8(const u32x4 rp, const u32x4 rc, const u32x4 rn, const float* cw, const float* cb, int cc, float scale, float (&o)[8]) {
    float up[8], uc[8], un[8]; unpack8(rp, up); unpack8(rc, uc); unpack8(rn, un);
    const f32x4 b0 = *(const f32x4*)(cb + cc), b1 = *(const f32x4*)(cb + cc + 4), w00 = *(const f32x4*)(cw + cc), w01 = *(const f32x4*)(cw + cc + 4);
    const f32x4 w10 = *(const f32x4*)(cw + 2048 + cc), w11 = *(const f32x4*)(cw + 2048 + cc + 4), w20 = *(const f32x4*)(cw + 4096 + cc), w21 = *(const f32x4*)(cw + 4096 + cc + 4);
#pragma unroll
    for (int i = 0; i < 4; ++i) { o[i] = siluf_(b0[i] + up[i] * w00[i] + uc[i] * w10[i] + un[i] * w20[i]) * scale; o[4 + i] = siluf_(b1[i] + up[4 + i] * w01[i] + uc[4 + i] * w11[i] + un[4 + i] * w21[i]) * scale; }
}
__device__ __forceinline__ void phase_mA(const Params& p, int layer, const bf16_t* mk_, const bf16_t* mv_, bf16_t* vT_, bf16_t* ST_, LDSP lds, int bid, int nb) {
    const bf16_t* mk = UP(mk_); const bf16_t* mv = UP(mv_); bf16_t* vT = UP(vT_); bf16_t* ST = UP(ST_);
    constexpr int RS = 576;
    LDSP Kt = lds; LDSP Vt = lds + 128 * RS;
    LASF tb = (LASF)(lds + 256 * RS);
    LASF part = tb + 512;
    const float* gbias = UP((const float*)p.m_gate_b + layer * 16); const float* Gp = UP((const float*)p.G);
    const float* cw = UP((const float*)p.m_conv_w + (size_t)layer * 3 * 2048); const float* cb = UP((const float*)p.m_conv_b + layer * 2048);
    float* scalp = UP((float*)p.scal); float* dnp = UP((float*)p.dn);
    for (int u = bid; u < 8 * 66; u += nb) {
        const int tid = ltid(), lane = tid & 63, r32 = lane & 31, hi = lane >> 5; const int wid = __builtin_amdgcn_readfirstlane(tid >> 6);
        const int c = u % 66, bh = u / 66, b = bh >> 2, h = bh & 3;
        const size_t row0 = (size_t)b * SEQB + 128 * c;
        const int idxf = scan_idx(0, c), idxb = scan_idx(1, c);
        const int tq = tid & 127, dsel = (tid >> 7) & 1;
        float li = 0.f, lf = 0.f;
        if (tid < 256) { const float* g = Gp + (row0 + tq) * 16; li = g[8 * dsel + h] + gbias[8 * dsel + h]; lf = logsigf_(g[8 * dsel + 4 + h] + gbias[8 * dsel + 4 + h]); }
        float inc = wave_scan_sum(lf, lane);
        if (lane == 63 && wid < 4) tb[256 + wid] = inc;
        __syncthreads();
        const float tot = tb[256 + 2 * dsel] + tb[257 + 2 * dsel]; if (wid == 1 || wid == 3) inc += tb[256 + wid - 1];
        const float wsv = (dsel == 0 ? tot - inc : inc - lf) + li;
        const float mxw = wave_max(tid < 256 ? wsv : -1e30f);
        if (lane == 0 && wid < 4) tb[272 + wid] = mxw;
        __syncthreads();
        { const float mloc = fmaxf(tb[272 + 2 * dsel], tb[273 + 2 * dsel]);
          if (tid < 256) tb[128 * dsel + tq] = __expf(wsv - mloc);
          if (tq == 0 && tid < 256) { float* s0 = scalp + ((size_t)(bh * 2 + dsel) * 66 + (dsel ? idxb : idxf)) * 2; s0[0] = tot; s0[1] = mloc; } }
        __syncthreads();
        const int ch8 = (tid & 31) * 8; float dnf[8], dnb[8];
#pragma unroll
        for (int e = 0; e < 8; ++e) { dnf[e] = 0.f; dnb[e] = 0.f; }
#pragma unroll
        for (int jb = 0; jb < 4; ++jb) { u32x4 rk[2][3], rv[2];
#pragma unroll
            for (int jj = 0; jj < 2; ++jj) { const int t = (tid >> 5) + 16 * (2 * jb + jj), pos = 128 * c + t; const bf16_t* src = mk + (row0 + t) * 1024 + h * 256 + ch8;
                const bool hasp = (pos != 0) && (pos != LC), hasn = (pos != LC - 1) && (pos != SEQB - 1);
                rk[jj][1] = *(const u32x4*)src; rk[jj][0] = hasp ? *(const u32x4*)(src - 1024) : (u32x4){0u, 0u, 0u, 0u}; rk[jj][2] = hasn ? *(const u32x4*)(src + 1024) : (u32x4){0u, 0u, 0u, 0u};
                rv[jj] = *(const u32x4*)(mv + (row0 + t) * 1024 + h * 256 + ch8); }
#pragma unroll
            for (int jj = 0; jj < 2; ++jj) { const int t = (tid >> 5) + 16 * (2 * jb + jj); float o[8];
                mconv8(rk[jj][0], rk[jj][1], rk[jj][2], cw, cb, 1024 + h * 256 + ch8, 0.0625f, o);
                const u32x4 kk = pack8(o); unpack8(kk, o);
                const float wf = tb[t], wb = tb[128 + t];
#pragma unroll
                for (int e = 0; e < 8; ++e) { dnf[e] += wf * o[e]; dnb[e] += wb * o[e]; }
                *(PG8_LAS u32x4*)(Kt + t * RS + ch8 * 2) = kk; *(PG8_LAS u32x4*)(Vt + t * RS + ch8 * 2) = rv[jj]; } }
#pragma unroll
        for (int e = 0; e < 8; ++e) { dnf[e] += __shfl_xor(dnf[e], 32); dnb[e] += __shfl_xor(dnb[e], 32); }
        if (hi == 0) {
#pragma unroll
            for (int e = 0; e < 8; ++e) part[wid * 256 + ch8 + e] = dnf[e]; }
        __syncthreads();
        if (tid < 256) { float sm = 0.f;
#pragma unroll
            for (int w = 0; w < 8; ++w) sm += part[w * 256 + tid];
            dnp[((size_t)(bh * 2) * 66 + idxf) * 256 + tid] = sm; }
        __syncthreads();
        if (hi == 0) {
#pragma unroll
            for (int e = 0; e < 8; ++e) part[wid * 256 + ch8 + e] = dnb[e]; }
#pragma unroll
        for (int it = 0; it < 2; ++it) { const int item = tid + NTH * it, dp = item >> 3, tg = item & 7;
            const PG8_LAS unsigned* srcl = (const PG8_LAS unsigned*)(Vt + (16 * tg) * RS + 4 * dp);
            bf16_t* dst = vT + ((size_t)(bh * 256 + 2 * dp)) * SEQB + 128 * c + 16 * tg;
            unsigned w[16];
#pragma unroll
            for (int i = 0; i < 16; ++i) w[i] = srcl[i * (RS / 4)];
            u32x4 lo0, lo1, hi0, hi1;
            lo0.x = __builtin_amdgcn_perm(w[1], w[0], 0x05040100u); lo0.y = __builtin_amdgcn_perm(w[3], w[2], 0x05040100u); lo0.z = __builtin_amdgcn_perm(w[5], w[4], 0x05040100u); lo0.w = __builtin_amdgcn_perm(w[7], w[6], 0x05040100u);
            lo1.x = __builtin_amdgcn_perm(w[9], w[8], 0x05040100u); lo1.y = __builtin_amdgcn_perm(w[11], w[10], 0x05040100u); lo1.z = __builtin_amdgcn_perm(w[13], w[12], 0x05040100u); lo1.w = __builtin_amdgcn_perm(w[15], w[14], 0x05040100u);
            hi0.x = __builtin_amdgcn_perm(w[1], w[0], 0x07060302u); hi0.y = __builtin_amdgcn_perm(w[3], w[2], 0x07060302u); hi0.z = __builtin_amdgcn_perm(w[5], w[4], 0x07060302u); hi0.w = __builtin_amdgcn_perm(w[7], w[6], 0x07060302u);
            hi1.x = __builtin_amdgcn_perm(w[9], w[8], 0x07060302u); hi1.y = __builtin_amdgcn_perm(w[11], w[10], 0x07060302u); hi1.z = __builtin_amdgcn_perm(w[13], w[12], 0x07060302u); hi1.w = __builtin_amdgcn_perm(w[15], w[14], 0x07060302u);
            *(u32x4*)(dst) = lo0; *(u32x4*)(dst + 8) = lo1; *(u32x4*)(dst + SEQB) = hi0; *(u32x4*)(dst + SEQB + 8) = hi1; }
        const int troff = ((lane >> 4) & 1) * 32 + (lane & 3) * 8 + (4 * hi + ((lane & 15) >> 2)) * RS;
        bf16x8 Bf[8];
#pragma unroll
        for (int ks = 0; ks < 8; ++ks) { const s16x4 lo = vtr16(Vt + troff + ks * 16 * RS + wid * 64), hh = vtr16(Vt + troff + (ks * 16 + 8) * RS + wid * 64);
            Bf[ks] = (bf16x8){lo[0], lo[1], lo[2], lo[3], hh[0], hh[1], hh[2], hh[3]}; }
        __syncthreads();
        if (tid < 256) { float sm = 0.f;
#pragma unroll
            for (int w = 0; w < 8; ++w) sm += part[w * 256 + tid];
            dnp[((size_t)(bh * 2 + 1) * 66 + idxb) * 256 + tid] = sm; }
        LDSP stg = Vt + wid * 8704;
#pragma unroll 1
        for (int dir = 0; dir < 2; ++dir) {
            bf16x8 Bs[8];
#pragma unroll
            for (int ks = 0; ks < 8; ++ks) { float f[8]; unpack8(__builtin_bit_cast(u32x4, Bf[ks]), f);
#pragma unroll
                for (int j = 0; j < 8; ++j) f[j] *= tb[128 * dir + 16 * ks + 8 * (j >> 2) + 4 * hi + (j & 3)];
                Bs[ks] = __builtin_bit_cast(bf16x8, pack8(f)); }
            unsigned char* st = (unsigned char*)ST + ((size_t)(bh * 2 + dir) * 66 + (dir ? idxb : idxf)) * 65536 + (size_t)(32 * wid) * 256;
#pragma unroll 1
            for (int kh = 0; kh < 2; ++kh) {
                f32x16 acc[4];
#pragma unroll
                for (int kb = 0; kb < 4; ++kb)
#pragma unroll
                    for (int r = 0; r < 16; ++r) acc[kb][r] = 0.f;
#pragma unroll
                for (int ks = 0; ks < 8; ++ks) {
#pragma unroll
                    for (int kb = 0; kb < 4; ++kb) { const s16x4 lo = vtr16(Kt + troff + ks * 16 * RS + (4 * kh + kb) * 64), hh = vtr16(Kt + troff + (ks * 16 + 8) * RS + (4 * kh + kb) * 64);
                        const bf16x8 aa = (bf16x8){lo[0], lo[1], lo[2], lo[3], hh[0], hh[1], hh[2], hh[3]};
                        acc[kb] = __builtin_amdgcn_mfma_f32_32x32x16_bf16(aa, Bs[ks], acc[kb], 0, 0, 0); }
                    if (ks & 1) __builtin_amdgcn_sched_barrier(0); }
#pragma unroll
                for (int kb = 0; kb < 4; ++kb)
#pragma unroll
                    for (int r4 = 0; r4 < 4; ++r4)
                        *(PG8_LAS unsigned*)(stg + r32 * 144 + (32 * kb + 8 * r4 + 4 * hi)) = pk4_fp8(acc[kb][4 * r4] * ST_SC, acc[kb][4 * r4 + 1] * ST_SC, acc[kb][4 * r4 + 2] * ST_SC, acc[kb][4 * r4 + 3] * ST_SC);
                asm volatile("s_waitcnt lgkmcnt(0)" ::: "memory");
#pragma unroll
                for (int i = 0; i < 4; ++i) { const int row = 8 * i + (lane >> 3), ch = lane & 7;
                    *(u32x4*)(st + (size_t)row * 256 + 128 * kh + 16 * ch) = *(const PG8_LAS u32x4*)(stg + row * 144 + ch * 16); }
            }
        }
        __syncthreads();
    }
}

__device__ __forceinline__ void phase_mB(const Params& p, bf16_t* ST, int bid, int nb) {
    const int tid = ltid();
    { const int ipb = (16 * 256 + nb - 1) / nb, it = bid * ipb + tid;
      if (tid < ipb && it < 16 * 256) {
          const int bhd = it >> 8, kd = it & 255; const float* sc = p.scal + (size_t)bhd * 132; float n = 0.f, m = 0.f;
          if (kd == 0) p.ms[bhd * 67] = 0.f;
          for (int i0 = 0; i0 < 66; i0 += 11) { float dv[11], bqv[11], mlv[11];
#pragma unroll
              for (int j = 0; j < 11; ++j) { dv[j] = p.dn[((size_t)bhd * 66 + i0 + j) * 256 + kd]; bqv[j] = sc[2 * (i0 + j)]; mlv[j] = sc[2 * (i0 + j) + 1]; }
#pragma unroll
              for (int j = 0; j < 11; ++j) { const float mn = fmaxf(bqv[j] + m, mlv[j]), a = __expf(bqv[j] + m - mn), bb = __expf(mlv[j] - mn);
                  n = a * n + bb * dv[j]; p.nst[((size_t)bhd * 66 + i0 + j) * 256 + kd] = n; m = mn; if (kd == 0) p.ms[bhd * 67 + i0 + j + 1] = mn; } } } }
    for (int it = bid * NTH + tid; it < 16 * 8192; it += nb * NTH) {
        const int bhd = it >> 13; unsigned char* st = (unsigned char*)ST + (size_t)bhd * 66 * 65536 + (size_t)(it & 8191) * 8; const float* sc = p.scal + (size_t)bhd * 132;
        float C[8];
#pragma unroll
        for (int e = 0; e < 8; ++e) C[e] = 0.f;
        float m = 0.f;
        for (int i0 = 0; i0 < 66; i0 += 11) {
            u32x2 v[11];
#pragma unroll
            for (int j = 0; j < 11; ++j) v[j] = *(const u32x2*)(st + (size_t)(i0 + j) * 65536);
#pragma unroll
            for (int j = 0; j < 11; ++j) { const float bq = sc[2 * (i0 + j)], ml = sc[2 * (i0 + j) + 1]; const float mn = fmaxf(bq + m, ml), a = __expf(bq + m - mn), bb = __expf(ml - mn);
                float f[8]; unpk8_fp8(v[j], f);
#pragma unroll
                for (int e = 0; e < 8; ++e) C[e] = a * C[e] + bb * f[e];
                u32x2 wo; wo.x = pk4_fp8(C[0], C[1], C[2], C[3]); wo.y = pk4_fp8(C[4], C[5], C[6], C[7]);
                *(u32x2*)(st + (size_t)(i0 + j) * 65536) = wo; m = mn; }
        }
    }
}

__device__ __forceinline__ void phase_mC(const Params& p, int layer, const bf16_t* mq_, const bf16_t* mk_, const bf16_t* vT_, const bf16_t* mo_, const bf16_t* ST_, bf16_t* ym_, LDSP lds, int bid, int nb) {
    const bf16_t* mq = UP(mq_); const bf16_t* mk = UP(mk_); const bf16_t* vT = UP(vT_);
    const float* cw = UP((const float*)p.m_conv_w + (size_t)layer * 3 * 2048); const float* cb = UP((const float*)p.m_conv_b + layer * 2048); const bf16_t* mo = UP(mo_); const bf16_t* ST = UP(ST_); bf16_t* ym = UP(ym_);
    LDSP qs = lds; LDSP ksm = lds + 67584; LDSP Wf = ksm; LDSP Wb = ksm + 34816;
    LASF T = (LASF)(lds + 67584 + 69632);
    LASF red = T + 2048; LASF den2 = red + 1024; LASF qn2 = den2 + 512;
    const int skip = layer == 0 ? 0 : 2;
    const int nun = 8 * (66 - skip);
    const float* gbias = UP((const float*)p.m_gate_b + layer * 16); const float* mng = UP((const float*)p.m_norm_g + layer * 256);
    const float* Gp = UP((const float*)p.G); const float* msp = UP((const float*)p.ms); const float* nstp = UP((const float*)p.nst);
    for (int u = bid; u < nun; u += nb) {
        const int tid = ltid(), lane = tid & 63, r32 = lane & 31, hi = lane >> 5; const int wid = __builtin_amdgcn_readfirstlane(tid >> 6);
        const int c = skip + u % (66 - skip), bh = u / (66 - skip), b = bh >> 2, h = bh & 3;
        const size_t row0 = (size_t)b * SEQB + 128 * c;
        const int idxf = scan_idx(0, c), idxb = scan_idx(1, c);
        const bf16_t* vp = vT + ((size_t)(bh * 256 + 32 * wid + r32)) * SEQB + 128 * c + 8 * hi;
        const int tq = tid & 127, dsel = (tid >> 7) & 1, tok = dsel ? 127 - tq : tq;
        float li = 0.f, lf = 0.f;
        if (tid < 256) { const float* g = Gp + (row0 + tok) * 16; li = g[8 * dsel + h] + gbias[8 * dsel + h]; lf = logsigf_(g[8 * dsel + 4 + h] + gbias[8 * dsel + 4 + h]); }
        const float mpf = msp[(bh * 2 + 0) * 67 + idxf], mpb = msp[(bh * 2 + 1) * 67 + idxb];
        { const int ch8 = (tid & 31) * 8;
#pragma unroll
          for (int jb = 0; jb < 4; ++jb) { u32x4 rq[2][3], rk[2][3];
#pragma unroll
              for (int jj = 0; jj < 2; ++jj) { const int t = (tid >> 5) + 16 * (2 * jb + jj), pos = 128 * c + t; const size_t off = (row0 + t) * 1024 + h * 256 + ch8;
                  const bool hasp = (pos != 0) && (pos != LC), hasn = (pos != LC - 1) && (pos != SEQB - 1); const u32x4 zz = {0u, 0u, 0u, 0u};
                  rq[jj][1] = *(const u32x4*)(mq + off); rq[jj][0] = hasp ? *(const u32x4*)(mq + off - 1024) : zz; rq[jj][2] = hasn ? *(const u32x4*)(mq + off + 1024) : zz;
                  rk[jj][1] = *(const u32x4*)(mk + off); rk[jj][0] = hasp ? *(const u32x4*)(mk + off - 1024) : zz; rk[jj][2] = hasn ? *(const u32x4*)(mk + off + 1024) : zz; }
#pragma unroll
              for (int jj = 0; jj < 2; ++jj) { const int t = (tid >> 5) + 16 * (2 * jb + jj); float o[8];
                  mconv8(rq[jj][0], rq[jj][1], rq[jj][2], cw, cb, h * 256 + ch8, 1.0f, o); *(PG8_LAS u32x4*)(qs + t * 528 + ch8 * 2) = pack8(o);
                  mconv8(rk[jj][0], rk[jj][1], rk[jj][2], cw, cb, 1024 + h * 256 + ch8, 0.0625f, o); *(PG8_LAS u32x4*)(ksm + t * 528 + ch8 * 2) = pack8(o); } } }
        float inc = wave_scan_sum(lf, lane);
        if (lane == 63 && wid < 4) red[wid] = inc;
        __syncthreads();
        if (wid == 1 || wid == 3) inc += red[wid - 1];
        const float av = li - inc;
        float pmx = wave_scan_max(tid < 256 ? av : -1e30f, lane);
        if (lane == 63 && wid < 4) red[8 + wid] = pmx;
        __syncthreads();
        if (wid == 1 || wid == 3) pmx = fmaxf(pmx, red[8 + wid - 1]);
        if (tid < 256) { const float mp = dsel ? mpb : mpf, g = fmaxf(mp, pmx);
            T[512 + 128 * dsel + tok] = av; T[768 + 128 * dsel + tok] = g; T[1024 + 128 * dsel + tok] = __expf(mp - g); T[1280 + 128 * dsel + tok] = __expf(-(inc + g)); }
        { const int t = tid & 127, part = tid >> 7; float sf = 0.f, sb = 0.f;
          if (idxf > 0 || idxb > 0) {
              const float* nf = nstp + ((size_t)(bh * 2 + 0) * 66 + (idxf > 0 ? idxf - 1 : 0)) * 256 + part * 64; const float* nbk = nstp + ((size_t)(bh * 2 + 1) * 66 + (idxb > 0 ? idxb - 1 : 0)) * 256 + part * 64;
              for (int d8 = 0; d8 < 8; ++d8) { float f[8]; unpack8(*(const PG8_LAS u32x4*)(qs + t * 528 + (part * 64 + d8 * 8) * 2), f);
#pragma unroll
                  for (int e = 0; e < 8; ++e) { sf += f[e] * nf[d8 * 8 + e]; sb += f[e] * nbk[d8 * 8 + e]; } } }
          qn2[(part * 2 + 0) * 128 + t] = idxf > 0 ? sf : 0.f; qn2[(part * 2 + 1) * 128 + t] = idxb > 0 ? sb : 0.f; }
        const int tj = wid & 3, sg = wid >> 2;
        f32x16 sacc[2];
#pragma unroll
        for (int e = 0; e < 2; ++e)
#pragma unroll
            for (int r = 0; r < 16; ++r) sacc[e][r] = 0.f;
#pragma unroll 4
        for (int kk = 0; kk < 16; ++kk) { const bf16x8 bq = *(const PG8_LAS bf16x8*)(qs + (32 * tj + r32) * 528 + (16 * kk + 8 * hi) * 2);
#pragma unroll
            for (int e = 0; e < 2; ++e) { const bf16x8 ak = *(const PG8_LAS bf16x8*)(ksm + (32 * (2 * sg + e) + r32) * 528 + (16 * kk + 8 * hi) * 2);
                sacc[e] = __builtin_amdgcn_mfma_f32_32x32x16_bf16(ak, bq, sacc[e], 0, 0, 0); } }
        __syncthreads();
        { const int tz2 = ltid(), r32b = tz2 & 31, hib = (tz2 >> 5) & 1;
          const int t = 32 * tj + r32b; const float gf = T[768 + t], gb = T[896 + t]; float denf = 0.f, denb = 0.f;
          const LASF Taf = T + 512 + 64 * sg + 4 * hib; const LASF Tab = T + 640 + 64 * sg + 4 * hib;
          LDSP wfp = Wf + t * 272 + (64 * sg + 4 * hib) * 2; LDSP wbp = Wb + t * 272 + (64 * sg + 4 * hib) * 2;
#pragma unroll
          for (int e = 0; e < 2; ++e)
#pragma unroll
              for (int r4 = 0; r4 < 4; ++r4) { const int s0 = 32 * (2 * sg + e) + 8 * r4 + 4 * hib; float wf[4], wb[4];
#pragma unroll
                  for (int i = 0; i < 4; ++i) { const int s = s0 + i; const float sv = sacc[e][4 * r4 + i];
                      wf[i] = (s <= t) ? sv * __expf(Taf[32 * e + 8 * r4 + i] - gf) : 0.f; wb[i] = (s >= t) ? sv * __expf(Tab[32 * e + 8 * r4 + i] - gb) : 0.f; denf += wf[i]; denb += wb[i]; }
                  u32x2 w; w.x = pk2(wf[0], wf[1]); w.y = pk2(wf[2], wf[3]); *(PG8_LAS u32x2*)(wfp + (32 * e + 8 * r4) * 2) = w;
                  w.x = pk2(wb[0], wb[1]); w.y = pk2(wb[2], wb[3]); *(PG8_LAS u32x2*)(wbp + (32 * e + 8 * r4) * 2) = w; }
          denf += __shfl_xor(denf, 32); denb += __shfl_xor(denb, 32);
          if (hib == 0) { den2[(sg * 2 + 0) * 128 + t] = denf; den2[(sg * 2 + 1) * 128 + t] = denb; } }
        __syncthreads();
        f32x16 hs[4]; unsigned hp[4][8];
#pragma unroll
        for (int dir = 0; dir < 2; ++dir) {
            const int idx = dir ? idxb : idxf;
            f32x16 acc[4];
#pragma unroll
            for (int j = 0; j < 4; ++j)
#pragma unroll
                for (int r = 0; r < 16; ++r) acc[j][r] = 0.f;
            if (idx > 0) {
                const unsigned char* Cp = (const unsigned char*)ST + ((size_t)(bh * 2 + dir) * 66 + idx - 1) * 65536 + (32 * wid + r32) * 256 + 8 * hi;
#pragma unroll
                for (int hb = 0; hb < 2; ++hb) {
                    bf16x8 Cf[8];
#pragma unroll
                    for (int k8 = 0; k8 < 8; ++k8) { const u32x2 cr = *(const u32x2*)(Cp + 16 * (8 * hb + k8)); float cf[8]; unpk8_fp8(cr, cf); Cf[k8] = __builtin_bit_cast(bf16x8, pack8(cf)); }
#pragma unroll
                    for (int k8 = 0; k8 < 8; ++k8) {
#pragma unroll
                        for (int j = 0; j < 4; ++j) { const bf16x8 bq = *(const PG8_LAS bf16x8*)(qs + (32 * j + r32) * 528 + (16 * (8 * hb + k8) + 8 * hi) * 2);
                            acc[j] = __builtin_amdgcn_mfma_f32_32x32x16_bf16(Cf[k8], bq, acc[j], 0, 0, 0); }
                        if (k8 & 1) __builtin_amdgcn_sched_barrier(0); } }
                const LASF Tw = T + 1024 + 128 * dir + (ltid() & 31);
#pragma unroll
                for (int j = 0; j < 4; ++j) { const float wi = Tw[32 * j] * ST_ISC;
#pragma unroll
                    for (int r = 0; r < 16; ++r) acc[j][r] *= wi; }
            }
            { bf16x8 Vf[8];
#pragma unroll
              for (int ks = 0; ks < 8; ++ks) Vf[ks] = *(const bf16x8*)(vp + 16 * ks);
              const LDSP W = dir ? Wb : Wf;
#pragma unroll
              for (int ks = 0; ks < 8; ++ks) {
#pragma unroll
                  for (int j = 0; j < 4; ++j) { const bf16x8 bw = *(const PG8_LAS bf16x8*)(W + (32 * j + r32) * 272 + (16 * ks + 8 * hi) * 2);
                      acc[j] = __builtin_amdgcn_mfma_f32_32x32x16_bf16(Vf[ks], bw, acc[j], 0, 0, 0); }
                  if (ks & 1) __builtin_amdgcn_sched_barrier(0); } }
            const int r32c = ltid() & 31;
            const LASF qnp = qn2 + dir * 128 + r32c; const LASF dnp = den2 + dir * 128 + r32c; const LASF Tp = T + 1024 + 128 * dir + r32c;
#pragma unroll
            for (int j = 0; j < 4; ++j) {
                const float qn = qnp[32 * j] + qnp[256 + 32 * j] + qnp[512 + 32 * j] + qnp[768 + 32 * j];
                const float den = dnp[32 * j] + dnp[256 + 32 * j] + Tp[32 * j] * qn;
                const float inv = 1.0f / fmaxf(fabsf(den), Tp[256 + 32 * j]);
                if (dir == 0) {
#pragma unroll
                    for (int r = 0; r < 16; r += 2) hp[j][r >> 1] = pk2(acc[j][r] * inv, acc[j][r + 1] * inv); }
                else {
#pragma unroll
                    for (int r = 0; r < 16; r += 2) { hs[j][r] = lo16(hp[j][r >> 1]) + acc[j][r] * inv; hs[j][r + 1] = hi16(hp[j][r >> 1]) + acc[j][r + 1] * inv; } } }
        }
        u32x2 gg[4][4];
        { const int tz = ltid(), r32o = tz & 31, hio = (tz >> 5) & 1, wido = tz >> 6; const size_t obase = (row0 + r32o) * 1024 + h * 256 + 32 * wido + 4 * hio;
#pragma unroll
          for (int j = 0; j < 4; ++j)
#pragma unroll
              for (int r4 = 0; r4 < 4; ++r4) gg[j][r4] = *(const u32x2*)(mo + obase + (size_t)j * 32 * 1024 + 8 * r4); }
#pragma unroll
        for (int j = 0; j < 4; ++j) { float ssq = 0.f;
#pragma unroll
            for (int r = 0; r < 16; ++r) ssq += hs[j][r] * hs[j][r];
            ssq += __shfl_xor(ssq, 32); const int tzr = ltid(); if (((tzr >> 5) & 1) == 0) red[(tzr >> 6) * 128 + 32 * j + (tzr & 31)] = ssq; }
        __syncthreads();
        {
          const int tz = ltid(), r32o = tz & 31, hio = (tz >> 5) & 1, wido = tz >> 6;
          const size_t obase = (row0 + r32o) * 1024 + h * 256 + 32 * wido + 4 * hio;
#pragma unroll
          for (int j = 0; j < 4; ++j) { const int t = 32 * j + r32o; float tot = 0.f;
#pragma unroll
              for (int w = 0; w < 8; ++w) tot += red[w * 128 + t];
              const float rstd = rsqrtf(tot * (1.0f / 256.0f) + EPS_);
#pragma unroll
              for (int r4 = 0; r4 < 4; ++r4) { const int v0 = 32 * wido + 8 * r4 + 4 * hio; const size_t off = obase + (size_t)j * 32 * 1024 + 8 * r4;
                  const u32x2 g = gg[j][r4]; u32x2 w;
                  w.x = pk2(hs[j][4 * r4] * rstd * mng[v0] * sigmoidf_(lo16(g.x)), hs[j][4 * r4 + 1] * rstd * mng[v0 + 1] * sigmoidf_(hi16(g.x)));
                  w.y = pk2(hs[j][4 * r4 + 2] * rstd * mng[v0 + 2] * sigmoidf_(lo16(g.y)), hs[j][4 * r4 + 3] * rstd * mng[v0 + 3] * sigmoidf_(hi16(g.y)));
                  *(u32x2*)(ym + off) = w; } } }
        __syncthreads();
    }
}

__device__ __forceinline__ void hconv8(const bf16_t* src, bool hasp, bool hasn, const float* cw, const float* cb, int cch, float (&o)[8]) {
    float up[8], uc[8], un[8];
    unpack8(*(const u32x4*)src, uc);
    if (hasp) unpack8(*(const u32x4*)(src - 1024), up); else {
#pragma unroll
        for (int i = 0; i < 8; ++i) up[i] = 0.f; }
    if (hasn) unpack8(*(const u32x4*)(src + 1024), un); else {
#pragma unroll
        for (int i = 0; i < 8; ++i) un[i] = 0.f; }
#pragma unroll
    for (int i = 0; i < 8; ++i) o[i] = cb[cch + i] + up[i] * cw[cch + i] + uc[i] * cw[3072 + cch + i] + un[i] * cw[6144 + cch + i];
}
struct H3 { u32x4 p, c, n; };
__device__ __forceinline__ H3 hload3(const bf16_t* src, bool hasp, bool hasn) { H3 r; const u32x4 z4 = {0u, 0u, 0u, 0u};
    r.c = *(const u32x4*)src; r.p = hasp ? *(const u32x4*)(src - 1024) : z4; r.n = hasn ? *(const u32x4*)(src + 1024) : z4; return r; }
__device__ __forceinline__ void hcomp8(const H3& r, const float* cw, const float* cb, int cch, float (&o)[8]) {
    float up[8], uc[8], un[8]; unpack8(r.p, up); unpack8(r.c, uc); unpack8(r.n, un);
#pragma unroll
    for (int i = 0; i < 8; ++i) o[i] = cb[cch + i] + up[i] * cw[cch + i] + uc[i] * cw[3072 + cch + i] + un[i] * cw[6144 + cch + i];
}
__device__ __forceinline__ void hw_stage(LASF wl, const float* cw, const float* cb, int conv0, int nconv, int cg) {
    for (int i = ltid(); i < nconv * 1024; i += NTH) { const int cv = i >> 10, r = (i >> 8) & 3, ch = i & 255; const int cch = (conv0 + cv) * 1024 + cg * 256 + ch;
        wl[i] = r == 0 ? cb[cch] : cw[(r - 1) * 3072 + cch]; } }
__device__ __forceinline__ void hcomp8l(const H3& r, const LASF w, float (&o)[8]) {
    float up[8], uc[8], un[8]; unpack8(r.p, up); unpack8(r.c, uc); unpack8(r.n, un);
    const f32x4 b0 = *(const PG8_LAS f32x4*)(w), b1 = *(const PG8_LAS f32x4*)(w + 4), p0 = *(const PG8_LAS f32x4*)(w + 256), p1 = *(const PG8_LAS f32x4*)(w + 260);
    const f32x4 c0 = *(const PG8_LAS f32x4*)(w + 512), c1 = *(const PG8_LAS f32x4*)(w + 516), n0 = *(const PG8_LAS f32x4*)(w + 768), n1 = *(const PG8_LAS f32x4*)(w + 772);
#pragma unroll
    for (int i = 0; i < 4; ++i) { o[i] = b0[i] + up[i] * p0[i] + uc[i] * c0[i] + un[i] * n0[i]; o[4 + i] = b1[i] + up[4 + i] * p1[i] + uc[4 + i] * c1[i] + un[4 + i] * n1[i]; }
}
__device__ __forceinline__ void phase_hprep(const Params& p, int layer, const bf16_t* hx1, const bf16_t* hv, bf16_t* zT, LDSP lds, int bid, int nb) {
    const int tid = ltid(); LASF zt = (LASF)lds;
    const float* cw = p.h_conv_w + (size_t)layer * 3 * 3072; const float* cb = p.h_conv_b + layer * 3072;
    constexpr int NU = 2 * 128 * 4;
    u32x4 ra[4], rb[4];
#define HP_LOAD(u_) do { const int cg_ = (u_) & 3, tb_ = ((u_) >> 2) & 127, b_ = (u_) >> 9; const int tl_ = tb_ * 64 + (tid >> 3); const size_t row_ = (size_t)b_ * SEQB + LC + tl_; const bool hp_ = tl_ != 0, hn_ = tl_ != LL - 1; \
        _Pragma("unroll") for (int v8 = 0; v8 < 4; ++v8) { const int c_ = cg_ * 256 + v8 * 64 + (tid & 7) * 8; ra[v8] = *(const u32x4*)(hx1 + row_ * 1024 + c_); rb[v8] = *(const u32x4*)(hv + row_ * 1024 + c_); } } while (0)
    int u = bid; int cgl = -1; LASF wl = zt + 16512;
    if (u < NU) HP_LOAD(u);
    for (; u < NU; u += nb) {
        const int cg = u & 3, tb = (u >> 2) & 127, b = u >> 9;
        if (cg != cgl) { hw_stage(wl, cw, cb, 1, 2, cg); cgl = cg; __syncthreads(); }
        const int t = tid >> 3, tl = tb * 64 + t; const size_t row = (size_t)b * SEQB + LC + tl; const bool hasp = tl != 0, hasn = tl != LL - 1; const u32x4 z4 = {0u, 0u, 0u, 0u};
#pragma unroll
        for (int v8 = 0; v8 < 4; ++v8) { const int cl = v8 * 64 + (tid & 7) * 8, c = cg * 256 + cl; float x1[8], vv[8];
            H3 ha, hb; ha.c = ra[v8]; hb.c = rb[v8];
            ha.p = hasp ? *(const u32x4*)(hx1 + (row - 1) * 1024 + c) : z4; ha.n = hasn ? *(const u32x4*)(hx1 + (row + 1) * 1024 + c) : z4;
            hb.p = hasp ? *(const u32x4*)(hv + (row - 1) * 1024 + c) : z4; hb.n = hasn ? *(const u32x4*)(hv + (row + 1) * 1024 + c) : z4;
            hcomp8l(ha, wl + cl, x1); hcomp8l(hb, wl + 1024 + cl, vv);
#pragma unroll
            for (int i = 0; i < 8; ++i) zt[t * 257 + cl + i] = vv[i] * x1[i]; }
        __syncthreads();
        if (u + nb < NU) HP_LOAD(u + nb);
        __builtin_amdgcn_sched_barrier(0);
        { const int cl = tid >> 1, th = tid & 1; bf16_t* dst = zT + ((size_t)(b * 1024 + cg * 256 + cl)) * LL + tb * 64 + 32 * th;
#pragma unroll
          for (int q = 0; q < 4; ++q) { float f[8];
#pragma unroll
              for (int e = 0; e < 8; ++e) f[e] = zt[(32 * th + 8 * q + e) * 257 + cl];
              *(u32x4*)(dst + 8 * q) = pack8(f); } }
        __syncthreads();
    }
#undef HP_LOAD
}

__device__ __forceinline__ f32x2v cmul_(f32x2v a, f32x2v b) { return mk2_(a.x * b.x - a.y * b.y, a.x * b.y + a.y * b.x); }
__device__ __forceinline__ f32x2v cmulc_(f32x2v a, f32x2v b) { return mk2_(a.x * b.x + a.y * b.y, a.y * b.x - a.x * b.y); }
__device__ __forceinline__ f32x2v cadd_(f32x2v a, f32x2v b) { return mk2_(a.x + b.x, a.y + b.y); }
__device__ __forceinline__ f32x2v csub_(f32x2v a, f32x2v b) { return mk2_(a.x - b.x, a.y - b.y); }
__device__ __forceinline__ int fphys(int i) { return i + (i >> 5); }
template <bool INV> __device__ __forceinline__ void bfly16(f32x2v (&v)[16], const f32x2v w1) {
    const f32x2v w2 = cmul_(w1, w1), w4 = cmul_(w2, w2), w8 = cmul_(w4, w4);
    const float C1 = 0.92387953251128674f, S1 = 0.38268343236508977f, R2 = 0.70710678118654752f;
    const f32x2v c16[8] = {mk2_(1.f, 0.f), mk2_(C1, -S1), mk2_(R2, -R2), mk2_(S1, -C1), mk2_(0.f, -1.f), mk2_(-S1, -C1), mk2_(-R2, -R2), mk2_(-C1, -S1)};
    if (!INV) {
#pragma unroll
        for (int m = 0; m < 8; ++m) { const f32x2v W = cmul_(w1, c16[m]); const f32x2v a = v[m], b = v[m + 8]; v[m] = cadd_(a, b); v[m + 8] = cmul_(csub_(a, b), W); }
#pragma unroll
        for (int g = 0; g < 16; g += 8)
#pragma unroll
            for (int m = 0; m < 4; ++m) { const f32x2v W = cmul_(w2, c16[2 * m]); const f32x2v a = v[g + m], b = v[g + m + 4]; v[g + m] = cadd_(a, b); v[g + m + 4] = cmul_(csub_(a, b), W); }
#pragma unroll
        for (int g = 0; g < 16; g += 4)
#pragma unroll
            for (int m = 0; m < 2; ++m) { const f32x2v W = cmul_(w4, c16[4 * m]); const f32x2v a = v[g + m], b = v[g + m + 2]; v[g + m] = cadd_(a, b); v[g + m + 2] = cmul_(csub_(a, b), W); }
#pragma unroll
        for (int g = 0; g < 16; g += 2) { const f32x2v a = v[g], b = v[g + 1]; v[g] = cadd_(a, b); v[g + 1] = cmul_(csub_(a, b), w8); }
    } else {
#pragma unroll
        for (int g = 0; g < 16; g += 2) { const f32x2v a = v[g], b = cmulc_(v[g + 1], w8); v[g] = cadd_(a, b); v[g + 1] = csub_(a, b); }
#pragma unroll
        for (int g = 0; g < 16; g += 4)
#pragma unroll
            for (int m = 0; m < 2; ++m) { const f32x2v W = cmul_(w4, c16[4 * m]); const f32x2v a = v[g + m], b = cmulc_(v[g + m + 2], W); v[g + m] = cadd_(a, b); v[g + m + 2] = csub_(a, b); }
#pragma unroll
        for (int g = 0; g < 16; g += 8)
#pragma unroll
            for (int m = 0; m < 4; ++m) { const f32x2v W = cmul_(w2, c16[2 * m]); const f32x2v a = v[g + m], b = cmulc_(v[g + m + 4], W); v[g + m] = cadd_(a, b); v[g + m + 4] = csub_(a, b); }
#pragma unroll
        for (int m = 0; m < 8; ++m) { const f32x2v W = cmul_(w1, c16[m]); const f32x2v a = v[m], b = cmulc_(v[m + 8], W); v[m] = cadd_(a, b); v[m + 8] = csub_(a, b); }
    }
}
template <bool INV, int S, bool SYNC = true> __device__ __forceinline__ void fft_pass16(PG8_LAS f32x2v* cb) {
    constexpr int STR = S / 16;
    int tz = ltid();
#pragma unroll 2
    for (int k = 0; k < 2; ++k) { const int q = tz + NTH * k; const int j = q & (STR - 1), base = (q / STR) * S + j;
        f32x2v v[16];
#pragma unroll
        for (int m = 0; m < 16; ++m) v[m] = cb[fphys(base + STR * m)];
        const float rev = (float)j * (1.0f / (float)S); const f32x2v w1 = mk2_(cos2pi(rev), -sin2pi(rev));
        bfly16<INV>(v, w1);
#pragma unroll
        for (int m = 0; m < 16; ++m) cb[fphys(base + STR * m)] = v[m]; }
    if (SYNC) __syncthreads();
}
template <int NM> __device__ __forceinline__ void fft_pass_first(PG8_LAS f32x2v* cb, const bf16_t* s0, const bf16_t* s1) {
    const int tz = ltid();
    bf16_t r0[2][NM], r1[2][NM];
#pragma unroll
    for (int k = 0; k < 2; ++k)
#pragma unroll
        for (int m = 0; m < NM; ++m) { r0[k][m] = s0[tz + NTH * k + 1024 * m]; r1[k][m] = s1 ? s1[tz + NTH * k + 1024 * m] : (bf16_t)0; }
#pragma unroll
    for (int k = 0; k < 2; ++k) { const int j = tz + NTH * k;
        f32x2v v[16];
#pragma unroll
        for (int m = 0; m < 16; ++m) v[m] = m < NM ? mk2_(bf2f(r0[k][m]), bf2f(r1[k][m])) : mk2_(0.f, 0.f);
        const float rev = (float)j * (1.0f / 16384.0f); const f32x2v w1 = mk2_(cos2pi(rev), -sin2pi(rev));
        bfly16<false>(v, w1);
#pragma unroll
        for (int m = 0; m < 16; ++m) cb[fphys(j + 1024 * m)] = v[m]; }
    __syncthreads();
}
__device__ __forceinline__ void fft_pass_last(PG8_LAS f32x2v* cb, bf16_t* d0, bf16_t* d1) {
    const int tz = ltid();
#pragma unroll 1
    for (int k = 0; k < 2; ++k) { const int j = tz + NTH * k;
        f32x2v v[16];
#pragma unroll
        for (int m = 0; m < 16; ++m) v[m] = cb[fphys(j + 1024 * m)];
        const float rev = (float)j * (1.0f / 16384.0f); const f32x2v w1 = mk2_(cos2pi(rev), -sin2pi(rev));
        bfly16<true>(v, w1);
#pragma unroll
        for (int m = 0; m < 8; ++m) { d0[j + 1024 * m] = f2bf(v[m].x); d1[j + 1024 * m] = f2bf(v[m].y); } }
    __syncthreads();
}
__device__ __forceinline__ void r4_dif(f32x2v (&a)[4]) {
    const f32x2v b0 = cadd_(a[0], a[2]), b2 = csub_(a[0], a[2]), b1 = cadd_(a[1], a[3]); const f32x2v d = csub_(a[1], a[3]); const f32x2v b3 = mk2_(d.y, -d.x);
    a[0] = cadd_(b0, b1); a[1] = csub_(b0, b1); a[2] = cadd_(b2, b3); a[3] = csub_(b2, b3); }
__device__ __forceinline__ void r4_dit(f32x2v (&c)[4]) {
    const f32x2v b0 = cadd_(c[0], c[1]), b1 = csub_(c[0], c[1]), b2 = cadd_(c[2], c[3]), b3 = csub_(c[2], c[3]); const f32x2v ib3 = mk2_(-b3.y, b3.x);
    c[0] = cadd_(b0, b2); c[2] = csub_(b0, b2); c[1] = cadd_(b1, ib3); c[3] = csub_(b1, ib3); }

__device__ __forceinline__ void phase_fft(const Params& p, int layer, const bf16_t* tapsT, bf16_t* zT, float* Hscr, LDSP lds, int bid, int nb) {
    PG8_LAS f32x2v* cb = (PG8_LAS f32x2v*)lds; const int tid = ltid();
    for (int c = bid; c < 1024; c += nb) {
        fft_pass_first<16>(cb, tapsT + (size_t)c * 16384, nullptr); fft_pass16<false, 1024, false>(cb); fft_pass16<false, 64, false>(cb);
        float ssq_c = 0.f;
#pragma unroll
        for (int q = 0; q < 8; ++q) ssq_c += p.sumsq[((size_t)(layer * 64 + (c >> 5)) * 8 + q) * 32 + (c & 31)];
#pragma unroll
        for (int q = 0; q < 8; ++q) ssq_c += p.sumsq[((size_t)(layer * 64 + 32 + (c >> 5)) * 8 + q) * 32 + (c & 31)];
        const float scale = rsqrtf(ssq_c + EPS_) * (1.0f / 16384.0f);
        f32x2v H[8][4];
        { const int tz = ltid();
#pragma unroll
          for (int k = 0; k < 8; ++k) { const int q = 256 * (tz >> 6) + 2048 * (k >> 2) + 64 * (k & 3) + (tz & 63); f32x2v a[4];
#pragma unroll
              for (int m = 0; m < 4; ++m) a[m] = cb[fphys(4 * q + m)];
              r4_dif(a);
#pragma unroll
              for (int m = 0; m < 4; ++m) H[k][m] = mk2_(a[m].x * scale, a[m].y * scale); } }
        __syncthreads();
        fft_pass_first<8>(cb, zT + (size_t)c * LL, zT + (size_t)(1024 + c) * LL); fft_pass16<false, 1024, false>(cb); fft_pass16<false, 64, false>(cb);
        { const int tz = ltid();
#pragma unroll
          for (int k = 0; k < 8; ++k) { const int q = 256 * (tz >> 6) + 2048 * (k >> 2) + 64 * (k & 3) + (tz & 63); f32x2v a[4];
#pragma unroll
              for (int m = 0; m < 4; ++m) a[m] = cb[fphys(4 * q + m)];
              r4_dif(a);
#pragma unroll
              for (int m = 0; m < 4; ++m) a[m] = cmul_(a[m], H[k][m]);
              r4_dit(a);
#pragma unroll
              for (int m = 0; m < 4; ++m) cb[fphys(4 * q + m)] = a[m]; } }
        fft_pass16<true, 64, false>(cb); fft_pass16<true, 1024>(cb);
        fft_pass_last(cb, zT + (size_t)c * LL, zT + (size_t)(1024 + c) * LL);
    }
}
__device__ __forceinline__ void phase_hfin(const Params& p, int layer, const bf16_t* __restrict__ hx0, const bf16_t* __restrict__ hx1, const bf16_t* __restrict__ hv, const bf16_t* __restrict__ yT, bf16_t* __restrict__ yh, LDSP lds, int bid, int nb) {
    const int tid = ltid(); LASF yt = (LASF)lds;
    const float* cw = p.h_conv_w + (size_t)layer * 3 * 3072; const float* cb = p.h_conv_b + layer * 3072; const float* hb = p.h_bias + layer * 1024;
    int cgl = -1; LASF wl = yt + 16640; LASF hbl = wl + 3072;
    for (int u = bid; u < 2 * 128 * 4; u += nb) {
        const int cg = u & 3, tb = (u >> 2) & 127, b = u >> 9;
        if (cg != cgl) { hw_stage(wl, cw, cb, 0, 3, cg); if (tid < 256) hbl[tid] = hb[cg * 256 + tid]; cgl = cg; }
        u32x4 rc0[4], rc1[4], rc2[4];
        { const size_t ro = ((size_t)b * SEQB + LC + tb * 64 + (tid >> 3)) * 1024 + cg * 256 + (tid & 7) * 8;
#pragma unroll
          for (int v8 = 0; v8 < 4; ++v8) { rc0[v8] = *(const u32x4*)(hx0 + ro + v8 * 64); rc1[v8] = *(const u32x4*)(hx1 + ro + v8 * 64); rc2[v8] = *(const u32x4*)(hv + ro + v8 * 64); } }
        { const int cl = tid >> 1, th = tid & 1; const bf16_t* src = yT + ((size_t)(b * 1024 + cg * 256 + cl)) * LL + tb * 64 + 32 * th;
          u32x4 yv[4];
#pragma unroll
          for (int q = 0; q < 4; ++q) yv[q] = *(const u32x4*)(src + 8 * q);
#pragma unroll
          for (int q = 0; q < 4; ++q) { float f[8]; unpack8(yv[q], f);
#pragma unroll
              for (int e = 0; e < 8; ++e) yt[cl * 65 + 32 * th + 8 * q + e] = f[e]; } }
        __syncthreads();
        const int t = tid >> 3, tl = tb * 64 + t; const size_t row = (size_t)b * SEQB + LC + tl; const bool hasp = tl != 0, hasn = tl != LL - 1;
#pragma unroll
        for (int v8 = 0; v8 < 4; ++v8) { const int cl = v8 * 64 + (tid & 7) * 8, c = cg * 256 + cl; float x0[8], x1[8], vv[8], o[8]; const u32x4 z4 = {0u, 0u, 0u, 0u};
            H3 h0, h1, h2; h0.c = rc0[v8]; h1.c = rc1[v8]; h2.c = rc2[v8];
            h0.p = hasp ? *(const u32x4*)(hx0 + (row - 1) * 1024 + c) : z4; h0.n = hasn ? *(const u32x4*)(hx0 + (row + 1) * 1024 + c) : z4;
            h1.p = hasp ? *(const u32x4*)(hx1 + (row - 1) * 1024 + c) : z4; h1.n = hasn ? *(const u32x4*)(hx1 + (row + 1) * 1024 + c) : z4;
            h2.p = hasp ? *(const u32x4*)(hv + (row - 1) * 1024 + c) : z4; h2.n = hasn ? *(const u32x4*)(hv + (row + 1) * 1024 + c) : z4;
            hcomp8l(h0, wl + cl, x0); hcomp8l(h1, wl + 1024 + cl, x1); hcomp8l(h2, wl + 2048 + cl, vv);
            const f32x4 hb0 = *(const PG8_LAS f32x4*)(hbl + cl), hb1 = *(const PG8_LAS f32x4*)(hbl + cl + 4);
#pragma unroll
            for (int i = 0; i < 8; ++i) o[i] = x0[i] * (yt[(cl + i) * 65 + t] + (i < 4 ? hb0[i] : hb1[i - 4]) * vv[i] * x1[i]);
            *(u32x4*)(yh + row * 1024 + c) = pack8(o); }
        __syncthreads();
    }
}
__device__ __forceinline__ void phase_hctx(const Params& p, int layer, const bf16_t* hx0, const bf16_t* hx1, const bf16_t* hv, bf16_t* yh, LDSP lds, int bid, int nb) {
    const int tid = ltid(); LASF zc = (LASF)lds, x0c = zc + 2048, hf = x0c + 2048, hbk = hf + 2048;
    const float* cw = p.h_conv_w + (size_t)layer * 3 * 3072; const float* cb = p.h_conv_b + layer * 3072; const float* hbias = p.h_bias + layer * 1024;
    for (int u = bid; u < 256; u += nb) {
        const int b = u >> 7, c0 = (u & 127) * 8;
        if (tid < 256) { const int t = tid; const size_t row = (size_t)b * SEQB + t; const bool hasp = t != 0, hasn = t != LC - 1; float x0[8], x1[8], vv[8];
            hconv8(hx0 + row * 1024 + c0, hasp, hasn, cw, cb, c0, x0); hconv8(hx1 + row * 1024 + c0, hasp, hasn, cw, cb, 1024 + c0, x1); hconv8(hv + row * 1024 + c0, hasp, hasn, cw, cb, 2048 + c0, vv);
#pragma unroll
            for (int i = 0; i < 8; ++i) { zc[t * 8 + i] = vv[i] * x1[i]; x0c[t * 8 + i] = x0[i]; } }
        for (int i = tid; i < 256 * 8; i += NTH) { const int j = i & 255, cl = i >> 8; const float rs = rsqrtf(p.sumsqC[2048 + c0 + cl] + p.sumsqC[2048 + 1024 + c0 + cl] + EPS_);
            hf[j * 8 + cl] = p.hfC[(size_t)(c0 + cl) * 256 + j] * rs; hbk[j * 8 + cl] = p.hbC[(size_t)(c0 + cl) * 256 + j] * rs; }
        __syncthreads();
        { const int cl = tid & 7, tg = tid >> 3;
#pragma unroll 1
          for (int ti = 0; ti < 4; ++ti) { const int t = tg + 64 * ti; float y = 0.f;
#pragma unroll 4
              for (int j = 0; j <= t; ++j) y += hf[j * 8 + cl] * zc[(t - j) * 8 + cl];
#pragma unroll 4
              for (int j = 1; j <= 255 - t; ++j) y += hbk[j * 8 + cl] * zc[(t + j) * 8 + cl];
              const float o = x0c[t * 8 + cl] * (y + hbias[c0 + cl] * zc[t * 8 + cl]);
              yh[((size_t)b * SEQB + t) * 1024 + c0 + cl] = f2bf(o); } }
        __syncthreads();
    }
}

__device__ __forceinline__ bool xcd_tile(int i, int c, int G, int T, int& tile) {
    if (G & 7) { tile = i * G + c; return tile < T; }
    const int per = G >> 3, x = c & 7, j = c >> 3, q = i * per + j, base = T >> 3, rem = T & 7;
    const int start = x * base + (x < rem ? x : rem), size = base + (x < rem ? 1 : 0);
    tile = start + q; return q < size; }
struct MergeOrder { int ntile, G, c, lat_only;
    __device__ __forceinline__ bool next(int i, pg8::Unit& u) const { const int tile = (i / 3) * G + c, j = i - (i / 3) * 3; if (tile >= ntile) return false;
        int pi = tile >> 2; const int n = tile & 3; if (lat_only) pi = (pi >> 5) * 33 + 1 + (pi & 31);
        u.pm = j * NPAN + pi; u.pn = j * 4 + n; return true; }
    __device__ __forceinline__ void a_ready(const pg8::Unit&) const {}
    __device__ __forceinline__ void done(const pg8::Unit&) const {} };
struct MergeEpi { static constexpr bool PERM = true, AFTER_DRAIN = false;
    const bf16_t* gates; const float* mb; bf16_t* ysum;
    __device__ __forceinline__ void operator()(const f32x4 (&acc)[2][2][4][2], const pg8::Unit& u, int wr, int wc, int fr, int fq) const {
        const int j = u.pn >> 2, pi = u.pm - j * NPAN, nt = u.pn & 3;
        const int row0 = pi * 256 + wr * 64 + fr, col0 = nt * 256 + wc * 32 + 8 * fq;
        const bf16_t* gj = gates + (size_t)j * TT * 1024;
#pragma unroll
        for (int bj = 0; bj < 2; ++bj) { const int col = col0 + bj * 128; float mbv[8];
#pragma unroll
            for (int i = 0; i < 8; ++i) mbv[i] = mb[j * 1024 + col + i];
#pragma unroll
            for (int ai = 0; ai < 2; ++ai) {
                u32x4 gv[4], ov[4];
#pragma unroll
                for (int m = 0; m < 4; ++m) { const size_t off = (size_t)(row0 + ai * 128 + m * 16) * 1024 + col; gv[m] = *(const u32x4*)(gj + off); if (j > 0) ov[m] = *(const u32x4*)(ysum + off); }
                __builtin_amdgcn_sched_barrier(0);
#pragma unroll
                for (int m = 0; m < 4; ++m) { const size_t off = (size_t)(row0 + ai * 128 + m * 16) * 1024 + col;
                    float g[8], o[8]; unpack8(gv[m], g);
#pragma unroll
                    for (int i = 0; i < 8; ++i) o[i] = sigmoidf_(g[i] + mbv[i]) * acc[ai][bj][m][i >> 2][i & 3];
                    if (j > 0) { float old[8]; unpack8(ov[m], old);
#pragma unroll
                        for (int i = 0; i < 8; ++i) o[i] += old[i]; }
                    *(u32x4*)(ysum + off) = pack8(o); }
                __builtin_amdgcn_sched_barrier(0); } }
    } };
struct OutOrder { int ntile, G, c, lat_only;
    __device__ __forceinline__ bool next(int i, pg8::Unit& u) const { const int tile = i * G + c; if (tile >= ntile) return false;
        int pi = tile >> 2; if (lat_only) pi = (pi >> 5) * 33 + 1 + (pi & 31); u.pm = pi; u.pn = tile & 3; return true; }
    __device__ __forceinline__ void a_ready(const pg8::Unit&) const {}
    __device__ __forceinline__ void done(const pg8::Unit&) const {} };
struct OutEpi { static constexpr bool PERM = false, AFTER_DRAIN = false;
    const Params* p; int layer;
    __device__ __forceinline__ void operator()(const f32x4 (&acc)[2][2][4][2], const pg8::Unit& u, int wr, int wc, int fr, int fq) const {
        const int row0 = u.pm * 256 + wr * 64 + fr, col0 = u.pn * 256 + wc * 32 + 4 * fq;
        const float* g1 = modvec(*p, layer, u.pm * 256) + 2048;
        f32x4 gq[4];
#pragma unroll
        for (int q = 0; q < 4; ++q) gq[q] = *(const f32x4*)(g1 + col0 + (q >> 1) * 128 + (q & 1) * 16);
#pragma unroll
        for (int ai = 0; ai < 2; ++ai) { f32x4 xv[16];
#pragma unroll
            for (int m = 0; m < 4; ++m) { const float* rin = resid_row_in(*p, layer, row0 + ai * 128 + m * 16);
#pragma unroll
                for (int q = 0; q < 4; ++q) xv[m * 4 + q] = *(const f32x4*)(rin + col0 + (q >> 1) * 128 + (q & 1) * 16); }
            __builtin_amdgcn_sched_barrier(0);
#pragma unroll
            for (int m = 0; m < 4; ++m) { float* ro = resid_row(*p, row0 + ai * 128 + m * 16);
#pragma unroll
                for (int q = 0; q < 4; ++q) *(f32x4*)(ro + col0 + (q >> 1) * 128 + (q & 1) * 16) = xv[m * 4 + q] + gq[q] * acc[ai][q >> 1][m][q & 1]; }
            __builtin_amdgcn_sched_barrier(0); }
    } };
struct MoeOrder { const PG8_LAS int* te; int ntl, G, c;
    __device__ __forceinline__ bool next(int i, pg8::Unit& u) const { int L; if (!xcd_tile(i, c, G, ntl * 4, L)) return false; const int tile = L >> 2; u.pm = tile; u.pn = te[tile] * 4 + (L & 3); return true; }
    __device__ __forceinline__ void a_ready(const pg8::Unit&) const {}
    __device__ __forceinline__ void done(const pg8::Unit&) const {} };
struct E1Epi { static constexpr bool PERM = true, AFTER_DRAIN = false;
    bf16_t* H;
    __device__ __forceinline__ void operator()(const f32x4 (&acc)[2][2][4][2], const pg8::Unit& u, int wr, int wc, int fr, int fq) const {
        const int row0 = u.pm * 256 + wr * 64 + fr, hid0 = ((u.pn & 3) * 256 + wc * 32 + 8 * fq) >> 1;
#pragma unroll
        for (int ai = 0; ai < 2; ++ai)
#pragma unroll
            for (int m = 0; m < 4; ++m)
#pragma unroll
                for (int bj = 0; bj < 2; ++bj) { const f32x4 a = acc[ai][bj][m][0], b = acc[ai][bj][m][1]; u32x2 w;
                    w.x = pk2(siluf_(a[0]) * b[0], siluf_(a[1]) * b[1]); w.y = pk2(siluf_(a[2]) * b[2], siluf_(a[3]) * b[3]);
                    *(u32x2*)(H + (size_t)(row0 + ai * 128 + m * 16) * 512 + hid0 + bj * 64) = w; }
    } };

struct EpiReg { static constexpr bool PERM = true, AFTER_DRAIN = false;
    bf16_t* O; size_t stride; bf16_t* O6; int col6;
    __device__ __forceinline__ void operator()(const f32x4 (&acc)[2][2][4][2], const pg8::Unit& u, int wr, int wc, int fr, int fq) const {
        const int row0 = u.pm * 256 + wr * 64 + fr; const int colt = u.pn * 256, reg = colt >> 10;
        bf16_t* base = reg < 6 ? O + (size_t)reg * stride : O6; const int col0 = (reg < 6 ? colt - (reg << 10) : col6 + colt - 6144) + wc * 32 + 8 * fq;
#pragma unroll
        for (int ai = 0; ai < 2; ++ai)
#pragma unroll
            for (int m = 0; m < 4; ++m) { bf16_t* rowp = base + (size_t)(row0 + ai * 128 + m * 16) * 1024 + col0;
#pragma unroll
                for (int bj = 0; bj < 2; ++bj) { const f32x4 v0 = acc[ai][bj][m][0], v1 = acc[ai][bj][m][1]; u32x4 w;
                    w.x = pk2(v0[0], v0[1]); w.y = pk2(v0[2], v0[3]); w.z = pk2(v1[0], v1[1]); w.w = pk2(v1[2], v1[3]);
                    *(u32x4*)(rowp + bj * 128) = w; } }
    } };

__device__ __forceinline__ void phase_norm2_router(const Params& p, int layer, LDSP lds, int bid, int nb, bool count = true) {
    LASF rw = (LASF)lds;
    const int tid = ltid(), lane = tid & 63, wid = tid >> 6;
    for (int i = bid * NTH + tid; i < TPAD; i += nb * NTH) p.rowidx[i] = 0;
    PG8_LAS int* hist = (PG8_LAS int*)(lds + 148 * 1024);
    if (tid < 32) hist[tid] = 0;
    { float4 wv[16];
#pragma unroll
      for (int j = 0; j < 16; ++j) { const int i = tid + NTH * j; wv[j] = *(const float4*)(p.router_w + (i >> 3) * 32 + (i & 7) * 4); }
#pragma unroll
      for (int j = 0; j < 16; ++j) { const int i = tid + NTH * j, n = i >> 3, e4 = (i & 7) * 4; rw[n * 36 + e4] = wv[j].x; rw[n * 36 + e4 + 1] = wv[j].y; rw[n * 36 + e4 + 2] = wv[j].z; rw[n * 36 + e4 + 3] = wv[j].w; } }
    __syncthreads();
    const float* gn = p.norm2_g + layer * 1024;
    float rb[8];
    { const f32x4 r0 = *(const f32x4*)(p.router_b + 8 * (lane >> 4)), r1 = *(const f32x4*)(p.router_b + 8 * (lane >> 4) + 4);
      rb[0] = r0[0]; rb[1] = r0[1]; rb[2] = r0[2]; rb[3] = r0[3]; rb[4] = r1[0]; rb[5] = r1[1]; rb[6] = r1[2]; rb[7] = r1[3]; }
    float gv[16], scv[16], shv[16]; const float* mvc = nullptr;
#pragma unroll
    for (int i = 0; i < 16; ++i) gv[i] = gn[lane + 64 * i];
    for (int s = bid * 8 + wid; s < TT; s += nb * 8) {
        const int pos = s % SEQB; if (layer == 1 && pos < LC) continue;
        const float* xr = resid_row(p, s); const float* mv = modvec(p, layer, s);
        float xv[16]; float ssq = 0.f;
#pragma unroll
        for (int i = 0; i < 16; ++i) xv[i] = xr[lane + 64 * i];
        if (mv != mvc) { mvc = mv;
#pragma unroll
            for (int i = 0; i < 16; ++i) { const int n = lane + 64 * i; scv[i] = mv[4096 + n]; shv[i] = mv[3072 + n]; } }
#pragma unroll
        for (int i = 0; i < 16; ++i) ssq += xv[i] * xv[i];
        ssq = wave_sum(ssq); const float rstd = rsqrtf(ssq * (1.0f / 1024.0f) + EPS_);
        float acc[32];
#pragma unroll
        for (int e = 0; e < 32; ++e) acc[e] = 0.f;
#pragma unroll
        for (int i = 0; i < 16; ++i) { const int n = lane + 64 * i; const float hv = xv[i] * rstd * gv[i] * (1.0f + scv[i]) + shv[i];
            p.hn[(size_t)s * 1024 + n] = f2bf(hv);
#pragma unroll
            for (int e4 = 0; e4 < 8; ++e4) { const f32x4 w = *(const PG8_LAS f32x4*)(rw + n * 36 + 4 * e4); acc[4 * e4] += hv * w.x; acc[4 * e4 + 1] += hv * w.y; acc[4 * e4 + 2] += hv * w.z; acc[4 * e4 + 3] += hv * w.w; }
            __builtin_amdgcn_sched_barrier(0); }
        wave_sum32(acc);
        float v1 = -1e30f, v2 = -1e30f, s1 = 0.f, s2 = 0.f; int i1 = 0, i2 = 0;
#pragma unroll
        for (int q = 0; q < 8; ++q) { const float sve = sigmoidf_(acc[q]), v = sve + rb[q];
            if (v > v1) { v2 = v1; i2 = i1; s2 = s1; v1 = v; i1 = q; s1 = sve; } else if (v > v2) { v2 = v; i2 = q; s2 = sve; } }
        const float gsc = v1 + v2; float best = readlane_f(gsc, 0); int bg = 0;
        { const float g1 = readlane_f(gsc, 16), g2 = readlane_f(gsc, 32), g3 = readlane_f(gsc, 48);
          if (g1 > best) { best = g1; bg = 1; } if (g2 > best) { best = g2; bg = 2; } if (g3 > best) { best = g3; bg = 3; } }
        if (lane == 16 * bg) { const float inv = 1.0f / (s1 + s2); const int be1 = 8 * bg + i1, be2 = 8 * bg + i2;
            p.sel_e[s * 2] = be1; p.sel_e[s * 2 + 1] = be2; p.sel_w[s * 2] = s1 * inv; p.sel_w[s * 2 + 1] = s2 * inv;
            atomicAdd((int*)(hist + be1), 1); atomicAdd((int*)(hist + be2), 1); }
    }
    __syncthreads();
    if (count && tid < 32 && hist[tid] != 0) atomicAdd(p.cnt + layer * 32 + tid, hist[tid]);
    __syncthreads();
}
__device__ __forceinline__ int moe_plan(const Params& p, int layer, PG8_LAS int* pstart, PG8_LAS int* te) {
    if (ltid() == 0) { int tl = 0; for (int e = 0; e < 32; ++e) { const int cn = p.cnt[layer * 32 + e]; pstart[e] = tl * 256; const int nt = (cn + 255) >> 8; for (int q = 0; q < nt; ++q) te[tl + q] = e; tl += nt; } pstart[32] = tl; }
    __syncthreads();
    return pstart[32];
}
__device__ __forceinline__ void phase_moe_assign(const Params& p, int layer, LDSP lds, int bid, int nb) {
    PG8_LAS int* pstart = (PG8_LAS int*)lds; PG8_LAS int* te = pstart + 64; PG8_LAS int* hist = pstart + 512; PG8_LAS int* base = hist + 32;
    const int tid = ltid();
    if (tid < 32) hist[tid] = 0;
    moe_plan(p, layer, pstart, te);
    const int per = (TT + nb - 1) / nb, s = bid * per + tid; const bool act = tid < per && s < TT && !(layer == 1 && (s % SEQB) < LC);
    int e0 = 0, e1 = 0, r0 = 0, r1 = 0;
    if (act) { e0 = p.sel_e[s * 2]; e1 = p.sel_e[s * 2 + 1]; r0 = atomicAdd((int*)(hist + e0), 1); r1 = atomicAdd((int*)(hist + e1), 1); }
    __syncthreads();
    if (tid < 32) base[tid] = hist[tid] ? atomicAdd(p.cur + layer * 32 + tid, hist[tid]) : 0;
    __syncthreads();
    if (act) { const int p0 = pstart[e0] + base[e0] + r0, p1 = pstart[e1] + base[e1] + r1;
        p.posbuf[s * 2] = p0; p.posbuf[s * 2 + 1] = p1; p.rowidx[p0] = s; p.rowidx[p1] = s; }
    __syncthreads();
}
template <bool NEXT_NORM> __device__ __forceinline__ void phase_moe_combine(const Params& p, int layer, const bf16_t* Yb_, LDSP lds, int bid, int nb) {
    const bf16_t* Yb = UP(Yb_);
    LASF wg = (LASF)lds;
    const int tid = ltid(), lane = tid & 63, wid = tid >> 6;
    if (NEXT_NORM) {
        float4 wv[8];
#pragma unroll
        for (int j = 0; j < 8; ++j) { const int i = tid + NTH * j; wv[j] = *(const float4*)(p.w_in + (size_t)(layer + 1) * 1024 * 13328 + (size_t)(i >> 2) * 13328 + 4096 + (i & 3) * 4); }
#pragma unroll
        for (int j = 0; j < 8; ++j) { const int i = tid + NTH * j, n = i >> 2, j4 = (i & 3) * 4; wg[n * 20 + j4] = wv[j].x; wg[n * 20 + j4 + 1] = wv[j].y; wg[n * 20 + j4 + 2] = wv[j].z; wg[n * 20 + j4 + 3] = wv[j].w; }
        __syncthreads();
    }
    const float* gn = p.norm1_g + (layer + 1) * 1024;
    f32x4 gvh[4], sch[4], shh[4]; const float* mvh = nullptr;
    if (NEXT_NORM) {
#pragma unroll
        for (int i = 0; i < 4; ++i) gvh[i] = *(const f32x4*)(gn + 4 * lane + 256 * i); }
    for (int s = bid * 8 + wid; s < TT; s += nb * 8) {
        const int pos = s % SEQB; if (layer == 1 && pos < LC) continue;
        const int p0 = p.posbuf[s * 2], p1 = p.posbuf[s * 2 + 1]; const float w0 = p.sel_w[s * 2], w1 = p.sel_w[s * 2 + 1];
        float* xr = resid_row(p, s); const float* g2 = modvec(p, layer, s) + 5120;
        f32x4 xn[4]; float ssq = 0.f;
#pragma unroll
        for (int i = 0; i < 4; ++i) { const int col = 4 * lane + 256 * i; const u32x2 a = *(const u32x2*)(Yb + (size_t)p0 * 1024 + col), b = *(const u32x2*)(Yb + (size_t)p1 * 1024 + col);
            f32x4 x = *(const f32x4*)(xr + col); const f32x4 g = *(const f32x4*)(g2 + col);
            x[0] += g[0] * (w0 * lo16(a.x) + w1 * lo16(b.x)); x[1] += g[1] * (w0 * hi16(a.x) + w1 * hi16(b.x)); x[2] += g[2] * (w0 * lo16(a.y) + w1 * lo16(b.y)); x[3] += g[3] * (w0 * hi16(a.y) + w1 * hi16(b.y));
            *(f32x4*)(xr + col) = x; xn[i] = x; ssq += x[0] * x[0] + x[1] * x[1] + x[2] * x[2] + x[3] * x[3]; }
        if (NEXT_NORM) {
            const float* mv = modvec(p, layer + 1, s);
            if (mv != mvh) { mvh = mv;
#pragma unroll
                for (int i = 0; i < 4; ++i) { sch[i] = *(const f32x4*)(mv + 1024 + 4 * lane + 256 * i); shh[i] = *(const f32x4*)(mv + 4 * lane + 256 * i); } }
            ssq = wave_sum(ssq); const float rstd = rsqrtf(ssq * (1.0f / 1024.0f) + EPS_);
            float acc[16];
#pragma unroll
            for (int j = 0; j < 16; ++j) acc[j] = 0.f;
#pragma unroll
            for (int i = 0; i < 4; ++i) { const int col = 4 * lane + 256 * i; const f32x4 gv = gvh[i], sc = sch[i], sh = shh[i]; float hv[4];
#pragma unroll
                for (int e = 0; e < 4; ++e) hv[e] = xn[i][e] * rstd * gv[e] * (1.0f + sc[e]) + sh[e];
                u32x2 w; w.x = pk2(hv[0], hv[1]); w.y = pk2(hv[2], hv[3]); *(u32x2*)(p.hn + (size_t)s * 1024 + col) = w;
#pragma unroll
                for (int e = 0; e < 4; ++e)
#pragma unroll
                    for (int j4 = 0; j4 < 4; ++j4) { const f32x4 wq = *(const PG8_LAS f32x4*)(wg + (col + e) * 20 + 4 * j4); acc[4 * j4] += hv[e] * wq.x; acc[4 * j4 + 1] += hv[e] * wq.y; acc[4 * j4 + 2] += hv[e] * wq.z; acc[4 * j4 + 3] += hv[e] * wq.w; }
                __builtin_amdgcn_sched_barrier(0); }
            wave_sum16(acc);
            if ((lane & 15) == 0) { f32x4 g4; g4[0] = acc[0]; g4[1] = acc[1]; g4[2] = acc[2]; g4[3] = acc[3]; *(f32x4*)(p.G + (size_t)s * 16 + (lane >> 4) * 4) = g4; }
        }
    }
    if (NEXT_NORM) __syncthreads();
}

constexpr size_t R_BYTES = 12 * UU;
constexpr size_t OFF_WT13 = 0, OFF_WT2 = OFF_WT13 + (size_t)32 * 1024 * 1024 * 2, OFF_XG = OFF_WT2 + (size_t)32 * 1024 * 512 * 2, OFF_H = OFF_XG + (size_t)TPAD * 1024 * 2, OFF_YB = OFF_H + (size_t)TPAD * 512 * 2;
static_assert(OFF_YB + (size_t)TPAD * 1024 * 2 <= R_BYTES, "MoE buffers must fit the big region");

#ifndef REPEAT_MASK
#define REPEAT_MASK 0
#endif
#define REP(bit) for (int rep_ = 0; rep_ < (((REPEAT_MASK) >> (bit)) & 1) + 1; ++rep_)
#define GRID_BAR() do { xcd_barrier(bar); if ((REPEAT_MASK >> 15) & 1) xcd_barrier(bar); asm volatile("" : "+s"(bid), "+s"(nb)); } while (0)

constexpr int PW = (int)(sizeof(Params) / 8);
static_assert(sizeof(Params) % 8 == 0 && sizeof(Params) <= 1024, "Params is a block of 8-byte words");
struct ParamsRaw { unsigned long long w[PW]; };
template <int layer> __device__ __forceinline__ void layer_body(const Params& p, const XcdBarrier& bar, LDSP lds, int& bid, int& nb);
__global__ void __launch_bounds__(512, 2) fwd_kernel(ParamsRaw raw, unsigned long long* gp, unsigned* barw) {
    extern __shared__ __attribute__((aligned(16))) unsigned char shm[];
    LDSP lds = (LDSP)shm;
    int bid = blockIdx.x, nb = gridDim.x; const int tid = threadIdx.x;
    unsigned long long* mygp = gp + (size_t)bid * 128;
    if (tid == 0) {
#pragma unroll
        for (int k = 0; k < PW; ++k) mygp[k] = raw.w[k];
        *(PG8_LAS u32x4*)(lds + LDS_BYTES - 16) = (u32x4){0u, 0u, 0u, 0u};
        asm volatile("s_waitcnt vmcnt(0)" ::: "memory"); }
    __syncthreads();
    const Params& p = *(const Params*)mygp;
    XcdBarrier bar = xcd_barrier_post(barw, (volatile LAS unsigned*)(lds + LDS_BYTES - 16));

#define RB ((unsigned char*)p.R)
#define aq ((bf16_t*)(RB))
#define ak ((bf16_t*)(RB + UU))
#define av ((bf16_t*)(RB + 2 * UU))
#define hx0 ((bf16_t*)(RB + 3 * UU))
#define hx1 ((bf16_t*)(RB + 4 * UU))
#define hv ((bf16_t*)(RB + 5 * UU))
#define zT ((bf16_t*)(RB + 6 * UU))
#define tapsT ((bf16_t*)(RB + 11 * UU))
#define ST ((bf16_t*)(RB))
#define mq ((bf16_t*)(RB + 4 * UU))
#define mk ((bf16_t*)(RB + 5 * UU))
#define mv ((bf16_t*)(RB + 6 * UU))
#define mo ((bf16_t*)(RB + 7 * UU))
#define gates ((bf16_t*)(RB + 8 * UU))
#define qc ((bf16_t*)(RB + 8 * UU))
#define kc ((bf16_t*)(RB + 9 * UU))
#define kT ((bf16_t*)(RB + 10 * UU))
#define vT ((bf16_t*)(RB + 11 * UU))
#define Wt13 ((bf16_t*)(RB + OFF_WT13))
#define Wt2 ((bf16_t*)(RB + OFF_WT2))
#define Xg ((bf16_t*)(RB + OFF_XG))
#define Hb ((bf16_t*)(RB + OFF_H))
#define Yb ((bf16_t*)(RB + OFF_YB))
#define ym ((bf16_t*)p.Y3)
#define ya ((bf16_t*)p.Y3 + (size_t)TT * 1024)
#define yh ((bf16_t*)p.Y3 + (size_t)2 * TT * 1024)

    REP(12) phase_conv_small(p, 0, lds, bid, nb);
    REP(7) { phase_modvec(p, lds, bid, nb);
    phase_hdn(p, lds, bid, nb); }
    GRID_BAR();
    layer_body<0>(p, bar, lds, bid, nb);
#if defined(PROBE_LEVEL) && (PROBE_LEVEL == 1 || PROBE_LEVEL == 2)
    return;
#endif
    layer_body<1>(p, bar, lds, bid, nb);
    if (bid == 0 && tid == 0 && xb_ld(&barw[XB_TMO]) != 0u) p.out[0] = __builtin_nanf("");
}
template <int layer> __device__ __forceinline__ void layer_body(const Params& p, const XcdBarrier& bar, LDSP lds, int& bid, int& nb) {
        if (layer == 0) {
            REP(10) phase_norm1(p, layer, lds, bid, nb);
            REP(13) phase_taps(p, layer, tapsT, lds, bid, nb);
            GRID_BAR(); }
        REP(0) { pg8::Gemm g{UP((const bf16_t*)p.hn), UP((const bf16_t*)p.Wt_in), TT, 6656, 1024}; pg8::StaticOrder S; S.init(TT, 6656, nb, bid);
          EpiReg E{UP(aq), (size_t)TT * 1024, UP(gates + (size_t)2 * TT * 1024), 0};
          pg8::gemm_phase<EpiReg, pg8::StaticOrder, false>(lds, g, S, E, nullptr);
        GRID_BAR(); }
        phase_attn_prep(p, layer, aq, ak, bid, nb);
        phase_hprep(p, layer, hx1, hv, zT, lds, bid, nb);
        if (layer == 0) REP(6) phase_hctx(p, layer, hx0, hx1, hv, yh, lds, bid, nb);
        GRID_BAR();
        phase_fft(p, layer, tapsT, zT, (float*)(RB + 10 * UU), lds, bid, nb);
        REP(1) phase_attn(p, layer, aq, ak, av, ya, lds, bid, nb);
        GRID_BAR();
        if ((REPEAT_MASK >> 3) & 1) { phase_hprep(p, layer, hx1, hv, zT, lds, bid, nb); GRID_BAR(); phase_fft(p, layer, tapsT, zT, (float*)(RB + 10 * UU), lds, bid, nb); GRID_BAR(); }
        REP(11) phase_hfin(p, layer, hx0, hx1, hv, zT, yh, lds, bid, nb);
        GRID_BAR();
        REP(0) { pg8::Gemm g{UP((const bf16_t*)p.hn), UP((const bf16_t*)p.Wt_in + (size_t)6656 * 1024), TT, 6656, 1024}; pg8::StaticOrder S; S.init(TT, 6656, nb, bid);
          EpiReg E{UP(mq), (size_t)TT * 1024, UP(gates + (size_t)2 * TT * 1024), 512};
          pg8::gemm_phase<EpiReg, pg8::StaticOrder, false>(lds, g, S, E, nullptr);
        GRID_BAR(); }
        REP(2) { phase_mA(p, layer, mk, mv, vT, ST, lds, bid, nb);
        GRID_BAR(); }
        phase_mB(p, ST, bid, nb);
        GRID_BAR();
        REP(14) { phase_mC(p, layer, mq, mk, vT, mo, ST, ym, lds, bid, nb);
        GRID_BAR(); }
        REP(4) { pg8::Gemm g{UP((const bf16_t*)p.Y3), UP((const bf16_t*)p.Wt_br + (size_t)layer * 3 * 1048576), 3 * TT, 3072, 1024}; MergeOrder S{layer == 0 ? 264 : 256, nb, bid, layer == 0 ? 0 : 1};
          MergeEpi E{UP((const bf16_t*)gates), UP((const float*)p.merge_b + layer * 3072), UP((bf16_t*)p.hn)};
          pg8::gemm_phase<MergeEpi, MergeOrder, false>(lds, g, S, E, nullptr);
          if (layer == 0 && rep_ == 0) {
              int me = bid, nl = nb; bool runf = true;
              if ((nb & 7) == 0) { const int per = nb >> 3, hx = 33 - per; if (hx > 0 && hx < per) { const int j = bid >> 3; runf = j >= hx; me = (j - hx) * 8 + (bid & 7); nl = nb - 8 * hx; } }
              if (runf) { __syncthreads();
                  phase_conv_experts(p, 0, Wt13, Wt2, lds, me, nl);
                  phase_taps(p, 1, tapsT, lds, me, nl);
                  phase_conv_small(p, 1, lds, me, nl); } }
        GRID_BAR(); }
        { pg8::Gemm g{UP((const bf16_t*)p.hn), UP((const bf16_t*)p.Wt_out + (size_t)layer * 1048576), TT, 1024, 1024}; OutOrder S{layer == 0 ? 264 : 256, nb, bid, layer == 0 ? 0 : 1};
          OutEpi E{&p, layer};
          pg8::gemm_phase<OutEpi, OutOrder, false>(lds, g, S, E, nullptr); }
        __syncthreads();
#if defined(PROBE_LEVEL) && PROBE_LEVEL == 1
        if (layer == 0) return;
#endif
#if defined(PROBE_LEVEL) && PROBE_LEVEL == 3
        if (layer == 1) return;
#endif
        if (layer == 1) REP(9) phase_conv_experts(p, layer, Wt13, Wt2, lds, bid, nb);
        GRID_BAR();
        REP(5) phase_norm2_router(p, layer, lds, bid, nb, rep_ == 0);
        GRID_BAR();
        phase_moe_assign(p, layer, lds, bid, nb);
        GRID_BAR();
        { PG8_LAS int* pstart = (PG8_LAS int*)(lds + 132 * 1024); PG8_LAS int* te = pstart + 64;
          const int ntl = moe_plan(p, layer, pstart, te);
          REP(16) { pg8::Gemm g{UP((const bf16_t*)p.hn), UP((const bf16_t*)Wt13), TT, 32 * 1024, 1024}; MoeOrder S{te, ntl, nb, bid}; E1Epi E{UP(Hb)};
            PG8_LAS int* rtab = (PG8_LAS int*)(lds + 133 * 1024);
            { pg8::Unit uu; const int tz = ltid();
#pragma unroll
              for (int i = 0; i < 4; ++i) { if (S.next(i, uu) && tz < 256) rtab[i * 256 + tz] = p.rowidx[uu.pm * 256 + tz]; } }
            __syncthreads();
            pg8::gemm_phase_g<E1Epi, MoeOrder, false>(lds, g, S, E, rtab);
          GRID_BAR(); }
          REP(17) { pg8::Gemm g{UP((const bf16_t*)Hb), UP((const bf16_t*)Wt2), TPAD, 32 * 1024, 512}; MoeOrder S{te, ntl, nb, bid}; pg8::EpiBf16<0> E{UP(Yb), 1024, nullptr, 1024, (size_t)0};
            pg8::gemm_phase<pg8::EpiBf16<0>, MoeOrder, false>(lds, g, S, E, nullptr);
          GRID_BAR(); } }
        if (layer == 0) phase_moe_combine<true>(p, layer, Yb, lds, bid, nb);
        else phase_moe_combine<false>(p, layer, Yb, lds, bid, nb);
        GRID_BAR();
}

extern "C" void kernel_launch(void* const* d_in, const int* in_sizes, int n_in, void* d_out, int out_size, void* d_ws, size_t ws_size, hipStream_t stream) {
    (void)in_sizes; (void)n_in; (void)out_size;
    Params p; memset(&p, 0, sizeof(p));
    const float* const* in = (const float* const*)d_in;
    p.x = in[0]; p.c = in[1]; p.ctx = in[2]; p.c_ctx = in[3]; p.mod_w = in[4]; p.mod_b = in[5]; p.norm1_g = in[6]; p.norm2_g = in[7]; p.w_in = in[8]; p.merge_b = in[9];
    p.m_conv_w = in[10]; p.m_conv_b = in[11]; p.m_gate_b = in[12]; p.m_norm_g = in[13]; p.a_qnorm_g = in[14]; p.a_knorm_g = in[15]; p.a_lambda = in[16]; p.a_subln_g = in[17];
    p.h_conv_w = in[18]; p.h_conv_b = in[19]; p.h_ffn_w1 = in[20]; p.h_ffn_b1 = in[21]; p.h_ffn_w2 = in[22]; p.h_ffn_b2 = in[23]; p.h_ffn_w3 = in[24]; p.h_freq = in[25]; p.h_decay = in[26]; p.h_bias = in[27];
    p.w_br_m = in[28]; p.w_br_a = in[29]; p.w_br_h = in[30]; p.w_out = in[31]; p.router_w = in[32]; p.router_b = in[33]; p.e_w1 = in[34]; p.e_w3 = in[35]; p.e_w2 = in[36];
    p.out = (float*)d_out;
    unsigned char* w = (unsigned char*)d_ws; size_t off = 0;
    auto take = [&](size_t bytes) { unsigned char* r = w + off; off += (bytes + 255) & ~(size_t)255; return r; };
    constexpr size_t ZERO_BYTES = 32768;
    unsigned char* z = take(ZERO_BYTES);
    p.bar = (unsigned*)z; p.cnt = (int*)(z + 16384); p.cur = (int*)(z + 16384 + 256); p.sumsq = (float*)take((size_t)2 * 64 * 8 * 32 * 4); p.sumsqC = (float*)take((size_t)4096 * 4);
    p.modv = (float*)take((size_t)6 * 6144 * 4); p.hdn2 = (float*)take((size_t)2 * 8448 * 64 * 4); p.G = (float*)take((size_t)TT * 16 * 4); p.xc = (float*)take((size_t)512 * 1024 * 4);
    p.sel_e = (int*)take((size_t)TT * 2 * 4); p.sel_w = (float*)take((size_t)TT * 2 * 4); p.posbuf = (int*)take((size_t)TT * 2 * 4); p.rowidx = (int*)take((size_t)TPAD * 4);
    p.scal = (float*)take((size_t)16 * 66 * 2 * 4); p.ms = (float*)take((size_t)16 * 67 * 4); p.dn = (float*)take((size_t)16 * 66 * 256 * 4); p.nst = (float*)take((size_t)16 * 66 * 256 * 4);
    p.hfC = (float*)take((size_t)1024 * 256 * 4); p.hbC = (float*)take((size_t)1024 * 256 * 4);
    p.Wt_in = (bf16_t*)take((size_t)13312 * 1024 * 2); p.Wt_br = (bf16_t*)take((size_t)2 * 3072 * 1024 * 2); p.Wt_out = (bf16_t*)take((size_t)2 * 1024 * 1024 * 2);
    unsigned long long* gpbuf = (unsigned long long*)take((size_t)1024 * 1024);
    p.hn = (bf16_t*)take(UU); p.Y3 = (bf16_t*)take(3 * UU); p.R = take(R_BYTES);
    if (off > ws_size) { fprintf(stderr, "kernel_launch: workspace too small: need %zu, have %zu\n", off, ws_size); return; }
    static int grid = 0;
    if (!grid) {
        int dev = 0, cus = 0; (void)hipGetDevice(&dev); (void)hipDeviceGetAttribute(&cus, hipDeviceAttributeMultiprocessorCount, dev);
        if (hipFuncSetAttribute((const void*)fwd_kernel, hipFuncAttributeMaxDynamicSharedMemorySize, LDS_BYTES) != hipSuccess) { fprintf(stderr, "kernel_launch: hipFuncSetAttribute failed\n"); return; }
        int per_cu = 0; (void)hipOccupancyMaxActiveBlocksPerMultiprocessor(&per_cu, (const void*)fwd_kernel, NTH, LDS_BYTES);
        if (per_cu < 1) fprintf(stderr, "kernel_launch: occupancy query reports %d blocks per CU\n", per_cu);
        grid = cus > 0 ? (cus > 1024 ? 1024 : cus) : 256;
    }
    (void)hipMemsetAsync(z, 0, ZERO_BYTES, stream);
    ParamsRaw raw; memcpy(&raw, &p, sizeof(raw));
    hipLaunchKernelGGL(fwd_kernel, dim3(grid), dim3(NTH), LDS_BYTES, stream, raw, gpbuf, (unsigned*)z);
}
```

```cpp
#include <hip/hip_runtime.h>
#include <cstdio>
#include <cstdint>
#include <cstring>
#define REPEAT_MASK 0
#define XB_TMO      128
#define XB_XCNT(j)  (256  + 64 * (j))
#define XB_XSUB(j)  (1280 + 64 * (j))
#define XB_XGEN(j)  (2304 + 64 * (j))
#define XB_TOP      3328
#define XB_TOPGEN   3392
#define XCD_BAR_WORDS 3456
#define XB_SPIN_CAP (1u << 24)
#define LAS __attribute__((address_space(3)))

__device__ __forceinline__ unsigned xb_ld(unsigned* p)              { return __hip_atomic_load(p, __ATOMIC_RELAXED, __HIP_MEMORY_SCOPE_AGENT); }
__device__ __forceinline__ unsigned xb_add(unsigned* p, unsigned v) { return __hip_atomic_fetch_add(p, v, __ATOMIC_RELAXED, __HIP_MEMORY_SCOPE_AGENT); }
__device__ __forceinline__ unsigned xb_xcc_id() { return (unsigned)__builtin_amdgcn_s_getreg((3 << 11) | 20) & 0xFu; }
#define XB_SPIN(cond, bar) do { unsigned _sp = 0; while (cond) { __builtin_amdgcn_s_sleep(1); \
    if ((++_sp & 255u) == 0u) { if (xb_ld(&(bar)[XB_TMO])) break; if (_sp > XB_SPIN_CAP) { atomicAdd(&(bar)[XB_TMO], 1u); break; } } } } while (0)

struct XcdBarrier {
    unsigned* bar; unsigned x;
    volatile LAS unsigned* st;
};

__device__ __forceinline__ XcdBarrier xcd_barrier_post(unsigned* bar, volatile LAS unsigned* st) {
    XcdBarrier b; b.bar = bar; b.x = xb_xcc_id(); b.st = st;
    if (threadIdx.x == 0) (void)xb_add(&bar[XB_XCNT(b.x)], 1u);
    return b;
}
__device__ __forceinline__ void xcd_barrier_complete(unsigned* bar, unsigned x, unsigned& nloc, unsigned& nx) {
    const unsigned G = gridDim.x * gridDim.y * gridDim.z;
    unsigned sum, cnt, mine, sp = 0u;
    for (;;) {
        sum = 0u; cnt = 0u; mine = 0u;
#pragma unroll
        for (unsigned j = 0; j < 16; ++j) { const unsigned c = xb_ld(&bar[XB_XCNT(j)]); sum += c; cnt += (c > 0u) ? 1u : 0u; mine = (j == x) ? c : mine; }
        if (sum == G) break;
        __builtin_amdgcn_s_sleep(1);
        if ((++sp & 255u) == 0u) { if (xb_ld(&bar[XB_TMO])) break; if (sp > XB_SPIN_CAP) { atomicAdd(&bar[XB_TMO], 1u); break; } }
    }
    nloc = mine > 0u ? mine : 1u; nx = cnt > 0u ? cnt : 1u;
}

__device__ __forceinline__ void xcd_barrier(const XcdBarrier& b) {
    asm volatile("s_waitcnt vmcnt(0)" ::: "memory");
    __syncthreads();
    if (threadIdx.x == 0) {
        unsigned* bar = b.bar;
        __builtin_amdgcn_s_waitcnt(0);
        unsigned nloc = b.st[0], nx = b.st[1];
        if (nloc == 0u) { xcd_barrier_complete(bar, b.x, nloc, nx); b.st[0] = nloc; b.st[1] = nx; }
        const unsigned old = xb_add(&bar[XB_XSUB(b.x)], 1u);
        const unsigned gen = old / nloc;
        if (old + 1u == (gen + 1u) * nloc) {
            __builtin_amdgcn_fence(__ATOMIC_RELEASE, "agent");
            asm volatile("s_waitcnt vmcnt(0)" ::: "memory");
            const unsigned og = xb_add(&bar[XB_TOP], 1u);
            const unsigned tg = og / nx;
            if (og + 1u == (tg + 1u) * nx) xb_add(&bar[XB_TOPGEN], 1u);
            else XB_SPIN(xb_ld(&bar[XB_TOPGEN]) == tg, bar);
            __builtin_amdgcn_fence(__ATOMIC_ACQUIRE, "agent");
            xb_add(&bar[XB_XGEN(b.x)], 1u);
            asm volatile("s_waitcnt vmcnt(0)" ::: "memory");
        } else {
            XB_SPIN(xb_ld(&bar[XB_XGEN(b.x)]) == gen, bar);
            __builtin_amdgcn_fence(__ATOMIC_ACQUIRE, "agent");
            asm volatile("s_waitcnt vmcnt(0)" ::: "memory");
        }
    }
    __syncthreads();
}
namespace pg8 {
#define PG8_LAS __attribute__((address_space(3)))
typedef unsigned short bf16_t;
typedef short bf16x8 __attribute__((ext_vector_type(8)));
typedef float f32x4 __attribute__((ext_vector_type(4)));
typedef unsigned u32x4 __attribute__((ext_vector_type(4)));
constexpr int BM = 256, BK = 64, HALF = 128, HTB = HALF * BK * 2  , STAGE_BYTES = 8 * HTB, NXCD = 8, WGM = 8;

__host__ __device__ __forceinline__ int lds_byte(int r, int c) { const int st = (r >> 4) * 2 + (c >> 5), rr = r & 15, cc = c & 31, ob = rr * 64 + cc * 2; return st * 1024 + (ob ^ (((ob >> 9) & 1) << 5)); }
__host__ __device__ __forceinline__ void stage_rc(int b, int& R, int& C) { const int st = b / 1024, sb = b % 1024, swz = sb ^ (((sb >> 9) & 1) << 5); R = (st >> 1) * 16 + swz / 64; C = (st & 1) * 32 + (swz % 64) / 2; }
__host__ __device__ __forceinline__ int perm32(int rho) { const int n = rho >> 4, i = rho & 15; return 8 * (i >> 2) + 4 * n + (i & 3); }

struct Unit { int pm, pn; };
struct Gemm { const bf16_t* A; const bf16_t* Bt; int M, N, K; };

struct StaticOrder {
    int nM, nN, nwg, G, c;
    __host__ __device__ void init(int M, int N, int G_, int c_) { nM = M / BM; nN = N / BM; nwg = nM * nN; G = G_; c = c_; }
    __host__ __device__ bool next(int i, Unit& u) const {
        const long L = (long)i * G + c; if (L >= nwg) return false;
        int wgid = (int)L; { const int q = nwg / NXCD, r = nwg % NXCD, xcd = wgid % NXCD, off = wgid / NXCD; wgid = (xcd < r ? xcd * (q + 1) : r * (q + 1) + (xcd - r) * q) + off; }
        const int nig = WGM * nN, gid = wgid / nig, fm = gid * WGM, gsz = (nM - fm) < WGM ? (nM - fm) : WGM;
        u.pm = fm + ((wgid % nig) % gsz); u.pn = (wgid % nig) / gsz; return true;
    }
    __device__ __forceinline__ void a_ready(const Unit&) const {}
    __device__ __forceinline__ void done(const Unit&) const {}
};
struct CountedOrder : StaticOrder {
    const unsigned* ready; unsigned need; unsigned* tmo;
    __device__ __forceinline__ void a_ready(const Unit& u) const {
        if (threadIdx.x < 64) {
            const unsigned long long t0 = __builtin_amdgcn_s_memrealtime(); unsigned polls = 0;
            while ((unsigned)__builtin_amdgcn_readfirstlane(__hip_atomic_load(ready + 64 * u.pm, __ATOMIC_RELAXED, __HIP_MEMORY_SCOPE_AGENT)) < need) {
                if ((++polls & 255u) == 0u && __builtin_amdgcn_readfirstlane(__hip_atomic_load(tmo, __ATOMIC_RELAXED, __HIP_MEMORY_SCOPE_AGENT)) != 0u) break;
                if (__builtin_amdgcn_s_memrealtime() - t0 > 2000000ull) {
                    if (threadIdx.x == 0) { unsigned expect = 0u; __hip_atomic_compare_exchange_strong(tmo + 1, &expect, 0x600u | (unsigned)(u.pm & 0xff), __ATOMIC_RELAXED, __ATOMIC_RELAXED, __HIP_MEMORY_SCOPE_AGENT); __hip_atomic_store(tmo, 1u, __ATOMIC_RELAXED, __HIP_MEMORY_SCOPE_AGENT); }
                    break; }
                __builtin_amdgcn_s_sleep(2); }
            __builtin_amdgcn_fence(__ATOMIC_ACQUIRE, "agent");
            asm volatile("s_waitcnt vmcnt(0)" ::: "memory");
        }
#if !defined(BROKEN_HOOK_NO_BARRIER)
        asm volatile("" ::: "memory"); __builtin_amdgcn_s_barrier(); asm volatile("" ::: "memory");
#endif
    }
};

__device__ __forceinline__ unsigned cvt_pk_bf16(float lo, float hi) { unsigned r; asm volatile("v_cvt_pk_bf16_f32 %0, %1, %2" : "=v"(r) : "v"(lo), "v"(hi)); return r; }
typedef float f32x2 __attribute__((ext_vector_type(2)));
__device__ __forceinline__ f32x2 gelu_pk(f32x2 v) {
    const f32x2 av = __builtin_elementwise_abs(v), d = av * 0.2316418882f + 1.0f;
    f32x2 t; t.x = __builtin_amdgcn_rcpf(d.x); t.y = __builtin_amdgcn_rcpf(d.y);
    f32x2 q = t * 0.5307027145f + (-0.7265760135f); q = q * t + 0.7107068705f; q = q * t + (-0.142248368f); q = q * t + 0.127414796f; q = q * t;
    const f32x2 s = (v * v) * (-0.72134752044f);
    f32x2 e; e.x = __builtin_amdgcn_exp2f(s.x); e.y = __builtin_amdgcn_exp2f(s.y);
    const f32x2 m = v * (q * e), r = v - m;
    f32x2 o; o.x = v.x < 0.f ? m.x : r.x; o.y = v.y < 0.f ? m.y : r.y; return o;
}

struct EpiF32 {
    static constexpr bool PERM = false, AFTER_DRAIN = false;
    float* C; int ldc; const float* bias;
    __device__ __forceinline__ void operator()(const f32x4 (&acc)[2][2][4][2], const Unit& u, int wr, int wc, int fr, int fq) const {
        const int row0 = u.pm * BM + wr * 64 + fr, col0 = u.pn * BM + wc * 32 + 4 * fq;
        f32x4 bv[2][2];
#pragma unroll
        for (int bj = 0; bj < 2; ++bj)
#pragma unroll
            for (int n = 0; n < 2; ++n) bv[bj][n] = bias ? *(const f32x4*)(bias + col0 + bj * HALF + n * 16) : (f32x4){0.f, 0.f, 0.f, 0.f};
#pragma unroll
        for (int ai = 0; ai < 2; ++ai)
#pragma unroll
            for (int m = 0; m < 4; ++m) { float* rowp = C + (size_t)(row0 + ai * HALF + m * 16) * ldc + col0;
#pragma unroll
                for (int bj = 0; bj < 2; ++bj)
#pragma unroll
                    for (int n = 0; n < 2; ++n) *(f32x4*)(rowp + bj * HALF + n * 16) = acc[ai][bj][m][n] + bv[bj][n]; }
    }
};
template <int ACT  > struct EpiBf16 {
    static constexpr bool PERM = true, AFTER_DRAIN = false;
    bf16_t* O; int ldc; const float* bias; int split_cols; size_t split_stride;
    __device__ __forceinline__ void operator()(const f32x4 (&acc)[2][2][4][2], const Unit& u, int wr, int wc, int fr, int fq) const {
        const int row0 = u.pm * BM + wr * 64 + fr; int colt = u.pn * BM; bf16_t* base = O;
        if (split_cols) { const int t = colt / split_cols; base += (size_t)t * split_stride; colt -= t * split_cols; }
        const int col0 = colt + wc * 32 + 8 * fq, bcol0 = u.pn * BM + wc * 32 + 8 * fq;
        f32x4 bv[2][2];
#pragma unroll
        for (int bj = 0; bj < 2; ++bj)
#pragma unroll
            for (int n = 0; n < 2; ++n) bv[bj][n] = bias ? *(const f32x4*)(bias + bcol0 + bj * HALF + 4 * n) : (f32x4){0.f, 0.f, 0.f, 0.f};
#pragma unroll
        for (int ai = 0; ai < 2; ++ai)
#pragma unroll
            for (int m = 0; m < 4; ++m) { bf16_t* rowp = base + (size_t)(row0 + ai * HALF + m * 16) * ldc + col0;
#pragma unroll
                for (int bj = 0; bj < 2; ++bj) { f32x4 v0 = acc[ai][bj][m][0] + bv[bj][0], v1 = acc[ai][bj][m][1] + bv[bj][1];
                    if (ACT == 1) { f32x2 a = gelu_pk((f32x2){v0[0], v0[1]}), b = gelu_pk((f32x2){v0[2], v0[3]}), c = gelu_pk((f32x2){v1[0], v1[1]}), d = gelu_pk((f32x2){v1[2], v1[3]});
                        v0 = (f32x4){a.x, a.y, b.x, b.y}; v1 = (f32x4){c.x, c.y, d.x, d.y}; }
                    if (ACT == 2) {
#pragma unroll
                        for (int j = 0; j < 4; ++j) { v0[j] = 0.5f * v0[j] * (1.0f + erff(v0[j] * 0.70710678f)); v1[j] = 0.5f * v1[j] * (1.0f + erff(v1[j] * 0.70710678f)); } }
                    u32x4 w; w.x = cvt_pk_bf16(v0[0], v0[1]); w.y = cvt_pk_bf16(v0[2], v0[3]); w.z = cvt_pk_bf16(v1[0], v1[1]); w.w = cvt_pk_bf16(v1[2], v1[3]);
                    *(u32x4*)(rowp + bj * HALF) = w; } }
    }
};

struct PanelStats {
    unsigned* xbuf;
    unsigned* cnt;
    unsigned* tmo;
    int ntn; float eps;
    unsigned code;
    __device__ __forceinline__ bool run(const f32x4 (&v)[2][2][4][2], const Unit& u, int wr, int wc, int fr, int fq, PG8_LAS unsigned char* lds, int wid, int lane) const {
        typedef float f32x2v __attribute__((ext_vector_type(2)));
        PG8_LAS f32x2v* P = (PG8_LAS f32x2v*)lds;
        PG8_LAS f32x2v* S = (PG8_LAS f32x2v*)(lds + 8192);
        PG8_LAS unsigned* flag = (PG8_LAS unsigned*)(lds + 8192 + 2048);
#pragma unroll
        for (int ai = 0; ai < 2; ++ai)
#pragma unroll
            for (int m = 0; m < 4; ++m) {
                float s = 0.f;
#pragma unroll
                for (int bj = 0; bj < 2; ++bj)
#pragma unroll
                    for (int n = 0; n < 2; ++n) { const f32x4 x = v[ai][bj][m][n]; s += (x[0] + x[1]) + (x[2] + x[3]); }
                s += __shfl_xor(s, 16); s += __shfl_xor(s, 32);
                const float mw = s * (1.0f / 64.0f); float q = 0.f;
#pragma unroll
                for (int bj = 0; bj < 2; ++bj)
#pragma unroll
                    for (int n = 0; n < 2; ++n) { const f32x4 d = v[ai][bj][m][n] - mw; q += (d[0] * d[0] + d[1] * d[1]) + (d[2] * d[2] + d[3] * d[3]); }
                q += __shfl_xor(q, 16); q += __shfl_xor(q, 32);
                if (fq == 0) P[(ai * HALF + wr * 64 + m * 16 + fr) * 4 + wc] = (f32x2v){mw, q};
            }
        asm volatile("s_waitcnt lgkmcnt(0)" ::: "memory"); __builtin_amdgcn_s_barrier(); asm volatile("" ::: "memory");
#if defined(BROKEN_NO_WAIT)
        if (blockIdx.x >= 64) { const long long t0 = clock64(); while (clock64() - t0 < 60000) __builtin_amdgcn_s_sleep(8); }
#endif
        const int row = wid * 32 + (lane & 31);
        if (lane < 32) {
            const f32x2v a = P[row * 4 + 0], b = P[row * 4 + 1], c = P[row * 4 + 2], d = P[row * 4 + 3];
            const float mt = (a.x + b.x + c.x + d.x) * 0.25f;
            const float da = a.x - mt, db = b.x - mt, dc = c.x - mt, dd = d.x - mt;
            const float m2 = (a.y + b.y) + (c.y + d.y) + 64.0f * ((da * da + db * db) + (dc * dc + dd * dd));
            unsigned long long* slot = (unsigned long long*)xbuf + ((size_t)(u.pm * BM + row) * 4 + u.pn);
            __hip_atomic_store(slot, ((unsigned long long)__float_as_uint(m2) << 32) | __float_as_uint(mt), __ATOMIC_RELAXED, __HIP_MEMORY_SCOPE_AGENT);
        }
        asm volatile("s_waitcnt vmcnt(0)" ::: "memory");
        if (lane == 0) __hip_atomic_fetch_add(cnt + 64 * u.pm, 1u, __ATOMIC_RELAXED, __HIP_MEMORY_SCOPE_AGENT);
        if (wid == 0) {
            bool dead = false; const unsigned long long t0 = __builtin_amdgcn_s_memrealtime(); const unsigned want = 8u * (unsigned)ntn;
            for (;;) {
#if defined(BROKEN_NO_WAIT)
                break;
#endif
                if ((unsigned)__builtin_amdgcn_readfirstlane(__hip_atomic_load(cnt + 64 * u.pm, __ATOMIC_RELAXED, __HIP_MEMORY_SCOPE_AGENT)) >= want) break;
                if (__builtin_amdgcn_s_memrealtime() - t0 > 2000000ull) {
                    if (lane == 0) { unsigned expect = 0u; __hip_atomic_compare_exchange_strong(tmo + 1, &expect, code | (unsigned)(u.pm & 0xff), __ATOMIC_RELAXED, __ATOMIC_RELAXED, __HIP_MEMORY_SCOPE_AGENT);
                                     __hip_atomic_store(tmo, 1u, __ATOMIC_RELAXED, __HIP_MEMORY_SCOPE_AGENT); }
                    dead = true; break; }
                __builtin_amdgcn_s_sleep(2);
            }
            __builtin_amdgcn_fence(__ATOMIC_ACQUIRE, "agent");
            if (lane == 0) flag[0] = dead ? 1u : 0u;
        }
        asm volatile("s_waitcnt vmcnt(0) lgkmcnt(0)" ::: "memory"); __builtin_amdgcn_s_barrier(); asm volatile("" ::: "memory");
        const bool bad = flag[0] != 0u;
        if (lane < 32) {
            const unsigned long long* slot = (const unsigned long long*)xbuf + (size_t)(u.pm * BM + row) * 4; float mt[4], m2[4]; float ms = 0.f;
#pragma unroll
            for (int t = 0; t < 4; ++t) { if (t < ntn) { const unsigned long long w = __hip_atomic_load(slot + t, __ATOMIC_RELAXED, __HIP_MEMORY_SCOPE_AGENT); mt[t] = __uint_as_float((unsigned)w); m2[t] = __uint_as_float((unsigned)(w >> 32)); } else { mt[t] = 0.f; m2[t] = 0.f; } ms += mt[t]; }
            const float mean = ms / (float)ntn; float q = 0.f;
#pragma unroll
            for (int t = 0; t < 4; ++t) if (t < ntn) { const float dm = mt[t] - mean; q += m2[t] + 256.0f * dm * dm; }
            S[row] = (f32x2v){mean, 1.0f / sqrtf(q / (256.0f * (float)ntn) + eps)};
        }
        asm volatile("s_waitcnt lgkmcnt(0)" ::: "memory"); __builtin_amdgcn_s_barrier(); asm volatile("" ::: "memory");
        return bad;
    }
};
struct EpiLnRes {
    static constexpr bool PERM = false, AFTER_DRAIN = true;
    const float* base; float* out; int ldc; const float* bias; PanelStats st; unsigned poison;
    __device__ __forceinline__ void refuse(size_t i0, size_t stride, int M, int N) const { const float q = __builtin_nanf(""); for (size_t i = i0; i < (size_t)M * N; i += stride) out[(i / N) * ldc + i % N] = q;
        if (i0 == 0) { unsigned expect = 0u; __hip_atomic_compare_exchange_strong(st.tmo + 1, &expect, 0x7f0u, __ATOMIC_RELAXED, __ATOMIC_RELAXED, __HIP_MEMORY_SCOPE_AGENT); __hip_atomic_store(st.tmo, 1u, __ATOMIC_RELAXED, __HIP_MEMORY_SCOPE_AGENT); } }
    __device__ __forceinline__ void fused(f32x4 (&acc)[2][2][4][2], const Unit& u, int wr, int wc, int fr, int fq, PG8_LAS unsigned char* lds, int wid, int lane) const {
        typedef float f32x2v __attribute__((ext_vector_type(2)));
        const PG8_LAS f32x2v* S = (const PG8_LAS f32x2v*)(lds + 8192);
        const int col0 = u.pn * BM + wc * 32 + 4 * fq;
#pragma unroll
        for (int bj = 0; bj < 2; ++bj)
#pragma unroll
            for (int n = 0; n < 2; ++n) { const f32x4 bv = bias ? *(const f32x4*)(bias + col0 + bj * HALF + n * 16) : (f32x4){0.f, 0.f, 0.f, 0.f};
#pragma unroll
                for (int ai = 0; ai < 2; ++ai)
#pragma unroll
                    for (int m = 0; m < 4; ++m) acc[ai][bj][m][n] += bv; }
        const bool bad = st.run(acc, u, wr, wc, fr, fq, lds, wid, lane) || poison != 0u;
        const float qnan = __builtin_nanf("");
#pragma unroll
        for (int ai = 0; ai < 2; ++ai)
#pragma unroll
            for (int m = 0; m < 4; ++m) { const int r = ai * HALF + wr * 64 + m * 16 + fr; const f32x2v sr = S[r]; const size_t off = (size_t)(u.pm * BM + r) * ldc + col0;
#pragma unroll
                for (int bj = 0; bj < 2; ++bj)
#pragma unroll
                    for (int n = 0; n < 2; ++n) { const f32x4 bs = *(const f32x4*)(base + off + bj * HALF + n * 16); f32x4 o = bs + (acc[ai][bj][m][n] - sr.x) * sr.y;
                        if (bad) o = (f32x4){qnan, qnan, qnan, qnan}; *(f32x4*)(out + off + bj * HALF + n * 16) = o; }
                asm volatile("" ::: "memory"); }
    }
};
struct EpiLnResLn {
    static constexpr bool PERM = false, AFTER_DRAIN = true;
    const float* base; float* out; bf16_t* xn; int ldc; const float* bias; PanelStats st1, st2; unsigned poison;
    __device__ __forceinline__ void refuse(size_t i0, size_t stride, int M, int N) const { const float q = __builtin_nanf(""); for (size_t i = i0; i < (size_t)M * N; i += stride) { const size_t o = (i / N) * ldc + i % N; out[o] = q; xn[o] = (bf16_t)0x7fc0u; }
        if (i0 == 0) { unsigned expect = 0u; __hip_atomic_compare_exchange_strong(st1.tmo + 1, &expect, 0x7f0u, __ATOMIC_RELAXED, __ATOMIC_RELAXED, __HIP_MEMORY_SCOPE_AGENT); __hip_atomic_store(st1.tmo, 1u, __ATOMIC_RELAXED, __HIP_MEMORY_SCOPE_AGENT); } }
    __device__ __forceinline__ void fused(f32x4 (&acc)[2][2][4][2], const Unit& u, int wr, int wc, int fr, int fq, PG8_LAS unsigned char* lds, int wid, int lane) const {
        typedef float f32x2v __attribute__((ext_vector_type(2))); typedef unsigned u32x2v __attribute__((ext_vector_type(2)));
        const PG8_LAS f32x2v* S = (const PG8_LAS f32x2v*)(lds + 8192);
        const int col0 = u.pn * BM + wc * 32 + 4 * fq;
#pragma unroll
        for (int bj = 0; bj < 2; ++bj)
#pragma unroll
            for (int n = 0; n < 2; ++n) { const f32x4 bv = bias ? *(const f32x4*)(bias + col0 + bj * HALF + n * 16) : (f32x4){0.f, 0.f, 0.f, 0.f};
#pragma unroll
                for (int ai = 0; ai < 2; ++ai)
#pragma unroll
                    for (int m = 0; m < 4; ++m) acc[ai][bj][m][n] += bv; }
        bool bad = st1.run(acc, u, wr, wc, fr, fq, lds, wid, lane) || poison != 0u;
        const float qnan = __builtin_nanf("");
#pragma unroll
        for (int ai = 0; ai < 2; ++ai)
#pragma unroll
            for (int m = 0; m < 4; ++m) { const int r = ai * HALF + wr * 64 + m * 16 + fr; const f32x2v sr = S[r]; const size_t off = (size_t)(u.pm * BM + r) * ldc + col0;
#pragma unroll
                for (int bj = 0; bj < 2; ++bj)
#pragma unroll
                    for (int n = 0; n < 2; ++n) { const f32x4 bs = *(const f32x4*)(base + off + bj * HALF + n * 16); acc[ai][bj][m][n] = bs + (acc[ai][bj][m][n] - sr.x) * sr.y; }
                asm volatile("" : "+v"(acc[ai][0][m][0]), "+v"(acc[ai][0][m][1]), "+v"(acc[ai][1][m][0]), "+v"(acc[ai][1][m][1]));
                if (m & 1) asm volatile("" ::: "memory"); }
        const bool bad1 = bad;
        bad = st2.run(acc, u, wr, wc, fr, fq, lds, wid, lane) || bad;
#pragma unroll
        for (int ai = 0; ai < 2; ++ai)
#pragma unroll
            for (int m = 0; m < 4; ++m) { const int r = ai * HALF + wr * 64 + m * 16 + fr; const f32x2v sr = S[r]; const size_t off = (size_t)(u.pm * BM + r) * ldc + col0;
#pragma unroll
                for (int bj = 0; bj < 2; ++bj)
#pragma unroll
                    for (int n = 0; n < 2; ++n) { const f32x4 x1 = acc[ai][bj][m][n]; *(f32x4*)(out + off + bj * HALF + n * 16) = bad1 ? (f32x4){qnan, qnan, qnan, qnan} : x1;
                        const f32x4 o = (x1 - sr.x) * sr.y; u32x2v w; w.x = cvt_pk_bf16(o[0], o[1]); w.y = cvt_pk_bf16(o[2], o[3]);
                        if (bad) { w.x = 0x7fc07fc0u; w.y = 0x7fc07fc0u; } *(u32x2v*)(xn + off + bj * HALF + n * 16) = w; }
                asm volatile("" ::: "memory"); }
    }
};

template <class Epi, class Sched, bool STAMP = false>
__device__ __forceinline__ void gemm_phase(PG8_LAS unsigned char* lds, const Gemm g, const Sched& S, const Epi& E, unsigned long long* stamps) {
    int tid_l_ = (int)threadIdx.x; asm volatile("" : "+v"(tid_l_)); const int tid = tid_l_, wid = __builtin_amdgcn_readfirstlane(tid >> 6), lane = tid & 63, wr = wid >> 2, wc = wid & 3, fr = lane & 15, fq = lane >> 4;
    const int K = g.K, nt = K / BK;
    int ts_lo = 0, ts_hi = 0, nts = 0; const unsigned long long rt_entry = STAMP ? (unsigned long long)wall_clock64() : 0ull;
#define PG8_STAMP() do { if (STAMP && wid == 0 && nts < 64) { const unsigned long long _c = (unsigned long long)clock64(); \
        ts_lo = (lane == nts) ? (int)(unsigned)_c : ts_lo; ts_hi = (lane == nts) ? (int)(unsigned)(_c >> 32) : ts_hi; ++nts; } } while (0)
    PG8_STAMP();
    unsigned voffA[2], voffB[2];
#pragma unroll
    for (int i = 0; i < 2; ++i) { int R, C; stage_rc(tid * 16 + i * 8192, R, C); const int Rb = Epi::PERM ? ((R & ~31) + perm32(R & 31)) : R;
        voffA[i] = (unsigned)(R * K + C) * 2u; voffB[i] = (unsigned)(Rb * K + C) * 2u; }
    const size_t kstep = (size_t)(BK * 2);
    const size_t hstep = (size_t)HALF * K * 2;
    const size_t tstep = 2 * hstep;
    const unsigned ldsw = (unsigned)wid * 1024u;
    const int aoff = lds_byte(wr * 64 + fr, fq * 8), boff = lds_byte(wc * 32 + fr, fq * 8);
#define PG8_SA(b, h) (((b) * 2 + (h)) * HTB)
#define PG8_SB(b, h) ((4 + (b) * 2 + (h)) * HTB)
#define PG8_STAGE(bufoff, gbase, voff) do { _Pragma("unroll") for (int _i = 0; _i < 2; ++_i) \
        __builtin_amdgcn_global_load_lds((const unsigned*)((const char*)(gbase) + (voff)[_i]), (PG8_LAS unsigned*)(lds + (bufoff) + ldsw + _i * 8192), 16, 0, 0); } while (0)
#define PG8_LDA(dst, b, h) do { _Pragma("unroll") for (int m = 0; m < 4; ++m) _Pragma("unroll") for (int k = 0; k < 2; ++k) dst[m][k] = *(const PG8_LAS bf16x8*)(lds + PG8_SA(b, h) + aoff + m * 2048 + k * 1024); } while (0)
#define PG8_LDB(dst, b, h) do { _Pragma("unroll") for (int n = 0; n < 2; ++n) _Pragma("unroll") for (int k = 0; k < 2; ++k) dst[n][k] = *(const PG8_LAS bf16x8*)(lds + PG8_SB(b, h) + boff + n * 2048 + k * 1024); } while (0)
#define PG8_MMA(ai, bj, At, Bt) do { __builtin_amdgcn_s_setprio(1); _Pragma("unroll") for (int m = 0; m < 4; ++m) _Pragma("unroll") for (int n = 0; n < 2; ++n) _Pragma("unroll") for (int k = 0; k < 2; ++k) \
        acc[ai][bj][m][n] = __builtin_amdgcn_mfma_f32_16x16x32_bf16(Bt[n][k], At[m][k], acc[ai][bj][m][n], 0, 0, 0); __builtin_amdgcn_s_setprio(0); } while (0)
#define PG8_WAIT_V(n) asm volatile("s_waitcnt vmcnt(" #n ")" ::: "memory")
#define PG8_WAIT_L(n) asm volatile("s_waitcnt lgkmcnt(" #n ")" ::: "memory")
#define PG8_BAR __builtin_amdgcn_s_barrier()
#define PG8_SCHED __builtin_amdgcn_sched_barrier(0)
    Unit cur, nxt; int ui = 0;
    if (!S.next(0, cur)) return;
    f32x4 acc[2][2][4][2];
#pragma unroll
    for (int a = 0; a < 2; ++a)
#pragma unroll
        for (int b = 0; b < 2; ++b)
#pragma unroll
            for (int m = 0; m < 4; ++m)
#pragma unroll
                for (int n = 0; n < 2; ++n) acc[a][b][m][n] = (f32x4){0.f, 0.f, 0.f, 0.f};
    bf16x8 At[4][2], B0[2][2], B1[2][2];
    const char* cA = (const char*)g.A + (size_t)cur.pm * tstep; const char* cB = (const char*)g.Bt + (size_t)cur.pn * tstep;
    S.a_ready(cur);
    PG8_STAGE(PG8_SB(0, 0), cB, voffB); PG8_STAGE(PG8_SA(0, 0), cA, voffA); PG8_STAGE(PG8_SB(0, 1), cB + hstep, voffB); PG8_STAGE(PG8_SA(0, 1), cA + hstep, voffA);
    if (wr == 1) PG8_BAR;
    PG8_WAIT_V(4); PG8_BAR;
    PG8_STAGE(PG8_SB(1, 0), cB + kstep, voffB); PG8_STAGE(PG8_SA(1, 0), cA + kstep, voffA); PG8_STAGE(PG8_SB(1, 1), cB + hstep + kstep, voffB);
    PG8_WAIT_V(6); PG8_BAR;
    PG8_STAMP();
    for (;;) {
        const bool has_next = S.next(ui + 1, nxt);
        const char* nA = has_next ? (const char*)g.A + (size_t)nxt.pm * tstep : cA; const char* nB = has_next ? (const char*)g.Bt + (size_t)nxt.pn * tstep : cB;
        for (int t = 0; t < nt; t += 2) {
            const bool last = (t == nt - 2);
            const char* a1 = cA + (size_t)(t + 1) * kstep;
            const char* a2 = last ? nA : cA + (size_t)(t + 2) * kstep; const char* b2 = last ? nB : cB + (size_t)(t + 2) * kstep;
            const char* a3 = a2 + kstep; const char* b3 = b2 + kstep;
            if (last && has_next) S.a_ready(nxt);
            PG8_LDB(B0, 0, 0); PG8_SCHED; PG8_LDA(At, 0, 0); PG8_STAGE(PG8_SA(1, 1), a1 + hstep, voffA);
            PG8_WAIT_L(8); PG8_BAR; PG8_WAIT_L(0); PG8_MMA(0, 0, At, B0); PG8_BAR; PG8_SCHED;
            PG8_LDB(B1, 0, 1); PG8_STAGE(PG8_SB(0, 0), b2, voffB);
            PG8_BAR; PG8_WAIT_L(0); PG8_MMA(0, 1, At, B1); PG8_BAR;
            PG8_LDA(At, 0, 1); PG8_STAGE(PG8_SA(0, 0), a2, voffA);
            PG8_BAR; PG8_WAIT_L(0); PG8_MMA(1, 0, At, B0); PG8_BAR; PG8_SCHED;
            PG8_STAGE(PG8_SB(0, 1), b2 + hstep, voffB);
            PG8_WAIT_V(6); PG8_BAR; PG8_MMA(1, 1, At, B1); PG8_BAR;
            PG8_LDB(B0, 1, 0); PG8_SCHED; PG8_LDA(At, 1, 0); PG8_STAGE(PG8_SA(0, 1), a2 + hstep, voffA);
            PG8_WAIT_L(8); PG8_BAR; PG8_WAIT_L(0); PG8_MMA(0, 0, At, B0); PG8_BAR; PG8_SCHED;
            PG8_LDB(B1, 1, 1); PG8_STAGE(PG8_SB(1, 0), b3, voffB);
            PG8_BAR; PG8_WAIT_L(0); PG8_MMA(0, 1, At, B1); PG8_BAR;
            PG8_LDA(At, 1, 1); PG8_STAGE(PG8_SA(1, 0), a3, voffA);
            PG8_BAR; PG8_WAIT_L(0); PG8_MMA(1, 0, At, B0); PG8_BAR; PG8_SCHED;
            PG8_STAGE(PG8_SB(1, 1), b3 + hstep, voffB);
            PG8_WAIT_V(6); PG8_BAR; PG8_MMA(1, 1, At, B1); PG8_BAR;
        }
        PG8_STAMP();
        if constexpr (!Epi::AFTER_DRAIN) { E(acc, cur, wr, wc, fr, fq); S.done(cur); }
        PG8_STAMP();
        if (!has_next) break;
#pragma unroll
        for (int a = 0; a < 2; ++a)
#pragma unroll
            for (int b = 0; b < 2; ++b)
#pragma unroll
                for (int m = 0; m < 4; ++m)
#pragma unroll
                    for (int n = 0; n < 2; ++n) acc[a][b][m][n] = (f32x4){0.f, 0.f, 0.f, 0.f};
        cur = nxt; cA = nA; cB = nB; ++ui;
    }
    PG8_WAIT_V(0);
    if (wr == 0) PG8_BAR;
    PG8_BAR;
    if constexpr (Epi::AFTER_DRAIN) { E.fused(acc, cur, wr, wc, fr, fq, lds, wid, lane); S.done(cur); }
    PG8_STAMP();
    if (STAMP && wid == 0) { stamps[lane] = lane < nts ? (((unsigned long long)(unsigned)ts_hi << 32) | (unsigned)ts_lo) : 0ull;
        if (lane == 62) stamps[62] = rt_entry; if (lane == 63) stamps[63] = (unsigned long long)wall_clock64(); }
#undef PG8_STAMP
#undef PG8_SA
#undef PG8_SB
#undef PG8_STAGE
#undef PG8_LDA
#undef PG8_LDB
#undef PG8_MMA
#undef PG8_WAIT_V
#undef PG8_WAIT_L
#undef PG8_BAR
#undef PG8_SCHED
}
template <class Epi, class Sched, bool STAMP = false>
__device__ __forceinline__ void gemm_phase_g(PG8_LAS unsigned char* lds, const Gemm g, const Sched& S, const Epi& E, const PG8_LAS int* ridx) {
    unsigned long long* stamps = nullptr;
    int tid_l_ = (int)threadIdx.x; asm volatile("" : "+v"(tid_l_)); const int tid = tid_l_, wid = __builtin_amdgcn_readfirstlane(tid >> 6), lane = tid & 63, wr = wid >> 2, wc = wid & 3, fr = lane & 15, fq = lane >> 4;
    const int K = g.K, nt = K / BK;
    int ts_lo = 0, ts_hi = 0, nts = 0; const unsigned long long rt_entry = STAMP ? (unsigned long long)wall_clock64() : 0ull;
#define PG8_STAMP() do { if (STAMP && wid == 0 && nts < 64) { const unsigned long long _c = (unsigned long long)clock64(); \
        ts_lo = (lane == nts) ? (int)(unsigned)_c : ts_lo; ts_hi = (lane == nts) ? (int)(unsigned)(_c >> 32) : ts_hi; ++nts; } } while (0)
    PG8_STAMP();
    unsigned voffB[2]; int rA[2]; unsigned cA2[2];
#pragma unroll
    for (int i = 0; i < 2; ++i) { int R, C; stage_rc(tid * 16 + i * 8192, R, C); const int Rb = Epi::PERM ? ((R & ~31) + perm32(R & 31)) : R;
        rA[i] = R; cA2[i] = (unsigned)C * 2u; voffB[i] = (unsigned)(Rb * K + C) * 2u; }
    unsigned vc[2][2], vn[2][2];
#define PG8_GIDX(dst, ui_) do { _Pragma("unroll") for (int h_ = 0; h_ < 2; ++h_) _Pragma("unroll") for (int i_ = 0; i_ < 2; ++i_) dst[h_][i_] = (unsigned)ridx[(ui_) * 256 + h_ * 128 + rA[i_]] * (unsigned)(K * 2) + cA2[i_]; \
        asm volatile("s_waitcnt lgkmcnt(0)" ::: "memory"); } while (0)
    const size_t kstep = (size_t)(BK * 2);
    const size_t hstep = (size_t)HALF * K * 2;
    const size_t tstep = 2 * hstep;
    const unsigned ldsw = (unsigned)wid * 1024u;
    const int aoff = lds_byte(wr * 64 + fr, fq * 8), boff = lds_byte(wc * 32 + fr, fq * 8);
#define PG8_SA(b, h) (((b) * 2 + (h)) * HTB)
#define PG8_SB(b, h) ((4 + (b) * 2 + (h)) * HTB)
#define PG8_STAGE(bufoff, gbase, voff) do { _Pragma("unroll") for (int _i = 0; _i < 2; ++_i) \
        __builtin_amdgcn_global_load_lds((const unsigned*)((const char*)(gbase) + (voff)[_i]), (PG8_LAS unsigned*)(lds + (bufoff) + ldsw + _i * 8192), 16, 0, 0); } while (0)
#define PG8_LDA(dst, b, h) do { _Pragma("unroll") for (int m = 0; m < 4; ++m) _Pragma("unroll") for (int k = 0; k < 2; ++k) dst[m][k] = *(const PG8_LAS bf16x8*)(lds + PG8_SA(b, h) + aoff + m * 2048 + k * 1024); } while (0)
#define PG8_LDB(dst, b, h) do { _Pragma("unroll") for (int n = 0; n < 2; ++n) _Pragma("unroll") for (int k = 0; k < 2; ++k) dst[n][k] = *(const PG8_LAS bf16x8*)(lds + PG8_SB(b, h) + boff + n * 2048 + k * 1024); } while (0)
#define PG8_MMA(ai, bj, At, Bt) do { __builtin_amdgcn_s_setprio(1); _Pragma("unroll") for (int m = 0; m < 4; ++m) _Pragma("unroll") for (int n = 0; n < 2; ++n) _Pragma("unroll") for (int k = 0; k < 2; ++k) \
        acc[ai][bj][m][n] = __builtin_amdgcn_mfma_f32_16x16x32_bf16(Bt[n][k], At[m][k], acc[ai][bj][m][n], 0, 0, 0); __builtin_amdgcn_s_setprio(0); } while (0)
#define PG8_WAIT_V(n) asm volatile("s_waitcnt vmcnt(" #n ")" ::: "memory")
#define PG8_WAIT_L(n) asm volatile("s_waitcnt lgkmcnt(" #n ")" ::: "memory")
#define PG8_BAR __builtin_amdgcn_s_barrier()
#define PG8_SCHED __builtin_amdgcn_sched_barrier(0)
    Unit cur, nxt; int ui = 0;
    if (!S.next(0, cur)) return;
    f32x4 acc[2][2][4][2];
#pragma unroll
    for (int a = 0; a < 2; ++a)
#pragma unroll
        for (int b = 0; b < 2; ++b)
#pragma unroll
            for (int m = 0; m < 4; ++m)
#pragma unroll
                for (int n = 0; n < 2; ++n) acc[a][b][m][n] = (f32x4){0.f, 0.f, 0.f, 0.f};
    bf16x8 At[4][2], B0[2][2], B1[2][2];
    const char* cA = (const char*)g.A; const char* cB = (const char*)g.Bt + (size_t)cur.pn * tstep;
    PG8_GIDX(vc, 0);
    S.a_ready(cur);
    PG8_STAGE(PG8_SB(0, 0), cB, voffB); PG8_STAGE(PG8_SA(0, 0), cA, vc[0]); PG8_STAGE(PG8_SB(0, 1), cB + hstep, voffB); PG8_STAGE(PG8_SA(0, 1), cA, vc[1]);
    if (wr == 1) PG8_BAR;
    PG8_WAIT_V(4); PG8_BAR;
    PG8_STAGE(PG8_SB(1, 0), cB + kstep, voffB); PG8_STAGE(PG8_SA(1, 0), cA + kstep, vc[0]); PG8_STAGE(PG8_SB(1, 1), cB + hstep + kstep, voffB);
    PG8_WAIT_V(6); PG8_BAR;
    PG8_STAMP();
    for (;;) {
        const bool has_next = S.next(ui + 1, nxt);
        const char* nB = has_next ? (const char*)g.Bt + (size_t)nxt.pn * tstep : cB;
        if (has_next) PG8_GIDX(vn, ui + 1); else {
#pragma unroll
            for (int h_ = 0; h_ < 2; ++h_)
#pragma unroll
                for (int i_ = 0; i_ < 2; ++i_) vn[h_][i_] = vc[h_][i_]; }
        for (int t = 0; t < nt; t += 2) {
            const bool last = (t == nt - 2);
            const char* a1 = cA + (size_t)(t + 1) * kstep;
            const char* a2 = last ? cA : cA + (size_t)(t + 2) * kstep; const char* b2 = last ? nB : cB + (size_t)(t + 2) * kstep;
            const char* a3 = a2 + kstep; const char* b3 = b2 + kstep;
            unsigned v2[2][2];
#pragma unroll
            for (int h_ = 0; h_ < 2; ++h_)
#pragma unroll
                for (int i_ = 0; i_ < 2; ++i_) v2[h_][i_] = last ? vn[h_][i_] : vc[h_][i_];
            if (last && has_next) S.a_ready(nxt);
            PG8_LDB(B0, 0, 0); PG8_SCHED; PG8_LDA(At, 0, 0); PG8_STAGE(PG8_SA(1, 1), a1, vc[1]);
            PG8_WAIT_L(8); PG8_BAR; PG8_WAIT_L(0); PG8_MMA(0, 0, At, B0); PG8_BAR; PG8_SCHED;
            PG8_LDB(B1, 0, 1); PG8_STAGE(PG8_SB(0, 0), b2, voffB);
            PG8_BAR; PG8_WAIT_L(0); PG8_MMA(0, 1, At, B1); PG8_BAR;
            PG8_LDA(At, 0, 1); PG8_STAGE(PG8_SA(0, 0), a2, v2[0]);
            PG8_BAR; PG8_WAIT_L(0); PG8_MMA(1, 0, At, B0); PG8_BAR; PG8_SCHED;
            PG8_STAGE(PG8_SB(0, 1), b2 + hstep, voffB);
            PG8_WAIT_V(6); PG8_BAR; PG8_MMA(1, 1, At, B1); PG8_BAR;
            PG8_LDB(B0, 1, 0); PG8_SCHED; PG8_LDA(At, 1, 0); PG8_STAGE(PG8_SA(0, 1), a2, v2[1]);
            PG8_WAIT_L(8); PG8_BAR; PG8_WAIT_L(0); PG8_MMA(0, 0, At, B0); PG8_BAR; PG8_SCHED;
            PG8_LDB(B1, 1, 1); PG8_STAGE(PG8_SB(1, 0), b3, voffB);
            PG8_BAR; PG8_WAIT_L(0); PG8_MMA(0, 1, At, B1); PG8_BAR;
            PG8_LDA(At, 1, 1); PG8_STAGE(PG8_SA(1, 0), a3, v2[0]);
            PG8_BAR; PG8_WAIT_L(0); PG8_MMA(1, 0, At, B0); PG8_BAR; PG8_SCHED;
            PG8_STAGE(PG8_SB(1, 1), b3 + hstep, voffB);
            PG8_WAIT_V(6); PG8_BAR; PG8_MMA(1, 1, At, B1); PG8_BAR;
        }
        PG8_STAMP();
        if constexpr (!Epi::AFTER_DRAIN) { E(acc, cur, wr, wc, fr, fq); S.done(cur); }
        PG8_STAMP();
        if (!has_next) break;
#pragma unroll
        for (int a = 0; a < 2; ++a)
#pragma unroll
            for (int b = 0; b < 2; ++b)
#pragma unroll
                for (int m = 0; m < 4; ++m)
#pragma unroll
                    for (int n = 0; n < 2; ++n) acc[a][b][m][n] = (f32x4){0.f, 0.f, 0.f, 0.f};
        cur = nxt; cB = nB; ++ui;
#pragma unroll
        for (int h_ = 0; h_ < 2; ++h_)
#pragma unroll
            for (int i_ = 0; i_ < 2; ++i_) vc[h_][i_] = vn[h_][i_];
    }
    PG8_WAIT_V(0);
    if (wr == 0) PG8_BAR;
    PG8_BAR;
    if constexpr (Epi::AFTER_DRAIN) { E.fused(acc, cur, wr, wc, fr, fq, lds, wid, lane); S.done(cur); }
    PG8_STAMP();
    if (STAMP && wid == 0) { stamps[lane] = lane < nts ? (((unsigned long long)(unsigned)ts_hi << 32) | (unsigned)ts_lo) : 0ull;
        if (lane == 62) stamps[62] = rt_entry; if (lane == 63) stamps[63] = (unsigned long long)wall_clock64(); }
#undef PG8_STAMP
#undef PG8_GIDX
#undef PG8_SA
#undef PG8_SB
#undef PG8_STAGE
#undef PG8_LDA
#undef PG8_LDB
#undef PG8_MMA
#undef PG8_WAIT_V
#undef PG8_WAIT_L
#undef PG8_BAR
#undef PG8_SCHED
}
}

using pg8::bf16_t; using pg8::bf16x8; using pg8::f32x4;
typedef float f32x16 __attribute__((ext_vector_type(16)));
typedef float f32x2v __attribute__((ext_vector_type(2)));
typedef __bf16 bf16x2v __attribute__((ext_vector_type(2)));
typedef short s16x4 __attribute__((ext_vector_type(4)));
typedef unsigned u32x4 __attribute__((ext_vector_type(4)));
typedef unsigned u32x2 __attribute__((ext_vector_type(2)));
typedef PG8_LAS unsigned char* LDSP;
typedef PG8_LAS float* LASF;

constexpr int NTH = 512;
constexpr int LDS_BYTES = 156 * 1024;
constexpr int DM = 1024, LL = 8192, LC = 256, SEQB = 8448, TT = 16896, NPAN = 66, TPAD = 41984;
constexpr size_t UU = (size_t)TT * 1024 * 2;
constexpr float EPS_ = 1e-6f;
constexpr float INV2PI = 0.15915494309189535f;

template <class T> __device__ __forceinline__ T* UP(T* q) { const unsigned long long v = (unsigned long long)q;
    const unsigned lo = (unsigned)__builtin_amdgcn_readfirstlane((int)(unsigned)v), hi = (unsigned)__builtin_amdgcn_readfirstlane((int)(unsigned)(v >> 32));
    return (T*)(__attribute__((address_space(1))) T*)(((unsigned long long)hi << 32) | lo); }
__device__ __forceinline__ int ltid() { int t = (int)threadIdx.x; asm volatile("" : "+v"(t)); return t; }
__device__ __forceinline__ f32x2v mk2_(float x, float y) { f32x2v r; r.x = x; r.y = y; return r; }
__device__ __forceinline__ float bf2f(bf16_t v) { return __uint_as_float(((unsigned)v) << 16); }
__device__ __forceinline__ unsigned pk2(float lo, float hi) { f32x2v v = {lo, hi}; bf16x2v b = __builtin_convertvector(v, bf16x2v); return __builtin_bit_cast(unsigned, b); }
__device__ __forceinline__ bf16_t f2bf(float f) { return (bf16_t)(pk2(f, 0.f) & 0xffffu); }
__device__ __forceinline__ float lo16(unsigned w) { return __uint_as_float(w << 16); }
__device__ __forceinline__ float hi16(unsigned w) { return __uint_as_float(w & 0xffff0000u); }
__device__ __forceinline__ float sigmoidf_(float x) { return __builtin_amdgcn_rcpf(1.0f + __expf(-x)); }
__device__ __forceinline__ float siluf_(float x) { return x * __builtin_amdgcn_rcpf(1.0f + __expf(-x)); }
__device__ __forceinline__ float logsigf_(float x) { return fminf(x, 0.f) - log1pf(__expf(-fabsf(x))); }
__device__ __forceinline__ float sin2pi(float rev) { return __builtin_amdgcn_sinf(rev); }
__device__ __forceinline__ float cos2pi(float rev) { return __builtin_amdgcn_cosf(rev); }
__device__ __forceinline__ int crow(int r, int hi) { return (r & 3) + 8 * (r >> 2) + 4 * hi; }
template <int CTRL> __device__ __forceinline__ float dpp_mov(float x) { return __int_as_float(__builtin_amdgcn_update_dpp(0, __float_as_int(x), CTRL, 0xf, 0xf, false)); }
__device__ __forceinline__ float row_sum(float x) { x += dpp_mov<0x128>(x); x += dpp_mov<0x124>(x); x += dpp_mov<0x122>(x); x += dpp_mov<0x121>(x); return x; }
__device__ __forceinline__ float row_max(float x) { x = fmaxf(x, dpp_mov<0x128>(x)); x = fmaxf(x, dpp_mov<0x124>(x)); x = fmaxf(x, dpp_mov<0x122>(x)); x = fmaxf(x, dpp_mov<0x121>(x)); return x; }
__device__ __forceinline__ void swap32_(float& a, float& b) { auto r = __builtin_amdgcn_permlane32_swap(__float_as_uint(a), __float_as_uint(b), false, false); a = __uint_as_float(r[0]); b = __uint_as_float(r[1]); }
__device__ __forceinline__ void swap16_(float& a, float& b) { auto r = __builtin_amdgcn_permlane16_swap(__float_as_uint(a), __float_as_uint(b), false, false); a = __uint_as_float(r[0]); b = __uint_as_float(r[1]); }
__device__ __forceinline__ float wave_sum(float v) { v = row_sum(v); float w = v; swap16_(v, w); v += w; w = v; swap32_(v, w); return v + w; }
__device__ __forceinline__ float wave_max(float v) { v = row_max(v); float w = v; swap16_(v, w); v = fmaxf(v, w); w = v; swap32_(v, w); return fmaxf(v, w); }
__device__ __forceinline__ void wave_sum32(float (&v)[32]) {
#pragma unroll
    for (int i = 0; i < 16; ++i) { swap32_(v[i], v[16 + i]); v[i] += v[16 + i]; }
#pragma unroll
    for (int i = 0; i < 8; ++i) { swap16_(v[i], v[8 + i]); v[i] += v[8 + i]; }
#pragma unroll
    for (int i = 0; i < 8; ++i) v[i] = row_sum(v[i]); }
__device__ __forceinline__ void wave_sum16(float (&v)[16]) {
#pragma unroll
    for (int i = 0; i < 8; ++i) { swap32_(v[i], v[8 + i]); v[i] += v[8 + i]; }
#pragma unroll
    for (int i = 0; i < 4; ++i) { swap16_(v[i], v[4 + i]); v[i] += v[4 + i]; }
#pragma unroll
    for (int i = 0; i < 4; ++i) v[i] = row_sum(v[i]); }
__device__ __forceinline__ float readlane_f(float x, int l) { return __int_as_float(__builtin_amdgcn_readlane(__float_as_int(x), l)); }
__device__ __forceinline__ void unpack8(const u32x4 w, float (&f)[8]) {
    f[0] = lo16(w.x); f[1] = hi16(w.x); f[2] = lo16(w.y); f[3] = hi16(w.y); f[4] = lo16(w.z); f[5] = hi16(w.z); f[6] = lo16(w.w); f[7] = hi16(w.w); }
constexpr float ST_SC = 4.0f, ST_ISC = 0.25f;
constexpr float GT_SC = 8.0f, GT_ISC = 0.125f;
__device__ __forceinline__ unsigned pk4_fp8(float a, float b, float c, float d) {
    a = fminf(fmaxf(a, -440.f), 440.f); b = fminf(fmaxf(b, -440.f), 440.f); c = fminf(fmaxf(c, -440.f), 440.f); d = fminf(fmaxf(d, -440.f), 440.f);
    unsigned w = 0u; w = (unsigned)__builtin_amdgcn_cvt_pk_fp8_f32(a, b, (int)w, false); w = (unsigned)__builtin_amdgcn_cvt_pk_fp8_f32(c, d, (int)w, true); return w; }
__device__ __forceinline__ void unpk8_fp8(const u32x2 w, float (&f)[8]) {
    const f32x2v a = __builtin_amdgcn_cvt_pk_f32_fp8((int)w.x, false), b = __builtin_amdgcn_cvt_pk_f32_fp8((int)w.x, true), c = __builtin_amdgcn_cvt_pk_f32_fp8((int)w.y, false), d = __builtin_amdgcn_cvt_pk_f32_fp8((int)w.y, true);
    f[0] = a.x; f[1] = a.y; f[2] = b.x; f[3] = b.y; f[4] = c.x; f[5] = c.y; f[6] = d.x; f[7] = d.y; }
__device__ __forceinline__ u32x4 pack8(const float (&f)[8]) { u32x4 w; w.x = pk2(f[0], f[1]); w.y = pk2(f[2], f[3]); w.z = pk2(f[4], f[5]); w.w = pk2(f[6], f[7]); return w; }

template <class T> struct GP { __attribute__((address_space(1))) T* p;
    __host__ __device__ __forceinline__ GP& operator=(T* q) { p = (__attribute__((address_space(1))) T*)q; return *this; }
    __device__ __forceinline__ operator T*() const { return (T*)p; } };
struct Params {
    GP<const float> x, c, ctx, c_ctx, mod_w, mod_b, norm1_g, norm2_g, w_in, merge_b, m_conv_w, m_conv_b, m_gate_b, m_norm_g;
    GP<const float> a_qnorm_g, a_knorm_g, a_lambda, a_subln_g, h_conv_w, h_conv_b, h_ffn_w1, h_ffn_b1, h_ffn_w2, h_ffn_b2, h_ffn_w3;
    GP<const float> h_freq, h_decay, h_bias, w_br_m, w_br_a, w_br_h, w_out, router_w, router_b, e_w1, e_w3, e_w2;
    GP<float> out;
    GP<unsigned> bar; GP<int> cnt; GP<int> cur; GP<float> sumsq; GP<float> sumsqC;
    GP<float> modv; GP<float> hdn2; GP<float> G; GP<float> xc; GP<int> sel_e; GP<float> sel_w; GP<int> posbuf; GP<int> rowidx;
    GP<float> scal; GP<float> ms; GP<float> dn; GP<float> nst; GP<float> hfC; GP<float> hbC;
    GP<bf16_t> Wt_in, Wt_br, Wt_out, hn, Y3;
    GP<unsigned char> R;
};

__device__ __forceinline__ const float* resid_row_in(const Params& p, int layer, int s) {
    const int b = s / SEQB, pos = s - b * SEQB;
    if (pos < LC) return (layer == 0 ? p.ctx : p.xc) + (size_t)(b * LC + pos) * DM;
    return (layer == 0 ? p.x : p.out) + (size_t)(b * LL + pos - LC) * DM; }
__device__ __forceinline__ float* resid_row(const Params& p, int s) {
    const int b = s / SEQB, pos = s - b * SEQB;
    if (pos < LC) return p.xc + (size_t)(b * LC + pos) * DM;
    return p.out + (size_t)(b * LL + pos - LC) * DM; }
__device__ __forceinline__ const float* modvec(const Params& p, int layer, int s) { const int b = s / SEQB, pos = s - b * SEQB; return p.modv + (size_t)(layer * 3 + (pos < LC ? 2 : b)) * 6144; }

struct MapWin { const float* w;
    __device__ __forceinline__ const float* operator()(int n0, int cb, int k) const { int col;
        if (n0 < 6144) col = 4112 + n0;
        else if (n0 < 6656) col = 12304 + (n0 - 6144);
        else if (n0 < 12800) { const int m = n0 - 6656, d = m >> 10; col = (d < 4 ? 1024 * d : (d == 4 ? 10256 : 11280)) + (m & 1023); }
        else col = 12304 + 512 + (n0 - 12800);
        return w + (size_t)k * 13328 + col + cb * 4; } };
struct MapPlain { const float* w; int ld;
    __device__ __forceinline__ const float* operator()(int n0, int cb, int k) const { return w + (size_t)k * ld + n0 + cb * 4; } };
struct MapE13 { const float* w1; long d31;
    __device__ __forceinline__ const float* operator()(int n0, int cb, int k) const { return w1 + ((cb & 1) ? d31 : 0l) + (size_t)k * 512 + (n0 >> 1) + 4 * (cb >> 1); } };
template <class MAP> __device__ __forceinline__ void xp_load(const MAP& map, int n0, int k0, float4 (&v)[4]) { const int tid = ltid();
#pragma unroll
    for (int pass = 0; pass < 4; ++pass) v[pass] = *(const float4*)map(n0, tid & 15, k0 + pass * 32 + (tid >> 4)); }
__device__ __forceinline__ void xp_lds_write(const float4 (&v)[4], LASF tl) { const int tid = ltid();
#pragma unroll
    for (int pass = 0; pass < 4; ++pass) { const int k = pass * 32 + (tid >> 4), cb = tid & 15;
        tl[k * 65 + cb * 4 + 0] = v[pass].x; tl[k * 65 + cb * 4 + 1] = v[pass].y; tl[k * 65 + cb * 4 + 2] = v[pass].z; tl[k * 65 + cb * 4 + 3] = v[pass].w; } }
__device__ __forceinline__ void xp_lds_store(const LASF tl, int n0, int k0, bf16_t* dst, int K) { const int tid = ltid();
    const int n = tid >> 3, kq = (tid & 7) * 16; float f[8], g[8];
#pragma unroll
    for (int i = 0; i < 8; ++i) { f[i] = tl[(kq + i) * 65 + n]; g[i] = tl[(kq + 8 + i) * 65 + n]; }
    bf16_t* d = dst + (size_t)(n0 + n) * K + k0 + kq;
    *(u32x4*)d = pack8(f); *(u32x4*)(d + 8) = pack8(g); }
constexpr int XP_T2 = 8448;
template <class MAP> __device__ __forceinline__ void xpose_mat(const MAP& map, int N, int K, bf16_t* dst, LDSP lds, int bid, int nb) {
    const int ntk = K / 128, nt_all = (N / 64) * ntk; LASF tl = (LASF)lds;
    for (int ti = bid; ti < nt_all; ti += 2 * nb) { const int tj = ti + nb; const bool two = tj < nt_all;
        float4 v0[4], v1[4];
        xp_load(map, (ti / ntk) * 64, (ti % ntk) * 128, v0); if (two) xp_load(map, (tj / ntk) * 64, (tj % ntk) * 128, v1);
        xp_lds_write(v0, tl); if (two) xp_lds_write(v1, tl + XP_T2);
        __syncthreads();
        xp_lds_store(tl, (ti / ntk) * 64, (ti % ntk) * 128, dst, K); if (two) xp_lds_store(tl + XP_T2, (tj / ntk) * 64, (tj % ntk) * 128, dst, K);
        __syncthreads(); }
}
__device__ __forceinline__ void phase_conv_small(const Params& p, int layer, LDSP lds, int bid, int nb) {
    { MapWin m{p.w_in + (size_t)layer * 1024 * 13328}; xpose_mat(m, 13312, 1024, p.Wt_in, lds, bid, nb); }
    { MapPlain m{p.w_br_m + (size_t)layer * 1048576, 1024}; xpose_mat(m, 1024, 1024, p.Wt_br + (size_t)layer * 3 * 1048576, lds, bid, nb); }
    { MapPlain m{p.w_br_a + (size_t)layer * 1048576, 1024}; xpose_mat(m, 1024, 1024, p.Wt_br + (size_t)layer * 3 * 1048576 + 1048576, lds, bid, nb); }
    { MapPlain m{p.w_br_h + (size_t)layer * 1048576, 1024}; xpose_mat(m, 1024, 1024, p.Wt_br + (size_t)layer * 3 * 1048576 + 2 * 1048576, lds, bid, nb); }
    { MapPlain m{p.w_out + (size_t)layer * 1048576, 1024}; xpose_mat(m, 1024, 1024, p.Wt_out + (size_t)layer * 1048576, lds, bid, nb); }
}
__device__ __forceinline__ void phase_conv_experts(const Params& p, int layer, bf16_t* Wt13, bf16_t* Wt2, LDSP lds, int bid, int nb) {
    const long d31 = (long)(p.e_w3 - p.e_w1); LASF tl = (LASF)lds;
#define XE13(t_) MapE13{p.e_w1 + ((size_t)layer * 32 + ((t_) >> 7)) * 524288, d31}, ((((t_) & 127) >> 3) * 64), (((t_) & 7) * 128)
#define XE13D(t_) ((((t_) & 127) >> 3) * 64), (((t_) & 7) * 128), Wt13 + (size_t)((t_) >> 7) * 1048576, 1024
    for (int ti = bid; ti < 32 * 128; ti += 2 * nb) { const int tj = ti + nb; const bool two = tj < 32 * 128;
        float4 v0[4], v1[4];
        xp_load(XE13(ti), v0); if (two) xp_load(XE13(tj), v1);
        xp_lds_write(v0, tl); if (two) xp_lds_write(v1, tl + XP_T2);
        __syncthreads();
        xp_lds_store(tl, XE13D(ti)); if (two) xp_lds_store(tl + XP_T2, XE13D(tj));
        __syncthreads(); }
#undef XE13
#undef XE13D
#define XE2(t_) MapPlain{p.e_w2 + ((size_t)layer * 32 + ((t_) >> 6)) * 524288, 1024}, ((((t_) & 63) >> 2) * 64), (((t_) & 3) * 128)
#define XE2D(t_) ((((t_) & 63) >> 2) * 64), (((t_) & 3) * 128), Wt2 + (size_t)((t_) >> 6) * 524288, 512
    for (int ti = bid; ti < 32 * 64; ti += 2 * nb) { const int tj = ti + nb; const bool two = tj < 32 * 64;
        float4 v0[4], v1[4];
        xp_load(XE2(ti), v0); if (two) xp_load(XE2(tj), v1);
        xp_lds_write(v0, tl); if (two) xp_lds_write(v1, tl + XP_T2);
        __syncthreads();
        xp_lds_store(tl, XE2D(ti)); if (two) xp_lds_store(tl + XP_T2, XE2D(tj));
        __syncthreads(); }
#undef XE2
#undef XE2D
}

__device__ __forceinline__ void phase_modvec(const Params& p, LDSP lds, int bid, int nb) {
    LASF red = (LASF)lds; LASF cs = red + 2048; const int tid = ltid();
    if (bid < 192) {
        for (int i = tid; i < 3072; i += NTH) cs[i] = siluf_(i < 2048 ? p.c[i] : p.c_ctx[i - 2048]);
        __syncthreads(); }
    for (int u = bid; u < 192; u += nb) {
        const int l = u / 96, cg = u - l * 96, col = tid & 63, ks = tid >> 6;
        const float* W = p.mod_w + (size_t)l * 1024 * 6144 + cg * 64 + col;
        float a0 = 0.f, a1 = 0.f, a2 = 0.f;
#pragma unroll 1
        for (int k0 = ks * 128; k0 < ks * 128 + 128; k0 += 32) { float w[32];
#pragma unroll
            for (int j = 0; j < 32; ++j) w[j] = W[(size_t)(k0 + j) * 6144];
#pragma unroll
            for (int j = 0; j < 32; ++j) { a0 += cs[k0 + j] * w[j]; a1 += cs[1024 + k0 + j] * w[j]; a2 += cs[2048 + k0 + j] * w[j]; } }
        red[(ks * 3 + 0) * 64 + col] = a0; red[(ks * 3 + 1) * 64 + col] = a1; red[(ks * 3 + 2) * 64 + col] = a2;
        __syncthreads();
        if (tid < 192) { const int v = tid >> 6, cc = tid & 63; float s = p.mod_b[l * 6144 + cg * 64 + cc];
#pragma unroll
            for (int q = 0; q < 8; ++q) s += red[(q * 3 + v) * 64 + cc];
            p.modv[(size_t)(l * 3 + v) * 6144 + cg * 64 + cc] = s; }
        __syncthreads();
    }
}

__device__ __forceinline__ void phase_hdn(const Params& p, LDSP lds, int bid, int nb) {
    LASF w1s = (LASF)lds, b1s = w1s + 33 * 64, w2s = b1s + 64, b2s = w2s + 64 * 64, frs = b2s + 64, hbuf = frs + 64;
    const int tid = ltid();
    for (int u = bid; u < 132; u += nb) {
        const int l = u / 66, pu = u - l * 66;
        for (int i = tid; i < 33 * 64; i += NTH) w1s[i] = p.h_ffn_w1[l * 33 * 64 + i];
        for (int i = tid; i < 64 * 64; i += NTH) w2s[i] = p.h_ffn_w2[l * 4096 + i];
        if (tid < 64) { b1s[tid] = p.h_ffn_b1[l * 64 + tid]; b2s[tid] = p.h_ffn_b2[l * 64 + tid]; frs[tid] = p.h_freq[l * 64 + tid]; }
        __syncthreads();
        const int pos = tid >> 2, qd = tid & 3, q = pu * 128 + pos;
        const int Lf = q < 8192 ? 8192 : 256, t = q < 8192 ? q : q - 8192;
        float z[33];
        z[0] = (float)t / (float)(Lf - 1);
        const float wrev = (float)t / (float)Lf;
#pragma unroll
        for (int j = 0; j < 16; ++j) { const float f = 1e-4f + (float)j * ((15.0f - 1e-4f) / 15.0f); float ph = f * wrev; ph -= floorf(ph); z[1 + j] = cos2pi(ph); z[17 + j] = -sin2pi(ph); }
#pragma unroll
        for (int jj = 0; jj < 16; ++jj) { const int j = qd * 16 + jj; float a = b1s[j];
#pragma unroll
            for (int i = 0; i < 33; ++i) a += z[i] * w1s[i * 64 + j];
            { float r_ = frs[j] * a * INV2PI; r_ -= floorf(r_); hbuf[pos * 65 + j] = sin2pi(r_); } }
        __syncthreads();
        float acc[16];
#pragma unroll
        for (int jj = 0; jj < 16; ++jj) acc[jj] = b2s[qd * 16 + jj];
        for (int i = 0; i < 64; ++i) { const float hv = hbuf[pos * 65 + i];
#pragma unroll
            for (int jj = 0; jj < 16; ++jj) acc[jj] += hv * w2s[i * 64 + qd * 16 + jj]; }
#pragma unroll
        for (int jj = 0; jj < 16; ++jj) { float r_ = frs[qd * 16 + jj] * acc[jj] * INV2PI; r_ -= floorf(r_); p.hdn2[((size_t)l * 8448 + q) * 64 + qd * 16 + jj] = sin2pi(r_); }
        __syncthreads();
    }
}
__device__ __forceinline__ void phase_taps(const Params& p, int layer, bf16_t* tapsT, LDSP lds, int bid, int nb) {
    LASF wsum = (LASF)lds;
    const int nunits = 512 + (layer == 0 ? 64 : 0);
    const float* w3 = UP((const float*)p.h_ffn_w3 + (size_t)layer * 64 * 2048); const float* hd = UP((const float*)p.hdn2 + (size_t)layer * 8448 * 64);
    const float* decp = UP((const float*)p.h_decay + layer * 2048);
    for (int u = bid; u < nunits; u += nb) {
        const int tid = ltid(), lane = tid & 63, r32 = lane & 31, hi = lane >> 5; const int wid = __builtin_amdgcn_readfirstlane(tid >> 6);
        const bool isc = u >= 512; const int cgp = isc ? u - 512 : (u >> 3), tch = isc ? 0 : (u & 7);
        const int Lf = isc ? 256 : 8192; const float rL = 1.0f / (float)(Lf - 1);
        bf16x8 afh[4], afl[4];
#pragma unroll
        for (int kk = 0; kk < 4; ++kk) { float a[8], lo[8]; u32x4 wh, wl;
#pragma unroll
            for (int j = 0; j < 8; ++j) a[j] = w3[(size_t)(16 * kk + 8 * hi + j) * 2048 + 32 * cgp + r32];
            wh = pack8(a);
            { float ah[8]; unpack8(wh, ah);
#pragma unroll
              for (int j = 0; j < 8; ++j) lo[j] = a[j] - ah[j]; }
            wl = pack8(lo); afh[kk] = __builtin_bit_cast(bf16x8, wh); afl[kk] = __builtin_bit_cast(bf16x8, wl); }
        float dcy[16], ss[16];
#pragma unroll
        for (int r = 0; r < 16; ++r) { dcy[r] = fabsf(decp[32 * cgp + crow(r, hi)]); ss[r] = 0.f; }
        const int ntb = isc ? 1 : 4;
        for (int tb = 0; tb < ntb; ++tb) {
            const int t0 = isc ? 32 * wid : tch * 1024 + (4 * wid + tb) * 32, t = t0 + r32;
            const float* hr = hd + (size_t)(isc ? 8192 + t : t) * 64;
            f32x4 hv[8];
#pragma unroll
            for (int i = 0; i < 4; ++i) { hv[2 * i] = *(const f32x4*)(hr + 16 * i + 8 * hi); hv[2 * i + 1] = *(const f32x4*)(hr + 16 * i + 8 * hi + 4); }
            f32x16 acc;
#pragma unroll
            for (int r = 0; r < 16; ++r) acc[r] = 0.f;
#pragma unroll
            for (int kk = 0; kk < 4; ++kk) { float b[8], lo[8];
                const f32x4 q0 = hv[2 * kk], q1 = hv[2 * kk + 1];
                b[0] = q0.x; b[1] = q0.y; b[2] = q0.z; b[3] = q0.w; b[4] = q1.x; b[5] = q1.y; b[6] = q1.z; b[7] = q1.w;
                const u32x4 wh = pack8(b); float bh[8]; unpack8(wh, bh);
#pragma unroll
                for (int j = 0; j < 8; ++j) lo[j] = b[j] - bh[j];
                const u32x4 wl = pack8(lo); const bf16x8 bfh = __builtin_bit_cast(bf16x8, wh), bfl = __builtin_bit_cast(bf16x8, wl);
                acc = __builtin_amdgcn_mfma_f32_32x32x16_bf16(afh[kk], bfh, acc, 0, 0, 0);
                acc = __builtin_amdgcn_mfma_f32_32x32x16_bf16(afh[kk], bfl, acc, 0, 0, 0);
                acc = __builtin_amdgcn_mfma_f32_32x32x16_bf16(afl[kk], bfh, acc, 0, 0, 0); }
            const float tl = (float)t * rL;
#pragma unroll
            for (int r = 0; r < 16; ++r) { const float a = acc[r] * __expf(-tl * dcy[r]); ss[r] += a * a;
                const int col = 32 * cgp + crow(r, hi);
                if (isc) { if (col < 1024) p.hfC[col * 256 + t] = a; else p.hbC[(col - 1024) * 256 + t] = a; }
                else if (col < 1024) tapsT[(size_t)col * 16384 + t] = f2bf(a);
                else { if (t > 0) tapsT[(size_t)(col - 1024) * 16384 + 16384 - t] = f2bf(a); else tapsT[(size_t)(col - 1024) * 16384 + 8192] = 0; } }
        }
#pragma unroll
        for (int r = 0; r < 16; ++r) { float v = ss[r];
#pragma unroll
            for (int o = 16; o >= 1; o >>= 1) v += __shfl_xor(v, o);
            if (r32 == 0) wsum[wid * 32 + crow(r, hi)] = v; }
        __syncthreads();
        if (tid < 32) { float tot = 0.f;
#pragma unroll
            for (int w = 0; w < 8; ++w) tot += wsum[w * 32 + tid];
            if (isc) p.sumsqC[2048 + 32 * cgp + tid] = tot; else p.sumsq[((size_t)(layer * 64 + cgp) * 8 + tch) * 32 + tid] = tot; }
        __syncthreads();
    }
}

__device__ __forceinline__ void phase_norm1(const Params& p, int layer, LDSP lds, int bid, int nb) {
    LASF wg = (LASF)lds;
    const int tid = ltid(), lane = tid & 63, wid = tid >> 6;
    { float4 wv[8];
#pragma unroll
      for (int j = 0; j < 8; ++j) { const int i = tid + NTH * j; wv[j] = *(const float4*)(p.w_in + (size_t)layer * 1024 * 13328 + (size_t)(i >> 2) * 13328 + 4096 + (i & 3) * 4); }
#pragma unroll
      for (int j = 0; j < 8; ++j) { const int i = tid + NTH * j, n = i >> 2, j4 = (i & 3) * 4; wg[n * 20 + j4] = wv[j].x; wg[n * 20 + j4 + 1] = wv[j].y; wg[n * 20 + j4 + 2] = wv[j].z; wg[n * 20 + j4 + 3] = wv[j].w; } }
    __syncthreads();
    const float* gn = p.norm1_g + layer * 1024;
    float gv[16], scv[16], shv[16]; const float* mvc = nullptr;
#pragma unroll
    for (int i = 0; i < 16; ++i) gv[i] = gn[lane + 64 * i];
    for (int s = bid * 8 + wid; s < TT; s += nb * 8) {
        const float* xr = resid_row_in(p, layer, s); const float* mv = modvec(p, layer, s);
        float xv[16]; float ssq = 0.f;
#pragma unroll
        for (int i = 0; i < 16; ++i) xv[i] = xr[lane + 64 * i];
        if (mv != mvc) { mvc = mv;
#pragma unroll
            for (int i = 0; i < 16; ++i) { const int n = lane + 64 * i; scv[i] = mv[1024 + n]; shv[i] = mv[n]; } }
#pragma unroll
        for (int i = 0; i < 16; ++i) ssq += xv[i] * xv[i];
        ssq = wave_sum(ssq); const float rstd = rsqrtf(ssq * (1.0f / 1024.0f) + EPS_);
        float acc[16];
#pragma unroll
        for (int j = 0; j < 16; ++j) acc[j] = 0.f;
#pragma unroll
        for (int i = 0; i < 16; ++i) { const int n = lane + 64 * i; const float hv = xv[i] * rstd * gv[i] * (1.0f + scv[i]) + shv[i];
            p.hn[(size_t)s * 1024 + n] = f2bf(hv);
#pragma unroll
            for (int j4 = 0; j4 < 4; ++j4) { const f32x4 w = *(const PG8_LAS f32x4*)(wg + n * 20 + 4 * j4); acc[4 * j4] += hv * w.x; acc[4 * j4 + 1] += hv * w.y; acc[4 * j4 + 2] += hv * w.z; acc[4 * j4 + 3] += hv * w.w; }
            if (i & 1) __builtin_amdgcn_sched_barrier(0); }
        wave_sum16(acc);
        if ((lane & 15) == 0) { f32x4 g4; g4[0] = acc[0]; g4[1] = acc[1]; g4[2] = acc[2]; g4[3] = acc[3]; *(f32x4*)(p.G + (size_t)s * 16 + (lane >> 4) * 4) = g4; }
    }
    __syncthreads();
}

__device__ __forceinline__ void phase_attn_prep(const Params& p, int layer, bf16_t* aq, bf16_t* ak, int bid, int nb) {
    const int tid = ltid(), lane = tid & 63, wid = tid >> 6;
    const int grp = lane >> 2, i4 = lane & 3;
    const float* qg = p.a_qnorm_g + layer * 64; const float* kg = p.a_knorm_g + layer * 64;
    float gq[16], gk[16];
#pragma unroll
    for (int c = 0; c < 4; ++c)
#pragma unroll
        for (int e = 0; e < 4; ++e) { gq[c * 4 + e] = qg[16 * c + 4 * i4 + e]; gk[c * 4 + e] = kg[16 * c + 4 * i4 + e]; }
    float inv[4];
#pragma unroll
    for (int e = 0; e < 4; ++e) inv[e] = exp2f(-(float)(4 * i4 + e) * (13.287712379549449f / 16.0f));
    const float qscale = 0.125f * 1.4426950408889634f;
    for (int s = bid * 8 + wid; s < TT; s += nb * 8) {
        const int b = s / SEQB, pos = s - b * SEQB; const bool lat = pos >= LC; const int t = pos - LC;
        float cs[8], sn[8];
        if (lat) { const float rowf = (float)(t >> 6), colf = (float)(t & 63);
#pragma unroll
            for (int e = 0; e < 4; ++e) { float ar = rowf * inv[e] * INV2PI, ac = colf * inv[e] * INV2PI; ar -= floorf(ar); ac -= floorf(ac);
                cs[e] = cos2pi(ar); sn[e] = sin2pi(ar); cs[4 + e] = cos2pi(ac); sn[4 + e] = sin2pi(ac); } }
        u32x2 wqk[2][4];
#pragma unroll
        for (int c = 0; c < 4; ++c) wqk[1][c] = *(const u32x2*)(ak + (size_t)s * 1024 + grp * 64 + 4 * i4 + 16 * c);
#pragma unroll
        for (int which = 1; which < 2; ++which) {
            bf16_t* base = (which ? ak : aq) + (size_t)s * 1024 + grp * 64 + 4 * i4;
            float v[16]; float ssq = 0.f;
#pragma unroll
            for (int c = 0; c < 4; ++c) { const u32x2 w = wqk[which][c]; v[4 * c] = lo16(w.x); v[4 * c + 1] = hi16(w.x); v[4 * c + 2] = lo16(w.y); v[4 * c + 3] = hi16(w.y); }
#pragma unroll
            for (int i = 0; i < 16; ++i) ssq += v[i] * v[i];
            ssq += __shfl_xor(ssq, 1); ssq += __shfl_xor(ssq, 2);
            const float rstd = rsqrtf(ssq * (1.0f / 64.0f) + EPS_) * (which ? 1.0f : qscale);
#pragma unroll
            for (int i = 0; i < 16; ++i) v[i] = v[i] * rstd * (which ? gk[i] : gq[i]);
            if (lat) {
#pragma unroll
                for (int hf = 0; hf < 2; ++hf)
#pragma unroll
                    for (int e = 0; e < 4; ++e) { const float x1 = v[8 * hf + e], x2 = v[8 * hf + 4 + e], cc = cs[4 * hf + e], sv = sn[4 * hf + e];
                        v[8 * hf + e] = x1 * cc - x2 * sv; v[8 * hf + 4 + e] = x2 * cc + x1 * sv; }
            }
#pragma unroll
            for (int c = 0; c < 4; ++c) { u32x2 w; w.x = pk2(v[4 * c], v[4 * c + 1]); w.y = pk2(v[4 * c + 2], v[4 * c + 3]); *(u32x2*)(base + 16 * c) = w; }
        }
    }
}

__device__ __forceinline__ s16x4 vtr16(const PG8_LAS unsigned char* ptr) {
    typedef short v4i16_t __attribute__((ext_vector_type(4)));
    return __builtin_bit_cast(s16x4, __builtin_amdgcn_ds_read_tr16_b64_v4i16((PG8_LAS v4i16_t*)ptr)); }

__device__ __forceinline__ void glds16(const void* gsrc, unsigned lds_dst) { unsigned keep;
    asm volatile("s_mov_b32 %0, m0\n\ts_mov_b32 m0, %2\n\ts_nop 0\n\tglobal_load_lds_dwordx4 %1, off\n\ts_mov_b32 m0, %0" : "=&s"(keep) : "v"(gsrc), "s"(lds_dst) : "memory"); }
__device__ __forceinline__ float max3f_(float a, float b, float c) { float r; asm("v_max3_f32 %0, %1, %2, %3" : "=v"(r) : "v"(a), "v"(b), "v"(c)); return r; }
#define ATT_WAIT_BAR(N) asm volatile("s_waitcnt vmcnt(" #N ") lgkmcnt(0)\n\ts_barrier" ::: "memory")
__device__ __forceinline__ void attn_unit(const Params& p, int layer, const bf16_t* Q, const bf16_t* K, const bf16_t* V, bf16_t* O, int b, int h, int q0pos, int nkeys, float lam, float lam_init, LDSP lds) {
    const int tid = ltid(), lane = tid & 63, r32 = lane & 31, hi = lane >> 5; const int wid = __builtin_amdgcn_readfirstlane(tid >> 6), comp = wid >> 2, qblk = wid & 3;
    const size_t rowb = (size_t)b * SEQB;
    const bf16_t* qrow = Q + (rowb + q0pos + 32 * qblk + r32) * 1024 + h * 128 + comp * 64 + hi * 8;
    bf16x8 qf[4];
#pragma unroll
    for (int d0 = 0; d0 < 4; ++d0) qf[d0] = *(const bf16x8*)(qrow + d0 * 16);
    { float v[4][8]; float ssq = 0.f;
#pragma unroll
      for (int d0 = 0; d0 < 4; ++d0) { unpack8(__builtin_bit_cast(u32x4, qf[d0]), v[d0]);
#pragma unroll
          for (int j = 0; j < 8; ++j) ssq += v[d0][j] * v[d0][j]; }
      { float w2 = ssq; swap32_(ssq, w2); ssq += w2; }
      const float rstd = rsqrtf(ssq * (1.0f / 64.0f) + EPS_) * (0.125f * 1.4426950408889634f);
      const float* qg = p.a_qnorm_g + layer * 64 + hi * 8;
#pragma unroll
      for (int d0 = 0; d0 < 4; ++d0) { const f32x4 g0 = *(const f32x4*)(qg + d0 * 16), g1 = *(const f32x4*)(qg + d0 * 16 + 4);
#pragma unroll
          for (int j = 0; j < 4; ++j) { v[d0][j] *= rstd * g0[j]; v[d0][4 + j] *= rstd * g1[j]; } }
      if (q0pos >= LC) { const int t = q0pos - LC + 32 * qblk + r32; const float rowf = (float)(t >> 6), colf = (float)(t & 63);
#pragma unroll
          for (int j = 0; j < 8; ++j) { const float inv = exp2f(-(float)(8 * hi + j) * (13.287712379549449f / 16.0f));
              float ar = rowf * inv * INV2PI, ac = colf * inv * INV2PI; ar -= floorf(ar); ac -= floorf(ac);
              const float cr = cos2pi(ar), sr = sin2pi(ar), cc = cos2pi(ac), sc = sin2pi(ac);
              const float a1 = v[0][j], a2 = v[1][j], b1 = v[2][j], b2 = v[3][j];
              v[0][j] = a1 * cr - a2 * sr; v[1][j] = a2 * cr + a1 * sr; v[2][j] = b1 * cc - b2 * sc; v[3][j] = b2 * cc + b1 * sc; } }
#pragma unroll
      for (int d0 = 0; d0 < 4; ++d0) qf[d0] = __builtin_bit_cast(bf16x8, pack8(v[d0])); }
    f32x16 o[4];
#pragma unroll
    for (int d0 = 0; d0 < 4; ++d0)
#pragma unroll
        for (int r = 0; r < 16; ++r) o[d0][r] = 0.f;
    float l = 0.f;
    const f32x16 zero16 = {0.f, 0.f, 0.f, 0.f, 0.f, 0.f, 0.f, 0.f, 0.f, 0.f, 0.f, 0.f, 0.f, 0.f, 0.f, 0.f};
    const int ntiles = nkeys >> 6;
    const unsigned lds0 = (unsigned)(uintptr_t)(unsigned char*)lds;
    const int krow0 = 8 * wid + (lane >> 4), krow1 = krow0 + 4, kpos = lane & 15;
    const unsigned kvo0 = (unsigned)(krow0 * 1024 + ((kpos ^ (krow0 & 15)) * 8)) * 2u, kvo1 = (unsigned)(krow1 * 1024 + ((kpos ^ (krow1 & 15)) * 8)) * 2u - 1024u;
    const unsigned vvo0 = (unsigned)((16 * ((2 * wid) & 3) + (lane >> 2)) * 1024 + ((2 * wid) >> 2) * 32 + (lane & 3) * 8) * 2u;
    const unsigned vvo1 = (unsigned)((16 * ((2 * wid + 1) & 3) + (lane >> 2)) * 1024 + ((2 * wid + 1) >> 2) * 32 + (lane & 3) * 8) * 2u - 1024u;
    const bf16_t* kub = K + rowb * 1024 + h * 128; const bf16_t* vub = V + rowb * 1024 + h * 128;
    const unsigned kd0 = lds0 + (2 * wid) * 1024, vd0 = lds0 + 16384 + (2 * wid) * 1024;
#define ATT_DMA2(sb, va, vb_, m0v) asm volatile("s_mov_b32 m0, %3\n\ts_nop 0\n\tglobal_load_lds_dwordx4 %0, %2\n\tglobal_load_lds_dwordx4 %1, %2 offset:1024" :: "v"(va), "v"(vb_), "s"(sb), "s"(m0v) : "memory", "m0")
#define ATT_DMA(t, slot) do { const size_t to_ = (size_t)(t) * 64 * 1024; const unsigned so_ = (unsigned)(slot) * 32768u; \
        ATT_DMA2(kub + to_, kvo0, kvo1, (unsigned)__builtin_amdgcn_readfirstlane(kd0 + so_)); ATT_DMA2(vub + to_, vvo0, vvo1, (unsigned)__builtin_amdgcn_readfirstlane(vd0 + so_)); } while (0)
    asm volatile("" : "+v"(qf[0]), "+v"(qf[1]), "+v"(qf[2]), "+v"(qf[3]));
    ATT_DMA(0, 0); ATT_DMA(1, 1); ATT_DMA(2, 2);
    ATT_WAIT_BAR(4);
    const PG8_LAS unsigned char* kbase = lds + r32 * 256; const int kx0 = ((comp * 8 + hi) ^ (r32 & 15)) << 4;
    const PG8_LAS unsigned char* vbase = lds + 16384 + ((lane >> 4) & 1) * 32 + (lane & 3) * 8 + (4 * hi + ((lane & 15) >> 2)) * 64;
    bf16x8 vbA[4], vbB[4], kb[4], pfA, pfB; f32x16 S0, S1; float la = 0.f, lb = 0.f;
#define ATT_SB __builtin_amdgcn_sched_barrier(0)
#define ATT_VLD(vb, Vp, ks) do { _Pragma("unroll") for (int d0 = 0; d0 < 4; ++d0) { const s16x4 lo = vtr16((Vp) + d0 * 4096 + (ks) * 1024), hh = vtr16((Vp) + d0 * 4096 + (ks) * 1024 + 512); \
        vb[d0] = (bf16x8){lo[0], lo[1], lo[2], lo[3], hh[0], hh[1], hh[2], hh[3]}; } } while (0)
#define ATT_KLD(Kp, half) do { _Pragma("unroll") for (int d0 = 0; d0 < 4; ++d0) kb[d0] = *(const PG8_LAS bf16x8*)((Kp) + (kx0 ^ (d0 << 5)) + (half) * 8192); } while (0)
#define ATT_STAGE(vbU, pfU, DOQK, QS, DOEXP, ES, off, pfN) do { unsigned w_[4]; \
        _Pragma("unroll") for (int g = 0; g < 4; ++g) { \
            o[g] = __builtin_amdgcn_mfma_f32_32x32x16_bf16(vbU[g], pfU, o[g], 0, 0, 0); \
            if (DOQK) QS = __builtin_amdgcn_mfma_f32_32x32x16_bf16(kb[g], qf[g], g ? QS : zero16, 0, 0, 0); \
            if (DOEXP) { const float ea_ = __builtin_amdgcn_exp2f(ES[(off) + 2 * g]), eb_ = __builtin_amdgcn_exp2f(ES[(off) + 2 * g + 1]); la += ea_; lb += eb_; w_[g] = pk2(ea_, eb_); } \
              \
            asm volatile("" : "+v"(o[g]), "+v"(pfU)); \
            if (DOQK) asm volatile("" : "+v"(QS)); \
            if (DOEXP) asm volatile("" : "+v"(w_[g]), "+v"(ES), "+v"(la), "+v"(lb)); \
            ATT_SB; } \
        if (DOEXP) { u32x4 wv_; wv_.x = w_[0]; wv_.y = w_[1]; wv_.z = w_[2]; wv_.w = w_[3]; pfN = __builtin_bit_cast(bf16x8, wv_); } } while (0)
    { ATT_KLD(kbase, 0);
#pragma unroll
      for (int d0 = 0; d0 < 4; ++d0) S0 = __builtin_amdgcn_mfma_f32_32x32x16_bf16(kb[d0], qf[d0], d0 ? S0 : zero16, 0, 0, 0);
      ATT_KLD(kbase, 1);
#pragma unroll
      for (int d0 = 0; d0 < 4; ++d0) S1 = __builtin_amdgcn_mfma_f32_32x32x16_bf16(kb[d0], qf[d0], d0 ? S1 : zero16, 0, 0, 0);
      ATT_VLD(vbA, vbase, 0);
      u32x4 w_;
#pragma unroll
      for (int g = 0; g < 4; ++g) { const float ea_ = __builtin_amdgcn_exp2f(S0[2 * g]), eb_ = __builtin_amdgcn_exp2f(S0[2 * g + 1]); la += ea_; lb += eb_; w_[g] = pk2(ea_, eb_); }
      pfA = __builtin_bit_cast(bf16x8, w_); ATT_SB; }
#define ATT_TILE(NX) do { const PG8_LAS unsigned char* Vs_ = vbase + (t & 3) * 32768; const PG8_LAS unsigned char* Vn_ = vbase + ((t + 1) & 3) * 32768; const PG8_LAS unsigned char* Kn_ = kbase + ((t + 1) & 3) * 32768; \
        ATT_VLD(vbB, Vs_, 1); if (NX) ATT_KLD(Kn_, 0); \
        { const int td = t + 3 < ntiles ? t + 3 : ntiles - 1; ATT_DMA(td, (t + 3) & 3); } ATT_SB; \
        ATT_STAGE(vbA, pfA, 0, S0, 1, S0, 8, pfB); \
        ATT_VLD(vbA, Vs_, 2); ATT_SB; \
        ATT_STAGE(vbB, pfB, NX, S0, 1, S1, 0, pfA); \
        ATT_VLD(vbB, Vs_, 3); if (NX) ATT_KLD(Kn_, 1); ATT_SB; \
        ATT_STAGE(vbA, pfA, 0, S1, 1, S1, 8, pfB); \
        if (NX) ATT_VLD(vbA, Vn_, 0); ATT_SB; \
        ATT_STAGE(vbB, pfB, NX, S1, NX, S0, 0, pfA); \
        ATT_WAIT_BAR(4); } while (0)
    int t = 0;
    for (; t < ntiles - 1; ++t) ATT_TILE(1);
    ATT_TILE(0);
    ATT_WAIT_BAR(0);
    l = la + lb;
#undef ATT_SB
#undef ATT_VLD
#undef ATT_KLD
#undef ATT_STAGE
#undef ATT_TILE
#undef ATT_DMA
#undef ATT_DMA2
    l += __shfl_xor(l, 32);
    const float rl = 1.0f / l;
    LASF xch = (LASF)(lds) + qblk * 4096;
    if (comp == 1) {
#pragma unroll
        for (int d0 = 0; d0 < 4; ++d0)
#pragma unroll
            for (int r = 0; r < 16; ++r) xch[(32 * d0 + crow(r, hi)) * 32 + r32] = o[d0][r] * rl;
    }
    __syncthreads();
    if (comp == 0) {
        float ssq = 0.f;
#pragma unroll
        for (int d0 = 0; d0 < 4; ++d0)
#pragma unroll
            for (int r = 0; r < 16; ++r) { const float y = o[d0][r] * rl - lam * xch[(32 * d0 + crow(r, hi)) * 32 + r32]; o[d0][r] = y; ssq += y * y; }
        ssq += __shfl_xor(ssq, 32);
        const float sc = rsqrtf(ssq * (1.0f / 128.0f) + EPS_) * (1.0f - lam_init);
        const float* sg = p.a_subln_g + layer * 128;
        bf16_t* orow = O + (rowb + q0pos + 32 * qblk + r32) * 1024 + h * 128;
#pragma unroll
        for (int d0 = 0; d0 < 4; ++d0)
#pragma unroll
            for (int r4 = 0; r4 < 4; ++r4) { const int d = 32 * d0 + 8 * r4 + 4 * hi; u32x2 w;
                w.x = pk2(o[d0][4 * r4] * sc * sg[d], o[d0][4 * r4 + 1] * sc * sg[d + 1]); w.y = pk2(o[d0][4 * r4 + 2] * sc * sg[d + 2], o[d0][4 * r4 + 3] * sc * sg[d + 3]);
                *(u32x2*)(orow + d) = w; }
    }
    __syncthreads();
}
__device__ __forceinline__ void phase_attn(const Params& p, int layer, const bf16_t* Q, const bf16_t* K, const bf16_t* V, bf16_t* O, LDSP lds, int bid, int nb) {
    const float lam_init = 0.8f - 0.6f * expf(-0.3f * (float)layer);
    const float* lp = p.a_lambda + layer * 256; float d1 = 0.f, d2 = 0.f;
    for (int i = 0; i < 64; ++i) { d1 += lp[i] * lp[64 + i]; d2 += lp[128 + i] * lp[192 + i]; }
    const float lam = expf(d1) - expf(d2) + lam_init;
    const int nunits = 1024 + (layer == 0 ? 32 : 0);
    for (int u = bid; u < nunits; u += nb) {
        if (u < 1024) { int bh = u >> 6, qb = u & 63;
            if (nb == 256) { const int x = bid & 7; bh = (x >> 1) + 4 * (u >> 8); qb = (x & 1) * 32 + (bid >> 3); }
            attn_unit(p, layer, Q, K, V, O, bh >> 3, bh & 7, LC + qb * 128, SEQB, lam, lam_init, lds); }
        else { const int v = u - 1024, bh = v >> 1, qb = v & 1; attn_unit(p, layer, Q, K, V, O, bh >> 3, bh & 7, qb * 128, LC, lam, lam_init, lds); }
    }
}

__device__ __forceinline__ int scan_idx(int dir, int c) { return dir == 0 ? c : (c < 2 ? 1 - c : 67 - c); }

__device__ __forceinline__ void load_gates(const Params& p, int layer, size_t row0, int h, LASF tb) {
    const int tid = ltid();
    if (tid < 128) { const float* g = p.G + (row0 + tid) * 16; const float* gb = p.m_gate_b + layer * 16;
        tb[tid] = g[h] + gb[h]; tb[128 + tid] = logsigf_(g[4 + h] + gb[4 + h]); tb[256 + tid] = g[8 + h] + gb[8 + h]; tb[384 + tid] = logsigf_(g[12 + h] + gb[12 + h]); }
}

__device__ __forceinline__ float wave_scan_sum(float v, int lane) {
#pragma unroll
    for (int o = 1; o < 64; o <<= 1) { const float y = __shfl_up(v, o); if (lane >= o) v += y; }
    return v; }
__device__ __forceinline__ float wave_scan_max(float v, int lane) {
#pragma unroll
    for (int o = 1; o < 64; o <<= 1) { const float y = __shfl_up(v, o); if (lane >= o) v = fmaxf(v, y); }
    return v; }

__device__ __forceinline__ void mconv8(const u32x4 rp, const u32x4 rc, const u32x4 rn, const float* cw, const float* cb, int cc, float scale, float (&o)[8]) {
    float up[8], uc[8], un[8]; unpack8(rp, up); unpack8(rc, uc); unpack8(rn, un);
    const f32x4 b0 = *(const f32x4*)(cb + cc), b1 = *(const f32x4*)(cb + cc + 4), w00 = *(const f32x4*)(cw + cc), w01 = *(const f32x4*)(cw + cc + 4);
    const f32x4 w10 = *(const f32x4*)(cw + 2048 + cc), w11 = *(const f32x4*)(cw + 2048 + cc + 4), w20 = *(const f32x4*)(cw + 4096 + cc), w21 = *(const f32x4*)(cw + 4096 + cc + 4);
#pragma unroll
    for (int i = 0; i < 4; ++i) { o[i] = siluf_(b0[i] + up[i] * w00[i] + uc[i] * w10[i] + un[i] * w20[i]) * scale; o[4 + i] = siluf_(b1[i] + up[4 + i] * w01[i] + uc[4 + i] * w11[i] + un[4 + i] * w21[i]) * scale; }
}
__device__ __forceinline__ void phase_mA(const Params& p, int layer, const bf16_t* mk_, const bf16_t* mv_, bf16_t* vT_, bf16_t* ST_, LDSP lds, int bid, int nb) {
    const bf16_t* mk = UP(mk_); const bf16_t* mv = UP(mv_); bf16_t* vT = UP(vT_); bf16_t* ST = UP(ST_);
    constexpr int RS = 576;
    LDSP Kt = lds; LDSP Vt = lds + 128 * RS;
    LASF tb = (LASF)(lds + 256 * RS);
    LASF part = tb + 512;
    const float* gbias = UP((const float*)p.m_gate_b + layer * 16); const float* Gp = UP((const float*)p.G);
    const float* cw = UP((const float*)p.m_conv_w + (size_t)layer * 3 * 2048); const float* cb = UP((const float*)p.m_conv_b + layer * 2048);
    float* scalp = UP((float*)p.scal); float* dnp = UP((float*)p.dn);
    for (int u = bid; u < 8 * 66; u += nb) {
        const int tid = ltid(), lane = tid & 63, r32 = lane & 31, hi = lane >> 5; const int wid = __builtin_amdgcn_readfirstlane(tid >> 6);
        const int c = u % 66, bh = u / 66, b = bh >> 2, h = bh & 3;
        const size_t row0 = (size_t)b * SEQB + 128 * c;
        const int idxf = scan_idx(0, c), idxb = scan_idx(1, c);
        const int tq = tid & 127, dsel = (tid >> 7) & 1;
        float li = 0.f, lf = 0.f;
        if (tid < 256) { const float* g = Gp + (row0 + tq) * 16; li = g[8 * dsel + h] + gbias[8 * dsel + h]; lf = logsigf_(g[8 * dsel + 4 + h] + gbias[8 * dsel + 4 + h]); }
        float inc = wave_scan_sum(lf, lane);
        if (lane == 63 && wid < 4) tb[256 + wid] = inc;
        __syncthreads();
        const float tot = tb[256 + 2 * dsel] + tb[257 + 2 * dsel]; if (wid == 1 || wid == 3) inc += tb[256 + wid - 1];
        const float wsv = (dsel == 0 ? tot - inc : inc - lf) + li;
        const float mxw = wave_max(tid < 256 ? wsv : -1e30f);
        if (lane == 0 && wid < 4) tb[272 + wid] = mxw;
        __syncthreads();
        { const float mloc = fmaxf(tb[272 + 2 * dsel], tb[273 + 2 * dsel]);
          if (tid < 256) tb[128 * dsel + tq] = __expf(wsv - mloc);
          if (tq == 0 && tid < 256) { float* s0 = scalp + ((size_t)(bh * 2 + dsel) * 66 + (dsel ? idxb : idxf)) * 2; s0[0] = tot; s0[1] = mloc; } }
        __syncthreads();
        const int ch8 = (tid & 31) * 8; float dnf[8], dnb[8];
#pragma unroll
        for (int e = 0; e < 8; ++e) { dnf[e] = 0.f; dnb[e] = 0.f; }
#pragma unroll
        for (int jb = 0; jb < 2; ++jb) { u32x4 rk[6], rv[4]; const int tb0 = 8 * (tid >> 5) + 4 * jb; const u32x4 zz = {0u, 0u, 0u, 0u};
#pragma unroll
            for (int r = 0; r < 6; ++r) { const int t = tb0 - 1 + r, pos = 128 * c + t; const bool ok = pos >= 0 && pos < SEQB;
                rk[r] = ok ? *(const u32x4*)(mk + (row0 + t) * 1024 + h * 256 + ch8) : zz; }
#pragma unroll
            for (int tt = 0; tt < 4; ++tt) rv[tt] = *(const u32x4*)(mv + (row0 + tb0 + tt) * 1024 + h * 256 + ch8);
#pragma unroll
            for (int tt = 0; tt < 4; ++tt) { const int t = tb0 + tt, pos = 128 * c + t; float o[8];
                const bool hasp = (pos != 0) && (pos != LC), hasn = (pos != LC - 1) && (pos != SEQB - 1);
                mconv8(hasp ? rk[tt] : zz, rk[tt + 1], hasn ? rk[tt + 2] : zz, cw, cb, 1024 + h * 256 + ch8, 0.0625f, o);
                const u32x4 kk = pack8(o); unpack8(kk, o);
                const float wf = tb[t], wb = tb[128 + t];
#pragma unroll
                for (int e = 0; e < 8; ++e) { dnf[e] += wf * o[e]; dnb[e] += wb * o[e]; }
                *(PG8_LAS u32x4*)(Kt + t * RS + ch8 * 2) = kk; *(PG8_LAS u32x4*)(Vt + t * RS + ch8 * 2) = rv[tt]; } }
#pragma unroll
        for (int e = 0; e < 8; ++e) { dnf[e] += __shfl_xor(dnf[e], 32); dnb[e] += __shfl_xor(dnb[e], 32); }
        if (hi == 0) {
#pragma unroll
            for (int e = 0; e < 8; ++e) part[wid * 256 + ch8 + e] = dnf[e]; }
        __syncthreads();
        if (tid < 256) { float sm = 0.f;
#pragma unroll
            for (int w = 0; w < 8; ++w) sm += part[w * 256 + tid];
            dnp[((size_t)(bh * 2) * 66 + idxf) * 256 + tid] = sm; }
        __syncthreads();
        if (hi == 0) {
#pragma unroll
            for (int e = 0; e < 8; ++e) part[wid * 256 + ch8 + e] = dnb[e]; }
#pragma unroll
        for (int it = 0; it < 2; ++it) { const int item = tid + NTH * it, dp = item >> 3, tg = item & 7;
            const PG8_LAS unsigned* srcl = (const PG8_LAS unsigned*)(Vt + (16 * tg) * RS + 4 * dp);
            bf16_t* dst = vT + ((size_t)(bh * 256 + 2 * dp)) * SEQB + 128 * c + 16 * tg;
            unsigned w[16];
#pragma unroll
            for (int i = 0; i < 16; ++i) w[i] = srcl[i * (RS / 4)];
            u32x4 lo0, lo1, hi0, hi1;
            lo0.x = __builtin_amdgcn_perm(w[1], w[0], 0x05040100u); lo0.y = __builtin_amdgcn_perm(w[3], w[2], 0x05040100u); lo0.z = __builtin_amdgcn_perm(w[5], w[4], 0x05040100u); lo0.w = __builtin_amdgcn_perm(w[7], w[6], 0x05040100u);
            lo1.x = __builtin_amdgcn_perm(w[9], w[8], 0x05040100u); lo1.y = __builtin_amdgcn_perm(w[11], w[10], 0x05040100u); lo1.z = __builtin_amdgcn_perm(w[13], w[12], 0x05040100u); lo1.w = __builtin_amdgcn_perm(w[15], w[14], 0x05040100u);
            hi0.x = __builtin_amdgcn_perm(w[1], w[0], 0x07060302u); hi0.y = __builtin_amdgcn_perm(w[3], w[2], 0x07060302u); hi0.z = __builtin_amdgcn_perm(w[5], w[4], 0x07060302u); hi0.w = __builtin_amdgcn_perm(w[7], w[6], 0x07060302u);
            hi1.x = __builtin_amdgcn_perm(w[9], w[8], 0x07060302u); hi1.y = __builtin_amdgcn_perm(w[11], w[10], 0x07060302u); hi1.z = __builtin_amdgcn_perm(w[13], w[12], 0x07060302u); hi1.w = __builtin_amdgcn_perm(w[15], w[14], 0x07060302u);
            *(u32x4*)(dst) = lo0; *(u32x4*)(dst + 8) = lo1; *(u32x4*)(dst + SEQB) = hi0; *(u32x4*)(dst + SEQB + 8) = hi1; }
        const int troff = ((lane >> 4) & 1) * 32 + (lane & 3) * 8 + (4 * hi + ((lane & 15) >> 2)) * RS;
        bf16x8 Bf[8];
#pragma unroll
        for (int ks = 0; ks < 8; ++ks) { const s16x4 lo = vtr16(Vt + troff + ks * 16 * RS + wid * 64), hh = vtr16(Vt + troff + (ks * 16 + 8) * RS + wid * 64);
            Bf[ks] = (bf16x8){lo[0], lo[1], lo[2], lo[3], hh[0], hh[1], hh[2], hh[3]}; }
        __syncthreads();
        if (tid < 256) { float sm = 0.f;
#pragma unroll
            for (int w = 0; w < 8; ++w) sm += part[w * 256 + tid];
            dnp[((size_t)(bh * 2 + 1) * 66 + idxb) * 256 + tid] = sm; }
        LDSP stg = Vt + wid * 8704;
#pragma unroll 1
        for (int dir = 0; dir < 2; ++dir) {
            bf16x8 Bs[8];
#pragma unroll
            for (int ks = 0; ks < 8; ++ks) { float f[8]; unpack8(__builtin_bit_cast(u32x4, Bf[ks]), f);
#pragma unroll
                for (int j = 0; j < 8; ++j) f[j] *= tb[128 * dir + 16 * ks + 8 * (j >> 2) + 4 * hi + (j & 3)];
                Bs[ks] = __builtin_bit_cast(bf16x8, pack8(f)); }
            unsigned char* st = (unsigned char*)ST + ((size_t)(bh * 2 + dir) * 66 + (dir ? idxb : idxf)) * 65536 + (size_t)(32 * wid) * 256;
#pragma unroll 1
            for (int kh = 0; kh < 2; ++kh) {
                f32x16 acc[4];
#pragma unroll
                for (int kb = 0; kb < 4; ++kb)
#pragma unroll
                    for (int r = 0; r < 16; ++r) acc[kb][r] = 0.f;
#pragma unroll
                for (int ks = 0; ks < 8; ++ks) {
#pragma unroll
                    for (int kb = 0; kb < 4; ++kb) { const s16x4 lo = vtr16(Kt + troff + ks * 16 * RS + (4 * kh + kb) * 64), hh = vtr16(Kt + troff + (ks * 16 + 8) * RS + (4 * kh + kb) * 64);
                        const bf16x8 aa = (bf16x8){lo[0], lo[1], lo[2], lo[3], hh[0], hh[1], hh[2], hh[3]};
                        acc[kb] = __builtin_amdgcn_mfma_f32_32x32x16_bf16(aa, Bs[ks], acc[kb], 0, 0, 0); }
                    if (ks & 1) __builtin_amdgcn_sched_barrier(0); }
#pragma unroll
                for (int kb = 0; kb < 4; ++kb)
#pragma unroll
                    for (int r4 = 0; r4 < 4; ++r4)
                        *(PG8_LAS unsigned*)(stg + r32 * 144 + (32 * kb + 8 * r4 + 4 * hi)) = pk4_fp8(acc[kb][4 * r4] * ST_SC, acc[kb][4 * r4 + 1] * ST_SC, acc[kb][4 * r4 + 2] * ST_SC, acc[kb][4 * r4 + 3] * ST_SC);
                asm volatile("s_waitcnt lgkmcnt(0)" ::: "memory");
#pragma unroll
                for (int i = 0; i < 4; ++i) { const int row = 8 * i + (lane >> 3), ch = lane & 7;
                    *(u32x4*)(st + (size_t)row * 256 + 128 * kh + 16 * ch) = *(const PG8_LAS u32x4*)(stg + row * 144 + ch * 16); }
            }
        }
        __syncthreads();
    }
}

__device__ __forceinline__ void phase_mB(const Params& p, bf16_t* ST, int bid, int nb) {
    const int tid = ltid();
    { const int ipb = (16 * 256 + nb - 1) / nb, it = bid * ipb + tid;
      if (tid < ipb && it < 16 * 256) {
          const int bhd = it >> 8, kd = it & 255; const float* sc = p.scal + (size_t)bhd * 132; float n = 0.f, m = 0.f;
          if (kd == 0) p.ms[bhd * 67] = 0.f;
          for (int i0 = 0; i0 < 66; i0 += 11) { float dv[11], bqv[11], mlv[11];
#pragma unroll
              for (int j = 0; j < 11; ++j) { dv[j] = p.dn[((size_t)bhd * 66 + i0 + j) * 256 + kd]; bqv[j] = sc[2 * (i0 + j)]; mlv[j] = sc[2 * (i0 + j) + 1]; }
#pragma unroll
              for (int j = 0; j < 11; ++j) { const float mn = fmaxf(bqv[j] + m, mlv[j]), a = __expf(bqv[j] + m - mn), bb = __expf(mlv[j] - mn);
                  n = a * n + bb * dv[j]; p.nst[((size_t)bhd * 66 + i0 + j) * 256 + kd] = n; m = mn; if (kd == 0) p.ms[bhd * 67 + i0 + j + 1] = mn; } } } }
    for (int it = bid * NTH + tid; it < 16 * 8192; it += nb * NTH) {
        const int bhd = it >> 13; unsigned char* st = (unsigned char*)ST + (size_t)bhd * 66 * 65536 + (size_t)(it & 8191) * 8; const float* sc = p.scal + (size_t)bhd * 132;
        float C[8];
#pragma unroll
        for (int e = 0; e < 8; ++e) C[e] = 0.f;
        float m = 0.f;
        for (int i0 = 0; i0 < 66; i0 += 11) {
            u32x2 v[11];
#pragma unroll
            for (int j = 0; j < 11; ++j) v[j] = *(const u32x2*)(st + (size_t)(i0 + j) * 65536);
#pragma unroll
            for (int j = 0; j < 11; ++j) { const float bq = sc[2 * (i0 + j)], ml = sc[2 * (i0 + j) + 1]; const float mn = fmaxf(bq + m, ml), a = __expf(bq + m - mn), bb = __expf(ml - mn);
                float f[8]; unpk8_fp8(v[j], f);
#pragma unroll
                for (int e = 0; e < 8; ++e) C[e] = a * C[e] + bb * f[e];
                u32x2 wo; wo.x = pk4_fp8(C[0], C[1], C[2], C[3]); wo.y = pk4_fp8(C[4], C[5], C[6], C[7]);
                *(u32x2*)(st + (size_t)(i0 + j) * 65536) = wo; m = mn; }
        }
    }
}

__device__ __forceinline__ void phase_mC(const Params& p, int layer, const bf16_t* mq_, const bf16_t* mk_, const bf16_t* vT_, const bf16_t* mo_, const bf16_t* ST_, bf16_t* ym_, LDSP lds, int bid, int nb) {
    const bf16_t* mq = UP(mq_); const bf16_t* mk = UP(mk_); const bf16_t* vT = UP(vT_);
    const float* cw = UP((const float*)p.m_conv_w + (size_t)layer * 3 * 2048); const float* cb = UP((const float*)p.m_conv_b + layer * 2048); const bf16_t* mo = UP(mo_); const bf16_t* ST = UP(ST_); bf16_t* ym = UP(ym_);
    LDSP qs = lds; LDSP ksm = lds + 67584; LDSP Wf = ksm; LDSP Wb = ksm + 34816;
    LASF T = (LASF)(lds + 67584 + 69632);
    LASF red = T + 2048; LASF den2 = red + 1024; LASF qn2 = den2 + 512;
    const int skip = layer == 0 ? 0 : 2;
    const int nun = 8 * (66 - skip);
    const float* gbias = UP((const float*)p.m_gate_b + layer * 16); const float* mng = UP((const float*)p.m_norm_g + layer * 256);
    const float* Gp = UP((const float*)p.G); const float* msp = UP((const float*)p.ms); const float* nstp = UP((const float*)p.nst);
    for (int u = bid; u < nun; u += nb) {
        const int tid = ltid(), lane = tid & 63, r32 = lane & 31, hi = lane >> 5; const int wid = __builtin_amdgcn_readfirstlane(tid >> 6);
        const int c = skip + u % (66 - skip), bh = u / (66 - skip), b = bh >> 2, h = bh & 3;
        const size_t row0 = (size_t)b * SEQB + 128 * c;
        const int idxf = scan_idx(0, c), idxb = scan_idx(1, c);
        const bf16_t* vp = vT + ((size_t)(bh * 256 + 32 * wid + r32)) * SEQB + 128 * c + 8 * hi;
        const int tq = tid & 127, dsel = (tid >> 7) & 1, tok = dsel ? 127 - tq : tq;
        float li = 0.f, lf = 0.f;
        if (tid < 256) { const float* g = Gp + (row0 + tok) * 16; li = g[8 * dsel + h] + gbias[8 * dsel + h]; lf = logsigf_(g[8 * dsel + 4 + h] + gbias[8 * dsel + 4 + h]); }
        const float mpf = msp[(bh * 2 + 0) * 67 + idxf], mpb = msp[(bh * 2 + 1) * 67 + idxb];
        { const int ch8 = (tid & 31) * 8; const u32x4 zz = {0u, 0u, 0u, 0u};
#pragma unroll
          for (int jb = 0; jb < 2; ++jb) { u32x4 rq[6], rk[6]; const int tb0 = 8 * (tid >> 5) + 4 * jb;
#pragma unroll
              for (int r = 0; r < 6; ++r) { const int t = tb0 - 1 + r, pos = 128 * c + t; const bool ok = pos >= 0 && pos < SEQB; const size_t off = (row0 + t) * 1024 + h * 256 + ch8;
                  rq[r] = ok ? *(const u32x4*)(mq + off) : zz; rk[r] = ok ? *(const u32x4*)(mk + off) : zz; }
#pragma unroll
              for (int tt = 0; tt < 4; ++tt) { const int t = tb0 + tt, pos = 128 * c + t; float o[8];
                  const bool hasp = (pos != 0) && (pos != LC), hasn = (pos != LC - 1) && (pos != SEQB - 1);
                  mconv8(hasp ? rq[tt] : zz, rq[tt + 1], hasn ? rq[tt + 2] : zz, cw, cb, h * 256 + ch8, 1.0f, o); *(PG8_LAS u32x4*)(qs + t * 528 + ch8 * 2) = pack8(o);
                  mconv8(hasp ? rk[tt] : zz, rk[tt + 1], hasn ? rk[tt + 2] : zz, cw, cb, 1024 + h * 256 + ch8, 0.0625f, o); *(PG8_LAS u32x4*)(ksm + t * 528 + ch8 * 2) = pack8(o); } } }
        float inc = wave_scan_sum(lf, lane);
        if (lane == 63 && wid < 4) red[wid] = inc;
        __syncthreads();
        if (wid == 1 || wid == 3) inc += red[wid - 1];
        const float av = li - inc;
        float pmx = wave_scan_max(tid < 256 ? av : -1e30f, lane);
        if (lane == 63 && wid < 4) red[8 + wid] = pmx;
        __syncthreads();
        if (wid == 1 || wid == 3) pmx = fmaxf(pmx, red[8 + wid - 1]);
        if (tid < 256) { const float mp = dsel ? mpb : mpf, g = fmaxf(mp, pmx);
            T[512 + 128 * dsel + tok] = av; T[768 + 128 * dsel + tok] = g; T[1024 + 128 * dsel + tok] = __expf(mp - g); T[1280 + 128 * dsel + tok] = __expf(-(inc + g)); }
        { const int t = tid & 127, part = tid >> 7; float sf = 0.f, sb = 0.f;
          if (idxf > 0 || idxb > 0) {
              const float* nf = nstp + ((size_t)(bh * 2 + 0) * 66 + (idxf > 0 ? idxf - 1 : 0)) * 256 + part * 64; const float* nbk = nstp + ((size_t)(bh * 2 + 1) * 66 + (idxb > 0 ? idxb - 1 : 0)) * 256 + part * 64;
              for (int d8 = 0; d8 < 8; ++d8) { float f[8]; unpack8(*(const PG8_LAS u32x4*)(qs + t * 528 + (part * 64 + d8 * 8) * 2), f);
#pragma unroll
                  for (int e = 0; e < 8; ++e) { sf += f[e] * nf[d8 * 8 + e]; sb += f[e] * nbk[d8 * 8 + e]; } } }
          qn2[(part * 2 + 0) * 128 + t] = idxf > 0 ? sf : 0.f; qn2[(part * 2 + 1) * 128 + t] = idxb > 0 ? sb : 0.f; }
        const int tj = wid & 3, sg = wid >> 2;
        f32x16 sacc[2];
#pragma unroll
        for (int e = 0; e < 2; ++e)
#pragma unroll
            for (int r = 0; r < 16; ++r) sacc[e][r] = 0.f;
#pragma unroll 4
        for (int kk = 0; kk < 16; ++kk) { const bf16x8 bq = *(const PG8_LAS bf16x8*)(qs + (32 * tj + r32) * 528 + (16 * kk + 8 * hi) * 2);
#pragma unroll
            for (int e = 0; e < 2; ++e) { const bf16x8 ak = *(const PG8_LAS bf16x8*)(ksm + (32 * (2 * sg + e) + r32) * 528 + (16 * kk + 8 * hi) * 2);
                sacc[e] = __builtin_amdgcn_mfma_f32_32x32x16_bf16(ak, bq, sacc[e], 0, 0, 0); } }
        __syncthreads();
        { const int tz2 = ltid(), r32b = tz2 & 31, hib = (tz2 >> 5) & 1;
          const int t = 32 * tj + r32b; const float gf = T[768 + t], gb = T[896 + t]; float denf = 0.f, denb = 0.f;
          const LASF Taf = T + 512 + 64 * sg + 4 * hib; const LASF Tab = T + 640 + 64 * sg + 4 * hib;
          LDSP wfp = Wf + t * 272 + (64 * sg + 4 * hib) * 2; LDSP wbp = Wb + t * 272 + (64 * sg + 4 * hib) * 2;
#pragma unroll
          for (int e = 0; e < 2; ++e)
#pragma unroll
              for (int r4 = 0; r4 < 4; ++r4) { const int s0 = 32 * (2 * sg + e) + 8 * r4 + 4 * hib; float wf[4], wb[4];
#pragma unroll
                  for (int i = 0; i < 4; ++i) { const int s = s0 + i; const float sv = sacc[e][4 * r4 + i];
                      wf[i] = (s <= t) ? sv * __expf(Taf[32 * e + 8 * r4 + i] - gf) : 0.f; wb[i] = (s >= t) ? sv * __expf(Tab[32 * e + 8 * r4 + i] - gb) : 0.f; denf += wf[i]; denb += wb[i]; }
                  u32x2 w; w.x = pk2(wf[0], wf[1]); w.y = pk2(wf[2], wf[3]); *(PG8_LAS u32x2*)(wfp + (32 * e + 8 * r4) * 2) = w;
                  w.x = pk2(wb[0], wb[1]); w.y = pk2(wb[2], wb[3]); *(PG8_LAS u32x2*)(wbp + (32 * e + 8 * r4) * 2) = w; }
          denf += __shfl_xor(denf, 32); denb += __shfl_xor(denb, 32);
          if (hib == 0) { den2[(sg * 2 + 0) * 128 + t] = denf; den2[(sg * 2 + 1) * 128 + t] = denb; } }
        __syncthreads();
        f32x16 hs[4]; unsigned hp[4][8];
#pragma unroll
        for (int dir = 0; dir < 2; ++dir) {
            const int idx = dir ? idxb : idxf;
            f32x16 acc[4];
#pragma unroll
            for (int j = 0; j < 4; ++j)
#pragma unroll
                for (int r = 0; r < 16; ++r) acc[j][r] = 0.f;
            if (idx > 0) {
                const unsigned char* Cp = (const unsigned char*)ST + ((size_t)(bh * 2 + dir) * 66 + idx - 1) * 65536 + (32 * wid + r32) * 256 + 8 * hi;
                u32x2 craw[2][8];
#pragma unroll
                for (int hb = 0; hb < 2; ++hb)
#pragma unroll
                    for (int k8 = 0; k8 < 8; ++k8) craw[hb][k8] = *(const u32x2*)(Cp + 16 * (8 * hb + k8));
#pragma unroll
                for (int hb = 0; hb < 2; ++hb) {
                    bf16x8 Cf[8];
#pragma unroll
                    for (int k8 = 0; k8 < 8; ++k8) { float cf[8]; unpk8_fp8(craw[hb][k8], cf); Cf[k8] = __builtin_bit_cast(bf16x8, pack8(cf)); }
#pragma unroll
                    for (int k8 = 0; k8 < 8; ++k8) {
#pragma unroll
                        for (int j = 0; j < 4; ++j) { const bf16x8 bq = *(const PG8_LAS bf16x8*)(qs + (32 * j + r32) * 528 + (16 * (8 * hb + k8) + 8 * hi) * 2);
                            acc[j] = __builtin_amdgcn_mfma_f32_32x32x16_bf16(Cf[k8], bq, acc[j], 0, 0, 0); }
                        if (k8 & 1) __builtin_amdgcn_sched_barrier(0); } }
                const LASF Tw = T + 1024 + 128 * dir + (ltid() & 31);
#pragma unroll
                for (int j = 0; j < 4; ++j) { const float wi = Tw[32 * j] * ST_ISC;
#pragma unroll
                    for (int r = 0; r < 16; ++r) acc[j][r] *= wi; }
            }
            { bf16x8 Vf[8];
#pragma unroll
              for (int ks = 0; ks < 8; ++ks) Vf[ks] = *(const bf16x8*)(vp + 16 * ks);
              const LDSP W = dir ? Wb : Wf;
#pragma unroll
              for (int ks = 0; ks < 8; ++ks) {
#pragma unroll
                  for (int j = 0; j < 4; ++j) { const bf16x8 bw = *(const PG8_LAS bf16x8*)(W + (32 * j + r32) * 272 + (16 * ks + 8 * hi) * 2);
                      acc[j] = __builtin_amdgcn_mfma_f32_32x32x16_bf16(Vf[ks], bw, acc[j], 0, 0, 0); }
                  if (ks & 1) __builtin_amdgcn_sched_barrier(0); } }
            const int r32c = ltid() & 31;
            const LASF qnp = qn2 + dir * 128 + r32c; const LASF dnp = den2 + dir * 128 + r32c; const LASF Tp = T + 1024 + 128 * dir + r32c;
#pragma unroll
            for (int j = 0; j < 4; ++j) {
                const float qn = qnp[32 * j] + qnp[256 + 32 * j] + qnp[512 + 32 * j] + qnp[768 + 32 * j];
                const float den = dnp[32 * j] + dnp[256 + 32 * j] + Tp[32 * j] * qn;
                const float inv = 1.0f / fmaxf(fabsf(den), Tp[256 + 32 * j]);
                if (dir == 0) {
#pragma unroll
                    for (int r = 0; r < 16; r += 2) hp[j][r >> 1] = pk2(acc[j][r] * inv, acc[j][r + 1] * inv); }
                else {
#pragma unroll
                    for (int r = 0; r < 16; r += 2) { hs[j][r] = lo16(hp[j][r >> 1]) + acc[j][r] * inv; hs[j][r + 1] = hi16(hp[j][r >> 1]) + acc[j][r + 1] * inv; } } }
        }
        u32x2 gg[4][4];
        { const int tz = ltid(), r32o = tz & 31, hio = (tz >> 5) & 1, wido = tz >> 6; const size_t obase = (row0 + r32o) * 1024 + h * 256 + 32 * wido + 4 * hio;
#pragma unroll
          for (int j = 0; j < 4; ++j)
#pragma unroll
              for (int r4 = 0; r4 < 4; ++r4) gg[j][r4] = *(const u32x2*)(mo + obase + (size_t)j * 32 * 1024 + 8 * r4); }
#pragma unroll
        for (int j = 0; j < 4; ++j) { float ssq = 0.f;
#pragma unroll
            for (int r = 0; r < 16; ++r) ssq += hs[j][r] * hs[j][r];
            ssq += __shfl_xor(ssq, 32); const int tzr = ltid(); if (((tzr >> 5) & 1) == 0) red[(tzr >> 6) * 128 + 32 * j + (tzr & 31)] = ssq; }
        __syncthreads();
        {
          const int tz = ltid(), r32o = tz & 31, hio = (tz >> 5) & 1, wido = tz >> 6;
          const size_t obase = (row0 + r32o) * 1024 + h * 256 + 32 * wido + 4 * hio;
#pragma unroll
          for (int j = 0; j < 4; ++j) { const int t = 32 * j + r32o; float tot = 0.f;
#pragma unroll
              for (int w = 0; w < 8; ++w) tot += red[w * 128 + t];
              const float rstd = rsqrtf(tot * (1.0f / 256.0f) + EPS_);
#pragma unroll
              for (int r4 = 0; r4 < 4; ++r4) { const int v0 = 32 * wido + 8 * r4 + 4 * hio; const size_t off = obase + (size_t)j * 32 * 1024 + 8 * r4;
                  const u32x2 g = gg[j][r4]; u32x2 w;
                  w.x = pk2(hs[j][4 * r4] * rstd * mng[v0] * sigmoidf_(lo16(g.x)), hs[j][4 * r4 + 1] * rstd * mng[v0 + 1] * sigmoidf_(hi16(g.x)));
                  w.y = pk2(hs[j][4 * r4 + 2] * rstd * mng[v0 + 2] * sigmoidf_(lo16(g.y)), hs[j][4 * r4 + 3] * rstd * mng[v0 + 3] * sigmoidf_(hi16(g.y)));
                  *(u32x2*)(ym + off) = w; } } }
        __syncthreads();
    }
}

__device__ __forceinline__ void hconv8(const unsigned char* src, bool hasp, bool hasn, const float* cw, const float* cb, int cch, float (&o)[8]) {
    float up[8], uc[8], un[8];
    unpk8_fp8(*(const u32x2*)src, uc);
    if (hasp) unpk8_fp8(*(const u32x2*)(src - 1024), up); else {
#pragma unroll
        for (int i = 0; i < 8; ++i) up[i] = 0.f; }
    if (hasn) unpk8_fp8(*(const u32x2*)(src + 1024), un); else {
#pragma unroll
        for (int i = 0; i < 8; ++i) un[i] = 0.f; }
#pragma unroll
    for (int i = 0; i < 8; ++i) o[i] = cb[cch + i] + GT_ISC * (up[i] * cw[cch + i] + uc[i] * cw[3072 + cch + i] + un[i] * cw[6144 + cch + i]);
}
struct H3 { u32x2 p, c, n; };
__device__ __forceinline__ H3 hload3(const unsigned char* src, bool hasp, bool hasn) { H3 r; const u32x2 z4 = {0u, 0u};
    r.c = *(const u32x2*)src; r.p = hasp ? *(const u32x2*)(src - 1024) : z4; r.n = hasn ? *(const u32x2*)(src + 1024) : z4; return r; }
__device__ __forceinline__ void hcomp8(const H3& r, const float* cw, const float* cb, int cch, float (&o)[8]) {
    float up[8], uc[8], un[8]; unpk8_fp8(r.p, up); unpk8_fp8(r.c, uc); unpk8_fp8(r.n, un);
#pragma unroll
    for (int i = 0; i < 8; ++i) o[i] = cb[cch + i] + GT_ISC * (up[i] * cw[cch + i] + uc[i] * cw[3072 + cch + i] + un[i] * cw[6144 + cch + i]);
}
__device__ __forceinline__ void hw_stage(LASF wl, const float* cw, const float* cb, int conv0, int nconv, int cg) {
    for (int i = ltid(); i < nconv * 1024; i += NTH) { const int cv = i >> 10, r = (i >> 8) & 3, ch = i & 255; const int cch = (conv0 + cv) * 1024 + cg * 256 + ch;
        wl[i] = r == 0 ? cb[cch] : cw[(r - 1) * 3072 + cch]; } }
__device__ __forceinline__ void hcomp8l(const H3& r, const LASF w, float (&o)[8]) {
    float up[8], uc[8], un[8]; unpk8_fp8(r.p, up); unpk8_fp8(r.c, uc); unpk8_fp8(r.n, un);
    const f32x4 b0 = *(const PG8_LAS f32x4*)(w), b1 = *(const PG8_LAS f32x4*)(w + 4), p0 = *(const PG8_LAS f32x4*)(w + 256), p1 = *(const PG8_LAS f32x4*)(w + 260);
    const f32x4 c0 = *(const PG8_LAS f32x4*)(w + 512), c1 = *(const PG8_LAS f32x4*)(w + 516), n0 = *(const PG8_LAS f32x4*)(w + 768), n1 = *(const PG8_LAS f32x4*)(w + 772);
#pragma unroll
    for (int i = 0; i < 4; ++i) { o[i] = b0[i] + GT_ISC * (up[i] * p0[i] + uc[i] * c0[i] + un[i] * n0[i]); o[4 + i] = b1[i] + GT_ISC * (up[4 + i] * p1[i] + uc[4 + i] * c1[i] + un[4 + i] * n1[i]); }
}
__device__ __forceinline__ void phase_hprep(const Params& p, int layer, const unsigned char* hx1, const unsigned char* hv, bf16_t* zT, LDSP lds, int bid, int nb) {
    const int tid = ltid(); LASF zt = (LASF)lds;
    const float* cw = p.h_conv_w + (size_t)layer * 3 * 3072; const float* cb = p.h_conv_b + layer * 3072;
    constexpr int NU = 2 * 128 * 4;
    u32x2 ra[4], rb[4];
#define HP_LOAD(u_) do { const int cg_ = (u_) & 3, tb_ = ((u_) >> 2) & 127, b_ = (u_) >> 9; const int tl_ = tb_ * 64 + (tid >> 3); const size_t row_ = (size_t)b_ * SEQB + LC + tl_; const bool hp_ = tl_ != 0, hn_ = tl_ != LL - 1; \
        _Pragma("unroll") for (int v8 = 0; v8 < 4; ++v8) { const int c_ = cg_ * 256 + v8 * 64 + (tid & 7) * 8; ra[v8] = *(const u32x2*)(hx1 + row_ * 1024 + c_); rb[v8] = *(const u32x2*)(hv + row_ * 1024 + c_); } } while (0)
    int u = bid; int cgl = -1; LASF wl = zt + 16512;
    if (u < NU) HP_LOAD(u);
    for (; u < NU; u += nb) {
        const int cg = u & 3, tb = (u >> 2) & 127, b = u >> 9;
        if (cg != cgl) { hw_stage(wl, cw, cb, 1, 2, cg); cgl = cg; __syncthreads(); }
        const int t = tid >> 3, tl = tb * 64 + t; const size_t row = (size_t)b * SEQB + LC + tl; const bool hasp = tl != 0, hasn = tl != LL - 1; const u32x2 z4 = {0u, 0u};
#pragma unroll
        for (int v8 = 0; v8 < 4; ++v8) { const int cl = v8 * 64 + (tid & 7) * 8, c = cg * 256 + cl; float x1[8], vv[8];
            H3 ha, hb; ha.c = ra[v8]; hb.c = rb[v8];
            ha.p = hasp ? *(const u32x2*)(hx1 + (row - 1) * 1024 + c) : z4; ha.n = hasn ? *(const u32x2*)(hx1 + (row + 1) * 1024 + c) : z4;
            hb.p = hasp ? *(const u32x2*)(hv + (row - 1) * 1024 + c) : z4; hb.n = hasn ? *(const u32x2*)(hv + (row + 1) * 1024 + c) : z4;
            hcomp8l(ha, wl + cl, x1); hcomp8l(hb, wl + 1024 + cl, vv);
#pragma unroll
            for (int i = 0; i < 8; ++i) zt[t * 257 + cl + i] = vv[i] * x1[i]; }
        __syncthreads();
        if (u + nb < NU) HP_LOAD(u + nb);
        __builtin_amdgcn_sched_barrier(0);
        { const int cl = tid >> 1, th = tid & 1; bf16_t* dst = zT + ((size_t)(b * 1024 + cg * 256 + cl)) * LL + tb * 64 + 32 * th;
#pragma unroll
          for (int q = 0; q < 4; ++q) { float f[8];
#pragma unroll
              for (int e = 0; e < 8; ++e) f[e] = zt[(32 * th + 8 * q + e) * 257 + cl];
              *(u32x4*)(dst + 8 * q) = pack8(f); } }
        __syncthreads();
    }
#undef HP_LOAD
}

__device__ __forceinline__ f32x2v cmul_(f32x2v a, f32x2v b) { return mk2_(a.x * b.x - a.y * b.y, a.x * b.y + a.y * b.x); }
__device__ __forceinline__ f32x2v cmulc_(f32x2v a, f32x2v b) { return mk2_(a.x * b.x + a.y * b.y, a.y * b.x - a.x * b.y); }
__device__ __forceinline__ f32x2v cadd_(f32x2v a, f32x2v b) { return mk2_(a.x + b.x, a.y + b.y); }
__device__ __forceinline__ f32x2v csub_(f32x2v a, f32x2v b) { return mk2_(a.x - b.x, a.y - b.y); }
__device__ __forceinline__ int fphys(int i) { return i + (i >> 5); }
template <bool INV> __device__ __forceinline__ void bfly16(f32x2v (&v)[16], const f32x2v w1) {
    const f32x2v w2 = cmul_(w1, w1), w4 = cmul_(w2, w2), w8 = cmul_(w4, w4);
    const float C1 = 0.92387953251128674f, S1 = 0.38268343236508977f, R2 = 0.70710678118654752f;
    const f32x2v c16[8] = {mk2_(1.f, 0.f), mk2_(C1, -S1), mk2_(R2, -R2), mk2_(S1, -C1), mk2_(0.f, -1.f), mk2_(-S1, -C1), mk2_(-R2, -R2), mk2_(-C1, -S1)};
    if (!INV) {
#pragma unroll
        for (int m = 0; m < 8; ++m) { const f32x2v W = cmul_(w1, c16[m]); const f32x2v a = v[m], b = v[m + 8]; v[m] = cadd_(a, b); v[m + 8] = cmul_(csub_(a, b), W); }
#pragma unroll
        for (int g = 0; g < 16; g += 8)
#pragma unroll
            for (int m = 0; m < 4; ++m) { const f32x2v W = cmul_(w2, c16[2 * m]); const f32x2v a = v[g + m], b = v[g + m + 4]; v[g + m] = cadd_(a, b); v[g + m + 4] = cmul_(csub_(a, b), W); }
#pragma unroll
        for (int g = 0; g < 16; g += 4)
#pragma unroll
            for (int m = 0; m < 2; ++m) { const f32x2v W = cmul_(w4, c16[4 * m]); const f32x2v a = v[g + m], b = v[g + m + 2]; v[g + m] = cadd_(a, b); v[g + m + 2] = cmul_(csub_(a, b), W); }
#pragma unroll
        for (int g = 0; g < 16; g += 2) { const f32x2v a = v[g], b = v[g + 1]; v[g] = cadd_(a, b); v[g + 1] = cmul_(csub_(a, b), w8); }
    } else {
#pragma unroll
        for (int g = 0; g < 16; g += 2) { const f32x2v a = v[g], b = cmulc_(v[g + 1], w8); v[g] = cadd_(a, b); v[g + 1] = csub_(a, b); }
#pragma unroll
        for (int g = 0; g < 16; g += 4)
#pragma unroll
            for (int m = 0; m < 2; ++m) { const f32x2v W = cmul_(w4, c16[4 * m]); const f32x2v a = v[g + m], b = cmulc_(v[g + m + 2], W); v[g + m] = cadd_(a, b); v[g + m + 2] = csub_(a, b); }
#pragma unroll
        for (int g = 0; g < 16; g += 8)
#pragma unroll
            for (int m = 0; m < 4; ++m) { const f32x2v W = cmul_(w2, c16[2 * m]); const f32x2v a = v[g + m], b = cmulc_(v[g + m + 4], W); v[g + m] = cadd_(a, b); v[g + m + 4] = csub_(a, b); }
#pragma unroll
        for (int m = 0; m < 8; ++m) { const f32x2v W = cmul_(w1, c16[m]); const f32x2v a = v[m], b = cmulc_(v[m + 8], W); v[m] = cadd_(a, b); v[m + 8] = csub_(a, b); }
    }
}
template <bool INV, int S, bool SYNC = true> __device__ __forceinline__ void fft_pass16(PG8_LAS f32x2v* cb) {
    constexpr int STR = S / 16;
    int tz = ltid();
#pragma unroll 2
    for (int k = 0; k < 2; ++k) { const int q = tz + NTH * k; const int j = q & (STR - 1), base = (q / STR) * S + j;
        f32x2v v[16];
#pragma unroll
        for (int m = 0; m < 16; ++m) v[m] = cb[fphys(base + STR * m)];
        const float rev = (float)j * (1.0f / (float)S); const f32x2v w1 = mk2_(cos2pi(rev), -sin2pi(rev));
        bfly16<INV>(v, w1);
#pragma unroll
        for (int m = 0; m < 16; ++m) cb[fphys(base + STR * m)] = v[m]; }
    if (SYNC) __syncthreads();
}
template <int NM> __device__ __forceinline__ void fft_pass_first(PG8_LAS f32x2v* cb, const bf16_t* s0, const bf16_t* s1) {
    const int tz = ltid();
    bf16_t r0[2][NM], r1[2][NM];
#pragma unroll
    for (int k = 0; k < 2; ++k)
#pragma unroll
        for (int m = 0; m < NM; ++m) { r0[k][m] = s0[tz + NTH * k + 1024 * m]; r1[k][m] = s1 ? s1[tz + NTH * k + 1024 * m] : (bf16_t)0; }
#pragma unroll
    for (int k = 0; k < 2; ++k) { const int j = tz + NTH * k;
        f32x2v v[16];
#pragma unroll
        for (int m = 0; m < 16; ++m) v[m] = m < NM ? mk2_(bf2f(r0[k][m]), bf2f(r1[k][m])) : mk2_(0.f, 0.f);
        const float rev = (float)j * (1.0f / 16384.0f); const f32x2v w1 = mk2_(cos2pi(rev), -sin2pi(rev));
        bfly16<false>(v, w1);
#pragma unroll
        for (int m = 0; m < 16; ++m) cb[fphys(j + 1024 * m)] = v[m]; }
    __syncthreads();
}
__device__ __forceinline__ void fft_pass_last(PG8_LAS f32x2v* cb, bf16_t* d0, bf16_t* d1) {
    const int tz = ltid();
#pragma unroll 1
    for (int k = 0; k < 2; ++k) { const int j = tz + NTH * k;
        f32x2v v[16];
#pragma unroll
        for (int m = 0; m < 16; ++m) v[m] = cb[fphys(j + 1024 * m)];
        const float rev = (float)j * (1.0f / 16384.0f); const f32x2v w1 = mk2_(cos2pi(rev), -sin2pi(rev));
        bfly16<true>(v, w1);
#pragma unroll
        for (int m = 0; m < 8; ++m) { d0[j + 1024 * m] = f2bf(v[m].x); d1[j + 1024 * m] = f2bf(v[m].y); } }
    __syncthreads();
}
__device__ __forceinline__ void r4_dif(f32x2v (&a)[4]) {
    const f32x2v b0 = cadd_(a[0], a[2]), b2 = csub_(a[0], a[2]), b1 = cadd_(a[1], a[3]); const f32x2v d = csub_(a[1], a[3]); const f32x2v b3 = mk2_(d.y, -d.x);
    a[0] = cadd_(b0, b1); a[1] = csub_(b0, b1); a[2] = cadd_(b2, b3); a[3] = csub_(b2, b3); }
__device__ __forceinline__ void r4_dit(f32x2v (&c)[4]) {
    const f32x2v b0 = cadd_(c[0], c[1]), b1 = csub_(c[0], c[1]), b2 = cadd_(c[2], c[3]), b3 = csub_(c[2], c[3]); const f32x2v ib3 = mk2_(-b3.y, b3.x);
    c[0] = cadd_(b0, b2); c[2] = csub_(b0, b2); c[1] = cadd_(b1, ib3); c[3] = csub_(b1, ib3); }

__device__ __forceinline__ void phase_fft(const Params& p, int layer, const bf16_t* tapsT, bf16_t* zT, float* Hscr, LDSP lds, int bid, int nb) {
    PG8_LAS f32x2v* cb = (PG8_LAS f32x2v*)lds; const int tid = ltid();
    for (int c = bid; c < 1024; c += nb) {
        fft_pass_first<16>(cb, tapsT + (size_t)c * 16384, nullptr); fft_pass16<false, 1024, false>(cb); fft_pass16<false, 64, false>(cb);
        float ssq_c = 0.f;
#pragma unroll
        for (int q = 0; q < 8; ++q) ssq_c += p.sumsq[((size_t)(layer * 64 + (c >> 5)) * 8 + q) * 32 + (c & 31)];
#pragma unroll
        for (int q = 0; q < 8; ++q) ssq_c += p.sumsq[((size_t)(layer * 64 + 32 + (c >> 5)) * 8 + q) * 32 + (c & 31)];
        const float scale = rsqrtf(ssq_c + EPS_) * (1.0f / 16384.0f);
        f32x2v H[8][4];
        { const int tz = ltid();
#pragma unroll
          for (int k = 0; k < 8; ++k) { const int q = 256 * (tz >> 6) + 2048 * (k >> 2) + 64 * (k & 3) + (tz & 63); f32x2v a[4];
#pragma unroll
              for (int m = 0; m < 4; ++m) a[m] = cb[fphys(4 * q + m)];
              r4_dif(a);
#pragma unroll
              for (int m = 0; m < 4; ++m) H[k][m] = mk2_(a[m].x * scale, a[m].y * scale); } }
        __syncthreads();
        fft_pass_first<8>(cb, zT + (size_t)c * LL, zT + (size_t)(1024 + c) * LL); fft_pass16<false, 1024, false>(cb); fft_pass16<false, 64, false>(cb);
        { const int tz = ltid();
#pragma unroll
          for (int k = 0; k < 8; ++k) { const int q = 256 * (tz >> 6) + 2048 * (k >> 2) + 64 * (k & 3) + (tz & 63); f32x2v a[4];
#pragma unroll
              for (int m = 0; m < 4; ++m) a[m] = cb[fphys(4 * q + m)];
              r4_dif(a);
#pragma unroll
              for (int m = 0; m < 4; ++m) a[m] = cmul_(a[m], H[k][m]);
              r4_dit(a);
#pragma unroll
              for (int m = 0; m < 4; ++m) cb[fphys(4 * q + m)] = a[m]; } }
        fft_pass16<true, 64, false>(cb); fft_pass16<true, 1024>(cb);
        fft_pass_last(cb, zT + (size_t)c * LL, zT + (size_t)(1024 + c) * LL);
    }
}
__device__ __forceinline__ void phase_hfin(const Params& p, int layer, const unsigned char* __restrict__ hx0, const unsigned char* __restrict__ hx1, const unsigned char* __restrict__ hv, const bf16_t* __restrict__ yT, bf16_t* __restrict__ yh, LDSP lds, int bid, int nb) {
    const int tid = ltid(); LASF yt = (LASF)lds;
    const float* cw = p.h_conv_w + (size_t)layer * 3 * 3072; const float* cb = p.h_conv_b + layer * 3072; const float* hb = p.h_bias + layer * 1024;
    int cgl = -1; LASF wl = yt + 16640; LASF hbl = wl + 3072;
    for (int u = bid; u < 2 * 128 * 4; u += nb) {
        const int cg = u & 3, tb = (u >> 2) & 127, b = u >> 9;
        if (cg != cgl) { hw_stage(wl, cw, cb, 0, 3, cg); if (tid < 256) hbl[tid] = hb[cg * 256 + tid]; cgl = cg; }
        u32x2 rc0[4], rc1[4], rc2[4];
        { const size_t ro = ((size_t)b * SEQB + LC + tb * 64 + (tid >> 3)) * 1024 + cg * 256 + (tid & 7) * 8;
#pragma unroll
          for (int v8 = 0; v8 < 4; ++v8) { rc0[v8] = *(const u32x2*)(hx0 + ro + v8 * 64); rc1[v8] = *(const u32x2*)(hx1 + ro + v8 * 64); rc2[v8] = *(const u32x2*)(hv + ro + v8 * 64); } }
        { const int cl = tid >> 1, th = tid & 1; const bf16_t* src = yT + ((size_t)(b * 1024 + cg * 256 + cl)) * LL + tb * 64 + 32 * th;
          u32x4 yv[4];
#pragma unroll
          for (int q = 0; q < 4; ++q) yv[q] = *(const u32x4*)(src + 8 * q);
#pragma unroll
          for (int q = 0; q < 4; ++q) { float f[8]; unpack8(yv[q], f);
#pragma unroll
              for (int e = 0; e < 8; ++e) yt[cl * 65 + 32 * th + 8 * q + e] = f[e]; } }
        __syncthreads();
        const int t = tid >> 3, tl = tb * 64 + t; const size_t row = (size_t)b * SEQB + LC + tl; const bool hasp = tl != 0, hasn = tl != LL - 1;
#pragma unroll
        for (int v8 = 0; v8 < 4; ++v8) { const int cl = v8 * 64 + (tid & 7) * 8, c = cg * 256 + cl; float x0[8], x1[8], vv[8], o[8]; const u32x2 z4 = {0u, 0u};
            H3 h0, h1, h2; h0.c = rc0[v8]; h1.c = rc1[v8]; h2.c = rc2[v8];
            h0.p = hasp ? *(const u32x2*)(hx0 + (row - 1) * 1024 + c) : z4; h0.n = hasn ? *(const u32x2*)(hx0 + (row + 1) * 1024 + c) : z4;
            h1.p = hasp ? *(const u32x2*)(hx1 + (row - 1) * 1024 + c) : z4; h1.n = hasn ? *(const u32x2*)(hx1 + (row + 1) * 1024 + c) : z4;
            h2.p = hasp ? *(const u32x2*)(hv + (row - 1) * 1024 + c) : z4; h2.n = hasn ? *(const u32x2*)(hv + (row + 1) * 1024 + c) : z4;
            hcomp8l(h0, wl + cl, x0); hcomp8l(h1, wl + 1024 + cl, x1); hcomp8l(h2, wl + 2048 + cl, vv);
            const f32x4 hb0 = *(const PG8_LAS f32x4*)(hbl + cl), hb1 = *(const PG8_LAS f32x4*)(hbl + cl + 4);
#pragma unroll
            for (int i = 0; i < 8; ++i) o[i] = x0[i] * (yt[(cl + i) * 65 + t] + (i < 4 ? hb0[i] : hb1[i - 4]) * vv[i] * x1[i]);
            *(u32x4*)(yh + row * 1024 + c) = pack8(o); }
        __syncthreads();
    }
}
__device__ __forceinline__ void phase_hctx(const Params& p, int layer, const unsigned char* hx0, const unsigned char* hx1, const unsigned char* hv, bf16_t* yh, LDSP lds, int bid, int nb) {
    const int tid = ltid(); LASF zc = (LASF)lds, x0c = zc + 2048, hf = x0c + 2048, hbk = hf + 2048;
    const float* cw = p.h_conv_w + (size_t)layer * 3 * 3072; const float* cb = p.h_conv_b + layer * 3072; const float* hbias = p.h_bias + layer * 1024;
    for (int u = bid; u < 256; u += nb) {
        const int b = u >> 7, c0 = (u & 127) * 8;
        if (tid < 256) { const int t = tid; const size_t row = (size_t)b * SEQB + t; const bool hasp = t != 0, hasn = t != LC - 1; float x0[8], x1[8], vv[8];
            hconv8(hx0 + row * 1024 + c0, hasp, hasn, cw, cb, c0, x0); hconv8(hx1 + row * 1024 + c0, hasp, hasn, cw, cb, 1024 + c0, x1); hconv8(hv + row * 1024 + c0, hasp, hasn, cw, cb, 2048 + c0, vv);
#pragma unroll
            for (int i = 0; i < 8; ++i) { zc[t * 8 + i] = vv[i] * x1[i]; x0c[t * 8 + i] = x0[i]; } }
        for (int i = tid; i < 256 * 8; i += NTH) { const int j = i & 255, cl = i >> 8; const float rs = rsqrtf(p.sumsqC[2048 + c0 + cl] + p.sumsqC[2048 + 1024 + c0 + cl] + EPS_);
            hf[j * 8 + cl] = p.hfC[(size_t)(c0 + cl) * 256 + j] * rs; hbk[j * 8 + cl] = p.hbC[(size_t)(c0 + cl) * 256 + j] * rs; }
        __syncthreads();
        { const int cl = tid & 7, tg = tid >> 3;
#pragma unroll 1
          for (int ti = 0; ti < 4; ++ti) { const int t = tg + 64 * ti; float y = 0.f;
#pragma unroll 4
              for (int j = 0; j <= t; ++j) y += hf[j * 8 + cl] * zc[(t - j) * 8 + cl];
#pragma unroll 4
              for (int j = 1; j <= 255 - t; ++j) y += hbk[j * 8 + cl] * zc[(t + j) * 8 + cl];
              const float o = x0c[t * 8 + cl] * (y + hbias[c0 + cl] * zc[t * 8 + cl]);
              yh[((size_t)b * SEQB + t) * 1024 + c0 + cl] = f2bf(o); } }
        __syncthreads();
    }
}

__device__ __forceinline__ bool xcd_tile(int i, int c, int G, int T, int& tile) {
    if (G & 7) { tile = i * G + c; return tile < T; }
    const int per = G >> 3, x = c & 7, j = c >> 3, q = i * per + j, base = T >> 3, rem = T & 7;
    const int start = x * base + (x < rem ? x : rem), size = base + (x < rem ? 1 : 0);
    tile = start + q; return q < size; }
struct MergeOrder { int ntile, G, c, lat_only;
    __device__ __forceinline__ bool next(int i, pg8::Unit& u) const { const int tile = (i / 3) * G + c, j = i - (i / 3) * 3; if (tile >= ntile) return false;
        int pi = tile >> 2; const int n = tile & 3; if (lat_only) pi = (pi >> 5) * 33 + 1 + (pi & 31);
        u.pm = j * NPAN + pi; u.pn = j * 4 + n; return true; }
    __device__ __forceinline__ void a_ready(const pg8::Unit&) const {}
    __device__ __forceinline__ void done(const pg8::Unit&) const {} };
struct MergeEpi { static constexpr bool PERM = true, AFTER_DRAIN = false;
    const bf16_t* gates; const float* mb; bf16_t* ysum;
    __device__ __forceinline__ void operator()(const f32x4 (&acc)[2][2][4][2], const pg8::Unit& u, int wr, int wc, int fr, int fq) const {
        const int j = u.pn >> 2, pi = u.pm - j * NPAN, nt = u.pn & 3;
        const int row0 = pi * 256 + wr * 64 + fr, col0 = nt * 256 + wc * 32 + 8 * fq;
        const unsigned char* gj = (const unsigned char*)(gates + (size_t)j * TT * 1024);
#pragma unroll
        for (int bj = 0; bj < 2; ++bj) { const int col = col0 + bj * 128; float mbv[8];
#pragma unroll
            for (int i = 0; i < 8; ++i) mbv[i] = mb[j * 1024 + col + i];
            u32x2 gv[2][4]; u32x4 ov[2][4];
#pragma unroll
            for (int ai = 0; ai < 2; ++ai)
#pragma unroll
                for (int m = 0; m < 4; ++m) { const size_t off = (size_t)(row0 + ai * 128 + m * 16) * 1024 + col; gv[ai][m] = *(const u32x2*)(gj + off); if (j > 0) ov[ai][m] = *(const u32x4*)(ysum + off); }
            __builtin_amdgcn_sched_barrier(0);
#pragma unroll
            for (int ai = 0; ai < 2; ++ai) {
#pragma unroll
                for (int m = 0; m < 4; ++m) { const size_t off = (size_t)(row0 + ai * 128 + m * 16) * 1024 + col;
                    float g[8], o[8]; unpk8_fp8(gv[ai][m], g);
#pragma unroll
                    for (int i = 0; i < 8; ++i) o[i] = sigmoidf_(g[i] * GT_ISC + mbv[i]) * acc[ai][bj][m][i >> 2][i & 3];
                    if (j > 0) { float old[8]; unpack8(ov[ai][m], old);
#pragma unroll
                        for (int i = 0; i < 8; ++i) o[i] += old[i]; }
                    *(u32x4*)(ysum + off) = pack8(o); } }
            __builtin_amdgcn_sched_barrier(0); }
    } };
struct OutOrder { int ntile, G, c, lat_only;
    __device__ __forceinline__ bool next(int i, pg8::Unit& u) const { const int tile = i * G + c; if (tile >= ntile) return false;
        int pi = tile >> 2; if (lat_only) pi = (pi >> 5) * 33 + 1 + (pi & 31); u.pm = pi; u.pn = tile & 3; return true; }
    __device__ __forceinline__ void a_ready(const pg8::Unit&) const {}
    __device__ __forceinline__ void done(const pg8::Unit&) const {} };
struct OutEpi { static constexpr bool PERM = false, AFTER_DRAIN = false;
    const Params* p; int layer;
    __device__ __forceinline__ void operator()(const f32x4 (&acc)[2][2][4][2], const pg8::Unit& u, int wr, int wc, int fr, int fq) const {
        const int row0 = u.pm * 256 + wr * 64 + fr, col0 = u.pn * 256 + wc * 32 + 4 * fq;
        const float* g1 = modvec(*p, layer, u.pm * 256) + 2048;
        f32x4 gq[4];
#pragma unroll
        for (int q = 0; q < 4; ++q) gq[q] = *(const f32x4*)(g1 + col0 + (q >> 1) * 128 + (q & 1) * 16);
#pragma unroll
        for (int ai = 0; ai < 2; ++ai) { f32x4 xv[16];
#pragma unroll
            for (int m = 0; m < 4; ++m) { const float* rin = resid_row_in(*p, layer, row0 + ai * 128 + m * 16);
#pragma unroll
                for (int q = 0; q < 4; ++q) xv[m * 4 + q] = *(const f32x4*)(rin + col0 + (q >> 1) * 128 + (q & 1) * 16); }
            __builtin_amdgcn_sched_barrier(0);
#pragma unroll
            for (int m = 0; m < 4; ++m) { float* ro = resid_row(*p, row0 + ai * 128 + m * 16);
#pragma unroll
                for (int q = 0; q < 4; ++q) *(f32x4*)(ro + col0 + (q >> 1) * 128 + (q & 1) * 16) = xv[m * 4 + q] + gq[q] * acc[ai][q >> 1][m][q & 1]; }
            __builtin_amdgcn_sched_barrier(0); }
    } };
struct MoeOrder { const PG8_LAS int* te; int ntl, G, c;
    __device__ __forceinline__ bool next(int i, pg8::Unit& u) const { int L; if (!xcd_tile(i, c, G, ntl * 4, L)) return false; const int tile = L >> 2; u.pm = tile; u.pn = te[tile] * 4 + (L & 3); return true; }
    __device__ __forceinline__ void a_ready(const pg8::Unit&) const {}
    __device__ __forceinline__ void done(const pg8::Unit&) const {} };
struct E1Epi { static constexpr bool PERM = true, AFTER_DRAIN = false;
    bf16_t* H;
    __device__ __forceinline__ void operator()(const f32x4 (&acc)[2][2][4][2], const pg8::Unit& u, int wr, int wc, int fr, int fq) const {
        const int row0 = u.pm * 256 + wr * 64 + fr, hid0 = ((u.pn & 3) * 256 + wc * 32 + 8 * fq) >> 1;
#pragma unroll
        for (int ai = 0; ai < 2; ++ai)
#pragma unroll
            for (int m = 0; m < 4; ++m)
#pragma unroll
                for (int bj = 0; bj < 2; ++bj) { const f32x4 a = acc[ai][bj][m][0], b = acc[ai][bj][m][1]; u32x2 w;
                    w.x = pk2(siluf_(a[0]) * b[0], siluf_(a[1]) * b[1]); w.y = pk2(siluf_(a[2]) * b[2], siluf_(a[3]) * b[3]);
                    *(u32x2*)(H + (size_t)(row0 + ai * 128 + m * 16) * 512 + hid0 + bj * 64) = w; }
    } };

constexpr float YB_SC = 16.0f, YB_ISC = 0.0625f;
struct E2Epi { static constexpr bool PERM = true, AFTER_DRAIN = false;
    unsigned char* Y;
    __device__ __forceinline__ void operator()(const f32x4 (&acc)[2][2][4][2], const pg8::Unit& u, int wr, int wc, int fr, int fq) const {
        const int row0 = u.pm * 256 + wr * 64 + fr, col0 = (u.pn & 3) * 256 + wc * 32 + 8 * fq;
#pragma unroll
        for (int ai = 0; ai < 2; ++ai)
#pragma unroll
            for (int m = 0; m < 4; ++m)
#pragma unroll
                for (int bj = 0; bj < 2; ++bj) { const f32x4 a = acc[ai][bj][m][0], b = acc[ai][bj][m][1]; u32x2 w;
                    w.x = pk4_fp8(a[0] * YB_SC, a[1] * YB_SC, a[2] * YB_SC, a[3] * YB_SC); w.y = pk4_fp8(b[0] * YB_SC, b[1] * YB_SC, b[2] * YB_SC, b[3] * YB_SC);
                    *(u32x2*)(Y + (size_t)(row0 + ai * 128 + m * 16) * 1024 + col0 + bj * 128) = w; }
    } };

struct EpiReg { static constexpr bool PERM = true, AFTER_DRAIN = false;
    bf16_t* O; size_t stride; bf16_t* O6; int col6; int f8;
    __device__ __forceinline__ void operator()(const f32x4 (&acc)[2][2][4][2], const pg8::Unit& u, int wr, int wc, int fr, int fq) const {
        const int row0 = u.pm * 256 + wr * 64 + fr; const int colt = u.pn * 256, reg = colt >> 10;
        bf16_t* base = reg < 6 ? O + (size_t)reg * stride : O6; const int col0 = (reg < 6 ? colt - (reg << 10) : col6 + colt - 6144) + wc * 32 + 8 * fq;
        if (reg >= f8) { unsigned char* b8 = (unsigned char*)base;
#pragma unroll
            for (int ai = 0; ai < 2; ++ai)
#pragma unroll
                for (int m = 0; m < 4; ++m) { unsigned char* rowp = b8 + (size_t)(row0 + ai * 128 + m * 16) * 1024 + col0;
#pragma unroll
                    for (int bj = 0; bj < 2; ++bj) { const f32x4 v0 = acc[ai][bj][m][0], v1 = acc[ai][bj][m][1]; u32x2 w;
                        w.x = pk4_fp8(v0[0] * GT_SC, v0[1] * GT_SC, v0[2] * GT_SC, v0[3] * GT_SC); w.y = pk4_fp8(v1[0] * GT_SC, v1[1] * GT_SC, v1[2] * GT_SC, v1[3] * GT_SC);
                        *(u32x2*)(rowp + bj * 128) = w; } }
            return; }
#pragma unroll
        for (int ai = 0; ai < 2; ++ai)
#pragma unroll
            for (int m = 0; m < 4; ++m) { bf16_t* rowp = base + (size_t)(row0 + ai * 128 + m * 16) * 1024 + col0;
#pragma unroll
                for (int bj = 0; bj < 2; ++bj) { const f32x4 v0 = acc[ai][bj][m][0], v1 = acc[ai][bj][m][1]; u32x4 w;
                    w.x = pk2(v0[0], v0[1]); w.y = pk2(v0[2], v0[3]); w.z = pk2(v1[0], v1[1]); w.w = pk2(v1[2], v1[3]);
                    *(u32x4*)(rowp + bj * 128) = w; } }
    } };

__device__ __forceinline__ void phase_norm2_router(const Params& p, int layer, LDSP lds, int bid, int nb, bool count = true) {
    LASF rw = (LASF)lds;
    const int tid = ltid(), lane = tid & 63, wid = tid >> 6;
    for (int i = bid * NTH + tid; i < TPAD; i += nb * NTH) p.rowidx[i] = 0;
    PG8_LAS int* hist = (PG8_LAS int*)(lds + 148 * 1024);
    if (tid < 32) hist[tid] = 0;
    { float4 wv[16];
#pragma unroll
      for (int j = 0; j < 16; ++j) { const int i = tid + NTH * j; wv[j] = *(const float4*)(p.router_w + (i >> 3) * 32 + (i & 7) * 4); }
#pragma unroll
      for (int j = 0; j < 16; ++j) { const int i = tid + NTH * j, n = i >> 3, e4 = (i & 7) * 4; rw[n * 36 + e4] = wv[j].x; rw[n * 36 + e4 + 1] = wv[j].y; rw[n * 36 + e4 + 2] = wv[j].z; rw[n * 36 + e4 + 3] = wv[j].w; } }
    __syncthreads();
    const float* gn = p.norm2_g + layer * 1024;
    float rb[8];
    { const f32x4 r0 = *(const f32x4*)(p.router_b + 8 * (lane >> 4)), r1 = *(const f32x4*)(p.router_b + 8 * (lane >> 4) + 4);
      rb[0] = r0[0]; rb[1] = r0[1]; rb[2] = r0[2]; rb[3] = r0[3]; rb[4] = r1[0]; rb[5] = r1[1]; rb[6] = r1[2]; rb[7] = r1[3]; }
    float gv[16], scv[16], shv[16]; const float* mvc = nullptr;
#pragma unroll
    for (int i = 0; i < 16; ++i) gv[i] = gn[lane + 64 * i];
    for (int s = bid * 8 + wid; s < TT; s += nb * 8) {
        const int pos = s % SEQB; if (layer == 1 && pos < LC) continue;
        const float* xr = resid_row(p, s); const float* mv = modvec(p, layer, s);
        float xv[16]; float ssq = 0.f;
#pragma unroll
        for (int i = 0; i < 16; ++i) xv[i] = xr[lane + 64 * i];
        if (mv != mvc) { mvc = mv;
#pragma unroll
            for (int i = 0; i < 16; ++i) { const int n = lane + 64 * i; scv[i] = mv[4096 + n]; shv[i] = mv[3072 + n]; } }
#pragma unroll
        for (int i = 0; i < 16; ++i) ssq += xv[i] * xv[i];
        ssq = wave_sum(ssq); const float rstd = rsqrtf(ssq * (1.0f / 1024.0f) + EPS_);
        float acc[32];
#pragma unroll
        for (int e = 0; e < 32; ++e) acc[e] = 0.f;
#pragma unroll
        for (int i = 0; i < 16; ++i) { const int n = lane + 64 * i; const float hv = xv[i] * rstd * gv[i] * (1.0f + scv[i]) + shv[i];
            p.hn[(size_t)s * 1024 + n] = f2bf(hv);
#pragma unroll
            for (int e4 = 0; e4 < 8; ++e4) { const f32x4 w = *(const PG8_LAS f32x4*)(rw + n * 36 + 4 * e4); acc[4 * e4] += hv * w.x; acc[4 * e4 + 1] += hv * w.y; acc[4 * e4 + 2] += hv * w.z; acc[4 * e4 + 3] += hv * w.w; }
            __builtin_amdgcn_sched_barrier(0); }
        wave_sum32(acc);
        float v1 = -1e30f, v2 = -1e30f, s1 = 0.f, s2 = 0.f; int i1 = 0, i2 = 0;
#pragma unroll
        for (int q = 0; q < 8; ++q) { const float sve = sigmoidf_(acc[q]), v = sve + rb[q];
            if (v > v1) { v2 = v1; i2 = i1; s2 = s1; v1 = v; i1 = q; s1 = sve; } else if (v > v2) { v2 = v; i2 = q; s2 = sve; } }
        const float gsc = v1 + v2; float best = readlane_f(gsc, 0); int bg = 0;
        { const float g1 = readlane_f(gsc, 16), g2 = readlane_f(gsc, 32), g3 = readlane_f(gsc, 48);
          if (g1 > best) { best = g1; bg = 1; } if (g2 > best) { best = g2; bg = 2; } if (g3 > best) { best = g3; bg = 3; } }
        if (lane == 16 * bg) { const float inv = 1.0f / (s1 + s2); const int be1 = 8 * bg + i1, be2 = 8 * bg + i2;
            p.sel_e[s * 2] = be1; p.sel_e[s * 2 + 1] = be2; p.sel_w[s * 2] = s1 * inv; p.sel_w[s * 2 + 1] = s2 * inv;
            atomicAdd((int*)(hist + be1), 1); atomicAdd((int*)(hist + be2), 1); }
    }
    __syncthreads();
    if (count && tid < 32 && hist[tid] != 0) atomicAdd(p.cnt + layer * 32 + tid, hist[tid]);
    __syncthreads();
}
__device__ __forceinline__ int moe_plan(const Params& p, int layer, PG8_LAS int* pstart, PG8_LAS int* te) {
    if (ltid() == 0) { int tl = 0; for (int e = 0; e < 32; ++e) { const int cn = p.cnt[layer * 32 + e]; pstart[e] = tl * 256; const int nt = (cn + 255) >> 8; for (int q = 0; q < nt; ++q) te[tl + q] = e; tl += nt; } pstart[32] = tl; }
    __syncthreads();
    return pstart[32];
}
__device__ __forceinline__ void phase_moe_assign(const Params& p, int layer, LDSP lds, int bid, int nb) {
    PG8_LAS int* pstart = (PG8_LAS int*)lds; PG8_LAS int* te = pstart + 64; PG8_LAS int* hist = pstart + 512; PG8_LAS int* base = hist + 32;
    const int tid = ltid();
    if (tid < 32) hist[tid] = 0;
    moe_plan(p, layer, pstart, te);
    const int per = (TT + nb - 1) / nb, s = bid * per + tid; const bool act = tid < per && s < TT && !(layer == 1 && (s % SEQB) < LC);
    int e0 = 0, e1 = 0, r0 = 0, r1 = 0;
    if (act) { e0 = p.sel_e[s * 2]; e1 = p.sel_e[s * 2 + 1]; r0 = atomicAdd((int*)(hist + e0), 1); r1 = atomicAdd((int*)(hist + e1), 1); }
    __syncthreads();
    if (tid < 32) base[tid] = hist[tid] ? atomicAdd(p.cur + layer * 32 + tid, hist[tid]) : 0;
    __syncthreads();
    if (act) { const int p0 = pstart[e0] + base[e0] + r0, p1 = pstart[e1] + base[e1] + r1;
        p.posbuf[s * 2] = p0; p.posbuf[s * 2 + 1] = p1; p.rowidx[p0] = s; p.rowidx[p1] = s; }
    __syncthreads();
}
template <bool NEXT_NORM> __device__ __forceinline__ void phase_moe_combine(const Params& p, int layer, const unsigned char* Yb_, LDSP lds, int bid, int nb) {
    const unsigned char* Yb = UP(Yb_);
    LASF wg = (LASF)lds;
    const int tid = ltid(), lane = tid & 63, wid = tid >> 6;
    if (NEXT_NORM) {
        float4 wv[8];
#pragma unroll
        for (int j = 0; j < 8; ++j) { const int i = tid + NTH * j; wv[j] = *(const float4*)(p.w_in + (size_t)(layer + 1) * 1024 * 13328 + (size_t)(i >> 2) * 13328 + 4096 + (i & 3) * 4); }
#pragma unroll
        for (int j = 0; j < 8; ++j) { const int i = tid + NTH * j, n = i >> 2, j4 = (i & 3) * 4; wg[n * 20 + j4] = wv[j].x; wg[n * 20 + j4 + 1] = wv[j].y; wg[n * 20 + j4 + 2] = wv[j].z; wg[n * 20 + j4 + 3] = wv[j].w; }
        __syncthreads();
    }
    const float* gn = p.norm1_g + (layer + 1) * 1024;
    f32x4 gvh[4], sch[4], shh[4]; const float* mvh = nullptr;
    if (NEXT_NORM) {
#pragma unroll
        for (int i = 0; i < 4; ++i) gvh[i] = *(const f32x4*)(gn + 4 * lane + 256 * i); }
    for (int s = bid * 8 + wid; s < TT; s += nb * 8) {
        const int pos = s % SEQB; if (layer == 1 && pos < LC) continue;
        const int p0 = p.posbuf[s * 2], p1 = p.posbuf[s * 2 + 1]; const float w0 = p.sel_w[s * 2] * YB_ISC, w1 = p.sel_w[s * 2 + 1] * YB_ISC;
        float* xr = resid_row(p, s); const float* g2 = modvec(p, layer, s) + 5120;
        f32x4 xn[4]; float ssq = 0.f;
#pragma unroll
        for (int i = 0; i < 4; ++i) { const int col = 4 * lane + 256 * i; const unsigned a = *(const unsigned*)(Yb + (size_t)p0 * 1024 + col), b = *(const unsigned*)(Yb + (size_t)p1 * 1024 + col);
            f32x4 x = *(const f32x4*)(xr + col); const f32x4 g = *(const f32x4*)(g2 + col);
            const f32x2v a0 = __builtin_amdgcn_cvt_pk_f32_fp8((int)a, false), a1 = __builtin_amdgcn_cvt_pk_f32_fp8((int)a, true), b0 = __builtin_amdgcn_cvt_pk_f32_fp8((int)b, false), b1 = __builtin_amdgcn_cvt_pk_f32_fp8((int)b, true);
            x[0] += g[0] * (w0 * a0.x + w1 * b0.x); x[1] += g[1] * (w0 * a0.y + w1 * b0.y); x[2] += g[2] * (w0 * a1.x + w1 * b1.x); x[3] += g[3] * (w0 * a1.y + w1 * b1.y);
            *(f32x4*)(xr + col) = x; xn[i] = x; ssq += x[0] * x[0] + x[1] * x[1] + x[2] * x[2] + x[3] * x[3]; }
        if (NEXT_NORM) {
            const float* mv = modvec(p, layer + 1, s);
            if (mv != mvh) { mvh = mv;
#pragma unroll
                for (int i = 0; i < 4; ++i) { sch[i] = *(const f32x4*)(mv + 1024 + 4 * lane + 256 * i); shh[i] = *(const f32x4*)(mv + 4 * lane + 256 * i); } }
            ssq = wave_sum(ssq); const float rstd = rsqrtf(ssq * (1.0f / 1024.0f) + EPS_);
            float acc[16];
#pragma unroll
            for (int j = 0; j < 16; ++j) acc[j] = 0.f;
#pragma unroll
            for (int i = 0; i < 4; ++i) { const int col = 4 * lane + 256 * i; const f32x4 gv = gvh[i], sc = sch[i], sh = shh[i]; float hv[4];
#pragma unroll
                for (int e = 0; e < 4; ++e) hv[e] = xn[i][e] * rstd * gv[e] * (1.0f + sc[e]) + sh[e];
                u32x2 w; w.x = pk2(hv[0], hv[1]); w.y = pk2(hv[2], hv[3]); *(u32x2*)(p.hn + (size_t)s * 1024 + col) = w;
#pragma unroll
                for (int e = 0; e < 4; ++e)
#pragma unroll
                    for (int j4 = 0; j4 < 4; ++j4) { const f32x4 wq = *(const PG8_LAS f32x4*)(wg + (col + e) * 20 + 4 * j4); acc[4 * j4] += hv[e] * wq.x; acc[4 * j4 + 1] += hv[e] * wq.y; acc[4 * j4 + 2] += hv[e] * wq.z; acc[4 * j4 + 3] += hv[e] * wq.w; }
                __builtin_amdgcn_sched_barrier(0); }
            wave_sum16(acc);
            if ((lane & 15) == 0) { f32x4 g4; g4[0] = acc[0]; g4[1] = acc[1]; g4[2] = acc[2]; g4[3] = acc[3]; *(f32x4*)(p.G + (size_t)s * 16 + (lane >> 4) * 4) = g4; }
        }
    }
    if (NEXT_NORM) __syncthreads();
}

constexpr size_t R_BYTES = 12 * UU;
constexpr size_t OFF_WT13 = 0, OFF_WT2 = OFF_WT13 + (size_t)32 * 1024 * 1024 * 2, OFF_XG = OFF_WT2 + (size_t)32 * 1024 * 512 * 2, OFF_H = OFF_XG + (size_t)TPAD * 1024 * 2, OFF_YB = OFF_H + (size_t)TPAD * 512 * 2;
static_assert(OFF_YB + (size_t)TPAD * 1024 * 2 <= R_BYTES, "MoE buffers must fit the big region");

#ifndef REPEAT_MASK
#define REPEAT_MASK 0
#endif
#define REP(bit) for (int rep_ = 0; rep_ < (((REPEAT_MASK) >> (bit)) & 1) + 1; ++rep_)
#define GRID_BAR() do { xcd_barrier(bar); if ((REPEAT_MASK >> 15) & 1) xcd_barrier(bar); asm volatile("" : "+s"(bid), "+s"(nb)); } while (0)

constexpr int PW = (int)(sizeof(Params) / 8);
static_assert(sizeof(Params) % 8 == 0 && sizeof(Params) <= 1024, "Params is a block of 8-byte words");
struct ParamsRaw { unsigned long long w[PW]; };
template <int layer> __device__ __forceinline__ void layer_body(const Params& p, const XcdBarrier& bar, LDSP lds, int& bid, int& nb);
__global__ void __launch_bounds__(512, 2) fwd_kernel(ParamsRaw raw, unsigned long long* gp, unsigned* barw) {
    extern __shared__ __attribute__((aligned(16))) unsigned char shm[];
    LDSP lds = (LDSP)shm;
    int bid = blockIdx.x, nb = gridDim.x; const int tid = threadIdx.x;
    unsigned long long* mygp = gp + (size_t)bid * 128;
    if (tid == 0) {
#pragma unroll
        for (int k = 0; k < PW; ++k) mygp[k] = raw.w[k];
        *(PG8_LAS u32x4*)(lds + LDS_BYTES - 16) = (u32x4){0u, 0u, 0u, 0u};
        asm volatile("s_waitcnt vmcnt(0)" ::: "memory"); }
    __syncthreads();
    const Params& p = *(const Params*)mygp;
    XcdBarrier bar = xcd_barrier_post(barw, (volatile LAS unsigned*)(lds + LDS_BYTES - 16));

#define RB ((unsigned char*)p.R)
#define aq ((bf16_t*)(RB))
#define ak ((bf16_t*)(RB + UU))
#define av ((bf16_t*)(RB + 2 * UU))
#define hx0 ((unsigned char*)(RB + 3 * UU))
#define hx1 ((unsigned char*)(RB + 4 * UU))
#define hv ((unsigned char*)(RB + 5 * UU))
#define zT ((bf16_t*)(RB + 6 * UU))
#define tapsT ((bf16_t*)(RB + 11 * UU))
#define ST ((bf16_t*)(RB))
#define mq ((bf16_t*)(RB + 4 * UU))
#define mk ((bf16_t*)(RB + 5 * UU))
#define mv ((bf16_t*)(RB + 6 * UU))
#define mo ((bf16_t*)(RB + 7 * UU))
#define gates ((bf16_t*)(RB + 8 * UU))
#define qc ((bf16_t*)(RB + 8 * UU))
#define kc ((bf16_t*)(RB + 9 * UU))
#define kT ((bf16_t*)(RB + 10 * UU))
#define vT ((bf16_t*)(RB + 11 * UU))
#define Wt13 ((bf16_t*)(RB + OFF_WT13))
#define Wt2 ((bf16_t*)(RB + OFF_WT2))
#define Xg ((bf16_t*)(RB + OFF_XG))
#define Hb ((bf16_t*)(RB + OFF_H))
#define Yb ((unsigned char*)(RB + OFF_YB))
#define ym ((bf16_t*)p.Y3)
#define ya ((bf16_t*)p.Y3 + (size_t)TT * 1024)
#define yh ((bf16_t*)p.Y3 + (size_t)2 * TT * 1024)

    REP(12) phase_conv_small(p, 0, lds, bid, nb);
    REP(7) { phase_modvec(p, lds, bid, nb);
    phase_hdn(p, lds, bid, nb); }
    GRID_BAR();
    layer_body<0>(p, bar, lds, bid, nb);
#if defined(PROBE_LEVEL) && (PROBE_LEVEL == 1 || PROBE_LEVEL == 2)
    return;
#endif
    layer_body<1>(p, bar, lds, bid, nb);
    if (bid == 0 && tid == 0 && xb_ld(&barw[XB_TMO]) != 0u) p.out[0] = __builtin_nanf("");
}
template <int layer> __device__ __forceinline__ void layer_body(const Params& p, const XcdBarrier& bar, LDSP lds, int& bid, int& nb) {
        if (layer == 0) {
            REP(10) phase_norm1(p, layer, lds, bid, nb);
            REP(13) phase_taps(p, layer, tapsT, lds, bid, nb);
            GRID_BAR(); }
        REP(0) { pg8::Gemm g{UP((const bf16_t*)p.hn), UP((const bf16_t*)p.Wt_in), TT, 6656, 1024}; pg8::StaticOrder S; S.init(TT, 6656, nb, bid);
          EpiReg E{UP(aq), (size_t)TT * 1024, UP(gates + (size_t)2 * TT * 1024), 0, 3};
          pg8::gemm_phase<EpiReg, pg8::StaticOrder, false>(lds, g, S, E, nullptr);
        GRID_BAR(); }
        phase_attn_prep(p, layer, aq, ak, bid, nb);
        phase_hprep(p, layer, hx1, hv, zT, lds, bid, nb);
        if (layer == 0) REP(6) phase_hctx(p, layer, hx0, hx1, hv, yh, lds, bid, nb);
        GRID_BAR();
        phase_fft(p, layer, tapsT, zT, (float*)(RB + 10 * UU), lds, bid, nb);
        REP(1) phase_attn(p, layer, aq, ak, av, ya, lds, bid, nb);
        GRID_BAR();
        if ((REPEAT_MASK >> 3) & 1) { phase_hprep(p, layer, hx1, hv, zT, lds, bid, nb); GRID_BAR(); phase_fft(p, layer, tapsT, zT, (float*)(RB + 10 * UU), lds, bid, nb); GRID_BAR(); }
        REP(11) phase_hfin(p, layer, hx0, hx1, hv, zT, yh, lds, bid, nb);
        GRID_BAR();
        REP(0) { pg8::Gemm g{UP((const bf16_t*)p.hn), UP((const bf16_t*)p.Wt_in + (size_t)6656 * 1024), TT, 6656, 1024}; pg8::StaticOrder S; S.init(TT, 6656, nb, bid);
          EpiReg E{UP(mq), (size_t)TT * 1024, UP(gates + (size_t)2 * TT * 1024), 512, 4};
          pg8::gemm_phase<EpiReg, pg8::StaticOrder, false>(lds, g, S, E, nullptr);
        GRID_BAR(); }
        REP(2) { phase_mA(p, layer, mk, mv, vT, ST, lds, bid, nb);
        GRID_BAR(); }
        phase_mB(p, ST, bid, nb);
        GRID_BAR();
        REP(14) { phase_mC(p, layer, mq, mk, vT, mo, ST, ym, lds, bid, nb);
        GRID_BAR(); }
        REP(4) { pg8::Gemm g{UP((const bf16_t*)p.Y3), UP((const bf16_t*)p.Wt_br + (size_t)layer * 3 * 1048576), 3 * TT, 3072, 1024}; MergeOrder S{layer == 0 ? 264 : 256, nb, bid, layer == 0 ? 0 : 1};
          MergeEpi E{UP((const bf16_t*)gates), UP((const float*)p.merge_b + layer * 3072), UP((bf16_t*)p.hn)};
          pg8::gemm_phase<MergeEpi, MergeOrder, false>(lds, g, S, E, nullptr);
          if (layer == 0 && rep_ == 0) {
              int me = bid, nl = nb; bool runf = true;
              if ((nb & 7) == 0) { const int per = nb >> 3, hx = 33 - per; if (hx > 0 && hx < per) { const int j = bid >> 3; runf = j >= hx; me = (j - hx) * 8 + (bid & 7); nl = nb - 8 * hx; } }
              if (runf) { __syncthreads();
                  phase_conv_experts(p, 0, Wt13, Wt2, lds, me, nl);
                  phase_taps(p, 1, tapsT, lds, me, nl);
                  phase_conv_small(p, 1, lds, me, nl); } }
        GRID_BAR(); }
        { pg8::Gemm g{UP((const bf16_t*)p.hn), UP((const bf16_t*)p.Wt_out + (size_t)layer * 1048576), TT, 1024, 1024}; OutOrder S{layer == 0 ? 264 : 256, nb, bid, layer == 0 ? 0 : 1};
          OutEpi E{&p, layer};
          pg8::gemm_phase<OutEpi, OutOrder, false>(lds, g, S, E, nullptr); }
        __syncthreads();
#if defined(PROBE_LEVEL) && PROBE_LEVEL == 1
        if (layer == 0) return;
#endif
#if defined(PROBE_LEVEL) && PROBE_LEVEL == 3
        if (layer == 1) return;
#endif
        if (layer == 1) REP(9) phase_conv_experts(p, layer, Wt13, Wt2, lds, bid, nb);
        GRID_BAR();
        REP(5) phase_norm2_router(p, layer, lds, bid, nb, rep_ == 0);
        GRID_BAR();
        phase_moe_assign(p, layer, lds, bid, nb);
        GRID_BAR();
        { PG8_LAS int* pstart = (PG8_LAS int*)(lds + 132 * 1024); PG8_LAS int* te = pstart + 64;
          const int ntl = moe_plan(p, layer, pstart, te);
          REP(16) { pg8::Gemm g{UP((const bf16_t*)p.hn), UP((const bf16_t*)Wt13), TT, 32 * 1024, 1024}; MoeOrder S{te, ntl, nb, bid}; E1Epi E{UP(Hb)};
            PG8_LAS int* rtab = (PG8_LAS int*)(lds + 133 * 1024);
            { pg8::Unit uu; const int tz = ltid();
#pragma unroll
              for (int i = 0; i < 4; ++i) { if (S.next(i, uu) && tz < 256) rtab[i * 256 + tz] = p.rowidx[uu.pm * 256 + tz]; } }
            __syncthreads();
            pg8::gemm_phase_g<E1Epi, MoeOrder, false>(lds, g, S, E, rtab);
          GRID_BAR(); }
          REP(17) { pg8::Gemm g{UP((const bf16_t*)Hb), UP((const bf16_t*)Wt2), TPAD, 32 * 1024, 512}; MoeOrder S{te, ntl, nb, bid}; E2Epi E{UP(Yb)};
            pg8::gemm_phase<E2Epi, MoeOrder, false>(lds, g, S, E, nullptr);
          GRID_BAR(); } }
        if (layer == 0) phase_moe_combine<true>(p, layer, Yb, lds, bid, nb);
        else phase_moe_combine<false>(p, layer, Yb, lds, bid, nb);
        GRID_BAR();
}

extern "C" void kernel_launch(void* const* d_in, const int* in_sizes, int n_in, void* d_out, int out_size, void* d_ws, size_t ws_size, hipStream_t stream) {
    (void)in_sizes; (void)n_in; (void)out_size;
    Params p; memset(&p, 0, sizeof(p));
    const float* const* in = (const float* const*)d_in;
    p.x = in[0]; p.c = in[1]; p.ctx = in[2]; p.c_ctx = in[3]; p.mod_w = in[4]; p.mod_b = in[5]; p.norm1_g = in[6]; p.norm2_g = in[7]; p.w_in = in[8]; p.merge_b = in[9];
    p.m_conv_w = in[10]; p.m_conv_b = in[11]; p.m_gate_b = in[12]; p.m_norm_g = in[13]; p.a_qnorm_g = in[14]; p.a_knorm_g = in[15]; p.a_lambda = in[16]; p.a_subln_g = in[17];
    p.h_conv_w = in[18]; p.h_conv_b = in[19]; p.h_ffn_w1 = in[20]; p.h_ffn_b1 = in[21]; p.h_ffn_w2 = in[22]; p.h_ffn_b2 = in[23]; p.h_ffn_w3 = in[24]; p.h_freq = in[25]; p.h_decay = in[26]; p.h_bias = in[27];
    p.w_br_m = in[28]; p.w_br_a = in[29]; p.w_br_h = in[30]; p.w_out = in[31]; p.router_w = in[32]; p.router_b = in[33]; p.e_w1 = in[34]; p.e_w3 = in[35]; p.e_w2 = in[36];
    p.out = (float*)d_out;
    unsigned char* w = (unsigned char*)d_ws; size_t off = 0;
    auto take = [&](size_t bytes) { unsigned char* r = w + off; off += (bytes + 255) & ~(size_t)255; return r; };
    constexpr size_t ZERO_BYTES = 32768;
    unsigned char* z = take(ZERO_BYTES);
    p.bar = (unsigned*)z; p.cnt = (int*)(z + 16384); p.cur = (int*)(z + 16384 + 256); p.sumsq = (float*)take((size_t)2 * 64 * 8 * 32 * 4); p.sumsqC = (float*)take((size_t)4096 * 4);
    p.modv = (float*)take((size_t)6 * 6144 * 4); p.hdn2 = (float*)take((size_t)2 * 8448 * 64 * 4); p.G = (float*)take((size_t)TT * 16 * 4); p.xc = (float*)take((size_t)512 * 1024 * 4);
    p.sel_e = (int*)take((size_t)TT * 2 * 4); p.sel_w = (float*)take((size_t)TT * 2 * 4); p.posbuf = (int*)take((size_t)TT * 2 * 4); p.rowidx = (int*)take((size_t)TPAD * 4);
    p.scal = (float*)take((size_t)16 * 66 * 2 * 4); p.ms = (float*)take((size_t)16 * 67 * 4); p.dn = (float*)take((size_t)16 * 66 * 256 * 4); p.nst = (float*)take((size_t)16 * 66 * 256 * 4);
    p.hfC = (float*)take((size_t)1024 * 256 * 4); p.hbC = (float*)take((size_t)1024 * 256 * 4);
    p.Wt_in = (bf16_t*)take((size_t)13312 * 1024 * 2); p.Wt_br = (bf16_t*)take((size_t)2 * 3072 * 1024 * 2); p.Wt_out = (bf16_t*)take((size_t)2 * 1024 * 1024 * 2);
    unsigned long long* gpbuf = (unsigned long long*)take((size_t)1024 * 1024);
    p.hn = (bf16_t*)take(UU); p.Y3 = (bf16_t*)take(3 * UU); p.R = take(R_BYTES);
    if (off > ws_size) { fprintf(stderr, "kernel_launch: workspace too small: need %zu, have %zu\n", off, ws_size); return; }
    static int grid = 0;
    if (!grid) {
        int dev = 0, cus = 0; (void)hipGetDevice(&dev); (void)hipDeviceGetAttribute(&cus, hipDeviceAttributeMultiprocessorCount, dev);
        if (hipFuncSetAttribute((const void*)fwd_kernel, hipFuncAttributeMaxDynamicSharedMemorySize, LDS_BYTES) != hipSuccess) { fprintf(stderr, "kernel_launch: hipFuncSetAttribute failed\n"); return; }
        int per_cu = 0; (void)hipOccupancyMaxActiveBlocksPerMultiprocessor(&per_cu, (const void*)fwd_kernel, NTH, LDS_BYTES);
        if (per_cu < 1) fprintf(stderr, "kernel_launch: occupancy query reports %d blocks per CU\n", per_cu);
        grid = cus > 0 ? (cus > 1024 ? 1024 : cus) : 256;
    }
    (void)hipMemsetAsync(z, 0, ZERO_BYTES, stream);
    ParamsRaw raw; memcpy(&raw, &p, sizeof(raw));
    hipLaunchKernelGGL(fwd_kernel, dim3(grid), dim3(NTH), LDS_BYTES, stream, raw, gpbuf, (unsigned*)z);
}
```
